# Optimizing an MI355X kernel written in HIP

```python
import math
import jax, jax.numpy as jnp
from jax import lax
import numpy as np

D_MODEL = 2048
BATCH = 1
SEQ = 16384
DEPTH = 4

GRID_W = 64
CTX_LEN = 256
F32 = jnp.float32

N_MOD = 9
D_FF = 5632
SSD_HEADS = 12
SSD_HEAD_DIM = 64
SSD_INNER = SSD_HEADS * SSD_HEAD_DIM
SSD_GROUPS = 2
SSD_STATE = 128
SSD_BC = SSD_GROUPS * SSD_STATE
SSD_XBC = SSD_INNER + 2 * SSD_BC
SSD_CONV = 5
SSD_CHUNK = 128
S5_WIDTH = 512
S5_GROUP = 16
S5_GROUPS = S5_WIDTH // S5_GROUP
S5_STATE = 64
HEAD_DIM = 64
ATT_Q_HEADS = 8
ATT_KV_HEADS = 2
GQA_GROUP = ATT_Q_HEADS // ATT_KV_HEADS
ATT_WIDTH = ATT_Q_HEADS * HEAD_DIM
ATT_KV_WIDTH = ATT_KV_HEADS * HEAD_DIM
ATT_SCALE = HEAD_DIM ** -0.5
ATT_BLOCK = 128
SWA_WINDOW = 128
ROPE_THETA = 10000.0
NEG_INF = -1e30
N_BRANCH = 4
IN_SIZES = (SSD_INNER, SSD_XBC, 2 * SSD_HEADS, S5_WIDTH,
            ATT_WIDTH, ATT_KV_WIDTH, ATT_KV_WIDTH,
            ATT_WIDTH, ATT_KV_WIDTH, ATT_KV_WIDTH,
            N_BRANCH * D_MODEL)
D_IN = sum(IN_SIZES)

kernel_name = 'hybrid_ssd_s5_swa_gqa_prefix_trunk'


def rms_norm(x, g, eps=1e-6):
    xf = x.astype(F32)
    y = xf * lax.rsqrt(jnp.mean(xf * xf, axis=-1, keepdims=True) + eps)
    return (y * g.astype(F32)).astype(x.dtype)


def modulate(x, g, shift, scale):
    return rms_norm(x, g) * (1 + scale) + shift


def swiglu(h, w_in, w_out):
    a, b = jnp.split(h @ w_in, 2, axis=-1)
    return (jax.nn.silu(a) * b) @ w_out


def split_in(p):
    return jnp.split(p, np.cumsum(IN_SIZES)[:-1].tolist(), axis=-1)


def axial_rope(length):
    rows = length // GRID_W
    row = jnp.repeat(jnp.arange(rows, dtype=F32), GRID_W)
    col = jnp.tile(jnp.arange(GRID_W, dtype=F32), rows)
    n_freq = HEAD_DIM // 4
    inv = ROPE_THETA ** (-jnp.arange(n_freq, dtype=F32) / n_freq)
    ang = jnp.concatenate([row[:, None] * inv, col[:, None] * inv], axis=-1)
    return jnp.cos(ang), jnp.sin(ang)


def apply_rope(x, cos, sin):
    half = x.shape[-1] // 2
    x1, x2 = x[..., :half].astype(F32), x[..., half:].astype(F32)
    c, s = cos[:, None, :], sin[:, None, :]
    return jnp.concatenate([x1 * c - x2 * s, x1 * s + x2 * c], axis=-1).astype(x.dtype)


def centred_dwconv(x, w, b):
    k = w.shape[0]
    y = lax.conv_general_dilated(x, w[:, None, :], window_strides=(1,),
                                 padding=[((k - 1) // 2, (k - 1) // 2)],
                                 dimension_numbers=('NWC', 'WIO', 'NWC'),
                                 feature_group_count=x.shape[-1])
    return y + b


def segsum(a):
    t = a.shape[-1]
    ar = jnp.broadcast_to(a[..., :, None], a.shape + (t,))
    ar = jnp.where(jnp.tril(jnp.ones((t, t), bool), -1), ar, 0.0)
    ss = jnp.cumsum(ar, axis=-2)
    return jnp.where(jnp.tril(jnp.ones((t, t), bool)), ss, -jnp.inf)


def ssd_chunked(xdt, adt, bm, cm, h0):
    bsz, l, h, p = xdt.shape
    g, n = bm.shape[2], bm.shape[3]
    hg = h // g
    t = SSD_CHUNK
    nc = l // t
    xc = xdt.reshape(bsz, nc, t, g, hg, p)
    bc = bm.reshape(bsz, nc, t, g, n)
    cc = cm.reshape(bsz, nc, t, g, n)
    ac = jnp.moveaxis(adt.reshape(bsz, nc, t, g, hg), 2, -1)
    a_cum = jnp.cumsum(ac, axis=-1)
    lmat = jnp.exp(segsum(ac))
    cb = jnp.einsum('bclgn,bcsgn->bcgls', cc, bc)
    y_diag = jnp.einsum('bcgls,bcghls,bcsghp->bclghp', cb, lmat, xc)
    decay_states = jnp.exp(a_cum[..., -1:] - a_cum)
    states = jnp.einsum('bclgn,bcghl,bclghp->bcghpn', bc, decay_states, xc)
    states = jnp.concatenate([h0.reshape(bsz, 1, g, hg, p, n), states], axis=1)
    chunk_a = jnp.pad(jnp.moveaxis(a_cum[..., -1], 1, -1), ((0, 0), (0, 0), (0, 0), (1, 0)))
    decay_chunk = jnp.exp(segsum(chunk_a))
    new_states = jnp.einsum('bghzc,bcghpn->bzghpn', decay_chunk, states)
    prev_states, final = new_states[:, :-1], new_states[:, -1]
    y_off = jnp.einsum('bclgn,bcghpn,bcghl->bclghp', cc, prev_states, jnp.exp(a_cum))
    y = (y_diag + y_off).reshape(bsz, l, h, p)
    return y, final.reshape(bsz, h, p, n)


def ssd_mixer(z_ctx, xbc_ctx, dt_ctx, z_lat, xbc_lat, dt_lat,
              conv_w, conv_b, a_log, dt_bias, d_skip, norm_g, need_ctx):
    dtype = z_lat.dtype
    a = -jnp.exp(a_log.astype(F32))

    def prep(xbc, dt):
        xbc = jax.nn.silu(centred_dwconv(xbc, conv_w, conv_b).astype(F32))
        b, l = xbc.shape[:2]
        xs = xbc[..., :SSD_INNER].reshape(b, l, SSD_HEADS, SSD_HEAD_DIM)
        bm = xbc[..., SSD_INNER:SSD_INNER + SSD_BC].reshape(b, l, SSD_GROUPS, SSD_STATE)
        cm = xbc[..., SSD_INNER + SSD_BC:].reshape(b, l, SSD_GROUPS, SSD_STATE)
        dt = jax.nn.softplus(dt.astype(F32).reshape(b, l, 2, SSD_HEADS) + dt_bias.astype(F32))
        return xs, bm, cm, dt

    def scan_dir(xs, bm, cm, dt, d, h0, reverse):
        if reverse:
            xs, bm, cm, dt = (jnp.flip(v, axis=1) for v in (xs, bm, cm, dt))
        y, h = ssd_chunked(xs * dt[:, :, d, :, None], a[d] * dt[:, :, d], bm, cm, h0)
        return (jnp.flip(y, axis=1) if reverse else y), h

    def finish(y, xs, z):
        b, l = z.shape[:2]
        y = (y + d_skip.astype(F32)[:, None] * xs).reshape(b, l, SSD_INNER) * jax.nn.silu(z.astype(F32))
        return rms_norm(y, norm_g).astype(dtype)

    ctx_in = prep(xbc_ctx, dt_ctx)
    lat_in = prep(xbc_lat, dt_lat)
    h0 = jnp.zeros((z_lat.shape[0], SSD_HEADS, SSD_HEAD_DIM, SSD_STATE), F32)
    yc_f, hc_f = scan_dir(*ctx_in, 0, h0, False)
    yc_b, hc_b = scan_dir(*ctx_in, 1, h0, True)
    yl_f, _ = scan_dir(*lat_in, 0, hc_f, False)
    yl_b, _ = scan_dir(*lat_in, 1, hc_b, True)
    y_lat = finish(yl_f + yl_b, lat_in[0], z_lat)
    y_ctx = finish(yc_f + yc_b, ctx_in[0], z_ctx) if need_ctx else None
    return y_ctx, y_lat


def s5_discretise(a_re, a_im, log_dt, b_re, b_im):
    a_re, a_im, b_re, b_im = (v.astype(F32) for v in (a_re, a_im, b_re, b_im))
    dt = jnp.exp(log_dt.astype(F32))[:, None]
    mag = jnp.exp(a_re * dt)
    lb_re, lb_im = mag * jnp.cos(a_im * dt), mag * jnp.sin(a_im * dt)
    den = a_re * a_re + a_im * a_im
    nr, ni = lb_re - 1.0, lb_im
    f_re = (nr * a_re + ni * a_im) / den
    f_im = (ni * a_re - nr * a_im) / den
    bb_re = f_re[..., None] * b_re - f_im[..., None] * b_im
    bb_im = f_re[..., None] * b_im + f_im[..., None] * b_re
    return lb_re, lb_im, bb_re, bb_im


def s5_combine(e1, e2):
    a1r, a1i, b1r, b1i = e1
    a2r, a2i, b2r, b2i = e2
    return (a2r * a1r - a2i * a1i, a2r * a1i + a2i * a1r,
            a2r * b1r - a2i * b1i + b2r, a2r * b1i + a2i * b1r + b2i)


def s5_scan(u, lb_re, lb_im, bb_re, bb_im, s0_re, s0_im):
    bu_re = jnp.einsum('blgh,gph->blgp', u, bb_re)
    bu_im = jnp.einsum('blgh,gph->blgp', u, bb_im)
    bu_re = bu_re.at[:, 0].add(lb_re * s0_re - lb_im * s0_im)
    bu_im = bu_im.at[:, 0].add(lb_re * s0_im + lb_im * s0_re)
    a_re = jnp.broadcast_to(lb_re, bu_re.shape)
    a_im = jnp.broadcast_to(lb_im, bu_im.shape)
    _, _, s_re, s_im = lax.associative_scan(s5_combine, (a_re, a_im, bu_re, bu_im), axis=1)
    return s_re, s_im


def s5_mixer(u_ctx, u_lat, a_re, a_im, log_dt, b_re, b_im, c_re, c_im, d_skip,
             glu_w, glu_b, need_ctx):
    dtype = u_lat.dtype
    disc = [s5_discretise(a_re[d], a_im[d], log_dt[d], b_re, b_im) for d in range(2)]
    c_re, c_im, d_skip = c_re.astype(F32), c_im.astype(F32), d_skip.astype(F32)

    def groups(u):
        b, l = u.shape[:2]
        return u.astype(F32).reshape(b, l, S5_GROUPS, S5_GROUP)

    def flip(v):
        return jnp.flip(v, axis=1)

    uc, ul = groups(u_ctx), groups(u_lat)
    zero = jnp.zeros((uc.shape[0], S5_GROUPS, S5_STATE), F32)
    fc = s5_scan(uc, *disc[0], zero, zero)
    bc = s5_scan(flip(uc), *disc[1], zero, zero)
    fl = s5_scan(ul, *disc[0], fc[0][:, -1], fc[1][:, -1])
    bl = s5_scan(flip(ul), *disc[1], bc[0][:, -1], bc[1][:, -1])

    def readout(u, sf, sb):
        s_re = sf[0] + flip(sb[0])
        s_im = sf[1] + flip(sb[1])
        y = (jnp.einsum('ghp,blgp->blgh', c_re, s_re) - jnp.einsum('ghp,blgp->blgh', c_im, s_im)
             + d_skip * u)
        b, l = u.shape[:2]
        y = jax.nn.gelu(y.reshape(b, l, S5_WIDTH))
        ya, yg = jnp.split(y @ glu_w.astype(F32) + glu_b.astype(F32), 2, axis=-1)
        return (ya * jax.nn.sigmoid(yg)).astype(dtype)

    y_lat = readout(ul, fl, bl)
    y_ctx = readout(uc, fc, bc) if need_ctx else None
    return y_ctx, y_lat


def attn_heads(q, k, v, qk_g, rope):
    b, l = q.shape[:2]
    q = rms_norm(q.reshape(b, l, ATT_Q_HEADS, HEAD_DIM), qk_g[0])
    k = rms_norm(k.reshape(b, l, ATT_KV_HEADS, HEAD_DIM), qk_g[1])
    if rope is not None:
        q = apply_rope(q, *rope)
        k = apply_rope(k, *rope)
    return (q.reshape(b, l, ATT_KV_HEADS, GQA_GROUP, HEAD_DIM), k,
            v.reshape(b, l, ATT_KV_HEADS, HEAD_DIM))


def softmax_with_sink(logits, sink):
    s = jnp.broadcast_to(sink.astype(F32), logits.shape[:-1] + (1,))
    p = jax.nn.softmax(jnp.concatenate([s, logits], axis=-1), axis=-1)
    return p[..., 1:]


def gqa_dense(q, k, v, sink):
    b, nq = q.shape[:2]
    logits = jnp.einsum('bqkgd,bskd->bkgqs', q, k).astype(F32) * ATT_SCALE
    if sink is None:
        p = jax.nn.softmax(logits, axis=-1)
    else:
        p = softmax_with_sink(logits, sink.reshape(ATT_KV_HEADS, GQA_GROUP)[None, :, :, None, None])
    out = jnp.einsum('bkgqs,bskd->bqkgd', p.astype(v.dtype), v)
    return out.reshape(b, nq, ATT_WIDTH)


def swa_latent(q, k, v, k_ctx, v_ctx, sink):
    b, l = q.shape[:2]
    w = ATT_BLOCK
    nb = l // w
    lc = k_ctx.shape[1]
    qb = q.reshape(b, nb, w, ATT_KV_HEADS, GQA_GROUP, HEAD_DIM)

    def band(t, t_ctx):
        tp = jnp.pad(t, ((0, 0), (w, w), (0, 0), (0, 0))).reshape(b, nb + 2, w, ATT_KV_HEADS, HEAD_DIM)
        tc = jnp.broadcast_to(t_ctx[:, None], (b, nb, lc, ATT_KV_HEADS, HEAD_DIM))
        return jnp.concatenate([tp[:, :-2], tp[:, 1:-1], tp[:, 2:], tc], axis=2)

    kw, vw = band(k, k_ctx), band(v, v_ctx)
    logits = jnp.einsum('bnqkgd,bnskd->bnkgqs', qb, kw).astype(F32) * ATT_SCALE
    qpos = jnp.arange(nb)[:, None] * w + jnp.arange(w)[None, :]
    kpos = jnp.arange(nb)[:, None] * w - w + jnp.arange(3 * w)[None, :]
    valid = ((jnp.abs(kpos[:, None, :] - qpos[:, :, None]) <= SWA_WINDOW)
             & (kpos[:, None, :] >= 0) & (kpos[:, None, :] < l))
    valid = jnp.concatenate([valid, jnp.ones((nb, w, lc), bool)], axis=-1)
    logits = jnp.where(valid[None, :, None, None], logits, NEG_INF)
    p = softmax_with_sink(logits, sink.reshape(ATT_KV_HEADS, GQA_GROUP)[None, None, :, :, None, None])
    out = jnp.einsum('bnkgqs,bnskd->bnqkgd', p.astype(vw.dtype), vw)
    return out.reshape(b, l, ATT_WIDTH)


def global_latent(q, k_all, v_all):
    b, l = q.shape[:2]
    nb = l // ATT_BLOCK
    qb = jnp.moveaxis(q.reshape(b, nb, ATT_BLOCK, ATT_KV_HEADS, GQA_GROUP, HEAD_DIM), 1, 0)
    out = lax.map(lambda qi: gqa_dense(qi, k_all, v_all, None), qb)
    return jnp.moveaxis(out, 0, 1).reshape(b, l, ATT_WIDTH)


def merge_branches(gate_logits, ys, w_brs, w_out):
    gates = jnp.split(jax.nn.sigmoid(gate_logits.astype(F32)), N_BRANCH, axis=-1)
    acc = gates[0] * (ys[0] @ w_brs[0])
    for gb, yb, wb in zip(gates[1:], ys[1:], w_brs[1:]):
        acc = acc + gb * (yb @ wb)
    return acc.astype(gate_logits.dtype) @ w_out


def token_mixing(h_ctx, h_lat, rope, lp, need_ctx):
    pc = split_in(h_ctx @ lp['w_in'])
    pl = split_in(h_lat @ lp['w_in'])
    ya_ctx, ya_lat = ssd_mixer(pc[0], pc[1], pc[2], pl[0], pl[1], pl[2],
                               lp['ssd_conv_w'], lp['ssd_conv_b'], lp['ssd_a_log'],
                               lp['ssd_dt_bias'], lp['ssd_d'], lp['ssd_norm_g'], need_ctx)
    yb_ctx, yb_lat = s5_mixer(pc[3], pl[3], lp['s5_a_re'], lp['s5_a_im'], lp['s5_log_dt'],
                              lp['s5_b_re'], lp['s5_b_im'], lp['s5_c_re'], lp['s5_c_im'],
                              lp['s5_d'], lp['s5_glu_w'], lp['s5_glu_b'], need_ctx)
    qc_c, kc_c, vc_c = attn_heads(pc[4], pc[5], pc[6], lp['swa_qk_g'], None)
    qc_l, kc_l, vc_l = attn_heads(pl[4], pl[5], pl[6], lp['swa_qk_g'], rope)
    yc_lat = swa_latent(qc_l, kc_l, vc_l, kc_c, vc_c, lp['swa_sink'])
    qd_c, kd_c, vd_c = attn_heads(pc[7], pc[8], pc[9], lp['glb_qk_g'], None)
    qd_l, kd_l, vd_l = attn_heads(pl[7], pl[8], pl[9], lp['glb_qk_g'], rope)
    yd_lat = global_latent(qd_l, jnp.concatenate([kd_l, kd_c], axis=1),
                           jnp.concatenate([vd_l, vd_c], axis=1))
    w_brs = (lp['w_br_ssd'], lp['w_br_s5'], lp['w_br_swa'], lp['w_br_glb'])
    y_lat = merge_branches(pl[10], (ya_lat, yb_lat, yc_lat, yd_lat), w_brs, lp['w_out'])
    if not need_ctx:
        return None, y_lat
    yc_ctx = gqa_dense(qc_c, kc_c, vc_c, lp['swa_sink'])
    yd_ctx = gqa_dense(qd_c, kd_c, vd_c, None)
    y_ctx = merge_branches(pc[10], (ya_ctx, yb_ctx, yc_ctx, yd_ctx), w_brs, lp['w_out'])
    return y_ctx, y_lat


def setup_inputs(seed: int = 0) -> dict:
    key = jax.random.key(seed)
    ks = iter(jax.random.split(key, 40))

    def nrm(shape, std):
        return std * jax.random.normal(next(ks), shape, F32)

    def uni(shape, lo, hi):
        return jax.random.uniform(next(ks), shape, F32, lo, hi)

    L = DEPTH
    dt0 = jnp.exp(uni((L, 2, SSD_HEADS), math.log(1e-3), math.log(1e-1)))
    return {
        'x': nrm((BATCH, SEQ, D_MODEL), 1.0),
        'c': nrm((BATCH, D_MODEL), 1.0),
        'ctx': nrm((BATCH, CTX_LEN, D_MODEL), 1.0),
        'c_ctx': nrm((D_MODEL,), 1.0),
        'w_mod': nrm((L, D_MODEL, N_MOD * D_MODEL), 0.5 * D_MODEL ** -0.5),
        'b_mod': nrm((L, N_MOD * D_MODEL), 0.01),
        'norm_g': 1.0 + nrm((L, 3, D_MODEL), 0.05),
        'ffn_in': nrm((L, 2, D_MODEL, 2 * D_FF), D_MODEL ** -0.5),
        'ffn_out': nrm((L, 2, D_FF, D_MODEL), D_FF ** -0.5),
        'w_in': nrm((L, D_MODEL, D_IN), D_MODEL ** -0.5),
        'ssd_conv_w': nrm((L, SSD_CONV, SSD_XBC), SSD_CONV ** -0.5),
        'ssd_conv_b': nrm((L, SSD_XBC), 0.01),
        'ssd_a_log': jnp.log(uni((L, 2, SSD_HEADS), 1.0, 16.0)),
        'ssd_dt_bias': dt0 + jnp.log(-jnp.expm1(-dt0)),
        'ssd_d': 1.0 + nrm((L, SSD_HEADS), 0.1),
        'ssd_norm_g': 1.0 + nrm((L, SSD_INNER), 0.05),
        's5_a_re': -0.5 + nrm((L, 2, S5_GROUPS, S5_STATE), 0.01),
        's5_a_im': jnp.pi * jnp.arange(S5_STATE, dtype=F32) + nrm((L, 2, S5_GROUPS, S5_STATE), 0.01),
        's5_log_dt': uni((L, 2, S5_GROUPS), math.log(1e-3), math.log(1e-1)),
        's5_b_re': nrm((L, S5_GROUPS, S5_STATE, S5_GROUP), (2 * S5_GROUP) ** -0.5),
        's5_b_im': nrm((L, S5_GROUPS, S5_STATE, S5_GROUP), (2 * S5_GROUP) ** -0.5),
        's5_c_re': nrm((L, S5_GROUPS, S5_GROUP, S5_STATE), S5_STATE ** -0.5),
        's5_c_im': nrm((L, S5_GROUPS, S5_GROUP, S5_STATE), S5_STATE ** -0.5),
        's5_d': nrm((L, S5_GROUPS, S5_GROUP), 1.0),
        's5_glu_w': nrm((L, S5_WIDTH, 2 * S5_WIDTH), S5_WIDTH ** -0.5),
        's5_glu_b': nrm((L, 2 * S5_WIDTH), 0.01),
        'swa_qk_g': 1.0 + nrm((L, 2, HEAD_DIM), 0.05),
        'swa_sink': nrm((L, ATT_Q_HEADS), 0.5),
        'glb_qk_g': 1.0 + nrm((L, 2, HEAD_DIM), 0.05),
        'w_br_ssd': nrm((L, SSD_INNER, D_MODEL), SSD_INNER ** -0.5),
        'w_br_s5': nrm((L, S5_WIDTH, D_MODEL), S5_WIDTH ** -0.5),
        'w_br_swa': nrm((L, ATT_WIDTH, D_MODEL), ATT_WIDTH ** -0.5),
        'w_br_glb': nrm((L, ATT_WIDTH, D_MODEL), ATT_WIDTH ** -0.5),
        'w_out': nrm((L, D_MODEL, D_MODEL), D_MODEL ** -0.5),
    }


def reference(x, c, ctx, c_ctx, w_mod, b_mod, norm_g, ffn_in, ffn_out, w_in,
              ssd_conv_w, ssd_conv_b, ssd_a_log, ssd_dt_bias, ssd_d, ssd_norm_g,
              s5_a_re, s5_a_im, s5_log_dt, s5_b_re, s5_b_im, s5_c_re, s5_c_im, s5_d,
              s5_glu_w, s5_glu_b, swa_qk_g, swa_sink, glb_qk_g,
              w_br_ssd, w_br_s5, w_br_swa, w_br_glb, w_out):
    rope = axial_rope(x.shape[1])
    sc = jax.nn.silu(c)
    scc = jax.nn.silu(c_ctx)
    xl, xc = x, ctx
    for i in range(DEPTH):
        need_ctx = i < DEPTH - 1
        ml = jnp.split((sc @ w_mod[i] + b_mod[i])[:, None, :], N_MOD, axis=-1)
        mc = jnp.split((scc @ w_mod[i] + b_mod[i])[None, None, :], N_MOD, axis=-1)
        xl = xl + 0.5 * ml[2] * swiglu(modulate(xl, norm_g[i, 0], ml[0], ml[1]), ffn_in[i, 0], ffn_out[i, 0])
        xc = xc + 0.5 * mc[2] * swiglu(modulate(xc, norm_g[i, 0], mc[0], mc[1]), ffn_in[i, 0], ffn_out[i, 0])
        lp = dict(w_in=w_in[i], ssd_conv_w=ssd_conv_w[i], ssd_conv_b=ssd_conv_b[i],
                  ssd_a_log=ssd_a_log[i], ssd_dt_bias=ssd_dt_bias[i], ssd_d=ssd_d[i],
                  ssd_norm_g=ssd_norm_g[i], s5_a_re=s5_a_re[i], s5_a_im=s5_a_im[i],
                  s5_log_dt=s5_log_dt[i], s5_b_re=s5_b_re[i], s5_b_im=s5_b_im[i],
                  s5_c_re=s5_c_re[i], s5_c_im=s5_c_im[i], s5_d=s5_d[i],
                  s5_glu_w=s5_glu_w[i], s5_glu_b=s5_glu_b[i], swa_qk_g=swa_qk_g[i],
                  swa_sink=swa_sink[i], glb_qk_g=glb_qk_g[i], w_br_ssd=w_br_ssd[i],
                  w_br_s5=w_br_s5[i], w_br_swa=w_br_swa[i], w_br_glb=w_br_glb[i], w_out=w_out[i])
        y_ctx, y_lat = token_mixing(modulate(xc, norm_g[i, 1], mc[3], mc[4]),
                                    modulate(xl, norm_g[i, 1], ml[3], ml[4]), rope, lp, need_ctx)
        xl = xl + ml[5] * y_lat
        xl = xl + 0.5 * ml[8] * swiglu(modulate(xl, norm_g[i, 2], ml[6], ml[7]), ffn_in[i, 1], ffn_out[i, 1])
        if need_ctx:
            xc = xc + mc[5] * y_ctx
            xc = xc + 0.5 * mc[8] * swiglu(modulate(xc, norm_g[i, 2], mc[6], mc[7]), ffn_in[i, 1], ffn_out[i, 1])
    return xl
```

```cpp
#include <hip/hip_runtime.h>
#include <cstdio>
#include <cstdint>
#ifndef WGM_SEL
#define WGM_SEL 2
#endif
namespace pg8 {
#define PG8_LAS __attribute__((address_space(3)))
typedef unsigned short bf16_t;
typedef short bf16x8 __attribute__((ext_vector_type(8)));
typedef float f32x4 __attribute__((ext_vector_type(4)));
typedef unsigned u32x4 __attribute__((ext_vector_type(4)));
constexpr int BM = 256, BK = 64, HALF = 128, HTB = HALF * BK * 2  , STAGE_BYTES = 8 * HTB, NXCD = 8, WGM = WGM_SEL;

__host__ __device__ __forceinline__ int lds_byte(int r, int c) { const int st = (r >> 4) * 2 + (c >> 5), rr = r & 15, cc = c & 31, ob = rr * 64 + cc * 2; return st * 1024 + (ob ^ (((ob >> 9) & 1) << 5)); }
__host__ __device__ __forceinline__ void stage_rc(int b, int& R, int& C) { const int st = b / 1024, sb = b % 1024, swz = sb ^ (((sb >> 9) & 1) << 5); R = (st >> 1) * 16 + swz / 64; C = (st & 1) * 32 + (swz % 64) / 2; }
__host__ __device__ __forceinline__ int perm32(int rho) { const int n = rho >> 4, i = rho & 15; return 8 * (i >> 2) + 4 * n + (i & 3); }

struct Unit { int pm, pn, ks, kofs, nt, seg; };
struct Gemm { const bf16_t* A; const bf16_t* Bt; int M, N, K, ld; };

struct StaticOrder {
    int nM, nN, nwg, G, c, wgm, rev;
    __host__ __device__ void init(int M, int N, int G_, int c_, int wgm_ = WGM, int rev_ = 0) { nM = M / BM; nN = N / BM; nwg = nM * nN; G = G_; c = c_; wgm = wgm_; rev = rev_; }
    __host__ __device__ bool next(int i, Unit& u) const {
        const long L = (long)i * G + c; if (L >= nwg) return false;
        int wgid = (int)L; { const int q = nwg / NXCD, r = nwg % NXCD, xcd = wgid % NXCD, off = wgid / NXCD; wgid = (xcd < r ? xcd * (q + 1) : r * (q + 1) + (xcd - r) * q) + off; }
        const int nig = wgm * nN, gid = wgid / nig, fm = gid * wgm, gsz = (nM - fm) < wgm ? (nM - fm) : wgm;
        u.pm = fm + ((wgid % nig) % gsz); if (rev) u.pm = nM - 1 - u.pm; u.pn = (wgid % nig) / gsz; u.ks = 0; u.kofs = 0; u.nt = 0; u.seg = 0; return true;
    }
    __device__ __forceinline__ void a_ready(const Unit&) const {}
    __device__ __forceinline__ void done(const Unit&) const {}
};
struct SplitKOrder {
    int pm, nN, nS, G, c;
    __device__ __forceinline__ bool next(int i, Unit& u) const { const int L = i * G + c; if (L >= nN * nS) return false; u.pm = pm; u.pn = L % nN; u.ks = L / nN; u.kofs = 0; u.nt = 0; u.seg = 0; return true; }
    __device__ __forceinline__ void a_ready(const Unit&) const {}
    __device__ __forceinline__ void done(const Unit&) const {}
};
struct MergeOrder {
    StaticOrder so;
    __device__ __forceinline__ bool next(int i, Unit& u) const { if (!so.next(i >> 2, u)) return false; const int s = i & 3; u.seg = s; u.kofs = s ? 256 + 512 * s : 0; u.nt = s ? 8 : 12; return true; }
    __device__ __forceinline__ void a_ready(const Unit&) const {}
    __device__ __forceinline__ void done(const Unit&) const {}
};
__device__ __forceinline__ unsigned cvt_pk_bf16(float lo, float hi) { unsigned r; asm volatile("v_cvt_pk_bf16_f32 %0, %1, %2" : "=v"(r) : "v"(lo), "v"(hi)); return r; }
typedef float f32x2 __attribute__((ext_vector_type(2)));
__device__ __forceinline__ float sigm(float x) { return __builtin_amdgcn_rcpf(1.0f + __builtin_amdgcn_exp2f(-1.4426950408889634f * x)); }
__device__ __forceinline__ float silu(float x) { return x * sigm(x); }
__device__ __forceinline__ float bf2f(unsigned short h) { return __uint_as_float(((unsigned)h) << 16); }
typedef unsigned u32x2 __attribute__((ext_vector_type(2)));

struct EpiBf16 {
    static constexpr bool PERM = true, AFTER_DRAIN = false, KEEP_ACC = false;
    bf16_t* O; int ldc;
    __device__ __forceinline__ void operator()(const f32x4 (&acc)[2][2][4][2], const Unit& u, int wr, int wc, int fr, int fq) const {
        const int row0 = u.pm * BM + wr * 64 + fr; const int col0 = u.pn * BM + wc * 32 + 8 * fq;
#pragma unroll
        for (int ai = 0; ai < 2; ++ai)
#pragma unroll
            for (int m = 0; m < 4; ++m) { bf16_t* rowp = O + (size_t)(row0 + ai * HALF + m * 16) * ldc + col0;
#pragma unroll
                for (int bj = 0; bj < 2; ++bj) { const f32x4 v0 = acc[ai][bj][m][0], v1 = acc[ai][bj][m][1];
                    u32x4 w; w.x = cvt_pk_bf16(v0[0], v0[1]); w.y = cvt_pk_bf16(v0[2], v0[3]); w.z = cvt_pk_bf16(v1[0], v1[1]); w.w = cvt_pk_bf16(v1[2], v1[3]);
                    *(u32x4*)(rowp + bj * HALF) = w; } }
    }
};
template <int MODE> struct EpiGated {
    static constexpr bool PERM = true, AFTER_DRAIN = false, KEEP_ACC = false;
    bf16_t* O; int ldo; const float* bias; int half;
    __device__ __forceinline__ void operator()(const f32x4 (&acc)[2][2][4][2], const Unit& u, int wr, int wc, int fr, int fq) const {
        const int row0 = u.pm * BM + wr * 64 + fr; const int col0 = u.pn * HALF + wc * 32 + 8 * fq;
        f32x4 ba[2], bb[2];
#pragma unroll
        for (int n = 0; n < 2; ++n) { if (MODE == 1) { ba[n] = *(const f32x4*)(bias + col0 + 4 * n); bb[n] = *(const f32x4*)(bias + half + col0 + 4 * n); } else { ba[n] = (f32x4){0.f, 0.f, 0.f, 0.f}; bb[n] = ba[n]; } }
#pragma unroll
        for (int ai = 0; ai < 2; ++ai)
#pragma unroll
            for (int m = 0; m < 4; ++m) { bf16_t* rowp = O + (size_t)(row0 + ai * HALF + m * 16) * ldo + col0;
                float r[8];
#pragma unroll
                for (int n = 0; n < 2; ++n)
#pragma unroll
                    for (int i = 0; i < 4; ++i) { const float a = acc[ai][0][m][n][i] + ba[n][i], b = acc[ai][1][m][n][i] + bb[n][i]; r[4 * n + i] = (MODE == 0) ? silu(a) * b : a * sigm(b); }
                u32x4 w; w.x = cvt_pk_bf16(r[0], r[1]); w.y = cvt_pk_bf16(r[2], r[3]); w.z = cvt_pk_bf16(r[4], r[5]); w.w = cvt_pk_bf16(r[6], r[7]);
                *(u32x4*)rowp = w; }
    }
};
struct EpiResid {
    static constexpr bool PERM = false, AFTER_DRAIN = false, KEEP_ACC = false;
    const float* base; float* out_lat; float* out_ctx; const float* gate_lat; const float* gate_ctx; float coef; int ctx_pm;
    __device__ __forceinline__ void operator()(const f32x4 (&acc)[2][2][4][2], const Unit& u, int wr, int wc, int fr, int fq) const {
        const bool isctx = u.pm >= ctx_pm; const float* g = isctx ? gate_ctx : gate_lat; float* o = isctx ? out_ctx : out_lat;
        const int row0 = u.pm * BM + wr * 64 + fr, col0 = u.pn * BM + wc * 32 + 4 * fq;
        f32x4 gv[2][2];
#pragma unroll
        for (int bj = 0; bj < 2; ++bj)
#pragma unroll
            for (int n = 0; n < 2; ++n) gv[bj][n] = *(const f32x4*)(g + col0 + bj * HALF + n * 16) * coef;
#pragma unroll
        for (int ai = 0; ai < 2; ++ai)
#pragma unroll
            for (int mp = 0; mp < 2; ++mp) { f32x4 bv[2][2][2];
#pragma unroll
                for (int mm = 0; mm < 2; ++mm) { const size_t off = (size_t)(row0 + ai * HALF + (2 * mp + mm) * 16) * 2048 + col0;
#pragma unroll
                    for (int bj = 0; bj < 2; ++bj)
#pragma unroll
                        for (int n = 0; n < 2; ++n) bv[mm][bj][n] = *(const f32x4*)(base + off + bj * HALF + n * 16); }
                asm volatile("" ::: "memory");
#pragma unroll
                for (int mm = 0; mm < 2; ++mm) { const size_t off = (size_t)(row0 + ai * HALF + (2 * mp + mm) * 16) * 2048 + col0;
#pragma unroll
                    for (int bj = 0; bj < 2; ++bj)
#pragma unroll
                        for (int n = 0; n < 2; ++n) *(f32x4*)(o + off + bj * HALF + n * 16) = bv[mm][bj][n] + gv[bj][n] * acc[ai][bj][2 * mp + mm][n]; }
                asm volatile("" ::: "memory"); }
    }
};
template <int MODE> struct EpiMerge {
    static constexpr bool PERM = false, AFTER_DRAIN = false, KEEP_ACC = false;
    const bf16_t* G; int ldg; float* F; bf16_t* O;
    __device__ __forceinline__ void operator()(const f32x4 (&acc)[2][2][4][2], const Unit& u, int wr, int wc, int fr, int fq) const {
        const int row0 = u.pm * BM + wr * 64 + fr, col0 = u.pn * BM + wc * 32 + 4 * fq;
#pragma unroll
        for (int ai = 0; ai < 2; ++ai)
#pragma unroll
            for (int m = 0; m < 4; ++m) { const size_t r = (size_t)(row0 + ai * HALF + m * 16);
#pragma unroll
                for (int bj = 0; bj < 2; ++bj)
#pragma unroll
                    for (int n = 0; n < 2; ++n) { const int c = col0 + bj * HALF + n * 16;
                        const u32x2 gw = *(const u32x2*)(G + r * ldg + c);
                        f32x4 t; t[0] = sigm(__uint_as_float(gw.x << 16)); t[1] = sigm(__uint_as_float(gw.x & 0xffff0000u)); t[2] = sigm(__uint_as_float(gw.y << 16)); t[3] = sigm(__uint_as_float(gw.y & 0xffff0000u));
                        t = t * acc[ai][bj][m][n];
                        if (MODE >= 1) t = t + *(const f32x4*)(F + r * 2048 + c);
                        if (MODE <= 1) *(f32x4*)(F + r * 2048 + c) = t;
                        else { u32x2 w; w.x = cvt_pk_bf16(t[0], t[1]); w.y = cvt_pk_bf16(t[2], t[3]); *(u32x2*)(O + r * 2048 + c) = w; } } }
    }
};
struct EpiPartial {
    static constexpr bool PERM = false, AFTER_DRAIN = false, KEEP_ACC = false;
    float* part; const float* gate; float coef;
    __device__ __forceinline__ void operator()(const f32x4 (&acc)[2][2][4][2], const Unit& u, int wr, int wc, int fr, int fq) const {
        const int row0 = u.ks * BM + wr * 64 + fr, col0 = u.pn * BM + wc * 32 + 4 * fq;
        f32x4 gv[2][2];
#pragma unroll
        for (int bj = 0; bj < 2; ++bj)
#pragma unroll
            for (int n = 0; n < 2; ++n) gv[bj][n] = *(const f32x4*)(gate + col0 + bj * HALF + n * 16) * coef;
#pragma unroll
        for (int ai = 0; ai < 2; ++ai)
#pragma unroll
            for (int m = 0; m < 4; ++m) { const size_t off = (size_t)(row0 + ai * HALF + m * 16) * 2048 + col0;
#pragma unroll
                for (int bj = 0; bj < 2; ++bj)
#pragma unroll
                    for (int n = 0; n < 2; ++n) *(f32x4*)(part + off + bj * HALF + n * 16) = gv[bj][n] * acc[ai][bj][m][n]; }
    }
};
struct EpiMergeR {
    static constexpr bool PERM = false, AFTER_DRAIN = false, KEEP_ACC = true;
    const bf16_t* G; int ldg; bf16_t* O;
    __device__ __forceinline__ bool zero_after(const Unit& u) const { return u.seg == 3; }
    __device__ __forceinline__ void operator()(f32x4 (&acc)[2][2][4][2], const Unit& u, int wr, int wc, int fr, int fq) const {
        const int row0 = u.pm * BM + wr * 64 + fr, col0 = u.pn * BM + wc * 32 + 4 * fq; const bf16_t* Gs = G + 2048 * u.seg + u.pn * BM + 64 * wc + 16 * fq; const bool fin = u.seg == 3;
#pragma unroll
        for (int ai = 0; ai < 2; ++ai)
#pragma unroll
            for (int m = 0; m < 4; ++m) { const size_t r = (size_t)(row0 + ai * HALF + m * 16);
                const u32x4 w0 = *(const u32x4*)(Gs + r * ldg), w1 = *(const u32x4*)(Gs + r * ldg + 8);
                acc[ai][0][m][0] = acc[ai][0][m][0] * (f32x4){__uint_as_float(w0.x << 16), __uint_as_float(w0.x & 0xffff0000u), __uint_as_float(w0.y << 16), __uint_as_float(w0.y & 0xffff0000u)};
                acc[ai][0][m][1] = acc[ai][0][m][1] * (f32x4){__uint_as_float(w0.z << 16), __uint_as_float(w0.z & 0xffff0000u), __uint_as_float(w0.w << 16), __uint_as_float(w0.w & 0xffff0000u)};
                acc[ai][1][m][0] = acc[ai][1][m][0] * (f32x4){__uint_as_float(w1.x << 16), __uint_as_float(w1.x & 0xffff0000u), __uint_as_float(w1.y << 16), __uint_as_float(w1.y & 0xffff0000u)};
                acc[ai][1][m][1] = acc[ai][1][m][1] * (f32x4){__uint_as_float(w1.z << 16), __uint_as_float(w1.z & 0xffff0000u), __uint_as_float(w1.w << 16), __uint_as_float(w1.w & 0xffff0000u)};
                if (fin) {
#pragma unroll
                    for (int bj = 0; bj < 2; ++bj)
#pragma unroll
                        for (int n = 0; n < 2; ++n) { const f32x4 t = acc[ai][bj][m][n]; u32x2 w; w.x = cvt_pk_bf16(t[0], t[1]); w.y = cvt_pk_bf16(t[2], t[3]); *(u32x2*)(O + r * 2048 + col0 + bj * HALF + n * 16) = w; } } }
    }
};
struct EpiWin {
    static constexpr bool PERM = true, AFTER_DRAIN = false, KEEP_ACC = false;
    bf16_t* O; int ldc; int gate_pn; int gate0;
    __device__ __forceinline__ void operator()(const f32x4 (&acc)[2][2][4][2], const Unit& u, int wr, int wc, int fr, int fq) const {
        const int row0 = u.pm * BM + wr * 64 + fr;
        if (u.pn < gate_pn) { const int col0 = u.pn * BM + wc * 32 + 8 * fq;
#pragma unroll
            for (int ai = 0; ai < 2; ++ai)
#pragma unroll
                for (int m = 0; m < 4; ++m) { bf16_t* rowp = O + (size_t)(row0 + ai * HALF + m * 16) * ldc + col0;
#pragma unroll
                    for (int bj = 0; bj < 2; ++bj) { const f32x4 v0 = acc[ai][bj][m][0], v1 = acc[ai][bj][m][1];
                        u32x4 w; w.x = cvt_pk_bf16(v0[0], v0[1]); w.y = cvt_pk_bf16(v0[2], v0[3]); w.z = cvt_pk_bf16(v1[0], v1[1]); w.w = cvt_pk_bf16(v1[2], v1[3]);
                        *(u32x4*)(rowp + bj * HALF) = w; } }
        } else {
            const int c = 64 * (u.pn - gate_pn) + 16 * wc + 4 * fq;
            const int sg = (c & ~255) + 64 * ((c >> 5) & 3) + 16 * ((c >> 2) & 3) + 8 * ((c >> 7) & 1) + 4 * ((c >> 4) & 1);
#pragma unroll
            for (int ai = 0; ai < 2; ++ai)
#pragma unroll
                for (int m = 0; m < 4; ++m) { bf16_t* rowp = O + (size_t)(row0 + ai * HALF + m * 16) * ldc + gate0 + sg;
                    f32x4 d[4];
#pragma unroll
                    for (int b = 0; b < 4; ++b)
#pragma unroll
                        for (int i = 0; i < 4; ++i) d[b][i] = 1.0f + __builtin_amdgcn_exp2f(-1.4426950408889634f * fminf(fmaxf(acc[ai][b >> 1][m][b & 1][i], -30.0f), 30.0f));
#pragma unroll
                    for (int s = 0; s < 4; ++s) { f32x4 rr;
#pragma unroll
                        for (int i = 0; i < 4; ++i) rr[i] = (s < 3 ? d[s < 3 ? s + 1 : 3][i] : 1.0f) * __builtin_amdgcn_rcpf(d[s][i]);
                        u32x2 w; w.x = cvt_pk_bf16(rr[0], rr[1]); w.y = cvt_pk_bf16(rr[2], rr[3]); *(u32x2*)(rowp + 2048 * s) = w; } }
        }
    }
};
template <class Epi, class Sched, bool ALIGN_EPI = false, bool SP2 = false>
__device__ __forceinline__ void gemm_phase(PG8_LAS unsigned char* lds, const Gemm g, const Sched& S, const Epi& E) {
    int tid_ = threadIdx.x; asm volatile("" : "+v"(tid_)); const int tid = tid_, wid = __builtin_amdgcn_readfirstlane(tid >> 6), lane = tid & 63, wr = wid >> 2, wc = wid & 3, fr = lane & 15, fq = lane >> 4;
    const int K = g.ld, nt = g.K / BK;
    unsigned voffA[2], voffB[2];
#pragma unroll
    for (int i = 0; i < 2; ++i) { int R, C; stage_rc(tid * 16 + i * 8192, R, C); const int Rb = Epi::PERM ? ((R & ~31) + perm32(R & 31)) : R;
        voffA[i] = (unsigned)(R * K + C) * 2u; voffB[i] = (unsigned)(Rb * K + C) * 2u; }
    const size_t kstep = (size_t)(BK * 2);
    const size_t hstep = (size_t)HALF * K * 2;
    const size_t tstep = 2 * hstep;
    const unsigned ldsw = (unsigned)wid * 1024u;
    const int aoff = lds_byte(wr * 64 + fr, fq * 8), boff = lds_byte(wc * 32 + fr, fq * 8);
#define PG8_SA(b, h) (((b) * 2 + (h)) * HTB)
#define PG8_SB(b, h) ((4 + (b) * 2 + (h)) * HTB)
#define PG8_STAGE(bufoff, gbase, voff) do { _Pragma("unroll") for (int _i = 0; _i < 2; ++_i) \
        __builtin_amdgcn_global_load_lds((const unsigned*)((const char*)(gbase) + (voff)[_i]), (PG8_LAS unsigned*)(lds + (bufoff) + ldsw + _i * 8192), 16, 0, 0); } while (0)
#define PG8_LDA(dst, b, h) do { _Pragma("unroll") for (int m = 0; m < 4; ++m) _Pragma("unroll") for (int k = 0; k < 2; ++k) dst[m][k] = *(const PG8_LAS bf16x8*)(lds + PG8_SA(b, h) + aoff + m * 2048 + k * 1024); } while (0)
#define PG8_LDB(dst, b, h) do { _Pragma("unroll") for (int n = 0; n < 2; ++n) _Pragma("unroll") for (int k = 0; k < 2; ++k) dst[n][k] = *(const PG8_LAS bf16x8*)(lds + PG8_SB(b, h) + boff + n * 2048 + k * 1024); } while (0)
#define PG8_MMA(ai, bj, At, Bt) do { __builtin_amdgcn_s_setprio(1); _Pragma("unroll") for (int m = 0; m < 4; ++m) _Pragma("unroll") for (int n = 0; n < 2; ++n) _Pragma("unroll") for (int k = 0; k < 2; ++k) \
        acc[ai][bj][m][n] = __builtin_amdgcn_mfma_f32_16x16x32_bf16(Bt[n][k], At[m][k], acc[ai][bj][m][n], 0, 0, 0); __builtin_amdgcn_s_setprio(0); } while (0)
#define PG8_WAIT_V(n) asm volatile("s_waitcnt vmcnt(" #n ")" ::: "memory")
#define PG8_WAIT_L(n) asm volatile("s_waitcnt lgkmcnt(" #n ")" ::: "memory")
#define PG8_BAR __builtin_amdgcn_s_barrier()
#define PG8_SCHED __builtin_amdgcn_sched_barrier(0)
    Unit cur, nxt; int ui = 0;
    if (!S.next(0, cur)) return;
    f32x4 acc[2][2][4][2];
#pragma unroll
    for (int a = 0; a < 2; ++a)
#pragma unroll
        for (int b = 0; b < 2; ++b)
#pragma unroll
            for (int m = 0; m < 4; ++m)
#pragma unroll
                for (int n = 0; n < 2; ++n) acc[a][b][m][n] = (f32x4){0.f, 0.f, 0.f, 0.f};
    bf16x8 At[4][2], B0[2][2], B1[2][2];
    const size_t kslice = (size_t)g.K * 2;
    const char* cA = (const char*)g.A + (size_t)cur.pm * tstep + (size_t)cur.ks * kslice + (size_t)cur.kofs * 2; const char* cB = (const char*)g.Bt + (size_t)cur.pn * tstep + (size_t)cur.ks * kslice + (size_t)cur.kofs * 2;
    S.a_ready(cur);
    if constexpr (SP2) {
        PG8_STAGE(PG8_SB(0, 0), cB, voffB); PG8_STAGE(PG8_SB(0, 1), cB + hstep, voffB); PG8_STAGE(PG8_SA(0, 0), cA, voffA); PG8_STAGE(PG8_SA(0, 1), cA + hstep, voffA);
        if (wr == 1) PG8_BAR;
        PG8_WAIT_V(2); PG8_BAR;
        PG8_STAGE(PG8_SB(1, 0), cB + kstep, voffB); PG8_STAGE(PG8_SA(1, 0), cA + kstep, voffA); PG8_STAGE(PG8_SB(1, 1), cB + hstep + kstep, voffB);
        PG8_WAIT_V(6); PG8_BAR;
    } else {
        PG8_STAGE(PG8_SB(0, 0), cB, voffB); PG8_STAGE(PG8_SA(0, 0), cA, voffA); PG8_STAGE(PG8_SB(0, 1), cB + hstep, voffB); PG8_STAGE(PG8_SA(0, 1), cA + hstep, voffA);
        if (wr == 1) PG8_BAR;
        PG8_WAIT_V(4); PG8_BAR;
        PG8_STAGE(PG8_SB(1, 0), cB + kstep, voffB); PG8_STAGE(PG8_SA(1, 0), cA + kstep, voffA); PG8_STAGE(PG8_SB(1, 1), cB + hstep + kstep, voffB);
        PG8_WAIT_V(6); PG8_BAR;
    }
    for (;;) {
        const bool has_next = S.next(ui + 1, nxt);
        const char* nA = has_next ? (const char*)g.A + (size_t)nxt.pm * tstep + (size_t)nxt.ks * kslice + (size_t)nxt.kofs * 2 : cA; const char* nB = has_next ? (const char*)g.Bt + (size_t)nxt.pn * tstep + (size_t)nxt.ks * kslice + (size_t)nxt.kofs * 2 : cB;
        const int nt_u = cur.nt ? cur.nt : nt;
        for (int t = 0; t < nt_u; t += 2) {
            const bool last = (t == nt_u - 2);
            const char* a1 = cA + (size_t)(t + 1) * kstep;
            const char* a2 = last ? nA : cA + (size_t)(t + 2) * kstep; const char* b2 = last ? nB : cB + (size_t)(t + 2) * kstep;
            const char* a3 = a2 + kstep; const char* b3 = b2 + kstep;
            if (last && has_next) S.a_ready(nxt);
            if constexpr (SP2) {
            PG8_LDB(B0, 0, 0); PG8_LDB(B1, 0, 1); PG8_SCHED; PG8_LDA(At, 0, 0); PG8_STAGE(PG8_SA(1, 1), a1 + hstep, voffA);
            PG8_WAIT_V(8); PG8_WAIT_L(0); PG8_BAR; PG8_MMA(0, 0, At, B0); PG8_MMA(0, 1, At, B1); PG8_BAR; PG8_SCHED;
            PG8_LDA(At, 0, 1); PG8_STAGE(PG8_SB(0, 0), b2, voffB); PG8_STAGE(PG8_SB(0, 1), b2 + hstep, voffB); PG8_STAGE(PG8_SA(0, 0), a2, voffA);
            PG8_WAIT_V(8); PG8_WAIT_L(0); PG8_BAR; PG8_MMA(1, 0, At, B0); PG8_MMA(1, 1, At, B1); PG8_BAR; PG8_SCHED;
            PG8_LDB(B0, 1, 0); PG8_LDB(B1, 1, 1); PG8_SCHED; PG8_LDA(At, 1, 0); PG8_STAGE(PG8_SA(0, 1), a2 + hstep, voffA);
            PG8_WAIT_V(8); PG8_WAIT_L(0); PG8_BAR; PG8_MMA(0, 0, At, B0); PG8_MMA(0, 1, At, B1); PG8_BAR; PG8_SCHED;
            PG8_LDA(At, 1, 1); PG8_STAGE(PG8_SB(1, 0), b3, voffB); PG8_STAGE(PG8_SB(1, 1), b3 + hstep, voffB); PG8_STAGE(PG8_SA(1, 0), a3, voffA);
            PG8_WAIT_V(8); PG8_WAIT_L(0); PG8_BAR; PG8_MMA(1, 0, At, B0); PG8_MMA(1, 1, At, B1); PG8_BAR; PG8_SCHED;
            } else {
            PG8_LDB(B0, 0, 0); PG8_SCHED; PG8_LDA(At, 0, 0); PG8_STAGE(PG8_SA(1, 1), a1 + hstep, voffA);
            PG8_WAIT_L(8); PG8_BAR; PG8_WAIT_L(0); PG8_MMA(0, 0, At, B0); PG8_BAR; PG8_SCHED;
            PG8_LDB(B1, 0, 1); PG8_STAGE(PG8_SB(0, 0), b2, voffB);
            PG8_BAR; PG8_WAIT_L(0); PG8_MMA(0, 1, At, B1); PG8_BAR;
            PG8_LDA(At, 0, 1); PG8_STAGE(PG8_SA(0, 0), a2, voffA);
            PG8_BAR; PG8_WAIT_L(0); PG8_MMA(1, 0, At, B0); PG8_BAR; PG8_SCHED;
            PG8_STAGE(PG8_SB(0, 1), b2 + hstep, voffB);
            PG8_WAIT_V(6); PG8_BAR; PG8_MMA(1, 1, At, B1); PG8_BAR;
            PG8_LDB(B0, 1, 0); PG8_SCHED; PG8_LDA(At, 1, 0); PG8_STAGE(PG8_SA(0, 1), a2 + hstep, voffA);
            PG8_WAIT_L(8); PG8_BAR; PG8_WAIT_L(0); PG8_MMA(0, 0, At, B0); PG8_BAR; PG8_SCHED;
            PG8_LDB(B1, 1, 1); PG8_STAGE(PG8_SB(1, 0), b3, voffB);
            PG8_BAR; PG8_WAIT_L(0); PG8_MMA(0, 1, At, B1); PG8_BAR;
            PG8_LDA(At, 1, 1); PG8_STAGE(PG8_SA(1, 0), a3, voffA);
            PG8_BAR; PG8_WAIT_L(0); PG8_MMA(1, 0, At, B0); PG8_BAR; PG8_SCHED;
            PG8_STAGE(PG8_SB(1, 1), b3 + hstep, voffB);
            PG8_WAIT_V(6); PG8_BAR; PG8_MMA(1, 1, At, B1); PG8_BAR;
            }
        }
        if constexpr (ALIGN_EPI) { if (wr == 0) PG8_BAR; }
        if constexpr (!Epi::AFTER_DRAIN) { E(acc, cur, wr, wc, fr, fq); S.done(cur); }
        if (!has_next) break;
        bool zero_ = true; if constexpr (Epi::KEEP_ACC) zero_ = E.zero_after(cur);
        if (zero_) {
#pragma unroll
        for (int a = 0; a < 2; ++a)
#pragma unroll
            for (int b = 0; b < 2; ++b)
#pragma unroll
                for (int m = 0; m < 4; ++m)
#pragma unroll
                    for (int n = 0; n < 2; ++n) acc[a][b][m][n] = (f32x4){0.f, 0.f, 0.f, 0.f};
        }
        cur = nxt; cA = nA; cB = nB; ++ui;
        if constexpr (ALIGN_EPI) { if (wr == 1) PG8_BAR; }
    }
    PG8_WAIT_V(0);
    if constexpr (!ALIGN_EPI) { if (wr == 0) PG8_BAR; }
    PG8_BAR;
    if constexpr (Epi::AFTER_DRAIN) { E.fused(acc, cur, wr, wc, fr, fq, lds, wid, lane); S.done(cur); }
#undef PG8_SA
#undef PG8_SB
#undef PG8_STAGE
#undef PG8_LDA
#undef PG8_LDB
#undef PG8_MMA
#undef PG8_WAIT_V
#undef PG8_WAIT_L
#undef PG8_BAR
#undef PG8_SCHED
}
}
#include <hip/hip_bf16.h>
#include <cmath>
#ifndef ATT_NEGM
#define ATT_NEGM 1
#endif
namespace attn_body {
using bf16=__hip_bfloat16;
using bf16x8=__attribute__((ext_vector_type(8)))short;
using s16x4=__attribute__((ext_vector_type(4)))short;
using f32x16=__attribute__((ext_vector_type(16)))float;
using u32x4=__attribute__((ext_vector_type(4)))unsigned;
constexpr int D=64, QP=512, KP=128, VP=12288, OP=2304;
constexpr int NW=8,QBLK=32,QB=QBLK*NW,KVBLK=64;
constexpr int ATTN_UNIT_ROWS=QB;
__device__ __forceinline__ int crow(int r,int hi){return (r&3)+8*(r>>2)+4*hi;}
#define SBAR() __builtin_amdgcn_sched_barrier(0)
__device__ __forceinline__ void swamask(f32x16&p0,f32x16&p1,int dbase){
  const float NEG=-INFINITY;
  #pragma unroll
  for(int r=0;r<16;++r){const int d=dbase+(r&3)+8*(r>>2); if(d>128||d<-128)p0[r]=NEG; if(d+32>128||d+32<-128)p1[r]=NEG;}
}

constexpr int NSLOT=3, SLOTB=8192;
constexpr int LDS_K=0, LDS_V=NSLOT*SLOTB, LDS_WS=2*NSLOT*SLOTB, LDS_OST=LDS_WS+NW*64*4, LDS_BYTES=LDS_OST+NW*4096;
constexpr float C2=0.125f*1.4426950408889634f;
__device__ __forceinline__ void glds16(const void*gsrc,unsigned lds_dst){unsigned keep;
  asm volatile("s_mov_b32 %0, m0\n\ts_mov_b32 m0, %2\n\ts_nop 0\n\tglobal_load_lds_dwordx4 %1, off\n\ts_mov_b32 m0, %0":"=&s"(keep):"v"(gsrc),"s"(lds_dst):"memory");}
__device__ __forceinline__ float max3f(float a,float b,float c){float r;asm("v_max3_f32 %0, %1, %2, %3":"=v"(r):"v"(a),"v"(b),"v"(c));return r;}
__device__ __forceinline__ float max2f(float a,float b){float r;asm("v_max_f32_e32 %0, %1, %2":"=v"(r):"v"(a),"v"(b));return r;}
__device__ __forceinline__ float fadd_s(float a,float b){float r;asm("v_add_f32_e32 %0, %1, %2":"=v"(r):"v"(a),"v"(b));return r;}
__device__ __forceinline__ float fsub_s(float a,float b){float r;asm("v_sub_f32_e32 %0, %1, %2":"=v"(r):"v"(a),"v"(b));return r;}
typedef float f32x2_t __attribute__((ext_vector_type(2))); typedef __bf16 bf16x2_t __attribute__((ext_vector_type(2)));
__device__ __forceinline__ unsigned cvtpk_s(float lo,float hi){f32x2_t v={lo,hi};bf16x2_t b=__builtin_convertvector(v,bf16x2_t);return __builtin_bit_cast(unsigned,b);}
#define WAIT_BAR(N) asm volatile("s_waitcnt vmcnt(" #N ") lgkmcnt(0)\n\ts_barrier":::"memory")

__device__ __forceinline__ void qkt(f32x16&p0,f32x16&p1,const char*Kslot,const bf16x8*qr,const f32x16&negm,int r32,int hi){
  const char*kb=Kslot+hi*1024+r32*16;
  #pragma unroll
  for(int d0=0;d0<4;++d0){
    const bf16x8 b0=*reinterpret_cast<const bf16x8*>(kb+d0*2048);
    const bf16x8 b1=*reinterpret_cast<const bf16x8*>(kb+d0*2048+512);
    if(d0==0){p0=__builtin_amdgcn_mfma_f32_32x32x16_bf16(b0,qr[0],negm,0,0,0);p1=__builtin_amdgcn_mfma_f32_32x32x16_bf16(b1,qr[0],negm,0,0,0);}
    else{p0=__builtin_amdgcn_mfma_f32_32x32x16_bf16(b0,qr[d0],p0,0,0,0);p1=__builtin_amdgcn_mfma_f32_32x32x16_bf16(b1,qr[d0],p1,0,0,0);}}
}
typedef __attribute__((address_space(3))) const char* lds_cptr;
typedef short v4i16_t __attribute__((ext_vector_type(4)));
__device__ __forceinline__ void kload8(bf16x8*kf,lds_cptr kp){
  kf[0]=*(const __attribute__((address_space(3))) bf16x8*)(kp);      kf[1]=*(const __attribute__((address_space(3))) bf16x8*)(kp+512);
  kf[2]=*(const __attribute__((address_space(3))) bf16x8*)(kp+2048); kf[3]=*(const __attribute__((address_space(3))) bf16x8*)(kp+2560);
  kf[4]=*(const __attribute__((address_space(3))) bf16x8*)(kp+4096); kf[5]=*(const __attribute__((address_space(3))) bf16x8*)(kp+4608);
  kf[6]=*(const __attribute__((address_space(3))) bf16x8*)(kp+6144); kf[7]=*(const __attribute__((address_space(3))) bf16x8*)(kp+6656);
}
__device__ __forceinline__ void kload2(bf16x8*kf,lds_cptr kp,int j){ kf[2*j]=*(const __attribute__((address_space(3))) bf16x8*)(kp+j*2048); kf[2*j+1]=*(const __attribute__((address_space(3))) bf16x8*)(kp+j*2048+512); }
__device__ __forceinline__ s16x4 vtr(lds_cptr p){ return __builtin_bit_cast(s16x4,__builtin_amdgcn_ds_read_tr16_b64_v4i16((__attribute__((address_space(3))) v4i16_t*)p)); }
__device__ __forceinline__ float rowmax(const f32x16&p0,const f32x16&p1){
  float a=max3f(p0[0],p0[1],p1[0]),b=max3f(p0[2],p0[3],p1[1]);a=max3f(a,p1[2],p1[3]);
  #pragma unroll
  for(int r=4;r<16;r+=4){a=max3f(a,p0[r],p0[r+1]);b=max3f(b,p0[r+2],p0[r+3]);a=max3f(a,p1[r],p1[r+1]);b=max3f(b,p1[r+2],p1[r+3]);}
  const float m=max2f(a,b);
  auto rr=__builtin_amdgcn_permlane32_swap(__float_as_uint(m),__float_as_uint(m),false,false);
  return max2f(__uint_as_float(rr[0]),__uint_as_float(rr[1]));
}
__device__ __forceinline__ void pv(f32x16*o,int vb,bf16x8 pa0,bf16x8 pa1,bf16x8 pa2,bf16x8 pa3){
  #pragma unroll
  for(int d0=0;d0<2;++d0){s16x4 lo[4],hi[4];
    #pragma unroll
    for(int ks=0;ks<4;++ks){
      asm volatile("ds_read_b64_tr_b16 %0,%1 offset:%c2":"=&v"(lo[ks]):"v"(vb),"i"(d0*4096+ks*1024):"memory");
      asm volatile("ds_read_b64_tr_b16 %0,%1 offset:%c2":"=&v"(hi[ks]):"v"(vb),"i"(d0*4096+ks*1024+512):"memory");}
    asm volatile("s_waitcnt lgkmcnt(0)":::"memory");SBAR();
    #define PK(k) (bf16x8){lo[k][0],lo[k][1],lo[k][2],lo[k][3],hi[k][0],hi[k][1],hi[k][2],hi[k][3]}
    o[d0]=__builtin_amdgcn_mfma_f32_32x32x16_bf16(pa0,PK(0),o[d0],0,0,0);
    o[d0]=__builtin_amdgcn_mfma_f32_32x32x16_bf16(pa1,PK(1),o[d0],0,0,0);
    o[d0]=__builtin_amdgcn_mfma_f32_32x32x16_bf16(pa2,PK(2),o[d0],0,0,0);
    o[d0]=__builtin_amdgcn_mfma_f32_32x32x16_bf16(pa3,PK(3),o[d0],0,0,0);
    #undef PK
  }
}

#ifndef ATTN_STORE16
#define ATTN_STORE16(p,v) (*(u32x4*)(p)=(v))
#endif
template<int THRL,int MODE> __device__ __forceinline__ void attn_unit(const bf16*Qu,const bf16*__restrict__ Kh,const bf16*__restrict__ Vh,bf16*Ou,int NT,int n0,int s0,int s1,int qrow0,float sink2,bool has_sink,char*shm){
  int tid_=threadIdx.x; asm volatile("":"+v"(tid_)); const int tid=tid_,lane=tid&63,r32=lane&31,hi=lane>>5; const int wid=__builtin_amdgcn_readfirstlane(tid>>6);
  const bf16*Qw=Qu+(long)(wid*QBLK)*QP;
  const unsigned lds0=(unsigned)(uintptr_t)shm;
  float*wsf=(float*)(shm+LDS_WS)+wid*64;
  const bf16*ksrc=Kh+(long)lane*KP+wid*8;
  const bf16*vsrc=Vh+(long)(16*(wid&3)+(lane>>2))*VP+(wid>>2)*32+(lane&3)*8;
  #define TROW(t) (MODE==0 ? KVBLK*(t) : ((t)<n0 ? s0+KVBLK*(t) : s1+KVBLK*((t)-n0)))
  const unsigned kdst=lds0+LDS_K+wid*1024, vdst=lds0+LDS_V+wid*1024;
  #define DMA_K(t,slot) glds16(ksrc+(long)TROW(t)*KP,(unsigned)__builtin_amdgcn_readfirstlane(kdst+(slot)))
  #define DMA_V(t,slot) glds16(vsrc+(long)TROW(t)*VP,(unsigned)__builtin_amdgcn_readfirstlane(vdst+(slot)))
  const int vb0=(int)(lds0+LDS_V)+((lane>>4)&1)*32+(lane&3)*8+(4*hi+((lane&15)>>2))*64;
  const char*Kbase=shm+LDS_K; bf16x8 kf[8];
  const lds_cptr shm3=(lds_cptr)shm; const lds_cptr kp0=shm3+LDS_K+hi*1024+r32*16; const lds_cptr vp0=shm3+LDS_V+((lane>>4)&1)*32+(lane&3)*8+(4*hi+((lane&15)>>2))*64;
  DMA_K(0,0);DMA_V(0,0);DMA_K(1,SLOTB);
  bf16x8 qr[4];
  #pragma unroll
  for(int d0=0;d0<4;++d0)qr[d0]=*reinterpret_cast<const bf16x8*>(&Qw[(long)r32*QP+d0*16+hi*8]);
  float mhat=0.f,l_reg=0.f;f32x16 o[2];o[0]=f32x16{};o[1]=f32x16{};f32x16 negm=f32x16{}; if(ATT_NEGM&&MODE==0)asm volatile("":"+v"(negm));
  const int qrow=qrow0+wid*QBLK+r32;
  #define CMASK(P0,P1,t) do{ if(MODE==1 && (t)>=n0) swamask(P0,P1,TROW(t)+4*hi-qrow); }while(0)
  bool resc=false;
  #define START(P0,P1) do{ const float rm=rowmax(P0,P1); resc=false; \
    { const float dl=rm; mhat=fadd_s(mhat,dl); \
      _Pragma("unroll") for(int r=0;r<16;++r){P0[r]=fsub_s(P0[r],dl);P1[r]=fsub_s(P1[r],dl);} \
      if(ATT_NEGM&&MODE==0){ _Pragma("unroll") for(int r=0;r<16;++r)negm[r]=-mhat; asm volatile("":"+v"(negm)); } } \
    _Pragma("unroll") for(int r=0;r<16;++r)P0[r]=__builtin_amdgcn_exp2f(P0[r]); }while(0)
  #define RESC() do{ if(resc){ asm volatile("s_waitcnt lgkmcnt(0)":::"memory"); \
      _Pragma("unroll") for(int d_=0;d_<2;++d_) _Pragma("unroll") for(int r=0;r<16;++r)o[d_][r]*=wsf[crow(r,hi)]; } }while(0)
  f32x16 pA0,pA1,pB0,pB1;
  int sl_prev=0,sl_cur=0,sl_next=SLOTB;
  #define ROT() do{sl_prev=sl_cur;sl_cur=sl_next;sl_next=(sl_next==(NSLOT-1)*SLOTB)?0:sl_next+SLOTB;}while(0)
  DMA_K(2,2*SLOTB);
  WAIT_BAR(3);
  qkt(pA0,pA1,Kbase,qr,negm,r32,hi);asm volatile("s_nop 15\n\ts_nop 7":"+v"(pA0),"+v"(pA1));CMASK(pA0,pA1,0);
  START(pA0,pA1);
  _Pragma("unroll") for(int r=0;r<16;++r)pA1[r]=__builtin_amdgcn_exp2f(pA1[r]);
  WAIT_BAR(0);
  DMA_K(3,0);DMA_V(1,SLOTB);
  ROT();
  kload8(kf,kp0+sl_cur);
  WAIT_BAR(2);
  s16x4 vlo[8],vhi[8]; u32x4 pw0,pw1,pw2,pw3;
  #define PKW(P,B) cvtpk_s(P[B],P[B+1])
  #define PAF(k) __builtin_bit_cast(bf16x8,pw##k)
  #define VFR(i) (bf16x8){vlo[i][0],vlo[i][1],vlo[i][2],vlo[i][3],vhi[i][0],vhi[i][1],vhi[i][2],vhi[i][3]}
  #define PIN(x) asm volatile("":"+v"(x))
  #define MX3(a,b,c) __builtin_fmaxf(__builtin_fmaxf((a),(b)),(c))
  #define GAPA(MF,A0,A1,A2,A3,W0,W1,PW) do{ MF; sacc+=A0; sacc+=A1; sacc+=A2; sacc+=A3; PIN(sacc); W0; W1; PIN(PW); SBAR(); }while(0)
  #define EX(v) __builtin_amdgcn_exp2f(v)
  #define GAPB(MF,X,B) do{ MF; X[B]=EX(X[B]); X[B+1]=EX(X[B+1]); X[B+2]=EX(X[B+2]); X[B+3]=EX(X[B+3]); PIN(X); SBAR(); }while(0)
  #define VRD(i) do{ vlo[i]=vtr(vp_+(((i)>>2)*4096+((i)&3)*1024)); vhi[i]=vtr(vp_+(((i)>>2)*4096+((i)&3)*1024+512)); }while(0)
  #define KRD(G,j) do{ if(G){ kload2(kf,kp0+sl_next,j); SBAR(); } }while(0)
  #define STEP(C0,C1,P0,P1,t,GK,GV,GL) do{ SBAR(); \
    const lds_cptr vp_=vp0+sl_prev; \
    VRD(0); SBAR(); float sacc=(P0[0]+P0[1]); \
    GAPA(C0=__builtin_amdgcn_mfma_f32_32x32x16_bf16(kf[0],qr[0],((ATT_NEGM&&MODE==0)?negm:f32x16{}),0,0,0), P0[2],P0[3],P0[4],P0[5],     pw0[0]=PKW(P0,0), pw0[1]=PKW(P0,2), pw0); \
    VRD(4); SBAR(); GAPA(C1=__builtin_amdgcn_mfma_f32_32x32x16_bf16(kf[1],qr[0],((ATT_NEGM&&MODE==0)?negm:f32x16{}),0,0,0), P0[6],P0[7],P0[8],P0[9],     pw0[2]=PKW(P0,4), pw0[3]=PKW(P0,6), pw0); \
    VRD(1); SBAR(); GAPA(C0=__builtin_amdgcn_mfma_f32_32x32x16_bf16(kf[2],qr[1],C0,0,0,0),   P0[10],P0[11],P0[12],P0[13], pw1[0]=PKW(P0,8), pw1[1]=PKW(P0,10), pw1); \
    VRD(5); SBAR(); GAPA(C1=__builtin_amdgcn_mfma_f32_32x32x16_bf16(kf[3],qr[1],C1,0,0,0),   P0[14],P0[15],P1[0],P1[1],   pw1[2]=PKW(P0,12),pw1[3]=PKW(P0,14), pw1); \
    VRD(2); SBAR(); GAPA(C0=__builtin_amdgcn_mfma_f32_32x32x16_bf16(kf[4],qr[2],C0,0,0,0),   P1[2],P1[3],P1[4],P1[5],     pw2[0]=PKW(P1,0), pw2[1]=PKW(P1,2), pw2); \
    VRD(6); SBAR(); GAPA(C1=__builtin_amdgcn_mfma_f32_32x32x16_bf16(kf[5],qr[2],C1,0,0,0),   P1[6],P1[7],P1[8],P1[9],     pw2[2]=PKW(P1,4), pw2[3]=PKW(P1,6), pw2); \
    VRD(3); SBAR(); GAPA(C0=__builtin_amdgcn_mfma_f32_32x32x16_bf16(kf[6],qr[3],C0,0,0,0),   P1[10],P1[11],P1[12],P1[13], pw3[0]=PKW(P1,8), pw3[1]=PKW(P1,10), pw3); \
    VRD(7); SBAR(); GAPA(C1=__builtin_amdgcn_mfma_f32_32x32x16_bf16(kf[7],qr[3],C1,0,0,0),   P1[14],P1[15],0.f,0.f,       pw3[2]=PKW(P1,12),pw3[3]=PKW(P1,14), pw3); \
    l_reg+=sacc; \
    if(GK){DMA_K((t)+3,sl_cur);} if(GV){DMA_V((t)+1,sl_next);} \
    if(!(ATT_NEGM&&MODE==0)){ _Pragma("unroll") for(int r=0;r<16;++r){C0[r]-=mhat;C1[r]-=mhat;} } \
    CMASK(C0,C1,t); \
    { float a=MX3(C0[0],C0[1],C1[0]),b=MX3(C0[2],C0[3],C1[1]); a=MX3(a,C1[2],C1[3]); \
      _Pragma("unroll") for(int r=4;r<16;r+=4){a=MX3(a,C0[r],C0[r+1]);b=MX3(b,C0[r+2],C0[r+3]);a=MX3(a,C1[r],C1[r+1]);b=MX3(b,C1[r+2],C1[r+3]);} \
      float rm=__builtin_fmaxf(a,b); { auto rr=__builtin_amdgcn_permlane32_swap(__float_as_uint(rm),__float_as_uint(rm),false,false); rm=__builtin_fmaxf(__uint_as_float(rr[0]),__uint_as_float(rr[1])); } \
      resc=false; \
      if(__builtin_expect(__any(rm>(float)THRL),0)){ const float dl=__builtin_fmaxf(rm,0.f); mhat+=dl; \
        _Pragma("unroll") for(int r=0;r<16;++r){C0[r]-=dl;C1[r]-=dl;} \
        if(ATT_NEGM&&MODE==0){ _Pragma("unroll") for(int r=0;r<16;++r)negm[r]=-mhat; asm volatile("":"+v"(negm)); } \
        const float f=__builtin_amdgcn_exp2f(-dl); l_reg*=f; if(hi==0)wsf[r32]=f; resc=true; } } \
    SBAR(); \
    GAPB(o[0]=__builtin_amdgcn_mfma_f32_32x32x16_bf16(PAF(0),VFR(0),o[0],0,0,0), C0,0); \
    GAPB(o[1]=__builtin_amdgcn_mfma_f32_32x32x16_bf16(PAF(0),VFR(4),o[1],0,0,0), C0,4); \
    KRD(GL,0); GAPB(o[0]=__builtin_amdgcn_mfma_f32_32x32x16_bf16(PAF(1),VFR(1),o[0],0,0,0), C0,8); \
    KRD(GL,1); GAPB(o[1]=__builtin_amdgcn_mfma_f32_32x32x16_bf16(PAF(1),VFR(5),o[1],0,0,0), C0,12); \
    KRD(GL,2); GAPB(o[0]=__builtin_amdgcn_mfma_f32_32x32x16_bf16(PAF(2),VFR(2),o[0],0,0,0), C1,0); \
    KRD(GL,3); GAPB(o[1]=__builtin_amdgcn_mfma_f32_32x32x16_bf16(PAF(2),VFR(6),o[1],0,0,0), C1,4); \
    GAPB(o[0]=__builtin_amdgcn_mfma_f32_32x32x16_bf16(PAF(3),VFR(3),o[0],0,0,0), C1,8); \
    GAPB(o[1]=__builtin_amdgcn_mfma_f32_32x32x16_bf16(PAF(3),VFR(7),o[1],0,0,0), C1,12); \
    }while(0)
  int t=1;
  for(;t+5<NT;t+=2){
    STEP(pB0,pB1,pA0,pA1,t,true,true,true);     WAIT_BAR(2); RESC(); ROT();
    STEP(pA0,pA1,pB0,pB1,t+1,true,true,true);   WAIT_BAR(2); RESC(); ROT();
  }
  #define ENDW(tt) do{ if((tt)+3<NT){WAIT_BAR(2);} else if((tt)+2<NT){WAIT_BAR(1);} else {WAIT_BAR(0);} }while(0)
  for(;t+1<NT;t+=2){
    STEP(pB0,pB1,pA0,pA1,t,(t+3<NT),(t+1<NT),(t+1<NT));       ENDW(t);   RESC(); ROT();
    STEP(pA0,pA1,pB0,pB1,t+1,(t+4<NT),(t+2<NT),(t+2<NT));     ENDW(t+1); RESC(); ROT();
  }
  STEP(pB0,pB1,pA0,pA1,NT-1,false,false,false); RESC();
  { float sacc=pB0[0]+pB0[1]; _Pragma("unroll") for(int r=2;r<16;++r)sacc+=pB0[r]; _Pragma("unroll") for(int r=0;r<16;++r)sacc+=pB1[r]; l_reg+=sacc;
    pw0=(u32x4){PKW(pB0,0),PKW(pB0,2),PKW(pB0,4),PKW(pB0,6)};pw1=(u32x4){PKW(pB0,8),PKW(pB0,10),PKW(pB0,12),PKW(pB0,14)};pw2=(u32x4){PKW(pB1,0),PKW(pB1,2),PKW(pB1,4),PKW(pB1,6)};pw3=(u32x4){PKW(pB1,8),PKW(pB1,10),PKW(pB1,12),PKW(pB1,14)};
    SBAR(); pv(o,vb0+sl_cur,PAF(0),PAF(1),PAF(2),PAF(3)); }
  #undef PKW
  #undef PAF
  #undef VFR
  #undef PIN
  #undef MX3
  #undef GAPA
  #undef GAPB
  #undef EX
  #undef VRD
  #undef KRD
  #undef STEP
  #undef ENDW
  {auto rr=__builtin_amdgcn_permlane32_swap(__float_as_uint(l_reg),__float_as_uint(l_reg),false,false);l_reg=__uint_as_float(rr[0])+__uint_as_float(rr[1]);}
  if(has_sink)l_reg+=__builtin_amdgcn_exp2f(sink2-mhat);
  if(hi==0)wsf[32+r32]=l_reg;asm volatile("s_waitcnt lgkmcnt(0)":::"memory");
  float rli[16];
  #pragma unroll
  for(int r=0;r<16;++r)rli[r]=__builtin_amdgcn_rcpf(wsf[32+crow(r,hi)]);
  bf16*Ow=Ou+(long)(wid*QBLK)*OP;
  { bf16*stg=(bf16*)(shm+LDS_OST)+wid*2048;
    #pragma unroll
    for(int r=0;r<16;++r){const int orow=crow(r,hi);
      #pragma unroll
      for(int d0=0;d0<2;++d0)stg[orow*64+d0*32+r32]=__float2bfloat16(o[d0][r]*rli[r]);}
    asm volatile("s_waitcnt lgkmcnt(0)":::"memory");
    #pragma unroll
    for(int i=0;i<4;++i){const int row=i*8+(lane>>3),ch=lane&7; const u32x4 v=*(const u32x4*)(stg+row*64+ch*8); ATTN_STORE16(Ow+(long)row*OP+ch*8,v);} }
  asm volatile("s_waitcnt lgkmcnt(0)\n\ts_barrier":::"memory");
  #undef TROW
  #undef DMA_K
  #undef DMA_V
  #undef CMASK
  #undef START
  #undef RESC
  #undef ROT
}
constexpr int ATTN_LDS_BYTES=LDS_BYTES;
#undef SBAR
#undef WAIT_BAR
}
constexpr int DM = 2048, SEQ = 16384, CTXN = 256, MR = SEQ + CTXN, DEPTH = 4;
constexpr int DFF = 5632, NFF = 2 * DFF, DIN = 12312, NP = 12288;
constexpr int PC_Z = 0, PC_XBC = 768, PC_U = 2048, PC_SQ = 2560, PC_SK = 3072, PC_SV = 3200, PC_GQ = 3328, PC_GK = 3840, PC_GV = 3968, PC_GATE = 4096;
constexpr int NMODV = 9 * DM;
constexpr float LOG2E = 1.4426950408889634f;
constexpr float QSCALE = 0.125f * LOG2E;
constexpr int NWAVES = 8;
enum { I_X = 0, I_C, I_CTX, I_CCTX, I_WMOD, I_BMOD, I_NORMG, I_FFIN, I_FFOUT, I_WIN, I_CONVW, I_CONVB, I_ALOG, I_DTB, I_SSDD, I_SSDNG, I_S5ARE, I_S5AIM, I_S5LDT, I_S5BRE, I_S5BIM,
       I_S5CRE, I_S5CIM, I_S5D, I_GLUW, I_GLUB, I_SWAG, I_SINK, I_GLBG, I_BRSSD, I_BRS5, I_BRSWA, I_BRGLB, I_WOUT, N_IN };

constexpr size_t al256(size_t x) { return (x + 255) & ~(size_t)255; }
constexpr size_t WS_CTL = 0, CTL_ZERO_BYTES = 64u << 10;
constexpr size_t WS_MODP = CTL_ZERO_BYTES;
constexpr size_t WS_MOD = WS_MODP + al256((size_t)DEPTH * 32 * 2 * NMODV * 4);
constexpr size_t WS_X = WS_MOD + al256((size_t)DEPTH * 2 * NMODV * 4);
constexpr size_t WS_H = WS_X + al256((size_t)MR * DM * 4);
constexpr size_t WS_HID = WS_H + al256((size_t)MR * DM * 2);
constexpr size_t WS_P = WS_HID + al256((size_t)MR * DFF * 2);
constexpr size_t WS_DTRAW = WS_P + al256((size_t)MR * NP * 2);
constexpr size_t WS_DT = WS_DTRAW + al256((size_t)MR * 32 * 4);
constexpr size_t WS_XBC = WS_DT + al256((size_t)MR * 24 * 4);
constexpr size_t WS_QS = WS_XBC + al256((size_t)MR * 1280 * 4);
constexpr size_t WS_QG = WS_QS + al256((size_t)MR * 512 * 2);
constexpr size_t WS_KS = WS_QG + al256((size_t)MR * 512 * 2);
constexpr size_t WS_KG = WS_KS + al256((size_t)MR * 128 * 2);
constexpr size_t WS_YS = WS_KG + al256((size_t)MR * 128 * 2);
constexpr size_t WS_YBF = WS_YS + al256((size_t)2 * MR * 768 * 4);
constexpr size_t WS_S5END = WS_YBF + al256((size_t)2 * MR * 512 * 4);
constexpr size_t WS_S5IN = WS_S5END + al256((size_t)64 * 260 * 128 * 4);
constexpr size_t WS_XSN = WS_S5IN + al256((size_t)64 * 260 * 128 * 4);
constexpr size_t WS_XT = WS_XSN + al256((size_t)MR * 768 * 2);
constexpr size_t WS_BN = WS_XT + al256((size_t)MR * 768 * 2);
constexpr size_t WS_CN = WS_BN + al256((size_t)MR * 256 * 2);
constexpr size_t WS_BT = WS_CN + al256((size_t)MR * 256 * 2);
constexpr size_t WS_STATES = WS_BT + al256((size_t)MR * 256 * 2);
constexpr size_t WS_SINB = WS_STATES + al256((size_t)260 * 24 * 8192 * 4);
constexpr size_t WS_CHD = WS_SINB + al256((size_t)260 * 24 * 8192 * 2);
constexpr size_t WS_YALL = WS_CHD + al256((size_t)260 * 24 * 4);
constexpr int YPITCH = 2304, YC_B = 768, YC_C = 1280, YC_D = 1792;
constexpr size_t WS_YBP = WS_YALL + al256((size_t)MR * YPITCH * 2);
constexpr size_t WS_MGF = WS_YBP + al256((size_t)MR * 512 * 2);
constexpr size_t WS_MG = WS_MGF + al256((size_t)MR * DM * 4);
constexpr size_t WS_W = WS_MG + al256((size_t)MR * DM * 2);
constexpr size_t WL_FFI = 0;
constexpr size_t WL_FFO = WL_FFI + (size_t)2 * NFF * DM;
constexpr size_t WL_WIN = WL_FFO + (size_t)2 * DM * DFF;
constexpr size_t WL_WDT = WL_WIN + (size_t)NP * DM;
constexpr size_t WL_GLU = WL_WDT + (size_t)32 * DM;
constexpr size_t WL_BRALL = WL_GLU + (size_t)1024 * 512;
constexpr size_t WL_OUT = WL_BRALL + (size_t)DM * YPITCH;
constexpr size_t WL_SIZE = WL_OUT + (size_t)DM * DM;
constexpr size_t WS_PART = WS_W + al256((size_t)DEPTH * WL_SIZE * 2);
constexpr size_t WS_END = WS_PART + al256((size_t)11 * 256 * DM * 4);
constexpr int CW_BAR = 4096;

constexpr int RING_OFF = 0, RING_BYTES = 131072;
constexpr int LDSCTL_OFF = RING_BYTES, MISC_OFF = LDSCTL_OFF + 320;
constexpr int LDS_BYTES = 147456;

#define GAS __attribute__((address_space(1)))
#define LAS __attribute__((address_space(3)))
typedef unsigned short bf16;
typedef unsigned v4u __attribute__((ext_vector_type(4)));
typedef unsigned v2u __attribute__((ext_vector_type(2)));
typedef float f32x4 __attribute__((ext_vector_type(4)));
typedef short bf16x8 __attribute__((ext_vector_type(8)));
typedef GAS unsigned gu32;
#define RLX_AGENT __ATOMIC_RELAXED, __HIP_MEMORY_SCOPE_AGENT
#define LDS_WAIT() asm volatile("s_waitcnt lgkmcnt(0)" ::: "memory")
#define VM_WAIT() asm volatile("s_waitcnt vmcnt(0)" ::: "memory")
__device__ __forceinline__ unsigned f2bf(float f) { unsigned u = __builtin_bit_cast(unsigned, f); return (u + 0x7fffu + ((u >> 16) & 1u)) >> 16; }
__device__ __forceinline__ unsigned pk2(float lo, float hi) { return f2bf(lo) | (f2bf(hi) << 16); }
__device__ __forceinline__ float bflo(unsigned w) { return __uint_as_float(w << 16); }
__device__ __forceinline__ float bfhi(unsigned w) { return __uint_as_float(w & 0xffff0000u); }
__device__ __forceinline__ float bf1(bf16 h) { return __uint_as_float(((unsigned)h) << 16); }
__device__ __forceinline__ float sigm_(float x) { return __builtin_amdgcn_rcpf(1.0f + __builtin_amdgcn_exp2f(-LOG2E * x)); }
__device__ __forceinline__ float silu_(float x) { return x * sigm_(x); }
#define XB_TMO      128
#define XB_XCNT(j)  (256  + 64 * (j))
#define XB_XSUB(j)  (1280 + 64 * (j))
#define XB_XGEN(j)  (2304 + 64 * (j))
#define XB_TOP      3328
#define XB_TOPGEN   3392
#define XCD_BAR_WORDS 3456
#define XB_SPIN_CAP (1u << 18)

__device__ __forceinline__ unsigned xb_ld(unsigned* p)              { return __hip_atomic_load(p, __ATOMIC_RELAXED, __HIP_MEMORY_SCOPE_AGENT); }
__device__ __forceinline__ unsigned xb_add(unsigned* p, unsigned v) { return __hip_atomic_fetch_add(p, v, __ATOMIC_RELAXED, __HIP_MEMORY_SCOPE_AGENT); }
__device__ __forceinline__ unsigned xb_xcc_id() { return (unsigned)__builtin_amdgcn_s_getreg((3 << 11) | 20) & 0xFu; }
#define XB_SPIN(cond, bar) do { unsigned _sp = 0; while (cond) { __builtin_amdgcn_s_sleep(1); \
    if ((++_sp & 255u) == 0u) { if (xb_ld(&(bar)[XB_TMO])) break; if (_sp > XB_SPIN_CAP) { atomicAdd(&(bar)[XB_TMO], 1u); break; } } } } while (0)

struct XcdBarrier {
    unsigned* bar; unsigned x;
    volatile LAS unsigned* st;
};

__device__ __forceinline__ XcdBarrier xcd_barrier_post(unsigned* bar, volatile LAS unsigned* st) {
    XcdBarrier b; b.bar = bar; b.x = xb_xcc_id(); b.st = st;
    if (threadIdx.x == 0) (void)xb_add(&bar[XB_XCNT(b.x)], 1u);
    return b;
}
__device__ __forceinline__ void xcd_barrier_complete(unsigned* bar, unsigned x, unsigned& nloc, unsigned& nx) {
    const unsigned G = gridDim.x * gridDim.y * gridDim.z;
    unsigned sum, cnt, mine, sp = 0u;
    for (;;) {
        sum = 0u; cnt = 0u; mine = 0u;
#pragma unroll
        for (unsigned j = 0; j < 16; ++j) { const unsigned c = xb_ld(&bar[XB_XCNT(j)]); sum += c; cnt += (c > 0u) ? 1u : 0u; }
        mine = xb_ld(&bar[XB_XCNT(x)]);
        if (sum == G) break;
        __builtin_amdgcn_s_sleep(1);
        if ((++sp & 255u) == 0u) { if (xb_ld(&bar[XB_TMO])) break; if (sp > XB_SPIN_CAP) { atomicAdd(&bar[XB_TMO], 1u); break; } }
    }
    nloc = mine > 0u ? mine : 1u; nx = cnt > 0u ? cnt : 1u;
}

__device__ __forceinline__ void xcd_barrier(const XcdBarrier& b) {
    asm volatile("s_waitcnt vmcnt(0)" ::: "memory");
    __syncthreads();
    if (threadIdx.x == 0) {
        unsigned* bar = b.bar;
        __builtin_amdgcn_s_waitcnt(0);
        unsigned nloc = b.st[0], nx = b.st[1];
        if (nloc == 0u) { xcd_barrier_complete(bar, b.x, nloc, nx); b.st[0] = nloc; b.st[1] = nx; }
        const unsigned old = xb_add(&bar[XB_XSUB(b.x)], 1u);
        const unsigned gen = old / nloc;
        if (old + 1u == (gen + 1u) * nloc) {
            __builtin_amdgcn_fence(__ATOMIC_RELEASE, "agent");
            asm volatile("s_waitcnt vmcnt(0)" ::: "memory");
            const unsigned og = xb_add(&bar[XB_TOP], 1u);
            const unsigned tg = og / nx;
            if (og + 1u == (tg + 1u) * nx) xb_add(&bar[XB_TOPGEN], 1u);
            else XB_SPIN(xb_ld(&bar[XB_TOPGEN]) == tg, bar);
            __builtin_amdgcn_fence(__ATOMIC_ACQUIRE, "agent");
            xb_add(&bar[XB_XGEN(b.x)], 1u);
            asm volatile("s_waitcnt vmcnt(0)" ::: "memory");
        } else {
            XB_SPIN(xb_ld(&bar[XB_XGEN(b.x)]) == gen, bar);
            __builtin_amdgcn_fence(__ATOMIC_ACQUIRE, "agent");
            asm volatile("s_waitcnt vmcnt(0)" ::: "memory");
        }
    }
    __syncthreads();
}
struct Args { const float* in[N_IN]; float* out; unsigned char* ws; int ph_lo, ph_hi; };
typedef const volatile __attribute__((address_space(4))) Args* KArgs;
#define AIN(i) ((const float*)(const __attribute__((address_space(1))) float*)a->in[i])
struct Frame {
    LAS unsigned char* lds;
    volatile LAS unsigned* MISC;
    gu32* ctl;
    int tid, lane, wave;
    int vcu, G;
    unsigned char* ws;
};
__device__ __forceinline__ Frame fresh(const Frame& F) { Frame Fp = F; unsigned long long w = (unsigned long long)F.ws; asm volatile("" : "+v"(Fp.tid), "+s"(Fp.vcu), "+s"(w)); Fp.ws = (unsigned char*)(GAS unsigned char*)w; Fp.lane = Fp.tid & 63; Fp.wave = __builtin_amdgcn_readfirstlane(Fp.tid >> 6); return Fp; }
__device__ __forceinline__ float bperm(float v, int srclane) { return __int_as_float(__builtin_amdgcn_ds_bpermute(srclane << 2, __float_as_int(v))); }
__device__ __forceinline__ float wave_sum(float v, int lane) {
#pragma unroll
    for (int o = 1; o < 64; o <<= 1) v += bperm(v, lane ^ o);
    return v;
}
__device__ __forceinline__ int rowof(int dir, int s) { return dir ? (MR - 1 - s) : (s < CTXN ? SEQ + s : s - CTXN); }
__device__ __forceinline__ void sincos_hw(float ang, float& s, float& c) { float r = ang * 0.15915494309189535f; r = r - floorf(r); s = __builtin_amdgcn_sinf(r); c = __builtin_amdgcn_cosf(r); }

__device__ __forceinline__ void transpose_item(const float* W, int ldw, int Nsrc, int src_c0, bf16* WT, int dst_r0, int k0, int nvalid, LAS float* scr, int lane, int my_col = -1) {
#pragma unroll 8
    for (int i = 0; i < 32; ++i) { const int kk = 2 * i + (lane >> 5); scr[kk * 33 + (lane & 31)] = __builtin_nontemporal_load(W + (size_t)(k0 + kk) * Nsrc + (my_col >= 0 ? my_col : src_c0 + (lane & 31))); }
    LDS_WAIT(); asm volatile("" ::: "memory");
    const int c = lane & 7;
#pragma unroll
    for (int j = 0; j < 4; ++j) { const int n = (lane >> 3) + 8 * j; const LAS float* s = scr + (8 * c) * 33 + n;
        v4u o; o.x = pk2(s[0 * 33], s[1 * 33]); o.y = pk2(s[2 * 33], s[3 * 33]); o.z = pk2(s[4 * 33], s[5 * 33]); o.w = pk2(s[6 * 33], s[7 * 33]);
        if (n >= nvalid) o = (v4u){0u, 0u, 0u, 0u};
        __builtin_nontemporal_store(o, (GAS v4u*)(WT + (size_t)(dst_r0 + n) * ldw + k0 + 8 * c)); }
    LDS_WAIT(); asm volatile("" ::: "memory");
}
constexpr int IT_FFI = 32 * 352, IT_FFO = 88 * 64, IT_WIN = 32 * 384, IT_GLU = 8 * 32, IT_BRA = 12 * 64, IT_BRX = 8 * 64, IT_OUT = 32 * 64, IT_WDT = 32;
constexpr int IT_LAYER = 2 * IT_FFI + 2 * IT_FFO + IT_WIN + IT_GLU + IT_BRA + 3 * IT_BRX + IT_OUT + IT_WDT;
#ifndef HIDE_CONVERT
#define HIDE_CONVERT 0
#endif
constexpr int IT_GA = IT_FFI + IT_FFO, IT_GB = IT_WIN + IT_WDT, IT_GC = IT_GLU + IT_BRA + 3 * IT_BRX + IT_OUT, IT_GD = IT_FFI + IT_FFO;
static_assert(IT_GA + IT_GB + IT_GC + IT_GD == IT_LAYER, "item groups");
__device__ __forceinline__ void convert_item(Frame& F, KArgs a, int l, int r, LAS float* scr) {
    bf16* wl = (bf16*)(F.ws + WS_W) + (size_t)l * WL_SIZE;
    int f = 0; if (r >= IT_GA + IT_GB + IT_GC) { f = 1; r -= IT_GA + IT_GB + IT_GC; }
    if (r < IT_FFI) { const int kb = r / 352, gd = r % 352, pn = gd >> 3, w = gd & 7; const int sc0 = (w < 4) ? 128 * pn + 32 * w : DFF + 128 * pn + 32 * (w - 4);
        transpose_item(AIN(I_FFIN) + (size_t)(l * 2 + f) * DM * NFF, DM, NFF, sc0, wl + WL_FFI + (size_t)f * NFF * DM, 32 * gd, 64 * kb, 32, scr, F.lane); return; } r -= IT_FFI;
    if (r < IT_FFO) { const int kb = r / 64, gd = r % 64;
        transpose_item(AIN(I_FFOUT) + (size_t)(l * 2 + f) * DFF * DM, DFF, DM, 32 * gd, wl + WL_FFO + (size_t)f * DM * DFF, 32 * gd, 64 * kb, 32, scr, F.lane); return; } r -= IT_FFO;
    if (r < IT_WIN) { const int kb = r / 384, gd = r % 384; const int d0 = 32 * gd;
        int mc = -1;
        if (d0 >= PC_GATE) { const int j = (d0 - PC_GATE) >> 8, w = (d0 >> 5) & 7, bj = w >> 2, wc = w & 3, o = F.lane & 31, fq = o >> 3, n = (o >> 2) & 1, i = o & 3;
            mc = (DIN - 4 * DM) + 2048 * (2 * bj + n) + 64 * j + 16 * wc + 4 * fq + i; }
        transpose_item(AIN(I_WIN) + (size_t)l * DM * DIN, DM, DIN, d0 < 2048 ? d0 : d0 + 24, wl + WL_WIN, d0, 64 * kb, 32, scr, F.lane, mc); return; } r -= IT_WIN;
    if (r < IT_WDT) { transpose_item(AIN(I_WIN) + (size_t)l * DM * DIN, DM, DIN, 2048, wl + WL_WDT, 0, 64 * r, 24, scr, F.lane); return; } r -= IT_WDT;
    if (r < IT_GLU) { const int kb = r / 32, gd = r % 32, pn = gd >> 3, w = gd & 7; const int sc0 = (w < 4) ? 128 * pn + 32 * w : 512 + 128 * pn + 32 * (w - 4);
        transpose_item(AIN(I_GLUW) + (size_t)l * 512 * 1024, 512, 1024, sc0, wl + WL_GLU, 32 * gd, 64 * kb, 32, scr, F.lane); return; } r -= IT_GLU;
    if (r < IT_BRA) { const int kb = r / 64, gd = r % 64;
        transpose_item(AIN(I_BRSSD) + (size_t)l * 768 * DM, YPITCH, DM, 32 * gd, wl + WL_BRALL, 32 * gd, 64 * kb, 32, scr, F.lane); return; } r -= IT_BRA;
    if (r < 3 * IT_BRX) { const int b = r / IT_BRX; r %= IT_BRX; const int kb = r / 64, gd = r % 64;
        const float* src = (b == 0 ? AIN(I_BRS5) : (b == 1 ? AIN(I_BRSWA) : AIN(I_BRGLB))) + (size_t)l * 512 * DM;
        transpose_item(src, YPITCH, DM, 32 * gd, wl + WL_BRALL + YC_B + 512 * b, 32 * gd, 64 * kb, 32, scr, F.lane); return; } r -= 3 * IT_BRX;
    { const int kb = r / 64, gd = r % 64; transpose_item(AIN(I_WOUT) + (size_t)l * DM * DM, DM, DM, 32 * gd, wl + WL_OUT, 32 * gd, 64 * kb, 32, scr, F.lane); }
}
__device__ __forceinline__ void convert_range(Frame& F, KArgs a, int l, int first, int n, int widx, int wstride) {
    LAS float* scr = (LAS float*)(F.lds + RING_OFF + F.wave * 16384);
    for (int it = first + widx; it < first + n; it += wstride) convert_item(F, a, l, it, scr);
}
__device__ __forceinline__ void convert_idle(Frame& F, KArgs a, int c, int rem, int l, int first, int n) {
    if (c < rem || l >= DEPTH) return;
    convert_range(F, a, l, first, n, (c - rem) * NWAVES + F.wave, (F.G - rem) * NWAVES);
}
__device__ __forceinline__ void p0_prologue(Frame& F, KArgs a) {
    const int gw = F.vcu * NWAVES + F.wave, NGW = F.G * NWAVES;
#if HIDE_CONVERT
    convert_range(F, a, 0, 0, IT_GA, gw, NGW);
#else
    for (int l = 0; l < DEPTH; ++l) convert_range(F, a, l, 0, IT_LAYER, gw, NGW);
#endif
    float* X = (float*)(F.ws + WS_X);
    for (int m = gw; m < MR; m += NGW) {
        const GAS f32x4* src = (const GAS f32x4*)(m < SEQ ? AIN(I_X) + (size_t)m * DM : AIN(I_CTX) + (size_t)(m - SEQ) * DM) + F.lane; GAS f32x4* dst = (GAS f32x4*)(X + (size_t)m * DM) + F.lane;
#pragma unroll
        for (int j = 0; j < 8; ++j) dst[64 * j] = src[64 * j];
    }
    __syncthreads();
    LAS float* sc = (LAS float*)(F.lds + RING_OFF);
    for (int i = F.tid; i < 2 * DM; i += NWAVES * 64) { const float c = (i < DM) ? AIN(I_C)[i] : AIN(I_CCTX)[i - DM]; sc[i] = silu_(c); }
    __syncthreads();
    float* MODP = (float*)(F.ws + WS_MODP);
    for (int it = F.vcu; it < DEPTH * 32 * 9; it += F.G) {
        const int l = it / 288, r = it % 288, s = r / 9, b = r % 9, col = b * 2048 + 4 * F.tid;
        const float* w = AIN(I_WMOD) + (size_t)l * DM * NMODV + (size_t)(64 * s) * NMODV + col;
        f32x4 a0 = {0.f, 0.f, 0.f, 0.f}, a1 = {0.f, 0.f, 0.f, 0.f};
#pragma unroll 8
        for (int k = 0; k < 64; ++k) { const f32x4 wv = __builtin_nontemporal_load((const f32x4*)(w + (size_t)k * NMODV)); a0 += wv * sc[64 * s + k]; a1 += wv * sc[DM + 64 * s + k]; }
        *(f32x4*)(MODP + (size_t)((l * 32 + s) * 2 + 0) * NMODV + col) = a0; *(f32x4*)(MODP + (size_t)((l * 32 + s) * 2 + 1) * NMODV + col) = a1;
    }
}
__device__ __forceinline__ void p1_modfinal(Frame& F, KArgs a) {
    const float* MODP = (const float*)(F.ws + WS_MODP); float* MOD = (float*)(F.ws + WS_MOD);
    for (int i = F.vcu * 512 + F.tid; i < DEPTH * 2 * NMODV; i += F.G * 512) {
        const int l = i / (2 * NMODV), v = (i / NMODV) & 1, j = i % NMODV; float s = AIN(I_BMOD)[l * NMODV + j];
#pragma unroll
        for (int q = 0; q < 32; ++q) s += MODP[(size_t)((l * 32 + q) * 2 + v) * NMODV + j];
        MOD[i] = s;
    }
}
__device__ __forceinline__ void norm_phase(Frame& F, KArgs a, int l, int k, int nsl) {
    const int gw = F.vcu * NWAVES + F.wave, NGW = F.G * NWAVES;
    const float* X = (const float*)(F.ws + WS_X); bf16* H = (bf16*)(F.ws + WS_H);
    const float* g = AIN(I_NORMG) + (size_t)(l * 3 + k) * DM;
    for (int v = 0; v < 2; ++v) {
        const float* mod = (const float*)(F.ws + WS_MOD) + (size_t)(l * 2 + v) * NMODV; const float* shift = mod + (3 * k) * DM; const float* scale = mod + (3 * k + 1) * DM;
        f32x4 gs[8], sh[8];
#pragma unroll
        for (int j = 0; j < 8; ++j) { const int c = 4 * F.lane + 256 * j; const f32x4 gg = *(const f32x4*)(g + c), ss = *(const f32x4*)(scale + c); gs[j] = gg * (ss + 1.0f); sh[j] = *(const f32x4*)(shift + c); }
        const int r0 = v ? SEQ : 0, r1 = v ? MR : SEQ;
        if (v == 0) {
            for (int m = r0 + gw; m < r1; m += 2 * NGW) {
                const bool two = m + NGW < r1; const int m2 = two ? m + NGW : m;
                const GAS f32x4* xa = (const GAS f32x4*)(X + (size_t)m * DM) + F.lane; const GAS f32x4* xb = (const GAS f32x4*)(X + (size_t)m2 * DM) + F.lane; f32x4 a[8], b[8]; float sa = 0.f, sb = 0.f;
#pragma unroll
                for (int j = 0; j < 8; ++j) { a[j] = __builtin_nontemporal_load(xa + 64 * j); b[j] = __builtin_nontemporal_load(xb + 64 * j); }
#pragma unroll
                for (int j = 0; j < 8; ++j) { sa += (a[j].x * a[j].x + a[j].y * a[j].y) + (a[j].z * a[j].z + a[j].w * a[j].w); sb += (b[j].x * b[j].x + b[j].y * b[j].y) + (b[j].z * b[j].z + b[j].w * b[j].w); }
                const float ra = 1.0f / sqrtf(wave_sum(sa, F.lane) * (1.0f / DM) + 1e-6f), rb = 1.0f / sqrtf(wave_sum(sb, F.lane) * (1.0f / DM) + 1e-6f);
                GAS v2u* oa = (GAS v2u*)(H + (size_t)m * DM) + F.lane; GAS v2u* ob = (GAS v2u*)(H + (size_t)m2 * DM) + F.lane;
#pragma unroll
                for (int j = 0; j < 8; ++j) { const f32x4 y = a[j] * ra * gs[j] + sh[j]; v2u w; w.x = pk2(y.x, y.y); w.y = pk2(y.z, y.w); oa[64 * j] = w; }
                if (two) {
#pragma unroll
                    for (int j = 0; j < 8; ++j) { const f32x4 y = b[j] * rb * gs[j] + sh[j]; v2u w; w.x = pk2(y.x, y.y); w.y = pk2(y.z, y.w); ob[64 * j] = w; } }
            }
        } else
        for (int m = r0 + gw; m < r1; m += NGW) {
            const GAS f32x4* xr = (const GAS f32x4*)(X + (size_t)m * DM) + F.lane; f32x4 x[8]; float s = 0.f;
#pragma unroll
            for (int j = 0; j < 8; ++j) x[j] = xr[64 * j];
            if (v == 1 && nsl > 0) { const float* PART = (const float*)(F.ws + WS_PART);
                for (int sl = 0; sl < nsl; ++sl) { const GAS f32x4* pr = (const GAS f32x4*)(PART + ((size_t)sl * 256 + (m - SEQ)) * DM) + F.lane;
#pragma unroll
                    for (int j = 0; j < 8; ++j) x[j] += pr[64 * j]; }
                GAS f32x4* xw = (GAS f32x4*)((float*)(F.ws + WS_X) + (size_t)m * DM) + F.lane;
#pragma unroll
                for (int j = 0; j < 8; ++j) xw[64 * j] = x[j]; }
#pragma unroll
            for (int j = 0; j < 8; ++j) s += (x[j].x * x[j].x + x[j].y * x[j].y) + (x[j].z * x[j].z + x[j].w * x[j].w);
            const float rstd = 1.0f / sqrtf(wave_sum(s, F.lane) * (1.0f / DM) + 1e-6f);
            GAS v2u* o = (GAS v2u*)(H + (size_t)m * DM) + F.lane;
#pragma unroll
            for (int j = 0; j < 8; ++j) { const f32x4 y = x[j] * rstd * gs[j] + sh[j]; v2u w; w.x = pk2(y.x, y.y); w.y = pk2(y.z, y.w); o[64 * j] = w; }
        }
    }
}
__device__ __forceinline__ void dt_gemm(Frame& F, int l, int c, int rem) {
    if (c < rem) return;
    const int gw = (c - rem) * NWAVES + F.wave, NGW = (F.G - rem) * NWAVES;
    const bf16* H = (const bf16*)(F.ws + WS_H); const bf16* Wd = (const bf16*)(F.ws + WS_W) + (size_t)l * WL_SIZE + WL_WDT; float* DTR = (float*)(F.ws + WS_DTRAW);
    const int fr = F.lane & 15, fq = F.lane >> 4;
    for (int t = gw; t < MR / 16; t += NGW) {
        const bf16* ap = H + (size_t)(16 * t + fr) * DM + 8 * fq; const bf16* b0 = Wd + (size_t)fr * DM + 8 * fq; const bf16* b1 = Wd + (size_t)(16 + fr) * DM + 8 * fq;
        f32x4 c0 = {0.f, 0.f, 0.f, 0.f}, c1 = {0.f, 0.f, 0.f, 0.f};
#pragma unroll 4
        for (int k0 = 0; k0 < DM; k0 += 32) { const bf16x8 av = *(const bf16x8*)(ap + k0), bv0 = *(const bf16x8*)(b0 + k0), bv1 = *(const bf16x8*)(b1 + k0);
            c0 = __builtin_amdgcn_mfma_f32_16x16x32_bf16(av, bv0, c0, 0, 0, 0); c1 = __builtin_amdgcn_mfma_f32_16x16x32_bf16(av, bv1, c1, 0, 0, 0); }
#pragma unroll
        for (int r = 0; r < 4; ++r) { float* o = DTR + (size_t)(16 * t + 4 * fq + r) * 32 + fr; o[0] = c0[r]; o[16] = c1[r]; }
    }
}
struct S5Disc { float lb_re, lb_im, bb_re[16], bb_im[16]; };
__device__ __forceinline__ void s5_disc(KArgs a, int l, int dir, int g, int p, S5Disc& d) {
    const int ig = (l * 2 + dir) * 32 + g; const float a_re = AIN(I_S5ARE)[ig * 64 + p], a_im = AIN(I_S5AIM)[ig * 64 + p]; const float dt = __expf(AIN(I_S5LDT)[ig]);
    const float mag = __expf(a_re * dt); float sn, cs; sincos_hw(a_im * dt, sn, cs);
    d.lb_re = mag * cs; d.lb_im = mag * sn;
    const float den = a_re * a_re + a_im * a_im, nr = d.lb_re - 1.0f, ni = d.lb_im;
    const float f_re = (nr * a_re + ni * a_im) / den, f_im = (ni * a_re - nr * a_im) / den;
    const float* br = AIN(I_S5BRE) + (size_t)((l * 32 + g) * 64 + p) * 16; const float* bi = AIN(I_S5BIM) + (size_t)((l * 32 + g) * 64 + p) * 16;
#pragma unroll
    for (int h = 0; h < 16; ++h) { const float x = br[h], y = bi[h]; d.bb_re[h] = f_re * x - f_im * y; d.bb_im[h] = f_re * y + f_im * x; }
}
typedef float f32x16 __attribute__((ext_vector_type(16)));
struct S5Pow { float r1, i1, r2, i2, r3, i3, r4, i4; };
__device__ __forceinline__ void s5_pow(const S5Disc& d, S5Pow& p) { p.r1 = d.lb_re; p.i1 = d.lb_im; p.r2 = p.r1 * p.r1 - p.i1 * p.i1; p.i2 = 2.0f * p.r1 * p.i1; p.r3 = p.r2 * p.r1 - p.i2 * p.i1; p.i3 = p.r2 * p.i1 + p.i2 * p.r1; p.r4 = p.r2 * p.r2 - p.i2 * p.i2; p.i4 = 2.0f * p.r2 * p.i2; }
__device__ __forceinline__ bf16x8 pack8(const float (&v)[16], bool hi) { v4u w; w.x = pk2(hi ? v[8] : v[0], hi ? v[9] : v[1]); w.y = pk2(hi ? v[10] : v[2], hi ? v[11] : v[3]); w.z = pk2(hi ? v[12] : v[4], hi ? v[13] : v[5]); w.w = pk2(hi ? v[14] : v[6], hi ? v[15] : v[7]); return __builtin_bit_cast(bf16x8, w); }
template <bool FIX> __device__ __forceinline__ void s5_state_scan(f32x16& R, f32x16& I, const S5Pow& p, float& cr, float& ci, bool hi) {
#pragma unroll
    for (int k = 0; k < 4; ++k)
#pragma unroll
        for (int j = 1; j < 4; ++j) { const int x = 4 * k + j; const float nr = p.r1 * R[x - 1] - p.i1 * I[x - 1] + R[x], ni = p.r1 * I[x - 1] + p.i1 * R[x - 1] + I[x]; R[x] = nr; I[x] = ni; }
    float cinr[4], cini[4], ce_r = 0.f, ce_i = 0.f;
#pragma unroll
    for (int G = 0; G < 8; ++G) { const int k = G >> 1;
        if ((G & 1) == 0) { ce_r = cr; ce_i = ci; } else { cinr[k] = hi ? cr : ce_r; cini[k] = hi ? ci : ce_i; }
        const float vr = p.r4 * cr - p.i4 * ci + R[4 * k + 3], vi = p.r4 * ci + p.i4 * cr + I[4 * k + 3];
        const auto sr = __builtin_amdgcn_permlane32_swap(__float_as_uint(vr), __float_as_uint(vr), false, false); const auto si = __builtin_amdgcn_permlane32_swap(__float_as_uint(vi), __float_as_uint(vi), false, false);
        cr = __uint_as_float(sr[G & 1]); ci = __uint_as_float(si[G & 1]); }
    if (FIX) {
#pragma unroll
        for (int k = 0; k < 4; ++k) { const float a = cinr[k], b = cini[k];
            R[4 * k + 0] += p.r1 * a - p.i1 * b; I[4 * k + 0] += p.r1 * b + p.i1 * a; R[4 * k + 1] += p.r2 * a - p.i2 * b; I[4 * k + 1] += p.r2 * b + p.i2 * a;
            R[4 * k + 2] += p.r3 * a - p.i3 * b; I[4 * k + 2] += p.r3 * b + p.i3 * a; R[4 * k + 3] += p.r4 * a - p.i4 * b; I[4 * k + 3] += p.r4 * b + p.i4 * a; }
    }
}
template <bool PASS2> __device__ __forceinline__ void s5_pass(Frame& F, KArgs a, int l) {
    const int gw = F.vcu * NWAVES + F.wave, NGW = F.G * NWAVES;
    if (NGW % 64 != 0) return;
    const int q = gw & 63, dir = q >> 5, g = q & 31, lane = F.lane, s = lane & 31; const bool hi = lane >= 32;
    S5Pow pA, pB; bf16x8 bbf[4];
    { S5Disc dA, dB; s5_disc(a, l, dir, g, s, dA); s5_disc(a, l, dir, g, s + 32, dB); s5_pow(dA, pA); s5_pow(dB, pB);
      bbf[0] = pack8(dA.bb_re, hi); bbf[1] = pack8(dB.bb_re, hi); bbf[2] = pack8(dA.bb_im, hi); bbf[3] = pack8(dB.bb_im, hi); }
    bf16x8 cmf[4];
    if (PASS2) { const int h = lane & 15, q4 = lane >> 4;
#pragma unroll
        for (int ks = 0; ks < 4; ++ks) { const float* src = (ks < 2 ? AIN(I_S5CRE) : AIN(I_S5CIM)) + (size_t)((l * 32 + g) * 16 + h) * 64 + 32 * (ks & 1) + 8 * q4; const float sg = ks < 2 ? 1.0f : -1.0f;
            const f32x4 v0 = *(const f32x4*)src * sg, v1 = *(const f32x4*)(src + 4) * sg; v4u w; w.x = pk2(v0.x, v0.y); w.y = pk2(v0.z, v0.w); w.z = pk2(v1.x, v1.y); w.w = pk2(v1.z, v1.w); cmf[ks] = __builtin_bit_cast(bf16x8, w); } }
    float* END = (float*)(F.ws + WS_S5END); const float* SIN = (const float*)(F.ws + WS_S5IN); const bf16* P = (const bf16*)(F.ws + WS_P); float* YBF = (float*)(F.ws + WS_YBF);
    LAS bf16* Sb = (LAS bf16*)(F.lds + RING_OFF + F.wave * 8192);
    for (int cs = gw >> 6; cs < MR / 64; cs += NGW >> 6) {
        const size_t o = ((size_t)q * (MR / 64) + cs) * 128;
        float cAr = 0.f, cAi = 0.f, cBr = 0.f, cBi = 0.f;
        if (PASS2) { cAr = SIN[o + 2 * s]; cAi = SIN[o + 2 * s + 1]; cBr = SIN[o + 2 * (s + 32)]; cBi = SIN[o + 2 * (s + 32) + 1]; }
#pragma unroll 1
        for (int tt = 0; tt < 2; ++tt) {
            const bf16x8 uf = *(const GAS bf16x8*)(P + (size_t)rowof(dir, 64 * cs + 32 * tt + s) * NP + PC_U + 16 * g + (hi ? 8 : 0));
            const f32x16 z = {0.f, 0.f, 0.f, 0.f, 0.f, 0.f, 0.f, 0.f, 0.f, 0.f, 0.f, 0.f, 0.f, 0.f, 0.f, 0.f};
            f32x16 T0 = __builtin_amdgcn_mfma_f32_32x32x16_bf16(uf, bbf[0], z, 0, 0, 0), T1 = __builtin_amdgcn_mfma_f32_32x32x16_bf16(uf, bbf[1], z, 0, 0, 0);
            f32x16 T2 = __builtin_amdgcn_mfma_f32_32x32x16_bf16(uf, bbf[2], z, 0, 0, 0), T3 = __builtin_amdgcn_mfma_f32_32x32x16_bf16(uf, bbf[3], z, 0, 0, 0);
            s5_state_scan<PASS2>(T0, T2, pA, cAr, cAi, hi);
            s5_state_scan<PASS2>(T1, T3, pB, cBr, cBi, hi);
            if (PASS2) {
#pragma unroll
                for (int r = 0; r < 16; ++r) { const int tl = 8 * (r >> 2) + (hi ? 4 : 0) + (r & 3); LAS bf16* dst = Sb + tl * 128 + s;
                    dst[0] = (bf16)f2bf(T0[r]); dst[32] = (bf16)f2bf(T1[r]); dst[64] = (bf16)f2bf(T2[r]); dst[96] = (bf16)f2bf(T3[r]); }
                LDS_WAIT(); asm volatile("" ::: "memory");
                const int r16 = lane & 15, q4 = lane >> 4;
#pragma unroll
                for (int mt = 0; mt < 2; ++mt) { f32x4 acc = {0.f, 0.f, 0.f, 0.f};
#pragma unroll
                    for (int ks = 0; ks < 4; ++ks) { const bf16x8 af = *(const LAS bf16x8*)(Sb + (16 * mt + r16) * 128 + 32 * ks + 8 * q4); acc = __builtin_amdgcn_mfma_f32_16x16x32_bf16(af, cmf[ks], acc, 0, 0, 0); }
#pragma unroll
                    for (int rg = 0; rg < 4; ++rg) { const int row = rowof(dir, 64 * cs + 32 * tt + 16 * mt + 4 * q4 + rg); YBF[((size_t)dir * MR + row) * 512 + 16 * g + r16] = acc[rg]; } }
                LDS_WAIT(); asm volatile("" ::: "memory");
            }
        }
        if (!PASS2 && !hi) { END[o + 2 * s] = cAr; END[o + 2 * s + 1] = cAi; END[o + 2 * (s + 32)] = cBr; END[o + 2 * (s + 32) + 1] = cBi; }
    }
}
__device__ __forceinline__ void s5_carry(Frame& F, KArgs a, int l, int first_wave) {
    const int gw = F.vcu * NWAVES + F.wave - first_wave; if (gw < 0 || gw >= 64) return;
    const int q = gw, dir = q >> 5, g = q & 31, p = F.lane;
    const int ig = (l * 2 + dir) * 32 + g; const float a_re = AIN(I_S5ARE)[ig * 64 + p], a_im = AIN(I_S5AIM)[ig * 64 + p]; const float dt = __expf(AIN(I_S5LDT)[ig]);
    const float mag = __expf(a_re * dt); float sn, cs_; sincos_hw(a_im * dt, sn, cs_);
    float pr = mag * cs_, pi = mag * sn;
#pragma unroll
    for (int i = 0; i < 6; ++i) { const float nr = pr * pr - pi * pi, ni = 2.0f * pr * pi; pr = nr; pi = ni; }
    const float* END = (const float*)(F.ws + WS_S5END); float* SIN = (float*)(F.ws + WS_S5IN);
    float s_re = 0.f, s_im = 0.f;
    for (int cs = 0; cs < MR / 64; cs += 4) {
        float er[4], ei[4];
#pragma unroll
        for (int i = 0; i < 4; ++i) { const size_t o = ((size_t)q * (MR / 64) + cs + i) * 128 + 2 * p; er[i] = END[o]; ei[i] = END[o + 1]; }
#pragma unroll
        for (int i = 0; i < 4; ++i) { const size_t o = ((size_t)q * (MR / 64) + cs + i) * 128 + 2 * p; SIN[o] = s_re; SIN[o + 1] = s_im;
            const float nr = pr * s_re - pi * s_im + er[i], ni = pr * s_im + pi * s_re + ei[i]; s_re = nr; s_im = ni; }
    }
}
__device__ __forceinline__ bf16x8 ldg8(const bf16* p) { return *(const GAS bf16x8*)p; }
__device__ __forceinline__ int ssd_chunk_of(int d, int j) { return d ? (MR / 64 - 1 - j) : (j < CTXN / 64 ? SEQ / 64 + j : j - CTXN / 64); }
__device__ __forceinline__ float scan64(float v, int d, int lane) {
#pragma unroll
    for (int o = 1; o < 64; o <<= 1) { const float up = bperm(v, lane - o), dn = bperm(v, lane + o); if (d == 0) { if (lane >= o) v += up; } else { if (lane + o < 64) v += dn; } }
    return v;
}
__device__ __forceinline__ void conv_item(Frame& F, const float* cw, const float* cb_, int k, int cb) {
    LAS float* tin = (LAS float*)(F.lds + RING_OFF);
    LAS float* tout = tin + 68 * 64;
    const bf16* P = (const bf16*)(F.ws + WS_P);
    const int row0 = 64 * k, lo = k < SEQ / 64 ? 0 : SEQ, hi = k < SEQ / 64 ? SEQ : MR, c0 = 64 * cb;
    const int t = F.tid >> 3, c8 = (F.tid & 7) * 8;
    __syncthreads();
#pragma unroll
    for (int rr = t; rr < 68; rr += 64) { const int grow = row0 - 2 + rr; v4u w = (v4u){0u, 0u, 0u, 0u}; if (grow >= lo && grow < hi) w = *(const GAS v4u*)(P + (size_t)grow * NP + PC_XBC + c0 + c8);
        *(LAS f32x4*)(tin + rr * 64 + c8) = (f32x4){bflo(w.x), bfhi(w.x), bflo(w.y), bfhi(w.y)}; *(LAS f32x4*)(tin + rr * 64 + c8 + 4) = (f32x4){bflo(w.z), bfhi(w.z), bflo(w.w), bfhi(w.w)}; }
    __syncthreads();
    { f32x4 a0 = *(const f32x4*)(cb_ + c0 + c8), a1 = *(const f32x4*)(cb_ + c0 + c8 + 4);
#pragma unroll
      for (int j = 0; j < 5; ++j) { const f32x4 w0 = *(const f32x4*)(cw + j * 1280 + c0 + c8), w1 = *(const f32x4*)(cw + j * 1280 + c0 + c8 + 4);
          a0 += w0 * *(const LAS f32x4*)(tin + (t + j) * 64 + c8); a1 += w1 * *(const LAS f32x4*)(tin + (t + j) * 64 + c8 + 4); }
      float o[8];
#pragma unroll
      for (int i = 0; i < 4; ++i) { o[i] = silu_(a0[i]); o[4 + i] = silu_(a1[i]); }
#pragma unroll
      for (int i = 0; i < 8; ++i) tout[t * 65 + c8 + i] = o[i];
      v4u w; w.x = pk2(o[0], o[1]); w.y = pk2(o[2], o[3]); w.z = pk2(o[4], o[5]); w.w = pk2(o[6], o[7]);
      bf16* nat = (cb < 12) ? (bf16*)(F.ws + WS_XSN) + (size_t)(row0 + t) * 768 + c0 + c8
                : (cb < 16) ? (bf16*)(F.ws + WS_BN) + (size_t)(row0 + t) * 256 + (c0 - 768) + c8
                            : (bf16*)(F.ws + WS_CN) + (size_t)(row0 + t) * 256 + (c0 - 1024) + c8;
      *(GAS v4u*)nat = w; }
    __syncthreads();
    if (cb < 16) {
        const int c = F.tid >> 3, t8 = (F.tid & 7) * 8; float o[8];
#pragma unroll
        for (int i = 0; i < 8; ++i) o[i] = tout[(t8 + i) * 65 + c];
        v4u w; w.x = pk2(o[0], o[1]); w.y = pk2(o[2], o[3]); w.z = pk2(o[4], o[5]); w.w = pk2(o[6], o[7]);
        bf16* tr = (cb < 12) ? (bf16*)(F.ws + WS_XT) + ((size_t)(k * 12 + cb) * 64 + c) * 64 + t8
                             : (bf16*)(F.ws + WS_BT) + ((size_t)k * 256 + (c0 - 768) + c) * 64 + t8;
        *(GAS v4u*)tr = w;
    }
}
__device__ __forceinline__ void conv_wave_item(Frame& F, const float* cw, const float* cb_, int k, int c0, LAS float* buf) {
    const bf16* P = (const bf16*)(F.ws + WS_P);
    const int row0 = 64 * k, lo = k < SEQ / 64 ? 0 : SEQ, hi = k < SEQ / 64 ? SEQ : MR, t = F.lane;
    { const int g0 = row0 - 2 + t; v4u w = (v4u){0u, 0u, 0u, 0u}; if (g0 >= lo && g0 < hi) w = *(const GAS v4u*)(P + (size_t)g0 * NP + PC_XBC + c0);
      *(LAS f32x4*)(buf + t * 8) = (f32x4){bflo(w.x), bfhi(w.x), bflo(w.y), bfhi(w.y)}; *(LAS f32x4*)(buf + t * 8 + 4) = (f32x4){bflo(w.z), bfhi(w.z), bflo(w.w), bfhi(w.w)};
      if (t < 4) { const int g1 = row0 + 62 + t; v4u w1 = (v4u){0u, 0u, 0u, 0u}; if (g1 >= lo && g1 < hi) w1 = *(const GAS v4u*)(P + (size_t)g1 * NP + PC_XBC + c0);
          *(LAS f32x4*)(buf + (64 + t) * 8) = (f32x4){bflo(w1.x), bfhi(w1.x), bflo(w1.y), bfhi(w1.y)}; *(LAS f32x4*)(buf + (64 + t) * 8 + 4) = (f32x4){bflo(w1.z), bfhi(w1.z), bflo(w1.w), bfhi(w1.w)}; } }
    LDS_WAIT(); asm volatile("" ::: "memory");
    f32x4 a0 = *(const f32x4*)(cb_ + c0), a1 = *(const f32x4*)(cb_ + c0 + 4);
#pragma unroll
    for (int j = 0; j < 5; ++j) { const f32x4 w0 = *(const f32x4*)(cw + j * 1280 + c0), w1 = *(const f32x4*)(cw + j * 1280 + c0 + 4);
        a0 += w0 * *(const LAS f32x4*)(buf + (t + j) * 8); a1 += w1 * *(const LAS f32x4*)(buf + (t + j) * 8 + 4); }
    float o[8];
#pragma unroll
    for (int i = 0; i < 4; ++i) { o[i] = silu_(a0[i]); o[4 + i] = silu_(a1[i]); }
    v4u w; w.x = pk2(o[0], o[1]); w.y = pk2(o[2], o[3]); w.z = pk2(o[4], o[5]); w.w = pk2(o[6], o[7]);
    bf16* nat = (c0 < 768) ? (bf16*)(F.ws + WS_XSN) + (size_t)(row0 + t) * 768 + c0 : (c0 < 1024) ? (bf16*)(F.ws + WS_BN) + (size_t)(row0 + t) * 256 + (c0 - 768) : (bf16*)(F.ws + WS_CN) + (size_t)(row0 + t) * 256 + (c0 - 1024);
    *(GAS v4u*)nat = w;
    if (c0 < 1024) { bf16* tr = (c0 < 768) ? (bf16*)(F.ws + WS_XT) + ((size_t)(k * 12 + (c0 >> 6)) * 64 + (c0 & 63)) * 64 + t : (bf16*)(F.ws + WS_BT) + ((size_t)k * 256 + (c0 - 768)) * 64 + t;
#pragma unroll
        for (int i = 0; i < 8; ++i) tr[(size_t)i * 64] = (bf16)f2bf(o[i]); }
    LDS_WAIT(); asm volatile("" ::: "memory");
}
__device__ __forceinline__ void ssd_states(Frame& F, KArgs a, int l) {
    const int gw = F.vcu * NWAVES + F.wave, NGW = F.G * NWAVES, lane = F.lane, r = lane & 15, q = lane >> 4;
    LAS float* wb = (LAS float*)(F.lds + RING_OFF + F.wave * 2048);
    const float* DT = (const float*)(F.ws + WS_DT); const bf16* XT = (const bf16*)(F.ws + WS_XT); const bf16* BT = (const bf16*)(F.ws + WS_BT);
    bf16* ST = (bf16*)(F.ws + WS_STATES); float* CHD = (float*)(F.ws + WS_CHD); const float* alog = AIN(I_ALOG) + l * 24;
    for (int item = gw; item < (MR / 64) * 4; item += NGW) {
        const int k = item >> 2, g = (item >> 1) & 1, d = item & 1, row0 = 64 * k;
#pragma unroll
        for (int hh = 0; hh < 6; ++hh) { const int dh = d * 12 + g * 6 + hh; const float dt = DT[(size_t)(row0 + lane) * 24 + dh]; const float A = -__expf(alog[dh]);
            const float cum = scan64(A * dt, d, lane); const float tot = __int_as_float(d ? __builtin_amdgcn_readlane(__float_as_int(cum), 0) : __builtin_amdgcn_readlane(__float_as_int(cum), 63));
            wb[hh * 64 + lane] = dt * __expf(tot - cum);
            if (lane == 0) CHD[k * 24 + dh] = __expf(tot); }
        LDS_WAIT(); asm volatile("" ::: "memory");
        for (int hh = 0; hh < 6; ++hh) {
            const int h = g * 6 + hh, dh = d * 12 + h;
            bf16x8 af[4][2];
#pragma unroll
            for (int ks = 0; ks < 2; ++ks) { const f32x4 w0 = *(const LAS f32x4*)(wb + hh * 64 + 32 * ks + 8 * q), w1 = *(const LAS f32x4*)(wb + hh * 64 + 32 * ks + 8 * q + 4);
#pragma unroll
                for (int pt = 0; pt < 4; ++pt) { const v4u x = *(const GAS v4u*)(XT + ((size_t)(k * 12 + h) * 64 + 16 * pt + r) * 64 + 32 * ks + 8 * q);
                    v4u y; y.x = pk2(bflo(x.x) * w0.x, bfhi(x.x) * w0.y); y.y = pk2(bflo(x.y) * w0.z, bfhi(x.y) * w0.w); y.z = pk2(bflo(x.z) * w1.x, bfhi(x.z) * w1.y); y.w = pk2(bflo(x.w) * w1.z, bfhi(x.w) * w1.w);
                    af[pt][ks] = __builtin_bit_cast(bf16x8, y); } }
#pragma unroll
            for (int half = 0; half < 2; ++half) {
                f32x4 acc[4][4];
#pragma unroll
                for (int pt = 0; pt < 4; ++pt)
#pragma unroll
                    for (int nt = 0; nt < 4; ++nt) acc[pt][nt] = (f32x4){0.f, 0.f, 0.f, 0.f};
#pragma unroll
                for (int ks = 0; ks < 2; ++ks)
#pragma unroll
                    for (int nt = 0; nt < 4; ++nt) { const bf16x8 bv = ldg8(BT + ((size_t)(k * 2 + g) * 128 + 64 * half + 16 * nt + r) * 64 + 32 * ks + 8 * q);
#pragma unroll
                        for (int pt = 0; pt < 4; ++pt) acc[pt][nt] = __builtin_amdgcn_mfma_f32_16x16x32_bf16(af[pt][ks], bv, acc[pt][nt], 0, 0, 0); }
#pragma unroll
                for (int pt = 0; pt < 4; ++pt)
#pragma unroll
                    for (int nt = 0; nt < 4; ++nt)
#pragma unroll
                        for (int rg = 0; rg < 4; ++rg) ST[((size_t)(k * 24 + dh) * 64 + 16 * pt + 4 * q + rg) * 128 + 64 * half + 16 * nt + r] = (bf16)f2bf(acc[pt][nt][rg]);
            }
        }
        LDS_WAIT(); asm volatile("" ::: "memory");
    }
}
__device__ __forceinline__ void ssd_carry(Frame& F) {
    const bf16* ST = (const bf16*)(F.ws + WS_STATES); const float* CHD = (const float*)(F.ws + WS_CHD); bf16* SB = (bf16*)(F.ws + WS_SINB);
    for (int idx = F.vcu * 512 + F.tid; idx < 24 * 64 * 32; idx += F.G * 512) {
        const int dh = idx >> 11, rem = idx & 2047, d = dh / 12; const size_t eo = (size_t)(rem >> 5) * 128 + (rem & 31) * 4;
        f32x4 S = {0.f, 0.f, 0.f, 0.f};
        for (int j = 0; j < MR / 64; j += 4) {
            f32x4 st[4]; float dc[4]; size_t off[4];
#pragma unroll
            for (int i = 0; i < 4; ++i) { const int k = ssd_chunk_of(d, j + i); off[i] = (size_t)(k * 24 + dh) * 8192 + eo; const v2u sw = *(const GAS v2u*)(ST + off[i]); st[i] = (f32x4){bflo(sw.x), bfhi(sw.x), bflo(sw.y), bfhi(sw.y)}; dc[i] = CHD[k * 24 + dh]; }
#pragma unroll
            for (int i = 0; i < 4; ++i) { v2u w; w.x = pk2(S.x, S.y); w.y = pk2(S.z, S.w); *(GAS v2u*)(SB + off[i]) = w; S = S * dc[i] + st[i]; }
        }
    }
}
__device__ __forceinline__ void ssd_outputs(Frame& F, KArgs a, int l) {
    const int gw = F.vcu * NWAVES + F.wave, NGW = F.G * NWAVES, lane = F.lane, r = lane & 15, q = lane >> 4;
    LAS bf16* Mb = (LAS bf16*)(F.lds + RING_OFF + F.wave * 10240);
    LAS float* cumb = (LAS float*)(F.lds + RING_OFF + F.wave * 10240 + 8192);
    const float* DT = (const float*)(F.ws + WS_DT); const bf16* XT = (const bf16*)(F.ws + WS_XT); const bf16* BN = (const bf16*)(F.ws + WS_BN); const bf16* CN = (const bf16*)(F.ws + WS_CN);
    const bf16* SB = (const bf16*)(F.ws + WS_SINB); float* YS = (float*)(F.ws + WS_YS); const float* alog = AIN(I_ALOG) + l * 24;
    for (int item = gw; item < (MR / 64) * 12; item += NGW) {
        const int hp = item % 3, i4 = item / 3, k = i4 >> 2, g = (i4 >> 1) & 1, d = i4 & 1, row0 = 64 * k;
        f32x4 G[4][4];
#pragma unroll
        for (int it = 0; it < 4; ++it)
#pragma unroll
            for (int st = 0; st < 4; ++st) G[it][st] = (f32x4){0.f, 0.f, 0.f, 0.f};
#pragma unroll 1
        for (int ks = 0; ks < 4; ++ks) { bf16x8 cf[4], bfr[4];
#pragma unroll
            for (int i = 0; i < 4; ++i) { cf[i] = ldg8(CN + (size_t)(row0 + 16 * i + r) * 256 + g * 128 + 32 * ks + 8 * q); bfr[i] = ldg8(BN + (size_t)(row0 + 16 * i + r) * 256 + g * 128 + 32 * ks + 8 * q); }
#pragma unroll
            for (int it = 0; it < 4; ++it)
#pragma unroll
                for (int st = 0; st < 4; ++st) G[it][st] = __builtin_amdgcn_mfma_f32_16x16x32_bf16(cf[it], bfr[st], G[it][st], 0, 0, 0); }
        for (int hh = 2 * hp; hh < 2 * hp + 2; ++hh) {
            const int h = g * 6 + hh, dh = d * 12 + h;
            { const float dt = DT[(size_t)(row0 + lane) * 24 + dh]; const float A = -__expf(alog[dh]); const float cum = scan64(A * dt, d, lane);
              cumb[lane] = cum; cumb[64 + lane] = __expf(cum); cumb[128 + lane] = dt; }
            LDS_WAIT(); asm volatile("" ::: "memory");
            { float cs[4], ds[4];
#pragma unroll
              for (int st = 0; st < 4; ++st) { cs[st] = cumb[16 * st + r]; ds[st] = cumb[128 + 16 * st + r]; }
#pragma unroll
              for (int it = 0; it < 4; ++it)
#pragma unroll
                  for (int rg = 0; rg < 4; ++rg) { const int i = 16 * it + 4 * q + rg; const float ci = cumb[i];
#pragma unroll
                      for (int st = 0; st < 4; ++st) { const int s = 16 * st + r; const bool on = d ? (s >= i) : (s <= i);
                          const float v = on ? G[it][st][rg] * __expf(ci - cs[st]) * ds[st] : 0.f; Mb[i * 64 + s] = (bf16)f2bf(v); } } }
            f32x4 acc[4][4];
#pragma unroll
            for (int it = 0; it < 4; ++it)
#pragma unroll
                for (int pt = 0; pt < 4; ++pt) acc[it][pt] = (f32x4){0.f, 0.f, 0.f, 0.f};
#pragma unroll 1
            for (int ks = 0; ks < 4; ++ks) { bf16x8 cf[4], sf[4];
#pragma unroll
                for (int i = 0; i < 4; ++i) { cf[i] = ldg8(CN + (size_t)(row0 + 16 * i + r) * 256 + g * 128 + 32 * ks + 8 * q); sf[i] = ldg8(SB + ((size_t)(k * 24 + dh) * 64 + 16 * i + r) * 128 + 32 * ks + 8 * q); }
#pragma unroll
                for (int it = 0; it < 4; ++it)
#pragma unroll
                    for (int pt = 0; pt < 4; ++pt) acc[it][pt] = __builtin_amdgcn_mfma_f32_16x16x32_bf16(cf[it], sf[pt], acc[it][pt], 0, 0, 0); }
#pragma unroll
            for (int it = 0; it < 4; ++it)
#pragma unroll
                for (int rg = 0; rg < 4; ++rg) { const float e = cumb[64 + 16 * it + 4 * q + rg];
#pragma unroll
                    for (int pt = 0; pt < 4; ++pt) acc[it][pt][rg] *= e; }
            LDS_WAIT(); asm volatile("" ::: "memory");
#pragma unroll 1
            for (int ks = 0; ks < 2; ++ks) { bf16x8 mf[4], xf[4];
#pragma unroll
                for (int i = 0; i < 4; ++i) { mf[i] = *(const LAS bf16x8*)(Mb + (16 * i + r) * 64 + 32 * ks + 8 * q); xf[i] = ldg8(XT + ((size_t)(k * 12 + h) * 64 + 16 * i + r) * 64 + 32 * ks + 8 * q); }
#pragma unroll
                for (int it = 0; it < 4; ++it)
#pragma unroll
                    for (int pt = 0; pt < 4; ++pt) acc[it][pt] = __builtin_amdgcn_mfma_f32_16x16x32_bf16(mf[it], xf[pt], acc[it][pt], 0, 0, 0); }
#pragma unroll
            for (int it = 0; it < 4; ++it)
#pragma unroll
                for (int pt = 0; pt < 4; ++pt)
#pragma unroll
                    for (int rg = 0; rg < 4; ++rg) YS[((size_t)d * MR + row0 + 16 * it + 4 * q + rg) * 768 + h * 64 + 16 * pt + r] = acc[it][pt][rg];
            LDS_WAIT(); asm volatile("" ::: "memory");
        }
    }
}
#ifndef SWA_EARLY
#define SWA_EARLY 304
#endif
#ifndef PREP_REV
#define PREP_REV 0
#endif
__device__ __forceinline__ void prep_phase(Frame& F, KArgs a, int l) {
    const bf16* P = (const bf16*)(F.ws + WS_P);
    { const float* cw = AIN(I_CONVW) + (size_t)l * 5 * 1280; const float* cb = AIN(I_CONVB) + (size_t)l * 1280;
      LAS float* cbuf = (LAS float*)(F.lds + RING_OFF + F.wave * 4096);
      for (int it = F.vcu * NWAVES + F.wave; it < (MR / 64) * 160; it += F.G * NWAVES) conv_wave_item(F, cw, cb, it / 160, 8 * (it % 160), cbuf);
      __syncthreads(); }
    { const float* DTR = (const float*)(F.ws + WS_DTRAW); float* DT = (float*)(F.ws + WS_DT); const float* dtb = AIN(I_DTB) + l * 24;
      for (int i = F.vcu * 512 + F.tid; i < MR * 24; i += F.G * 512) { const int m = i / 24, j = i % 24; const float x = DTR[m * 32 + j] + dtb[j];
          DT[i] = fmaxf(x, 0.f) + __logf(1.0f + __expf(-fabsf(x))); } }
    { const int gw = F.vcu * NWAVES + F.wave, NGW = F.G * NWAVES, lane = F.lane, j8 = lane & 7;
      float inv[8];
#pragma unroll
      for (int j = 0; j < 8; ++j) inv[j] = __builtin_amdgcn_exp2f(-(float)(((j8 & 1) * 8 + j)) * (13.287712379549449f / 16.0f));
      bf16* QS = (bf16*)(F.ws + WS_QS); bf16* QG = (bf16*)(F.ws + WS_QG); bf16* KS = (bf16*)(F.ws + WS_KS); bf16* KG = (bf16*)(F.ws + WS_KG);
      const float* gsw = AIN(I_SWAG) + l * 128; const float* ggl = AIN(I_GLBG) + l * 128;
      for (int it = gw; it < MR * 3; it += NGW) {
          const int m = PREP_REV ? (MR - 1 - it / 3) : it / 3, part = it % 3; const bool act = part < 2 || lane < 32; const bool glb = part == 1 || (part == 2 && lane >= 16); const bool isk = part == 2;
          const int hl = isk ? ((lane >> 3) & 1) : (lane >> 3);
          const int col = (glb ? (isk ? PC_GK : PC_GQ) : (isk ? PC_SK : PC_SQ)) + 64 * hl + 8 * j8;
          v4u w = (v4u){0u, 0u, 0u, 0u}; if (act) w = *(const GAS v4u*)(P + (size_t)m * NP + col);
          float x[8] = {bflo(w.x), bfhi(w.x), bflo(w.y), bfhi(w.y), bflo(w.z), bfhi(w.z), bflo(w.w), bfhi(w.w)};
          float ss = 0.f;
#pragma unroll
          for (int j = 0; j < 8; ++j) ss += x[j] * x[j];
          ss += bperm(ss, lane ^ 1); ss += bperm(ss, lane ^ 2); ss += bperm(ss, lane ^ 4);
          const float rs = 1.0f / sqrtf(ss * (1.0f / 64.0f) + 1e-6f);
          const float* gp = (glb ? ggl : gsw) + (isk ? 64 : 0) + 8 * j8; const f32x4 g0 = *(const f32x4*)gp, g1 = *(const f32x4*)(gp + 4);
          const float gg[8] = {g0.x, g0.y, g0.z, g0.w, g1.x, g1.y, g1.z, g1.w};
#pragma unroll
          for (int j = 0; j < 8; ++j) x[j] = x[j] * rs * gg[j];
          if (m < SEQ) { const float pos = ((j8 & 3) < 2) ? (float)(m >> 6) : (float)(m & 63); const bool lo = j8 < 4;
#pragma unroll
              for (int j = 0; j < 8; ++j) { float sn, cs; sincos_hw(pos * inv[j], sn, cs); const float other = bperm(x[j], lane ^ 4); x[j] = lo ? (x[j] * cs - other * sn) : (other * sn + x[j] * cs); } }
          if (!isk) {
#pragma unroll
              for (int j = 0; j < 8; ++j) x[j] *= QSCALE; }
          v4u o; o.x = pk2(x[0], x[1]); o.y = pk2(x[2], x[3]); o.z = pk2(x[4], x[5]); o.w = pk2(x[6], x[7]);
          bf16* dst = isk ? ((glb ? KG : KS) + (size_t)m * 128 + 64 * hl + 8 * j8) : ((glb ? QG : QS) + (size_t)m * 512 + 64 * hl + 8 * j8);
          if (act) *(GAS v4u*)dst = o;
      } }
}
__device__ __forceinline__ void attn_all(Frame& F, KArgs a, int l) {
    typedef attn_body::bf16 ab;
    char* shm = (char*)(unsigned char*)(F.lds + RING_OFF);
#ifndef NO_MODE0
    for (int u = F.vcu; u < 528; u += F.G) {
        unsigned long long w_ = (unsigned long long)F.ws; asm volatile("" : "+s"(w_)); unsigned char* ws = (unsigned char*)(GAS unsigned char*)w_;
        if (u < 512) { const int kvh = u >> 8, g = (u >> 6) & 3, qb = u & 63, head = kvh * 4 + g; const size_t qo = (size_t)(qb * 256) * 512 + head * 64, oo = (size_t)(qb * 256) * YPITCH + YC_D + head * 64;
            attn_body::attn_unit<8, 0>((const ab*)(ws + WS_QG) + qo, (const ab*)(ws + WS_KG) + kvh * 64, (const ab*)(ws + WS_P) + PC_GV + kvh * 64, (ab*)(ws + WS_YALL) + oo, MR / 64, 0, 0, 0, 0, 0.f, false, shm); }
        else { const int ty = (u - 512) >> 3, head = (u - 512) & 7, kvh = head >> 2; const size_t qo = (size_t)SEQ * 512 + head * 64, oo = (size_t)SEQ * YPITCH + (ty ? YC_C : YC_D) + head * 64;
            const float s2 = ty ? (AIN(I_SINK) + l * 8)[head] * LOG2E : 0.f;
            attn_body::attn_unit<8, 0>((const ab*)(ws + (ty ? WS_QS : WS_QG)) + qo, (const ab*)(ws + (ty ? WS_KS : WS_KG)) + (size_t)SEQ * 128 + kvh * 64, (const ab*)(ws + WS_P) + (ty ? PC_SV : PC_GV) + (size_t)SEQ * NP + kvh * 64,
                                       (ab*)(ws + WS_YALL) + oo, 4, 0, 0, 0, 0, s2, ty != 0, shm); }
    }
#endif
}
__device__ __forceinline__ void attn_swa(Frame& F, KArgs a, int l, int ubeg, int uend, int bfirst, int nb) {
    typedef attn_body::bf16 ab;
    char* shm = (char*)(unsigned char*)(F.lds + RING_OFF);
    if (F.vcu < bfirst || F.vcu >= bfirst + nb) return;
    for (int u = ubeg + F.vcu - bfirst; u < uend; u += nb) {
        unsigned long long w_ = (unsigned long long)F.ws; asm volatile("" : "+s"(w_)); unsigned char* ws = (unsigned char*)(GAS unsigned char*)w_;
        const int head = u >> 6, qb = u & 63, kvh = head >> 2, q0 = qb * 256; const int wlo = q0 - 128 < 0 ? 0 : q0 - 128, whi = q0 + 384 > SEQ ? SEQ : q0 + 384; const size_t qo = (size_t)q0 * 512 + head * 64, oo = (size_t)q0 * YPITCH + YC_C + head * 64;
        attn_body::attn_unit<8, 1>((const ab*)(ws + WS_QS) + qo, (const ab*)(ws + WS_KS) + kvh * 64, (const ab*)(ws + WS_P) + PC_SV + kvh * 64, (ab*)(ws + WS_YALL) + oo, 4 + (whi - wlo) / 64, 4, SEQ, wlo, q0, (AIN(I_SINK) + l * 8)[head] * LOG2E, true, shm);
    }
}
#ifndef MIXDUP
#define MIXDUP 0
#endif
__device__ __forceinline__ void mixers_phase(Frame& F0, KArgs a, int l) {
    for (int rep_ = 0; rep_ <= ((MIXDUP >> 0) & 1); ++rep_) { Frame F = fresh(F0); attn_all(F, a, l); __syncthreads(); }
    { Frame F = fresh(F0); attn_swa(F, a, l, SWA_EARLY, 512, 0, F.G); __syncthreads(); }
#if 0
    for (int rep_ = 0; rep_ <= ((MIXDUP >> 1) & 1); ++rep_) { Frame F = fresh(F0); for (int it = F.vcu; it < 256; it += F.G) attn_simple_item(F, a, l, 1, it >> 7, it & 127); __syncthreads(); }
#endif
    for (int rep_ = 0; rep_ <= ((MIXDUP >> 2) & 1); ++rep_) { Frame F = fresh(F0); s5_pass<true>(F, a, l); __syncthreads(); }
    for (int rep_ = 0; rep_ <= ((MIXDUP >> 3) & 1); ++rep_) { Frame F = fresh(F0); ssd_outputs(F, a, l); __syncthreads(); }
}
__device__ __forceinline__ void post_phase(Frame& F, KArgs a, int l) {
    const int gw = F.vcu * NWAVES + F.wave, NGW = F.G * NWAVES;
    const bf16* P = (const bf16*)(F.ws + WS_P); const bf16* XSN = (const bf16*)(F.ws + WS_XSN); const float* YS = (const float*)(F.ws + WS_YS);
    bf16* YA = (bf16*)(F.ws + WS_YALL); const float* dsk = AIN(I_SSDD) + l * 12; const float* ng = AIN(I_SSDNG) + l * 768;
    for (int m = gw; m < MR; m += NGW) {
        float y[12]; float ss = 0.f;
#pragma unroll
        for (int j = 0; j < 3; ++j) { const int c = 4 * F.lane + 256 * j;
            const f32x4 yf = *(const f32x4*)(YS + (size_t)m * 768 + c), yb = *(const f32x4*)(YS + (size_t)(MR + m) * 768 + c); const v2u xw = *(const GAS v2u*)(XSN + (size_t)m * 768 + c); const f32x4 xv = {bflo(xw.x), bfhi(xw.x), bflo(xw.y), bfhi(xw.y)};
            const v2u zw = *(const GAS v2u*)(P + (size_t)m * NP + PC_Z + c); const float dd = dsk[c >> 6];
            const float z[4] = {bflo(zw.x), bfhi(zw.x), bflo(zw.y), bfhi(zw.y)};
#pragma unroll
            for (int i = 0; i < 4; ++i) { const float t = (yf[i] + yb[i] + dd * xv[i]) * silu_(z[i]); y[4 * j + i] = t; ss += t * t; } }
        const float rstd = 1.0f / sqrtf(wave_sum(ss, F.lane) * (1.0f / 768.0f) + 1e-6f);
#pragma unroll
        for (int j = 0; j < 3; ++j) { const int c = 4 * F.lane + 256 * j; const f32x4 gg = *(const f32x4*)(ng + c);
            v2u w; w.x = pk2(y[4 * j] * rstd * gg.x, y[4 * j + 1] * rstd * gg.y); w.y = pk2(y[4 * j + 2] * rstd * gg.z, y[4 * j + 3] * rstd * gg.w);
            *(GAS v2u*)(YA + (size_t)m * YPITCH + c) = w; }
    }
    const float* YBF = (const float*)(F.ws + WS_YBF); bf16* YBP = (bf16*)(F.ws + WS_YBP); const float* d5 = AIN(I_S5D) + l * 512;
    for (int i = F.vcu * 512 + F.tid; i < MR * 128; i += F.G * 512) {
        const int m = i >> 7, c = (i & 127) * 4;
        const f32x4 y0 = *(const f32x4*)(YBF + (size_t)m * 512 + c), y1 = *(const f32x4*)(YBF + (size_t)(MR + m) * 512 + c), dd = *(const f32x4*)(d5 + c);
        const v2u uw = *(const GAS v2u*)(P + (size_t)m * NP + PC_U + c); const float u[4] = {bflo(uw.x), bfhi(uw.x), bflo(uw.y), bfhi(uw.y)}; float r[4];
#pragma unroll
        for (int q = 0; q < 4; ++q) { const float x = y0[q] + y1[q] + dd[q] * u[q]; const float t = 0.7978845608028654f * (x + 0.044715f * x * x * x);
            const float th = 1.0f - 2.0f * __builtin_amdgcn_rcpf(1.0f + __builtin_amdgcn_exp2f(2.0f * LOG2E * t));
            r[q] = 0.5f * x * (1.0f + th); }
        v2u w; w.x = pk2(r[0], r[1]); w.y = pk2(r[2], r[3]); *(GAS v2u*)(YBP + (size_t)m * 512 + c) = w;
    }
}
#ifndef MK_PER_PHASE
#define MK_PER_PHASE 0
#endif
#ifndef REV_RES
#define REV_RES 1
#endif
#ifndef WGM_FFI
#define WGM_FFI 2
#endif
#ifndef WGM_WIN
#define WGM_WIN 2
#endif
#ifndef WGM_RES
#define WGM_RES 2
#endif
#ifndef WGM_MRG
#define WGM_MRG 2
#endif
constexpr int PH_PER_LAYER = 16, NPHASE = 2 + DEPTH * PH_PER_LAYER;
#ifndef GPA
#define GPA true
#endif
#ifndef GPS
#define GPS true
#endif
#ifndef GPAR
#define GPAR true
#endif
constexpr bool GP_ALIGN = GPA, GP_SP2 = GPS, GP_ALIGN_RESID = GPAR;
__global__ void __launch_bounds__(NWAVES * 64, 2) trunk_fwd(Args args) {
    extern __shared__ __attribute__((aligned(16))) unsigned char lds[];
    KArgs KA = (KArgs)__builtin_amdgcn_kernarg_segment_ptr();
    Frame F;
    F.lds = (LAS unsigned char*)lds;
    F.MISC = (volatile LAS unsigned*)(F.lds + MISC_OFF);
    F.tid = threadIdx.x; F.lane = F.tid & 63; F.wave = __builtin_amdgcn_readfirstlane(F.tid >> 6);
    F.G = gridDim.x; { const int bx = blockIdx.x; F.vcu = (F.G % 8 == 0) ? (bx % 8) * (F.G / 8) + bx / 8 : bx; }
    F.ws = (unsigned char*)(GAS unsigned char*)args.ws; F.ctl = (gu32*)(args.ws + WS_CTL);
    for (int u = F.tid; u < (LDS_BYTES - LDSCTL_OFF) / 4; u += NWAVES * 64) ((LAS unsigned*)(F.lds + LDSCTL_OFF))[u] = 0u;
    __syncthreads();
    XcdBarrier bar; bar.bar = (unsigned*)(F.ctl + CW_BAR); bar.x = 0; bar.st = nullptr;
    if (!MK_PER_PHASE) bar = xcd_barrier_post((unsigned*)(F.ctl + CW_BAR), F.MISC + 8);
    const int lo = args.ph_lo, hi = args.ph_hi;
#ifndef ONLY
#define ONLY -1
#endif
#define KON(i) (ONLY < 0 || ONLY == (i))
#ifndef DUPMASK
#define DUPMASK 0ull
#endif
#define DUPK(i) ((int)(((unsigned long long)(DUPMASK) >> (i)) & 1ull))
#define IN(k) (lo <= (k) && (k) < hi)
#define GEMM_PTRS() FRESH(); unsigned char* ws = Fp.ws; float* X = (float*)(ws + WS_X); bf16* H = (bf16*)(ws + WS_H); bf16* HID = (bf16*)(ws + WS_HID); bf16* P = (bf16*)(ws + WS_P); const bf16* WL = (const bf16*)(ws + WS_W) + (size_t)lp * WL_SIZE; \
    const float* modl = (const float*)(ws + WS_MOD) + (size_t)(lp * 2 + 0) * NMODV; const float* modc = (const float*)(ws + WS_MOD) + (size_t)(lp * 2 + 1) * NMODV; (void)X; (void)H; (void)HID; (void)P; (void)WL; (void)modl; (void)modc;
#define FRESH() Frame Fp = fresh(F); int lp = l; asm volatile("" : "+s"(lp));
#define SEAM(k) do { if (!MK_PER_PHASE && (k) + 1 < hi) xcd_barrier(bar); } while (0)
    PG8_LAS unsigned char* ring = (PG8_LAS unsigned char*)(F.lds + RING_OFF);

    if (KON(100) && IN(0)) { for (int rep_ = 0; rep_ <= DUPK(40); ++rep_) { if (rep_) xcd_barrier(bar); p0_prologue(F, KA); } SEAM(0); }
    if (KON(101) && IN(1)) { p1_modfinal(F, KA); SEAM(1); }
    for (int st = 0; st < 2 * DEPTH; ++st) {
        const int l = st >> 1, f = st & 1; const int pb = 2 + PH_PER_LAYER * l;
        if (f) {
            if (KON(3) && IN(pb + 3)) { FRESH(); norm_phase(Fp, KA, lp, 1, DFF / 512); SEAM(pb + 3); }
            if (KON(4) && IN(pb + 4)) { for (int rep_ = 0; rep_ <= DUPK(4); ++rep_) { if (rep_) xcd_barrier(bar); { GEMM_PTRS(); pg8::Gemm g{H, WL + WL_WIN, MR, NP, DM, DM}; pg8::StaticOrder S; S.init(MR, NP, Fp.G, (int)blockIdx.x, WGM_WIN); pg8::EpiWin E{P, NP, PC_GATE / 256, PC_GATE};
                pg8::gemm_phase<pg8::EpiWin, pg8::StaticOrder, GP_ALIGN, GP_SP2>(ring, g, S, E);
                if (HIDE_CONVERT) { convert_idle(Fp, KA, (int)blockIdx.x, (MR / 256) * (NP / 256) % Fp.G, lp, IT_GA + IT_GB, IT_GC + (lp == DEPTH - 1 ? IT_GD : IT_GD / 2)); }    dt_gemm(Fp, lp, (int)blockIdx.x, (MR / 256) * (NP / 256) % Fp.G); } } SEAM(pb + 4); }
            if (KON(5) && IN(pb + 5)) { for (int rep_ = 0; rep_ <= DUPK(5); ++rep_) { if (rep_) xcd_barrier(bar); { FRESH(); prep_phase(Fp, KA, lp); __syncthreads(); s5_pass<false>(Fp, KA, lp); } } SEAM(pb + 5); }
            if (KON(6) && IN(pb + 6)) { for (int rep_ = 0; rep_ <= DUPK(6); ++rep_) { if (rep_) xcd_barrier(bar); { { FRESH(); ssd_states(Fp, KA, lp); } } } SEAM(pb + 6); }
            if (KON(7) && IN(pb + 7)) { for (int rep_ = 0; rep_ <= DUPK(7); ++rep_) { if (rep_) xcd_barrier(bar); { { FRESH(); s5_carry(Fp, KA, lp, 96 * NWAVES); } { FRESH(); ssd_carry(Fp); } if (SWA_EARLY > 0) { FRESH(); attn_swa(Fp, KA, lp, 0, SWA_EARLY, 104, Fp.G - 104); } } } SEAM(pb + 7); }
            if (KON(8) && IN(pb + 8)) { for (int rep_ = 0; rep_ <= DUPK(8); ++rep_) { if (rep_) xcd_barrier(bar); { FRESH(); mixers_phase(Fp, KA, lp); } } SEAM(pb + 8); }
            if (KON(9) && IN(pb + 9)) { for (int rep_ = 0; rep_ <= DUPK(9); ++rep_) { if (rep_) xcd_barrier(bar); { FRESH(); post_phase(Fp, KA, lp); } } SEAM(pb + 9); }
            if (KON(10) && IN(pb + 10)) { for (int rep_ = 0; rep_ <= DUPK(10); ++rep_) { if (rep_) xcd_barrier(bar); { GEMM_PTRS(); const int Mq = (lp == DEPTH - 1) ? SEQ : MR; pg8::Gemm g{(const bf16*)(ws + WS_YBP), WL + WL_GLU, Mq, 1024, 512, 512}; pg8::StaticOrder S; S.init(Mq, 1024, Fp.G, (int)blockIdx.x);
                pg8::EpiGated<1> E{(bf16*)(ws + WS_YALL) + YC_B, YPITCH, ((const float*)(const GAS float*)KA->in[I_GLUB]) + (size_t)lp * 1024, 512};
                pg8::gemm_phase<pg8::EpiGated<1>, pg8::StaticOrder, GP_ALIGN, GP_SP2>(ring, g, S, E); } } SEAM(pb + 10); }
            if (KON(11) && IN(pb + 11)) { for (int rep_ = 0; rep_ <= DUPK(11); ++rep_) { if (rep_) xcd_barrier(bar); { GEMM_PTRS(); const int Mq = (lp == DEPTH - 1) ? SEQ : MR;
                pg8::Gemm g{(const bf16*)(ws + WS_YALL), WL + WL_BRALL, Mq, DM, YPITCH, YPITCH}; pg8::MergeOrder S; S.so.init(Mq, DM, Fp.G, (int)blockIdx.x, WGM_MRG); pg8::EpiMergeR E{P + PC_GATE, NP, (bf16*)(ws + WS_MG)};
                pg8::gemm_phase<pg8::EpiMergeR, pg8::MergeOrder, GP_ALIGN, GP_SP2>(ring, g, S, E);
                if (HIDE_CONVERT && lp < DEPTH - 1) { const int rem = (MR / 256) * (DM / 256) % Fp.G; convert_idle(Fp, KA, (int)blockIdx.x, rem, lp, IT_LAYER - IT_GD / 2, IT_GD / 2); convert_idle(Fp, KA, (int)blockIdx.x, rem, lp + 1, 0, IT_GA / 2); } } } SEAM(pb + 11); }
            if (KON(12) && IN(pb + 12)) { for (int rep_ = 0; rep_ <= DUPK(12); ++rep_) { if (rep_) xcd_barrier(bar); { GEMM_PTRS();
                { pg8::Gemm g{(const bf16*)(ws + WS_MG), WL + WL_OUT, SEQ, DM, DM, DM}; pg8::StaticOrder S; S.init(SEQ, DM, Fp.G, (int)blockIdx.x, WGM_RES, REV_RES); pg8::EpiResid E{X, (rep_ < DUPK(12)) ? (float*)(ws + WS_MGF) : X, X, modl + 5 * DM, modc + 5 * DM, 1.0f, SEQ / 256};
                  pg8::gemm_phase<pg8::EpiResid, pg8::StaticOrder, GP_ALIGN_RESID, GP_SP2>(ring, g, S, E); }
                if (lp < DEPTH - 1) { pg8::Gemm g{(const bf16*)(ws + WS_MG), WL + WL_OUT, MR, DM, 512, DM}; pg8::SplitKOrder S{SEQ / 256, DM / 256, DM / 512, Fp.G, (int)blockIdx.x}; pg8::EpiPartial E{(float*)(ws + WS_PART), modc + 5 * DM, 1.0f};
                  pg8::gemm_phase<pg8::EpiPartial, pg8::SplitKOrder, GP_ALIGN, GP_SP2>(ring, g, S, E); }
                } } SEAM(pb + 12); }
        }
        const int pf = pb + (f ? 13 : 0); const bool no_ctx = (f == 1 && l == DEPTH - 1);
        if (KON(0) && IN(pf + 0)) { FRESH(); int fp = f; asm volatile("" : "+s"(fp)); norm_phase(Fp, KA, lp, 2 * fp, fp ? (lp < DEPTH - 1 ? DM / 512 : 0) : (lp > 0 ? DFF / 512 : 0)); SEAM(pf + 0); }
        if (KON(1) && IN(pf + 1)) { GEMM_PTRS(); int fp = f; asm volatile("" : "+s"(fp)); const int Mq = no_ctx ? SEQ : MR;
            pg8::Gemm g{H, WL + WL_FFI + (size_t)fp * NFF * DM, Mq, NFF, DM, DM}; pg8::StaticOrder S; S.init(Mq, NFF, Fp.G, (int)blockIdx.x, WGM_FFI); pg8::EpiGated<0> E{HID, DFF, nullptr, 0};
            pg8::gemm_phase<pg8::EpiGated<0>, pg8::StaticOrder, GP_ALIGN, GP_SP2>(ring, g, S, E); SEAM(pf + 1); }
        if (KON(2) && IN(pf + 2)) { GEMM_PTRS(); int fp = f; asm volatile("" : "+s"(fp)); const bf16* Wo = WL + WL_FFO + (size_t)fp * DM * DFF; const int gs = (2 + 6 * fp) * DM;
            { pg8::Gemm g{HID, Wo, SEQ, DM, DFF, DFF}; pg8::StaticOrder S; S.init(SEQ, DM, Fp.G, (int)blockIdx.x, WGM_RES, REV_RES);
              pg8::EpiResid E{X, (fp == 1 && lp == DEPTH - 1) ? (float*)KA->out : X, X, modl + gs, modc + gs, 0.5f, SEQ / 256};
              pg8::gemm_phase<pg8::EpiResid, pg8::StaticOrder, GP_ALIGN_RESID, GP_SP2>(ring, g, S, E); }
            if (!no_ctx) { pg8::Gemm g{HID, Wo, MR, DM, 512, DFF}; pg8::SplitKOrder S{SEQ / 256, DM / 256, DFF / 512, Fp.G, (int)blockIdx.x}; pg8::EpiPartial E{(float*)(ws + WS_PART), modc + gs, 0.5f};
              pg8::gemm_phase<pg8::EpiPartial, pg8::SplitKOrder, GP_ALIGN, GP_SP2>(ring, g, S, E); }
            SEAM(pf + 2); }
    }
#undef IN
#undef SEAM
}

extern "C" void kernel_launch(void* const* d_in, const int* in_sizes, int n_in, void* d_out, int out_size, void* d_ws, size_t ws_size, hipStream_t stream) {
    static int grid = 0;
    if (grid == 0) {
        if (n_in != N_IN || out_size != SEQ * DM || ws_size < WS_END) { fprintf(stderr, "kernel_launch: built for %d inputs, %d outputs, >= %zu bytes of workspace; got n_in %d, out %d, ws %zu; nothing launched\n", N_IN, SEQ * DM, (size_t)WS_END, n_in, out_size, ws_size); grid = -1; return; }
        int dev = 0, cus = 0, per_cu = 0;
        if (hipGetDevice(&dev) != hipSuccess || hipDeviceGetAttribute(&cus, hipDeviceAttributeMultiprocessorCount, dev) != hipSuccess) { fprintf(stderr, "kernel_launch: hipGetDevice / hipDeviceGetAttribute failed\n"); grid = -1; return; }
        if (hipFuncSetAttribute((const void*)trunk_fwd, hipFuncAttributeMaxDynamicSharedMemorySize, LDS_BYTES) != hipSuccess) { fprintf(stderr, "kernel_launch: hipFuncSetAttribute failed\n"); grid = -1; return; }
        if (hipOccupancyMaxActiveBlocksPerMultiprocessor(&per_cu, (const void*)trunk_fwd, NWAVES * 64, LDS_BYTES) != hipSuccess || per_cu < 1)
            fprintf(stderr, "kernel_launch: note: occupancy query reports %d workgroups per CU\n", per_cu);
        (void)hipGetLastError();
        grid = cus;
        if (grid % 8 != 0 || grid < 8) { fprintf(stderr, "kernel_launch: unexpected CU count %d\n", cus); }
    }
    if (grid < 0) return;
    if (hipMemsetAsync((char*)d_ws + WS_CTL, 0, CTL_ZERO_BYTES, stream) != hipSuccess) { fprintf(stderr, "kernel_launch: hipMemsetAsync failed\n"); return; }
    Args a{};
    for (int i = 0; i < N_IN; ++i) a.in[i] = (const float*)d_in[i];
    a.out = (float*)d_out; a.ws = (unsigned char*)d_ws;
#if MK_PER_PHASE
    for (int k = 0; k < NPHASE; ++k) { a.ph_lo = k; a.ph_hi = k + 1; hipLaunchKernelGGL(trunk_fwd, dim3(grid), dim3(NWAVES * 64), LDS_BYTES, stream, a); }
#else
    a.ph_lo = 0; a.ph_hi = NPHASE;
    hipLaunchKernelGGL(trunk_fwd, dim3(grid), dim3(NWAVES * 64), LDS_BYTES, stream, a);
#endif
    const hipError_t le = hipPeekAtLastError();
    if (le != hipSuccess) fprintf(stderr, "kernel_launch: launch failed: %s\n", hipGetErrorName(le));
}
```

```cpp
#include <hip/hip_runtime.h>
#include <cstdio>
#include <cstdint>
#ifndef WGM_SEL
#define WGM_SEL 2
#endif
namespace pg8 {
#define PG8_LAS __attribute__((address_space(3)))
typedef unsigned short bf16_t;
typedef short bf16x8 __attribute__((ext_vector_type(8)));
typedef float f32x4 __attribute__((ext_vector_type(4)));
typedef unsigned u32x4 __attribute__((ext_vector_type(4)));
constexpr int BM = 256, BK = 64, HALF = 128, HTB = HALF * BK * 2  , STAGE_BYTES = 8 * HTB, NXCD = 8, WGM = WGM_SEL;

__host__ __device__ __forceinline__ int lds_byte(int r, int c) { const int st = (r >> 4) * 2 + (c >> 5), rr = r & 15, cc = c & 31, ob = rr * 64 + cc * 2; return st * 1024 + (ob ^ (((ob >> 9) & 1) << 5)); }
__host__ __device__ __forceinline__ void stage_rc(int b, int& R, int& C) { const int st = b / 1024, sb = b % 1024, swz = sb ^ (((sb >> 9) & 1) << 5); R = (st >> 1) * 16 + swz / 64; C = (st & 1) * 32 + (swz % 64) / 2; }
__host__ __device__ __forceinline__ int perm32(int rho) { const int n = rho >> 4, i = rho & 15; return 8 * (i >> 2) + 4 * n + (i & 3); }

struct Unit { int pm, pn, ks, kofs, nt, seg; };
struct Gemm { const bf16_t* A; const bf16_t* Bt; int M, N, K, ld; };

struct StaticOrder {
    int nM, nN, nwg, G, c, wgm, rev;
    __host__ __device__ void init(int M, int N, int G_, int c_, int wgm_ = WGM, int rev_ = 0) { nM = M / BM; nN = N / BM; nwg = nM * nN; G = G_; c = c_; wgm = wgm_; rev = rev_; }
    __host__ __device__ bool next(int i, Unit& u) const {
        const long L = (long)i * G + c; if (L >= nwg) return false;
        int wgid = (int)L; { const int q = nwg / NXCD, r = nwg % NXCD, xcd = wgid % NXCD, off = wgid / NXCD; wgid = (xcd < r ? xcd * (q + 1) : r * (q + 1) + (xcd - r) * q) + off; }
        const int nig = wgm * nN, gid = wgid / nig, fm = gid * wgm, gsz = (nM - fm) < wgm ? (nM - fm) : wgm;
        u.pm = fm + ((wgid % nig) % gsz); if (rev) u.pm = nM - 1 - u.pm; u.pn = (wgid % nig) / gsz; u.ks = 0; u.kofs = 0; u.nt = 0; u.seg = 0; return true;
    }
    __device__ __forceinline__ void a_ready(const Unit&) const {}
    __device__ __forceinline__ void done(const Unit&) const {}
};
struct SplitKOrder {
    int pm, nN, nS, G, c;
    __device__ __forceinline__ bool next(int i, Unit& u) const { const int L = i * G + c; if (L >= nN * nS) return false; u.pm = pm; u.pn = L % nN; u.ks = L / nN; u.kofs = 0; u.nt = 0; u.seg = 0; return true; }
    __device__ __forceinline__ void a_ready(const Unit&) const {}
    __device__ __forceinline__ void done(const Unit&) const {}
};
struct MergeOrder {
    StaticOrder so;
    __device__ __forceinline__ bool next(int i, Unit& u) const { if (!so.next(i >> 2, u)) return false; const int s = i & 3; u.seg = s; u.kofs = s ? 256 + 512 * s : 0; u.nt = s ? 8 : 12; return true; }
    __device__ __forceinline__ void a_ready(const Unit&) const {}
    __device__ __forceinline__ void done(const Unit&) const {}
};
__device__ __forceinline__ unsigned cvt_pk_bf16(float lo, float hi) { unsigned r; asm volatile("v_cvt_pk_bf16_f32 %0, %1, %2" : "=v"(r) : "v"(lo), "v"(hi)); return r; }
typedef float f32x2 __attribute__((ext_vector_type(2)));
__device__ __forceinline__ float sigm(float x) { return __builtin_amdgcn_rcpf(1.0f + __builtin_amdgcn_exp2f(-1.4426950408889634f * x)); }
__device__ __forceinline__ float silu(float x) { return x * sigm(x); }
__device__ __forceinline__ float bf2f(unsigned short h) { return __uint_as_float(((unsigned)h) << 16); }
typedef unsigned u32x2 __attribute__((ext_vector_type(2)));

struct EpiBf16 {
    static constexpr bool PERM = true, AFTER_DRAIN = false, KEEP_ACC = false;
    bf16_t* O; int ldc;
    __device__ __forceinline__ void operator()(const f32x4 (&acc)[2][2][4][2], const Unit& u, int wr, int wc, int fr, int fq) const {
        const int row0 = u.pm * BM + wr * 64 + fr; const int col0 = u.pn * BM + wc * 32 + 8 * fq;
#pragma unroll
        for (int ai = 0; ai < 2; ++ai)
#pragma unroll
            for (int m = 0; m < 4; ++m) { bf16_t* rowp = O + (size_t)(row0 + ai * HALF + m * 16) * ldc + col0;
#pragma unroll
                for (int bj = 0; bj < 2; ++bj) { const f32x4 v0 = acc[ai][bj][m][0], v1 = acc[ai][bj][m][1];
                    u32x4 w; w.x = cvt_pk_bf16(v0[0], v0[1]); w.y = cvt_pk_bf16(v0[2], v0[3]); w.z = cvt_pk_bf16(v1[0], v1[1]); w.w = cvt_pk_bf16(v1[2], v1[3]);
                    *(u32x4*)(rowp + bj * HALF) = w; } }
    }
};
template <int MODE> struct EpiGated {
    static constexpr bool PERM = true, AFTER_DRAIN = false, KEEP_ACC = false;
    bf16_t* O; int ldo; const float* bias; int half;
    __device__ __forceinline__ void operator()(const f32x4 (&acc)[2][2][4][2], const Unit& u, int wr, int wc, int fr, int fq) const {
        const int row0 = u.pm * BM + wr * 64 + fr; const int col0 = u.pn * HALF + wc * 32 + 8 * fq;
        f32x4 ba[2], bb[2];
#pragma unroll
        for (int n = 0; n < 2; ++n) { if (MODE == 1) { ba[n] = *(const f32x4*)(bias + col0 + 4 * n); bb[n] = *(const f32x4*)(bias + half + col0 + 4 * n); } else { ba[n] = (f32x4){0.f, 0.f, 0.f, 0.f}; bb[n] = ba[n]; } }
#pragma unroll
        for (int ai = 0; ai < 2; ++ai)
#pragma unroll
            for (int m = 0; m < 4; ++m) { bf16_t* rowp = O + (size_t)(row0 + ai * HALF + m * 16) * ldo + col0;
                float r[8];
#pragma unroll
                for (int n = 0; n < 2; ++n)
#pragma unroll
                    for (int i = 0; i < 4; ++i) { const float a = acc[ai][0][m][n][i] + ba[n][i], b = acc[ai][1][m][n][i] + bb[n][i]; r[4 * n + i] = (MODE == 0) ? silu(a) * b : a * sigm(b); }
                u32x4 w; w.x = cvt_pk_bf16(r[0], r[1]); w.y = cvt_pk_bf16(r[2], r[3]); w.z = cvt_pk_bf16(r[4], r[5]); w.w = cvt_pk_bf16(r[6], r[7]);
                *(u32x4*)rowp = w; }
    }
};
struct EpiResid {
    static constexpr bool PERM = false, AFTER_DRAIN = false, KEEP_ACC = false;
    const float* base; float* out_lat; float* out_ctx; const float* gate_lat; const float* gate_ctx; float coef; int ctx_pm;
    __device__ __forceinline__ void operator()(const f32x4 (&acc)[2][2][4][2], const Unit& u, int wr, int wc, int fr, int fq) const {
        const bool isctx = u.pm >= ctx_pm; const float* g = isctx ? gate_ctx : gate_lat; float* o = isctx ? out_ctx : out_lat;
        const int row0 = u.pm * BM + wr * 64 + fr, col0 = u.pn * BM + wc * 32 + 4 * fq;
        f32x4 gv[2][2];
#pragma unroll
        for (int bj = 0; bj < 2; ++bj)
#pragma unroll
            for (int n = 0; n < 2; ++n) gv[bj][n] = *(const f32x4*)(g + col0 + bj * HALF + n * 16) * coef;
#pragma unroll
        for (int ai = 0; ai < 2; ++ai)
#pragma unroll
            for (int mp = 0; mp < 2; ++mp) { f32x4 bv[2][2][2];
#pragma unroll
                for (int mm = 0; mm < 2; ++mm) { const size_t off = (size_t)(row0 + ai * HALF + (2 * mp + mm) * 16) * 2048 + col0;
#pragma unroll
                    for (int bj = 0; bj < 2; ++bj)
#pragma unroll
                        for (int n = 0; n < 2; ++n) bv[mm][bj][n] = *(const f32x4*)(base + off + bj * HALF + n * 16); }
                asm volatile("" ::: "memory");
#pragma unroll
                for (int mm = 0; mm < 2; ++mm) { const size_t off = (size_t)(row0 + ai * HALF + (2 * mp + mm) * 16) * 2048 + col0;
#pragma unroll
                    for (int bj = 0; bj < 2; ++bj)
#pragma unroll
                        for (int n = 0; n < 2; ++n) *(f32x4*)(o + off + bj * HALF + n * 16) = bv[mm][bj][n] + gv[bj][n] * acc[ai][bj][2 * mp + mm][n]; }
                asm volatile("" ::: "memory"); }
    }
};
template <int MODE> struct EpiMerge {
    static constexpr bool PERM = false, AFTER_DRAIN = false, KEEP_ACC = false;
    const bf16_t* G; int ldg; float* F; bf16_t* O;
    __device__ __forceinline__ void operator()(const f32x4 (&acc)[2][2][4][2], const Unit& u, int wr, int wc, int fr, int fq) const {
        const int row0 = u.pm * BM + wr * 64 + fr, col0 = u.pn * BM + wc * 32 + 4 * fq;
#pragma unroll
        for (int ai = 0; ai < 2; ++ai)
#pragma unroll
            for (int m = 0; m < 4; ++m) { const size_t r = (size_t)(row0 + ai * HALF + m * 16);
#pragma unroll
                for (int bj = 0; bj < 2; ++bj)
#pragma unroll
                    for (int n = 0; n < 2; ++n) { const int c = col0 + bj * HALF + n * 16;
                        const u32x2 gw = *(const u32x2*)(G + r * ldg + c);
                        f32x4 t; t[0] = sigm(__uint_as_float(gw.x << 16)); t[1] = sigm(__uint_as_float(gw.x & 0xffff0000u)); t[2] = sigm(__uint_as_float(gw.y << 16)); t[3] = sigm(__uint_as_float(gw.y & 0xffff0000u));
                        t = t * acc[ai][bj][m][n];
                        if (MODE >= 1) t = t + *(const f32x4*)(F + r * 2048 + c);
                        if (MODE <= 1) *(f32x4*)(F + r * 2048 + c) = t;
                        else { u32x2 w; w.x = cvt_pk_bf16(t[0], t[1]); w.y = cvt_pk_bf16(t[2], t[3]); *(u32x2*)(O + r * 2048 + c) = w; } } }
    }
};
struct EpiPartial {
    static constexpr bool PERM = false, AFTER_DRAIN = false, KEEP_ACC = false;
    float* part; const float* gate; float coef;
    __device__ __forceinline__ void operator()(const f32x4 (&acc)[2][2][4][2], const Unit& u, int wr, int wc, int fr, int fq) const {
        const int row0 = u.ks * BM + wr * 64 + fr, col0 = u.pn * BM + wc * 32 + 4 * fq;
        f32x4 gv[2][2];
#pragma unroll
        for (int bj = 0; bj < 2; ++bj)
#pragma unroll
            for (int n = 0; n < 2; ++n) gv[bj][n] = *(const f32x4*)(gate + col0 + bj * HALF + n * 16) * coef;
#pragma unroll
        for (int ai = 0; ai < 2; ++ai)
#pragma unroll
            for (int m = 0; m < 4; ++m) { const size_t off = (size_t)(row0 + ai * HALF + m * 16) * 2048 + col0;
#pragma unroll
                for (int bj = 0; bj < 2; ++bj)
#pragma unroll
                    for (int n = 0; n < 2; ++n) *(f32x4*)(part + off + bj * HALF + n * 16) = gv[bj][n] * acc[ai][bj][m][n]; }
    }
};
struct EpiMergeR {
    static constexpr bool PERM = false, AFTER_DRAIN = false, KEEP_ACC = true;
    const bf16_t* G; int ldg; bf16_t* O;
    __device__ __forceinline__ bool zero_after(const Unit& u) const { return u.seg == 3; }
    __device__ __forceinline__ void operator()(f32x4 (&acc)[2][2][4][2], const Unit& u, int wr, int wc, int fr, int fq) const {
        const int row0 = u.pm * BM + wr * 64 + fr, col0 = u.pn * BM + wc * 32 + 4 * fq; const bf16_t* Gs = G + 2048 * u.seg + u.pn * BM + 64 * wc + 16 * fq; const bool fin = u.seg == 3;
#pragma unroll
        for (int ai = 0; ai < 2; ++ai)
#pragma unroll
            for (int m = 0; m < 4; ++m) { const size_t r = (size_t)(row0 + ai * HALF + m * 16);
                const u32x4 w0 = *(const u32x4*)(Gs + r * ldg), w1 = *(const u32x4*)(Gs + r * ldg + 8);
                acc[ai][0][m][0] = acc[ai][0][m][0] * (f32x4){__uint_as_float(w0.x << 16), __uint_as_float(w0.x & 0xffff0000u), __uint_as_float(w0.y << 16), __uint_as_float(w0.y & 0xffff0000u)};
                acc[ai][0][m][1] = acc[ai][0][m][1] * (f32x4){__uint_as_float(w0.z << 16), __uint_as_float(w0.z & 0xffff0000u), __uint_as_float(w0.w << 16), __uint_as_float(w0.w & 0xffff0000u)};
                acc[ai][1][m][0] = acc[ai][1][m][0] * (f32x4){__uint_as_float(w1.x << 16), __uint_as_float(w1.x & 0xffff0000u), __uint_as_float(w1.y << 16), __uint_as_float(w1.y & 0xffff0000u)};
                acc[ai][1][m][1] = acc[ai][1][m][1] * (f32x4){__uint_as_float(w1.z << 16), __uint_as_float(w1.z & 0xffff0000u), __uint_as_float(w1.w << 16), __uint_as_float(w1.w & 0xffff0000u)};
                if (fin) {
#pragma unroll
                    for (int bj = 0; bj < 2; ++bj)
#pragma unroll
                        for (int n = 0; n < 2; ++n) { const f32x4 t = acc[ai][bj][m][n]; u32x2 w; w.x = cvt_pk_bf16(t[0], t[1]); w.y = cvt_pk_bf16(t[2], t[3]); *(u32x2*)(O + r * 2048 + col0 + bj * HALF + n * 16) = w; } } }
    }
};
struct EpiWin {
    static constexpr bool PERM = true, AFTER_DRAIN = false, KEEP_ACC = false;
    bf16_t* O; int ldc; int gate_pn; int gate0;
    __device__ __forceinline__ void operator()(const f32x4 (&acc)[2][2][4][2], const Unit& u, int wr, int wc, int fr, int fq) const {
        const int row0 = u.pm * BM + wr * 64 + fr;
        if (u.pn < gate_pn) { const int col0 = u.pn * BM + wc * 32 + 8 * fq;
#pragma unroll
            for (int ai = 0; ai < 2; ++ai)
#pragma unroll
                for (int m = 0; m < 4; ++m) { bf16_t* rowp = O + (size_t)(row0 + ai * HALF + m * 16) * ldc + col0;
#pragma unroll
                    for (int bj = 0; bj < 2; ++bj) { const f32x4 v0 = acc[ai][bj][m][0], v1 = acc[ai][bj][m][1];
                        u32x4 w; w.x = cvt_pk_bf16(v0[0], v0[1]); w.y = cvt_pk_bf16(v0[2], v0[3]); w.z = cvt_pk_bf16(v1[0], v1[1]); w.w = cvt_pk_bf16(v1[2], v1[3]);
                        *(u32x4*)(rowp + bj * HALF) = w; } }
        } else {
            const int c = 64 * (u.pn - gate_pn) + 16 * wc + 4 * fq;
            const int sg = (c & ~255) + 64 * ((c >> 5) & 3) + 16 * ((c >> 2) & 3) + 8 * ((c >> 7) & 1) + 4 * ((c >> 4) & 1);
#pragma unroll
            for (int ai = 0; ai < 2; ++ai)
#pragma unroll
                for (int m = 0; m < 4; ++m) { bf16_t* rowp = O + (size_t)(row0 + ai * HALF + m * 16) * ldc + gate0 + sg;
                    f32x4 d[4];
#pragma unroll
                    for (int b = 0; b < 4; ++b)
#pragma unroll
                        for (int i = 0; i < 4; ++i) d[b][i] = 1.0f + __builtin_amdgcn_exp2f(-1.4426950408889634f * fminf(fmaxf(acc[ai][b >> 1][m][b & 1][i], -30.0f), 30.0f));
#pragma unroll
                    for (int s = 0; s < 4; ++s) { f32x4 rr;
#pragma unroll
                        for (int i = 0; i < 4; ++i) rr[i] = (s < 3 ? d[s < 3 ? s + 1 : 3][i] : 1.0f) * __builtin_amdgcn_rcpf(d[s][i]);
                        u32x2 w; w.x = cvt_pk_bf16(rr[0], rr[1]); w.y = cvt_pk_bf16(rr[2], rr[3]); *(u32x2*)(rowp + 2048 * s) = w; } }
        }
    }
};
#ifndef PG8_AUX_A
#define PG8_AUX_A 0
#endif
#ifndef PG8_AUX_B
#define PG8_AUX_B 0
#endif
template <class Epi, class Sched, bool ALIGN_EPI = false, bool SP2 = false>
__device__ __forceinline__ void gemm_phase(PG8_LAS unsigned char* lds, const Gemm g, const Sched& S, const Epi& E) {
    int tid_ = threadIdx.x; asm volatile("" : "+v"(tid_)); const int tid = tid_, wid = __builtin_amdgcn_readfirstlane(tid >> 6), lane = tid & 63, wr = wid >> 2, wc = wid & 3, fr = lane & 15, fq = lane >> 4;
    const int K = g.ld, nt = g.K / BK;
    unsigned voffA[2], voffB[2];
#pragma unroll
    for (int i = 0; i < 2; ++i) { int R, C; stage_rc(tid * 16 + i * 8192, R, C); const int Rb = Epi::PERM ? ((R & ~31) + perm32(R & 31)) : R;
        voffA[i] = (unsigned)(R * K + C) * 2u; voffB[i] = (unsigned)(Rb * K + C) * 2u; }
    const size_t kstep = (size_t)(BK * 2);
    const size_t hstep = (size_t)HALF * K * 2;
    const size_t tstep = 2 * hstep;
    const unsigned ldsw = (unsigned)wid * 1024u;
    const int aoff = lds_byte(wr * 64 + fr, fq * 8), boff = lds_byte(wc * 32 + fr, fq * 8);
#define PG8_SA(b, h) (((b) * 2 + (h)) * HTB)
#define PG8_SB(b, h) ((4 + (b) * 2 + (h)) * HTB)
#define PG8_STAGE(bufoff, gbase, voff) do { _Pragma("unroll") for (int _i = 0; _i < 2; ++_i) \
        __builtin_amdgcn_global_load_lds((const unsigned*)((const char*)(gbase) + (voff)[_i]), (PG8_LAS unsigned*)(lds + (bufoff) + ldsw + _i * 8192), 16, 0, PG8_AUX_A); } while (0)
#define PG8_STAGEB(bufoff, gbase, voff) do { _Pragma("unroll") for (int _i = 0; _i < 2; ++_i) \
        __builtin_amdgcn_global_load_lds((const unsigned*)((const char*)(gbase) + (voff)[_i]), (PG8_LAS unsigned*)(lds + (bufoff) + ldsw + _i * 8192), 16, 0, PG8_AUX_B); } while (0)
#define PG8_LDA(dst, b, h) do { _Pragma("unroll") for (int m = 0; m < 4; ++m) _Pragma("unroll") for (int k = 0; k < 2; ++k) dst[m][k] = *(const PG8_LAS bf16x8*)(lds + PG8_SA(b, h) + aoff + m * 2048 + k * 1024); } while (0)
#define PG8_LDB(dst, b, h) do { _Pragma("unroll") for (int n = 0; n < 2; ++n) _Pragma("unroll") for (int k = 0; k < 2; ++k) dst[n][k] = *(const PG8_LAS bf16x8*)(lds + PG8_SB(b, h) + boff + n * 2048 + k * 1024); } while (0)
#define PG8_MMA(ai, bj, At, Bt) do { __builtin_amdgcn_s_setprio(1); _Pragma("unroll") for (int m = 0; m < 4; ++m) _Pragma("unroll") for (int n = 0; n < 2; ++n) _Pragma("unroll") for (int k = 0; k < 2; ++k) \
        acc[ai][bj][m][n] = __builtin_amdgcn_mfma_f32_16x16x32_bf16(Bt[n][k], At[m][k], acc[ai][bj][m][n], 0, 0, 0); __builtin_amdgcn_s_setprio(0); } while (0)
#define PG8_WAIT_V(n) asm volatile("s_waitcnt vmcnt(" #n ")" ::: "memory")
#define PG8_WAIT_L(n) asm volatile("s_waitcnt lgkmcnt(" #n ")" ::: "memory")
#define PG8_BAR __builtin_amdgcn_s_barrier()
#define PG8_SCHED __builtin_amdgcn_sched_barrier(0)
    Unit cur, nxt; int ui = 0;
    if (!S.next(0, cur)) return;
    f32x4 acc[2][2][4][2];
#pragma unroll
    for (int a = 0; a < 2; ++a)
#pragma unroll
        for (int b = 0; b < 2; ++b)
#pragma unroll
            for (int m = 0; m < 4; ++m)
#pragma unroll
                for (int n = 0; n < 2; ++n) acc[a][b][m][n] = (f32x4){0.f, 0.f, 0.f, 0.f};
    bf16x8 At[4][2], B0[2][2], B1[2][2];
    const size_t kslice = (size_t)g.K * 2;
    const char* cA = (const char*)g.A + (size_t)cur.pm * tstep + (size_t)cur.ks * kslice + (size_t)cur.kofs * 2; const char* cB = (const char*)g.Bt + (size_t)cur.pn * tstep + (size_t)cur.ks * kslice + (size_t)cur.kofs * 2;
    S.a_ready(cur);
    if constexpr (SP2) {
        PG8_STAGEB(PG8_SB(0, 0), cB, voffB); PG8_STAGEB(PG8_SB(0, 1), cB + hstep, voffB); PG8_STAGE(PG8_SA(0, 0), cA, voffA); PG8_STAGE(PG8_SA(0, 1), cA + hstep, voffA);
        if (wr == 1) PG8_BAR;
        PG8_WAIT_V(2); PG8_BAR;
        PG8_STAGEB(PG8_SB(1, 0), cB + kstep, voffB); PG8_STAGE(PG8_SA(1, 0), cA + kstep, voffA); PG8_STAGEB(PG8_SB(1, 1), cB + hstep + kstep, voffB);
        PG8_WAIT_V(6); PG8_BAR;
    } else {
        PG8_STAGEB(PG8_SB(0, 0), cB, voffB); PG8_STAGE(PG8_SA(0, 0), cA, voffA); PG8_STAGEB(PG8_SB(0, 1), cB + hstep, voffB); PG8_STAGE(PG8_SA(0, 1), cA + hstep, voffA);
        if (wr == 1) PG8_BAR;
        PG8_WAIT_V(4); PG8_BAR;
        PG8_STAGEB(PG8_SB(1, 0), cB + kstep, voffB); PG8_STAGE(PG8_SA(1, 0), cA + kstep, voffA); PG8_STAGEB(PG8_SB(1, 1), cB + hstep + kstep, voffB);
        PG8_WAIT_V(6); PG8_BAR;
    }
    for (;;) {
        const bool has_next = S.next(ui + 1, nxt);
        const char* nA = has_next ? (const char*)g.A + (size_t)nxt.pm * tstep + (size_t)nxt.ks * kslice + (size_t)nxt.kofs * 2 : cA; const char* nB = has_next ? (const char*)g.Bt + (size_t)nxt.pn * tstep + (size_t)nxt.ks * kslice + (size_t)nxt.kofs * 2 : cB;
        const int nt_u = cur.nt ? cur.nt : nt;
        for (int t = 0; t < nt_u; t += 2) {
            const bool last = (t == nt_u - 2);
            const char* a1 = cA + (size_t)(t + 1) * kstep;
            const char* a2 = last ? nA : cA + (size_t)(t + 2) * kstep; const char* b2 = last ? nB : cB + (size_t)(t + 2) * kstep;
            const char* a3 = a2 + kstep; const char* b3 = b2 + kstep;
            if (last && has_next) S.a_ready(nxt);
            if constexpr (SP2) {
            PG8_LDB(B0, 0, 0); PG8_LDB(B1, 0, 1); PG8_SCHED; PG8_LDA(At, 0, 0); PG8_STAGE(PG8_SA(1, 1), a1 + hstep, voffA);
            PG8_WAIT_V(8); PG8_WAIT_L(0); PG8_BAR; PG8_MMA(0, 0, At, B0); PG8_MMA(0, 1, At, B1); PG8_BAR; PG8_SCHED;
            PG8_LDA(At, 0, 1); PG8_STAGEB(PG8_SB(0, 0), b2, voffB); PG8_STAGEB(PG8_SB(0, 1), b2 + hstep, voffB); PG8_STAGE(PG8_SA(0, 0), a2, voffA);
            PG8_WAIT_V(8); PG8_WAIT_L(0); PG8_BAR; PG8_MMA(1, 0, At, B0); PG8_MMA(1, 1, At, B1); PG8_BAR; PG8_SCHED;
            PG8_LDB(B0, 1, 0); PG8_LDB(B1, 1, 1); PG8_SCHED; PG8_LDA(At, 1, 0); PG8_STAGE(PG8_SA(0, 1), a2 + hstep, voffA);
            PG8_WAIT_V(8); PG8_WAIT_L(0); PG8_BAR; PG8_MMA(0, 0, At, B0); PG8_MMA(0, 1, At, B1); PG8_BAR; PG8_SCHED;
            PG8_LDA(At, 1, 1); PG8_STAGEB(PG8_SB(1, 0), b3, voffB); PG8_STAGEB(PG8_SB(1, 1), b3 + hstep, voffB); PG8_STAGE(PG8_SA(1, 0), a3, voffA);
            PG8_WAIT_V(8); PG8_WAIT_L(0); PG8_BAR; PG8_MMA(1, 0, At, B0); PG8_MMA(1, 1, At, B1); PG8_BAR; PG8_SCHED;
            } else {
            PG8_LDB(B0, 0, 0); PG8_SCHED; PG8_LDA(At, 0, 0); PG8_STAGE(PG8_SA(1, 1), a1 + hstep, voffA);
            PG8_WAIT_L(8); PG8_BAR; PG8_WAIT_L(0); PG8_MMA(0, 0, At, B0); PG8_BAR; PG8_SCHED;
            PG8_LDB(B1, 0, 1); PG8_STAGEB(PG8_SB(0, 0), b2, voffB);
            PG8_BAR; PG8_WAIT_L(0); PG8_MMA(0, 1, At, B1); PG8_BAR;
            PG8_LDA(At, 0, 1); PG8_STAGE(PG8_SA(0, 0), a2, voffA);
            PG8_BAR; PG8_WAIT_L(0); PG8_MMA(1, 0, At, B0); PG8_BAR; PG8_SCHED;
            PG8_STAGEB(PG8_SB(0, 1), b2 + hstep, voffB);
            PG8_WAIT_V(6); PG8_BAR; PG8_MMA(1, 1, At, B1); PG8_BAR;
            PG8_LDB(B0, 1, 0); PG8_SCHED; PG8_LDA(At, 1, 0); PG8_STAGE(PG8_SA(0, 1), a2 + hstep, voffA);
            PG8_WAIT_L(8); PG8_BAR; PG8_WAIT_L(0); PG8_MMA(0, 0, At, B0); PG8_BAR; PG8_SCHED;
            PG8_LDB(B1, 1, 1); PG8_STAGEB(PG8_SB(1, 0), b3, voffB);
            PG8_BAR; PG8_WAIT_L(0); PG8_MMA(0, 1, At, B1); PG8_BAR;
            PG8_LDA(At, 1, 1); PG8_STAGE(PG8_SA(1, 0), a3, voffA);
            PG8_BAR; PG8_WAIT_L(0); PG8_MMA(1, 0, At, B0); PG8_BAR; PG8_SCHED;
            PG8_STAGEB(PG8_SB(1, 1), b3 + hstep, voffB);
            PG8_WAIT_V(6); PG8_BAR; PG8_MMA(1, 1, At, B1); PG8_BAR;
            }
        }
        if constexpr (ALIGN_EPI) { if (wr == 0) PG8_BAR; }
        if constexpr (!Epi::AFTER_DRAIN) { E(acc, cur, wr, wc, fr, fq); S.done(cur); }
        if (!has_next) break;
        bool zero_ = true; if constexpr (Epi::KEEP_ACC) zero_ = E.zero_after(cur);
        if (zero_) {
#pragma unroll
        for (int a = 0; a < 2; ++a)
#pragma unroll
            for (int b = 0; b < 2; ++b)
#pragma unroll
                for (int m = 0; m < 4; ++m)
#pragma unroll
                    for (int n = 0; n < 2; ++n) acc[a][b][m][n] = (f32x4){0.f, 0.f, 0.f, 0.f};
        }
        cur = nxt; cA = nA; cB = nB; ++ui;
        if constexpr (ALIGN_EPI) { if (wr == 1) PG8_BAR; }
    }
    PG8_WAIT_V(0);
    if constexpr (!ALIGN_EPI) { if (wr == 0) PG8_BAR; }
    PG8_BAR;
    if constexpr (Epi::AFTER_DRAIN) { E.fused(acc, cur, wr, wc, fr, fq, lds, wid, lane); S.done(cur); }
#undef PG8_SA
#undef PG8_SB
#undef PG8_STAGE
#undef PG8_STAGEB
#undef PG8_LDA
#undef PG8_LDB
#undef PG8_MMA
#undef PG8_WAIT_V
#undef PG8_WAIT_L
#undef PG8_BAR
#undef PG8_SCHED
}
}
#include <hip/hip_bf16.h>
#include <cmath>
#ifndef ATT_NEGM
#define ATT_NEGM 1
#endif
namespace attn_body {
using bf16=__hip_bfloat16;
using bf16x8=__attribute__((ext_vector_type(8)))short;
using s16x4=__attribute__((ext_vector_type(4)))short;
using f32x16=__attribute__((ext_vector_type(16)))float;
using u32x4=__attribute__((ext_vector_type(4)))unsigned;
constexpr int D=64, QP=512, KP=128, VP=12288, OP=2304;
constexpr int NW=8,QBLK=32,QB=QBLK*NW,KVBLK=64;
constexpr int ATTN_UNIT_ROWS=QB;
__device__ __forceinline__ int crow(int r,int hi){return (r&3)+8*(r>>2)+4*hi;}
#define SBAR() __builtin_amdgcn_sched_barrier(0)
__device__ __forceinline__ void swamask(f32x16&p0,f32x16&p1,int dbase){
  const float NEG=-INFINITY;
  #pragma unroll
  for(int r=0;r<16;++r){const int d=dbase+(r&3)+8*(r>>2); if(d>128||d<-128)p0[r]=NEG; if(d+32>128||d+32<-128)p1[r]=NEG;}
}

constexpr int NSLOT=3, SLOTB=8192;
constexpr int LDS_K=0, LDS_V=NSLOT*SLOTB, LDS_WS=2*NSLOT*SLOTB, LDS_OST=LDS_WS+NW*64*4, LDS_BYTES=LDS_OST+NW*4096;
constexpr float C2=0.125f*1.4426950408889634f;
__device__ __forceinline__ void glds16(const void*gsrc,unsigned lds_dst){unsigned keep;
  asm volatile("s_mov_b32 %0, m0\n\ts_mov_b32 m0, %2\n\ts_nop 0\n\tglobal_load_lds_dwordx4 %1, off\n\ts_mov_b32 m0, %0":"=&s"(keep):"v"(gsrc),"s"(lds_dst):"memory");}
__device__ __forceinline__ float max3f(float a,float b,float c){float r;asm("v_max3_f32 %0, %1, %2, %3":"=v"(r):"v"(a),"v"(b),"v"(c));return r;}
__device__ __forceinline__ float max2f(float a,float b){float r;asm("v_max_f32_e32 %0, %1, %2":"=v"(r):"v"(a),"v"(b));return r;}
__device__ __forceinline__ float fadd_s(float a,float b){float r;asm("v_add_f32_e32 %0, %1, %2":"=v"(r):"v"(a),"v"(b));return r;}
__device__ __forceinline__ float fsub_s(float a,float b){float r;asm("v_sub_f32_e32 %0, %1, %2":"=v"(r):"v"(a),"v"(b));return r;}
typedef float f32x2_t __attribute__((ext_vector_type(2))); typedef __bf16 bf16x2_t __attribute__((ext_vector_type(2)));
__device__ __forceinline__ unsigned cvtpk_s(float lo,float hi){f32x2_t v={lo,hi};bf16x2_t b=__builtin_convertvector(v,bf16x2_t);return __builtin_bit_cast(unsigned,b);}
#define WAIT_BAR(N) asm volatile("s_waitcnt vmcnt(" #N ") lgkmcnt(0)\n\ts_barrier":::"memory")

__device__ __forceinline__ void qkt(f32x16&p0,f32x16&p1,const char*Kslot,const bf16x8*qr,const f32x16&negm,int r32,int hi){
  const char*kb=Kslot+hi*1024+r32*16;
  #pragma unroll
  for(int d0=0;d0<4;++d0){
    const bf16x8 b0=*reinterpret_cast<const bf16x8*>(kb+d0*2048);
    const bf16x8 b1=*reinterpret_cast<const bf16x8*>(kb+d0*2048+512);
    if(d0==0){p0=__builtin_amdgcn_mfma_f32_32x32x16_bf16(b0,qr[0],negm,0,0,0);p1=__builtin_amdgcn_mfma_f32_32x32x16_bf16(b1,qr[0],negm,0,0,0);}
    else{p0=__builtin_amdgcn_mfma_f32_32x32x16_bf16(b0,qr[d0],p0,0,0,0);p1=__builtin_amdgcn_mfma_f32_32x32x16_bf16(b1,qr[d0],p1,0,0,0);}}
}
typedef __attribute__((address_space(3))) const char* lds_cptr;
typedef short v4i16_t __attribute__((ext_vector_type(4)));
__device__ __forceinline__ void kload8(bf16x8*kf,lds_cptr kp){
  kf[0]=*(const __attribute__((address_space(3))) bf16x8*)(kp);      kf[1]=*(const __attribute__((address_space(3))) bf16x8*)(kp+512);
  kf[2]=*(const __attribute__((address_space(3))) bf16x8*)(kp+2048); kf[3]=*(const __attribute__((address_space(3))) bf16x8*)(kp+2560);
  kf[4]=*(const __attribute__((address_space(3))) bf16x8*)(kp+4096); kf[5]=*(const __attribute__((address_space(3))) bf16x8*)(kp+4608);
  kf[6]=*(const __attribute__((address_space(3))) bf16x8*)(kp+6144); kf[7]=*(const __attribute__((address_space(3))) bf16x8*)(kp+6656);
}
__device__ __forceinline__ void kload2(bf16x8*kf,lds_cptr kp,int j){ kf[2*j]=*(const __attribute__((address_space(3))) bf16x8*)(kp+j*2048); kf[2*j+1]=*(const __attribute__((address_space(3))) bf16x8*)(kp+j*2048+512); }
__device__ __forceinline__ s16x4 vtr(lds_cptr p){ return __builtin_bit_cast(s16x4,__builtin_amdgcn_ds_read_tr16_b64_v4i16((__attribute__((address_space(3))) v4i16_t*)p)); }
__device__ __forceinline__ float rowmax(const f32x16&p0,const f32x16&p1){
  float a=max3f(p0[0],p0[1],p1[0]),b=max3f(p0[2],p0[3],p1[1]);a=max3f(a,p1[2],p1[3]);
  #pragma unroll
  for(int r=4;r<16;r+=4){a=max3f(a,p0[r],p0[r+1]);b=max3f(b,p0[r+2],p0[r+3]);a=max3f(a,p1[r],p1[r+1]);b=max3f(b,p1[r+2],p1[r+3]);}
  const float m=max2f(a,b);
  auto rr=__builtin_amdgcn_permlane32_swap(__float_as_uint(m),__float_as_uint(m),false,false);
  return max2f(__uint_as_float(rr[0]),__uint_as_float(rr[1]));
}
__device__ __forceinline__ void pv(f32x16*o,int vb,bf16x8 pa0,bf16x8 pa1,bf16x8 pa2,bf16x8 pa3){
  #pragma unroll
  for(int d0=0;d0<2;++d0){s16x4 lo[4],hi[4];
    #pragma unroll
    for(int ks=0;ks<4;++ks){
      asm volatile("ds_read_b64_tr_b16 %0,%1 offset:%c2":"=&v"(lo[ks]):"v"(vb),"i"(d0*4096+ks*1024):"memory");
      asm volatile("ds_read_b64_tr_b16 %0,%1 offset:%c2":"=&v"(hi[ks]):"v"(vb),"i"(d0*4096+ks*1024+512):"memory");}
    asm volatile("s_waitcnt lgkmcnt(0)":::"memory");SBAR();
    #define PK(k) (bf16x8){lo[k][0],lo[k][1],lo[k][2],lo[k][3],hi[k][0],hi[k][1],hi[k][2],hi[k][3]}
    o[d0]=__builtin_amdgcn_mfma_f32_32x32x16_bf16(pa0,PK(0),o[d0],0,0,0);
    o[d0]=__builtin_amdgcn_mfma_f32_32x32x16_bf16(pa1,PK(1),o[d0],0,0,0);
    o[d0]=__builtin_amdgcn_mfma_f32_32x32x16_bf16(pa2,PK(2),o[d0],0,0,0);
    o[d0]=__builtin_amdgcn_mfma_f32_32x32x16_bf16(pa3,PK(3),o[d0],0,0,0);
    #undef PK
  }
}

#ifndef ATTN_STORE16
#define ATTN_STORE16(p,v) (*(u32x4*)(p)=(v))
#endif
template<int THRL,int MODE> __device__ __forceinline__ void attn_unit(const bf16*Qu,const bf16*__restrict__ Kh,const bf16*__restrict__ Vh,bf16*Ou,int NT,int n0,int s0,int s1,int qrow0,float sink2,bool has_sink,char*shm){
  int tid_=threadIdx.x; asm volatile("":"+v"(tid_)); const int tid=tid_,lane=tid&63,r32=lane&31,hi=lane>>5; const int wid=__builtin_amdgcn_readfirstlane(tid>>6);
  const bf16*Qw=Qu+(long)(wid*QBLK)*QP;
  const unsigned lds0=(unsigned)(uintptr_t)shm;
  float*wsf=(float*)(shm+LDS_WS)+wid*64;
  const bf16*ksrc=Kh+(long)lane*KP+wid*8;
  const bf16*vsrc=Vh+(long)(16*(wid&3)+(lane>>2))*VP+(wid>>2)*32+(lane&3)*8;
  #define TROW(t) (MODE==0 ? KVBLK*(t) : ((t)<n0 ? s0+KVBLK*(t) : s1+KVBLK*((t)-n0)))
  const unsigned kdst=lds0+LDS_K+wid*1024, vdst=lds0+LDS_V+wid*1024;
  #define DMA_K(t,slot) glds16(ksrc+(long)TROW(t)*KP,(unsigned)__builtin_amdgcn_readfirstlane(kdst+(slot)))
  #define DMA_V(t,slot) glds16(vsrc+(long)TROW(t)*VP,(unsigned)__builtin_amdgcn_readfirstlane(vdst+(slot)))
  const int vb0=(int)(lds0+LDS_V)+((lane>>4)&1)*32+(lane&3)*8+(4*hi+((lane&15)>>2))*64;
  const char*Kbase=shm+LDS_K; bf16x8 kf[8];
  const lds_cptr shm3=(lds_cptr)shm; const lds_cptr kp0=shm3+LDS_K+hi*1024+r32*16; const lds_cptr vp0=shm3+LDS_V+((lane>>4)&1)*32+(lane&3)*8+(4*hi+((lane&15)>>2))*64;
  DMA_K(0,0);DMA_V(0,0);DMA_K(1,SLOTB);
  bf16x8 qr[4];
  #pragma unroll
  for(int d0=0;d0<4;++d0)qr[d0]=*reinterpret_cast<const bf16x8*>(&Qw[(long)r32*QP+d0*16+hi*8]);
  float mhat=0.f,l_reg=0.f;f32x16 o[2];o[0]=f32x16{};o[1]=f32x16{};f32x16 negm=f32x16{}; if(ATT_NEGM&&MODE==0)asm volatile("":"+v"(negm));
  const int qrow=qrow0+wid*QBLK+r32;
  #define CMASK(P0,P1,t) do{ if(MODE==1 && (t)>=n0) swamask(P0,P1,TROW(t)+4*hi-qrow); }while(0)
  bool resc=false;
  #define START(P0,P1) do{ const float rm=rowmax(P0,P1); resc=false; \
    { const float dl=rm; mhat=fadd_s(mhat,dl); \
      _Pragma("unroll") for(int r=0;r<16;++r){P0[r]=fsub_s(P0[r],dl);P1[r]=fsub_s(P1[r],dl);} \
      if(ATT_NEGM&&MODE==0){ _Pragma("unroll") for(int r=0;r<16;++r)negm[r]=-mhat; asm volatile("":"+v"(negm)); } } \
    _Pragma("unroll") for(int r=0;r<16;++r)P0[r]=__builtin_amdgcn_exp2f(P0[r]); }while(0)
  #define RESC() do{ if(resc){ asm volatile("s_waitcnt lgkmcnt(0)":::"memory"); \
      _Pragma("unroll") for(int d_=0;d_<2;++d_) _Pragma("unroll") for(int r=0;r<16;++r)o[d_][r]*=wsf[crow(r,hi)]; } }while(0)
  f32x16 pA0,pA1,pB0,pB1;
  int sl_prev=0,sl_cur=0,sl_next=SLOTB;
  #define ROT() do{sl_prev=sl_cur;sl_cur=sl_next;sl_next=(sl_next==(NSLOT-1)*SLOTB)?0:sl_next+SLOTB;}while(0)
  DMA_K(2,2*SLOTB);
  WAIT_BAR(3);
  qkt(pA0,pA1,Kbase,qr,negm,r32,hi);asm volatile("s_nop 15\n\ts_nop 7":"+v"(pA0),"+v"(pA1));CMASK(pA0,pA1,0);
  START(pA0,pA1);
  _Pragma("unroll") for(int r=0;r<16;++r)pA1[r]=__builtin_amdgcn_exp2f(pA1[r]);
  WAIT_BAR(0);
  DMA_K(3,0);DMA_V(1,SLOTB);
  ROT();
  kload8(kf,kp0+sl_cur);
  WAIT_BAR(2);
  s16x4 vlo[8],vhi[8]; u32x4 pw0,pw1,pw2,pw3;
  #define PKW(P,B) cvtpk_s(P[B],P[B+1])
  #define PAF(k) __builtin_bit_cast(bf16x8,pw##k)
  #define VFR(i) (bf16x8){vlo[i][0],vlo[i][1],vlo[i][2],vlo[i][3],vhi[i][0],vhi[i][1],vhi[i][2],vhi[i][3]}
  #define PIN(x) asm volatile("":"+v"(x))
  #define MX3(a,b,c) __builtin_fmaxf(__builtin_fmaxf((a),(b)),(c))
  #define GAPA(MF,A0,A1,A2,A3,W0,W1,PW) do{ MF; sacc+=A0; sacc+=A1; sacc+=A2; sacc+=A3; PIN(sacc); W0; W1; PIN(PW); SBAR(); }while(0)
  #define EX(v) __builtin_amdgcn_exp2f(v)
  #define GAPB(MF,X,B) do{ MF; X[B]=EX(X[B]); X[B+1]=EX(X[B+1]); X[B+2]=EX(X[B+2]); X[B+3]=EX(X[B+3]); PIN(X); SBAR(); }while(0)
  #define VRD(i) do{ vlo[i]=vtr(vp_+(((i)>>2)*4096+((i)&3)*1024)); vhi[i]=vtr(vp_+(((i)>>2)*4096+((i)&3)*1024+512)); }while(0)
  #define KRD(G,j) do{ if(G){ kload2(kf,kp0+sl_next,j); SBAR(); } }while(0)
  #define STEP(C0,C1,P0,P1,t,GK,GV,GL) do{ SBAR(); \
    const lds_cptr vp_=vp0+sl_prev; \
    VRD(0); SBAR(); float sacc=(P0[0]+P0[1]); \
    GAPA(C0=__builtin_amdgcn_mfma_f32_32x32x16_bf16(kf[0],qr[0],((ATT_NEGM&&MODE==0)?negm:f32x16{}),0,0,0), P0[2],P0[3],P0[4],P0[5],     pw0[0]=PKW(P0,0), pw0[1]=PKW(P0,2), pw0); \
    VRD(4); SBAR(); GAPA(C1=__builtin_amdgcn_mfma_f32_32x32x16_bf16(kf[1],qr[0],((ATT_NEGM&&MODE==0)?negm:f32x16{}),0,0,0), P0[6],P0[7],P0[8],P0[9],     pw0[2]=PKW(P0,4), pw0[3]=PKW(P0,6), pw0); \
    VRD(1); SBAR(); GAPA(C0=__builtin_amdgcn_mfma_f32_32x32x16_bf16(kf[2],qr[1],C0,0,0,0),   P0[10],P0[11],P0[12],P0[13], pw1[0]=PKW(P0,8), pw1[1]=PKW(P0,10), pw1); \
    VRD(5); SBAR(); GAPA(C1=__builtin_amdgcn_mfma_f32_32x32x16_bf16(kf[3],qr[1],C1,0,0,0),   P0[14],P0[15],P1[0],P1[1],   pw1[2]=PKW(P0,12),pw1[3]=PKW(P0,14), pw1); \
    VRD(2); SBAR(); GAPA(C0=__builtin_amdgcn_mfma_f32_32x32x16_bf16(kf[4],qr[2],C0,0,0,0),   P1[2],P1[3],P1[4],P1[5],     pw2[0]=PKW(P1,0), pw2[1]=PKW(P1,2), pw2); \
    VRD(6); SBAR(); GAPA(C1=__builtin_amdgcn_mfma_f32_32x32x16_bf16(kf[5],qr[2],C1,0,0,0),   P1[6],P1[7],P1[8],P1[9],     pw2[2]=PKW(P1,4), pw2[3]=PKW(P1,6), pw2); \
    VRD(3); SBAR(); GAPA(C0=__builtin_amdgcn_mfma_f32_32x32x16_bf16(kf[6],qr[3],C0,0,0,0),   P1[10],P1[11],P1[12],P1[13], pw3[0]=PKW(P1,8), pw3[1]=PKW(P1,10), pw3); \
    VRD(7); SBAR(); GAPA(C1=__builtin_amdgcn_mfma_f32_32x32x16_bf16(kf[7],qr[3],C1,0,0,0),   P1[14],P1[15],0.f,0.f,       pw3[2]=PKW(P1,12),pw3[3]=PKW(P1,14), pw3); \
    l_reg+=sacc; \
    if(GK){DMA_K((t)+3,sl_cur);} if(GV){DMA_V((t)+1,sl_next);} \
    if(!(ATT_NEGM&&MODE==0)){ _Pragma("unroll") for(int r=0;r<16;++r){C0[r]-=mhat;C1[r]-=mhat;} } \
    CMASK(C0,C1,t); \
    { float a=MX3(C0[0],C0[1],C1[0]),b=MX3(C0[2],C0[3],C1[1]); a=MX3(a,C1[2],C1[3]); \
      _Pragma("unroll") for(int r=4;r<16;r+=4){a=MX3(a,C0[r],C0[r+1]);b=MX3(b,C0[r+2],C0[r+3]);a=MX3(a,C1[r],C1[r+1]);b=MX3(b,C1[r+2],C1[r+3]);} \
      float rm=__builtin_fmaxf(a,b); { auto rr=__builtin_amdgcn_permlane32_swap(__float_as_uint(rm),__float_as_uint(rm),false,false); rm=__builtin_fmaxf(__uint_as_float(rr[0]),__uint_as_float(rr[1])); } \
      resc=false; \
      if(__builtin_expect(__any(rm>(float)THRL),0)){ const float dl=__builtin_fmaxf(rm,0.f); mhat+=dl; \
        _Pragma("unroll") for(int r=0;r<16;++r){C0[r]-=dl;C1[r]-=dl;} \
        if(ATT_NEGM&&MODE==0){ _Pragma("unroll") for(int r=0;r<16;++r)negm[r]=-mhat; asm volatile("":"+v"(negm)); } \
        const float f=__builtin_amdgcn_exp2f(-dl); l_reg*=f; if(hi==0)wsf[r32]=f; resc=true; } } \
    SBAR(); \
    GAPB(o[0]=__builtin_amdgcn_mfma_f32_32x32x16_bf16(PAF(0),VFR(0),o[0],0,0,0), C0,0); \
    GAPB(o[1]=__builtin_amdgcn_mfma_f32_32x32x16_bf16(PAF(0),VFR(4),o[1],0,0,0), C0,4); \
    KRD(GL,0); GAPB(o[0]=__builtin_amdgcn_mfma_f32_32x32x16_bf16(PAF(1),VFR(1),o[0],0,0,0), C0,8); \
    KRD(GL,1); GAPB(o[1]=__builtin_amdgcn_mfma_f32_32x32x16_bf16(PAF(1),VFR(5),o[1],0,0,0), C0,12); \
    KRD(GL,2); GAPB(o[0]=__builtin_amdgcn_mfma_f32_32x32x16_bf16(PAF(2),VFR(2),o[0],0,0,0), C1,0); \
    KRD(GL,3); GAPB(o[1]=__builtin_amdgcn_mfma_f32_32x32x16_bf16(PAF(2),VFR(6),o[1],0,0,0), C1,4); \
    GAPB(o[0]=__builtin_amdgcn_mfma_f32_32x32x16_bf16(PAF(3),VFR(3),o[0],0,0,0), C1,8); \
    GAPB(o[1]=__builtin_amdgcn_mfma_f32_32x32x16_bf16(PAF(3),VFR(7),o[1],0,0,0), C1,12); \
    }while(0)
  int t=1;
  for(;t+5<NT;t+=2){
    STEP(pB0,pB1,pA0,pA1,t,true,true,true);     WAIT_BAR(2); RESC(); ROT();
    STEP(pA0,pA1,pB0,pB1,t+1,true,true,true);   WAIT_BAR(2); RESC(); ROT();
  }
  #define ENDW(tt) do{ if((tt)+3<NT){WAIT_BAR(2);} else if((tt)+2<NT){WAIT_BAR(1);} else {WAIT_BAR(0);} }while(0)
  for(;t+1<NT;t+=2){
    STEP(pB0,pB1,pA0,pA1,t,(t+3<NT),(t+1<NT),(t+1<NT));       ENDW(t);   RESC(); ROT();
    STEP(pA0,pA1,pB0,pB1,t+1,(t+4<NT),(t+2<NT),(t+2<NT));     ENDW(t+1); RESC(); ROT();
  }
  STEP(pB0,pB1,pA0,pA1,NT-1,false,false,false); RESC();
  { float sacc=pB0[0]+pB0[1]; _Pragma("unroll") for(int r=2;r<16;++r)sacc+=pB0[r]; _Pragma("unroll") for(int r=0;r<16;++r)sacc+=pB1[r]; l_reg+=sacc;
    pw0=(u32x4){PKW(pB0,0),PKW(pB0,2),PKW(pB0,4),PKW(pB0,6)};pw1=(u32x4){PKW(pB0,8),PKW(pB0,10),PKW(pB0,12),PKW(pB0,14)};pw2=(u32x4){PKW(pB1,0),PKW(pB1,2),PKW(pB1,4),PKW(pB1,6)};pw3=(u32x4){PKW(pB1,8),PKW(pB1,10),PKW(pB1,12),PKW(pB1,14)};
    SBAR(); pv(o,vb0+sl_cur,PAF(0),PAF(1),PAF(2),PAF(3)); }
  #undef PKW
  #undef PAF
  #undef VFR
  #undef PIN
  #undef MX3
  #undef GAPA
  #undef GAPB
  #undef EX
  #undef VRD
  #undef KRD
  #undef STEP
  #undef ENDW
  {auto rr=__builtin_amdgcn_permlane32_swap(__float_as_uint(l_reg),__float_as_uint(l_reg),false,false);l_reg=__uint_as_float(rr[0])+__uint_as_float(rr[1]);}
  if(has_sink)l_reg+=__builtin_amdgcn_exp2f(sink2-mhat);
  if(hi==0)wsf[32+r32]=l_reg;asm volatile("s_waitcnt lgkmcnt(0)":::"memory");
  float rli[16];
  #pragma unroll
  for(int r=0;r<16;++r)rli[r]=__builtin_amdgcn_rcpf(wsf[32+crow(r,hi)]);
  bf16*Ow=Ou+(long)(wid*QBLK)*OP;
  { bf16*stg=(bf16*)(shm+LDS_OST)+wid*2048;
    #pragma unroll
    for(int r=0;r<16;++r){const int orow=crow(r,hi);
      #pragma unroll
      for(int d0=0;d0<2;++d0)stg[orow*64+d0*32+r32]=__float2bfloat16(o[d0][r]*rli[r]);}
    asm volatile("s_waitcnt lgkmcnt(0)":::"memory");
    #pragma unroll
    for(int i=0;i<4;++i){const int row=i*8+(lane>>3),ch=lane&7; const u32x4 v=*(const u32x4*)(stg+row*64+ch*8); ATTN_STORE16(Ow+(long)row*OP+ch*8,v);} }
  asm volatile("s_waitcnt lgkmcnt(0)\n\ts_barrier":::"memory");
  #undef TROW
  #undef DMA_K
  #undef DMA_V
  #undef CMASK
  #undef START
  #undef RESC
  #undef ROT
}
constexpr int ATTN_LDS_BYTES=LDS_BYTES;
#undef SBAR
#undef WAIT_BAR
}
constexpr int DM = 2048, SEQ = 16384, CTXN = 256, MR = SEQ + CTXN, DEPTH = 4;
constexpr int DFF = 5632, NFF = 2 * DFF, DIN = 12312, NP = 12288;
constexpr int PC_Z = 0, PC_XBC = 768, PC_U = 2048, PC_SQ = 2560, PC_SK = 3072, PC_SV = 3200, PC_GQ = 3328, PC_GK = 3840, PC_GV = 3968, PC_GATE = 4096;
constexpr int NMODV = 9 * DM;
constexpr float LOG2E = 1.4426950408889634f;
constexpr float QSCALE = 0.125f * LOG2E;
constexpr int NWAVES = 8;
enum { I_X = 0, I_C, I_CTX, I_CCTX, I_WMOD, I_BMOD, I_NORMG, I_FFIN, I_FFOUT, I_WIN, I_CONVW, I_CONVB, I_ALOG, I_DTB, I_SSDD, I_SSDNG, I_S5ARE, I_S5AIM, I_S5LDT, I_S5BRE, I_S5BIM,
       I_S5CRE, I_S5CIM, I_S5D, I_GLUW, I_GLUB, I_SWAG, I_SINK, I_GLBG, I_BRSSD, I_BRS5, I_BRSWA, I_BRGLB, I_WOUT, N_IN };

constexpr size_t al256(size_t x) { return (x + 255) & ~(size_t)255; }
constexpr size_t WS_CTL = 0, CTL_ZERO_BYTES = 64u << 10;
constexpr size_t WS_MODP = CTL_ZERO_BYTES;
constexpr size_t WS_MOD = WS_MODP + al256((size_t)DEPTH * 32 * 2 * NMODV * 4);
constexpr size_t WS_X = WS_MOD + al256((size_t)DEPTH * 2 * NMODV * 4);
constexpr size_t WS_H = WS_X + al256((size_t)MR * DM * 4);
constexpr size_t WS_HID = WS_H + al256((size_t)MR * DM * 2);
constexpr size_t WS_P = WS_HID + al256((size_t)MR * DFF * 2);
constexpr size_t WS_DTRAW = WS_P + al256((size_t)MR * NP * 2);
constexpr size_t WS_DT = WS_DTRAW + al256((size_t)MR * 32 * 4);
constexpr size_t WS_XBC = WS_DT + al256((size_t)MR * 24 * 4);
constexpr size_t WS_QS = WS_XBC + al256((size_t)MR * 1280 * 4);
constexpr size_t WS_QG = WS_QS + al256((size_t)MR * 512 * 2);
constexpr size_t WS_KS = WS_QG + al256((size_t)MR * 512 * 2);
constexpr size_t WS_KG = WS_KS + al256((size_t)MR * 128 * 2);
constexpr size_t WS_YS = WS_KG + al256((size_t)MR * 128 * 2);
constexpr size_t WS_YBF = WS_YS + al256((size_t)2 * MR * 768 * 4);
constexpr size_t WS_S5END = WS_YBF + al256((size_t)2 * MR * 512 * 4);
constexpr size_t WS_S5IN = WS_S5END + al256((size_t)64 * 260 * 128 * 4);
constexpr size_t WS_XSN = WS_S5IN + al256((size_t)64 * 260 * 128 * 4);
constexpr size_t WS_XT = WS_XSN + al256((size_t)MR * 768 * 2);
constexpr size_t WS_BN = WS_XT + al256((size_t)MR * 768 * 2);
constexpr size_t WS_CN = WS_BN + al256((size_t)MR * 256 * 2);
constexpr size_t WS_BT = WS_CN + al256((size_t)MR * 256 * 2);
constexpr size_t WS_STATES = WS_BT + al256((size_t)MR * 256 * 2);
constexpr size_t WS_SINB = WS_STATES + al256((size_t)260 * 24 * 8192 * 4);
constexpr size_t WS_CHD = WS_SINB + al256((size_t)260 * 24 * 8192 * 2);
constexpr size_t WS_YALL = WS_CHD + al256((size_t)260 * 24 * 4);
constexpr int YPITCH = 2304, YC_B = 768, YC_C = 1280, YC_D = 1792;
constexpr size_t WS_YBP = WS_YALL + al256((size_t)MR * YPITCH * 2);
constexpr size_t WS_MGF = WS_YBP + al256((size_t)MR * 512 * 2);
constexpr size_t WS_MG = WS_MGF + al256((size_t)MR * DM * 4);
constexpr size_t WS_W = WS_MG + al256((size_t)MR * DM * 2);
constexpr size_t WL_FFI = 0;
constexpr size_t WL_FFO = WL_FFI + (size_t)2 * NFF * DM;
constexpr size_t WL_WIN = WL_FFO + (size_t)2 * DM * DFF;
constexpr size_t WL_WDT = WL_WIN + (size_t)NP * DM;
constexpr size_t WL_GLU = WL_WDT + (size_t)32 * DM;
constexpr size_t WL_BRALL = WL_GLU + (size_t)1024 * 512;
constexpr size_t WL_OUT = WL_BRALL + (size_t)DM * YPITCH;
constexpr size_t WL_SIZE = WL_OUT + (size_t)DM * DM;
constexpr size_t WS_PART = WS_W + al256((size_t)DEPTH * WL_SIZE * 2);
constexpr size_t WS_END = WS_PART + al256((size_t)11 * 256 * DM * 4);
constexpr int CW_BAR = 4096;

constexpr int RING_OFF = 0, RING_BYTES = 131072;
constexpr int LDSCTL_OFF = RING_BYTES, MISC_OFF = LDSCTL_OFF + 320;
constexpr int LDS_BYTES = 147456;

#define GAS __attribute__((address_space(1)))
#define LAS __attribute__((address_space(3)))
typedef unsigned short bf16;
typedef unsigned v4u __attribute__((ext_vector_type(4)));
typedef unsigned v2u __attribute__((ext_vector_type(2)));
typedef float f32x4 __attribute__((ext_vector_type(4)));
typedef short bf16x8 __attribute__((ext_vector_type(8)));
typedef GAS unsigned gu32;
#define RLX_AGENT __ATOMIC_RELAXED, __HIP_MEMORY_SCOPE_AGENT
#define LDS_WAIT() asm volatile("s_waitcnt lgkmcnt(0)" ::: "memory")
#define VM_WAIT() asm volatile("s_waitcnt vmcnt(0)" ::: "memory")
__device__ __forceinline__ unsigned f2bf(float f) { unsigned u = __builtin_bit_cast(unsigned, f); return (u + 0x7fffu + ((u >> 16) & 1u)) >> 16; }
__device__ __forceinline__ unsigned pk2(float lo, float hi) { return f2bf(lo) | (f2bf(hi) << 16); }
__device__ __forceinline__ float bflo(unsigned w) { return __uint_as_float(w << 16); }
__device__ __forceinline__ float bfhi(unsigned w) { return __uint_as_float(w & 0xffff0000u); }
__device__ __forceinline__ float bf1(bf16 h) { return __uint_as_float(((unsigned)h) << 16); }
__device__ __forceinline__ float sigm_(float x) { return __builtin_amdgcn_rcpf(1.0f + __builtin_amdgcn_exp2f(-LOG2E * x)); }
__device__ __forceinline__ float silu_(float x) { return x * sigm_(x); }
#define XB_TMO      128
#define XB_XCNT(j)  (256  + 64 * (j))
#define XB_XSUB(j)  (1280 + 64 * (j))
#define XB_XGEN(j)  (2304 + 64 * (j))
#define XB_TOP      3328
#define XB_TOPGEN   3392
#define XCD_BAR_WORDS 3456
#define XB_SPIN_CAP (1u << 18)

__device__ __forceinline__ unsigned xb_ld(unsigned* p)              { return __hip_atomic_load(p, __ATOMIC_RELAXED, __HIP_MEMORY_SCOPE_AGENT); }
__device__ __forceinline__ unsigned xb_add(unsigned* p, unsigned v) { return __hip_atomic_fetch_add(p, v, __ATOMIC_RELAXED, __HIP_MEMORY_SCOPE_AGENT); }
__device__ __forceinline__ unsigned xb_xcc_id() { return (unsigned)__builtin_amdgcn_s_getreg((3 << 11) | 20) & 0xFu; }
#define XB_SPIN(cond, bar) do { unsigned _sp = 0; while (cond) { __builtin_amdgcn_s_sleep(1); \
    if ((++_sp & 255u) == 0u) { if (xb_ld(&(bar)[XB_TMO])) break; if (_sp > XB_SPIN_CAP) { atomicAdd(&(bar)[XB_TMO], 1u); break; } } } } while (0)

struct XcdBarrier {
    unsigned* bar; unsigned x;
    volatile LAS unsigned* st;
};

__device__ __forceinline__ XcdBarrier xcd_barrier_post(unsigned* bar, volatile LAS unsigned* st) {
    XcdBarrier b; b.bar = bar; b.x = xb_xcc_id(); b.st = st;
    if (threadIdx.x == 0) (void)xb_add(&bar[XB_XCNT(b.x)], 1u);
    return b;
}
__device__ __forceinline__ void xcd_barrier_complete(unsigned* bar, unsigned x, unsigned& nloc, unsigned& nx) {
    const unsigned G = gridDim.x * gridDim.y * gridDim.z;
    unsigned sum, cnt, mine, sp = 0u;
    for (;;) {
        sum = 0u; cnt = 0u; mine = 0u;
#pragma unroll
        for (unsigned j = 0; j < 16; ++j) { const unsigned c = xb_ld(&bar[XB_XCNT(j)]); sum += c; cnt += (c > 0u) ? 1u : 0u; }
        mine = xb_ld(&bar[XB_XCNT(x)]);
        if (sum == G) break;
        __builtin_amdgcn_s_sleep(1);
        if ((++sp & 255u) == 0u) { if (xb_ld(&bar[XB_TMO])) break; if (sp > XB_SPIN_CAP) { atomicAdd(&bar[XB_TMO], 1u); break; } }
    }
    nloc = mine > 0u ? mine : 1u; nx = cnt > 0u ? cnt : 1u;
}

__device__ __forceinline__ void xcd_barrier(const XcdBarrier& b) {
    asm volatile("s_waitcnt vmcnt(0)" ::: "memory");
    __syncthreads();
    if (threadIdx.x == 0) {
        unsigned* bar = b.bar;
        __builtin_amdgcn_s_waitcnt(0);
        unsigned nloc = b.st[0], nx = b.st[1];
        if (nloc == 0u) { xcd_barrier_complete(bar, b.x, nloc, nx); b.st[0] = nloc; b.st[1] = nx; }
        const unsigned old = xb_add(&bar[XB_XSUB(b.x)], 1u);
        const unsigned gen = old / nloc;
        if (old + 1u == (gen + 1u) * nloc) {
            __builtin_amdgcn_fence(__ATOMIC_RELEASE, "agent");
            asm volatile("s_waitcnt vmcnt(0)" ::: "memory");
            const unsigned og = xb_add(&bar[XB_TOP], 1u);
            const unsigned tg = og / nx;
            if (og + 1u == (tg + 1u) * nx) xb_add(&bar[XB_TOPGEN], 1u);
            else XB_SPIN(xb_ld(&bar[XB_TOPGEN]) == tg, bar);
            __builtin_amdgcn_fence(__ATOMIC_ACQUIRE, "agent");
            xb_add(&bar[XB_XGEN(b.x)], 1u);
            asm volatile("s_waitcnt vmcnt(0)" ::: "memory");
        } else {
            XB_SPIN(xb_ld(&bar[XB_XGEN(b.x)]) == gen, bar);
            __builtin_amdgcn_fence(__ATOMIC_ACQUIRE, "agent");
            asm volatile("s_waitcnt vmcnt(0)" ::: "memory");
        }
    }
    __syncthreads();
}
struct Args { const float* in[N_IN]; float* out; unsigned char* ws; int ph_lo, ph_hi; };
typedef const volatile __attribute__((address_space(4))) Args* KArgs;
#define AIN(i) ((const float*)(const __attribute__((address_space(1))) float*)a->in[i])
struct Frame {
    LAS unsigned char* lds;
    volatile LAS unsigned* MISC;
    gu32* ctl;
    int tid, lane, wave;
    int vcu, G;
    unsigned char* ws;
};
__device__ __forceinline__ Frame fresh(const Frame& F) { Frame Fp = F; unsigned long long w = (unsigned long long)F.ws; asm volatile("" : "+v"(Fp.tid), "+s"(Fp.vcu), "+s"(w)); Fp.ws = (unsigned char*)(GAS unsigned char*)w; Fp.lane = Fp.tid & 63; Fp.wave = __builtin_amdgcn_readfirstlane(Fp.tid >> 6); return Fp; }
__device__ __forceinline__ float bperm(float v, int srclane) { return __int_as_float(__builtin_amdgcn_ds_bpermute(srclane << 2, __float_as_int(v))); }
__device__ __forceinline__ float wave_sum(float v, int lane) {
#pragma unroll
    for (int o = 1; o < 64; o <<= 1) v += bperm(v, lane ^ o);
    return v;
}
__device__ __forceinline__ int rowof(int dir, int s) { return dir ? (MR - 1 - s) : (s < CTXN ? SEQ + s : s - CTXN); }
__device__ __forceinline__ void sincos_hw(float ang, float& s, float& c) { float r = ang * 0.15915494309189535f; r = r - floorf(r); s = __builtin_amdgcn_sinf(r); c = __builtin_amdgcn_cosf(r); }

__device__ __forceinline__ void transpose_item(const float* W, int ldw, int Nsrc, int src_c0, bf16* WT, int dst_r0, int k0, int nvalid, LAS float* scr, int lane, int my_col = -1) {
#pragma unroll 8
    for (int i = 0; i < 32; ++i) { const int kk = 2 * i + (lane >> 5); scr[kk * 33 + (lane & 31)] = __builtin_nontemporal_load(W + (size_t)(k0 + kk) * Nsrc + (my_col >= 0 ? my_col : src_c0 + (lane & 31))); }
    LDS_WAIT(); asm volatile("" ::: "memory");
    const int c = lane & 7;
#pragma unroll
    for (int j = 0; j < 4; ++j) { const int n = (lane >> 3) + 8 * j; const LAS float* s = scr + (8 * c) * 33 + n;
        v4u o; o.x = pk2(s[0 * 33], s[1 * 33]); o.y = pk2(s[2 * 33], s[3 * 33]); o.z = pk2(s[4 * 33], s[5 * 33]); o.w = pk2(s[6 * 33], s[7 * 33]);
        if (n >= nvalid) o = (v4u){0u, 0u, 0u, 0u};
        __builtin_nontemporal_store(o, (GAS v4u*)(WT + (size_t)(dst_r0 + n) * ldw + k0 + 8 * c)); }
    LDS_WAIT(); asm volatile("" ::: "memory");
}
constexpr int IT_FFI = 32 * 352, IT_FFO = 88 * 64, IT_WIN = 32 * 384, IT_GLU = 8 * 32, IT_BRA = 12 * 64, IT_BRX = 8 * 64, IT_OUT = 32 * 64, IT_WDT = 32;
constexpr int IT_LAYER = 2 * IT_FFI + 2 * IT_FFO + IT_WIN + IT_GLU + IT_BRA + 3 * IT_BRX + IT_OUT + IT_WDT;
#ifndef HIDE_CONVERT
#define HIDE_CONVERT 0
#endif
constexpr int IT_GA = IT_FFI + IT_FFO, IT_GB = IT_WIN + IT_WDT, IT_GC = IT_GLU + IT_BRA + 3 * IT_BRX + IT_OUT, IT_GD = IT_FFI + IT_FFO;
static_assert(IT_GA + IT_GB + IT_GC + IT_GD == IT_LAYER, "item groups");
__device__ __forceinline__ void convert_item(Frame& F, KArgs a, int l, int r, LAS float* scr) {
    bf16* wl = (bf16*)(F.ws + WS_W) + (size_t)l * WL_SIZE;
    int f = 0; if (r >= IT_GA + IT_GB + IT_GC) { f = 1; r -= IT_GA + IT_GB + IT_GC; }
    if (r < IT_FFI) { const int kb = r / 352, gd = r % 352, pn = gd >> 3, w = gd & 7; const int sc0 = (w < 4) ? 128 * pn + 32 * w : DFF + 128 * pn + 32 * (w - 4);
        transpose_item(AIN(I_FFIN) + (size_t)(l * 2 + f) * DM * NFF, DM, NFF, sc0, wl + WL_FFI + (size_t)f * NFF * DM, 32 * gd, 64 * kb, 32, scr, F.lane); return; } r -= IT_FFI;
    if (r < IT_FFO) { const int kb = r / 64, gd = r % 64;
        transpose_item(AIN(I_FFOUT) + (size_t)(l * 2 + f) * DFF * DM, DFF, DM, 32 * gd, wl + WL_FFO + (size_t)f * DM * DFF, 32 * gd, 64 * kb, 32, scr, F.lane); return; } r -= IT_FFO;
    if (r < IT_WIN) { const int kb = r / 384, gd = r % 384; const int d0 = 32 * gd;
        int mc = -1;
        if (d0 >= PC_GATE) { const int j = (d0 - PC_GATE) >> 8, w = (d0 >> 5) & 7, bj = w >> 2, wc = w & 3, o = F.lane & 31, fq = o >> 3, n = (o >> 2) & 1, i = o & 3;
            mc = (DIN - 4 * DM) + 2048 * (2 * bj + n) + 64 * j + 16 * wc + 4 * fq + i; }
        transpose_item(AIN(I_WIN) + (size_t)l * DM * DIN, DM, DIN, d0 < 2048 ? d0 : d0 + 24, wl + WL_WIN, d0, 64 * kb, 32, scr, F.lane, mc); return; } r -= IT_WIN;
    if (r < IT_WDT) { transpose_item(AIN(I_WIN) + (size_t)l * DM * DIN, DM, DIN, 2048, wl + WL_WDT, 0, 64 * r, 24, scr, F.lane); return; } r -= IT_WDT;
    if (r < IT_GLU) { const int kb = r / 32, gd = r % 32, pn = gd >> 3, w = gd & 7; const int sc0 = (w < 4) ? 128 * pn + 32 * w : 512 + 128 * pn + 32 * (w - 4);
        transpose_item(AIN(I_GLUW) + (size_t)l * 512 * 1024, 512, 1024, sc0, wl + WL_GLU, 32 * gd, 64 * kb, 32, scr, F.lane); return; } r -= IT_GLU;
    if (r < IT_BRA) { const int kb = r / 64, gd = r % 64;
        transpose_item(AIN(I_BRSSD) + (size_t)l * 768 * DM, YPITCH, DM, 32 * gd, wl + WL_BRALL, 32 * gd, 64 * kb, 32, scr, F.lane); return; } r -= IT_BRA;
    if (r < 3 * IT_BRX) { const int b = r / IT_BRX; r %= IT_BRX; const int kb = r / 64, gd = r % 64;
        const float* src = (b == 0 ? AIN(I_BRS5) : (b == 1 ? AIN(I_BRSWA) : AIN(I_BRGLB))) + (size_t)l * 512 * DM;
        transpose_item(src, YPITCH, DM, 32 * gd, wl + WL_BRALL + YC_B + 512 * b, 32 * gd, 64 * kb, 32, scr, F.lane); return; } r -= 3 * IT_BRX;
    { const int kb = r / 64, gd = r % 64; transpose_item(AIN(I_WOUT) + (size_t)l * DM * DM, DM, DM, 32 * gd, wl + WL_OUT, 32 * gd, 64 * kb, 32, scr, F.lane); }
}
__device__ __forceinline__ void convert_range(Frame& F, KArgs a, int l, int first, int n, int widx, int wstride) {
    LAS float* scr = (LAS float*)(F.lds + RING_OFF + F.wave * 16384);
    for (int it = first + widx; it < first + n; it += wstride) convert_item(F, a, l, it, scr);
}
__device__ __forceinline__ void convert_idle(Frame& F, KArgs a, int c, int rem, int l, int first, int n) {
    if (c < rem || l >= DEPTH) return;
    convert_range(F, a, l, first, n, (c - rem) * NWAVES + F.wave, (F.G - rem) * NWAVES);
}
__device__ __forceinline__ void p0_prologue(Frame& F, KArgs a) {
    const int gw = F.vcu * NWAVES + F.wave, NGW = F.G * NWAVES;
#if HIDE_CONVERT
    convert_range(F, a, 0, 0, IT_GA, gw, NGW);
#else
    for (int l = 0; l < DEPTH; ++l) convert_range(F, a, l, 0, IT_LAYER, gw, NGW);
#endif
    float* X = (float*)(F.ws + WS_X);
    for (int m = gw; m < MR; m += NGW) {
        const GAS f32x4* src = (const GAS f32x4*)(m < SEQ ? AIN(I_X) + (size_t)m * DM : AIN(I_CTX) + (size_t)(m - SEQ) * DM) + F.lane; GAS f32x4* dst = (GAS f32x4*)(X + (size_t)m * DM) + F.lane;
#pragma unroll
        for (int j = 0; j < 8; ++j) dst[64 * j] = src[64 * j];
    }
    __syncthreads();
    LAS float* sc = (LAS float*)(F.lds + RING_OFF);
    for (int i = F.tid; i < 2 * DM; i += NWAVES * 64) { const float c = (i < DM) ? AIN(I_C)[i] : AIN(I_CCTX)[i - DM]; sc[i] = silu_(c); }
    __syncthreads();
    float* MODP = (float*)(F.ws + WS_MODP);
    for (int it = F.vcu; it < DEPTH * 32 * 9; it += F.G) {
        const int l = it / 288, r = it % 288, s = r / 9, b = r % 9, col = b * 2048 + 4 * F.tid;
        const float* w = AIN(I_WMOD) + (size_t)l * DM * NMODV + (size_t)(64 * s) * NMODV + col;
        f32x4 a0 = {0.f, 0.f, 0.f, 0.f}, a1 = {0.f, 0.f, 0.f, 0.f};
#pragma unroll 8
        for (int k = 0; k < 64; ++k) { const f32x4 wv = __builtin_nontemporal_load((const f32x4*)(w + (size_t)k * NMODV)); a0 += wv * sc[64 * s + k]; a1 += wv * sc[DM + 64 * s + k]; }
        *(f32x4*)(MODP + (size_t)((l * 32 + s) * 2 + 0) * NMODV + col) = a0; *(f32x4*)(MODP + (size_t)((l * 32 + s) * 2 + 1) * NMODV + col) = a1;
    }
}
__device__ __forceinline__ void p1_modfinal(Frame& F, KArgs a) {
    const float* MODP = (const float*)(F.ws + WS_MODP); float* MOD = (float*)(F.ws + WS_MOD);
    for (int i = F.vcu * 512 + F.tid; i < DEPTH * 2 * NMODV; i += F.G * 512) {
        const int l = i / (2 * NMODV), v = (i / NMODV) & 1, j = i % NMODV; float s = AIN(I_BMOD)[l * NMODV + j];
#pragma unroll
        for (int q = 0; q < 32; ++q) s += MODP[(size_t)((l * 32 + q) * 2 + v) * NMODV + j];
        MOD[i] = s;
    }
}
__device__ __forceinline__ void norm_phase(Frame& F, KArgs a, int l, int k, int nsl) {
    const int gw = F.vcu * NWAVES + F.wave, NGW = F.G * NWAVES;
    const float* X = (const float*)(F.ws + WS_X); bf16* H = (bf16*)(F.ws + WS_H);
    const float* g = AIN(I_NORMG) + (size_t)(l * 3 + k) * DM;
    for (int v = 0; v < 2; ++v) {
        const float* mod = (const float*)(F.ws + WS_MOD) + (size_t)(l * 2 + v) * NMODV; const float* shift = mod + (3 * k) * DM; const float* scale = mod + (3 * k + 1) * DM;
        f32x4 gs[8], sh[8];
#pragma unroll
        for (int j = 0; j < 8; ++j) { const int c = 4 * F.lane + 256 * j; const f32x4 gg = *(const f32x4*)(g + c), ss = *(const f32x4*)(scale + c); gs[j] = gg * (ss + 1.0f); sh[j] = *(const f32x4*)(shift + c); }
        const int r0 = v ? SEQ : 0, r1 = v ? MR : SEQ;
        if (v == 0) {
            for (int m = r0 + gw; m < r1; m += 2 * NGW) {
                const bool two = m + NGW < r1; const int m2 = two ? m + NGW : m;
                const GAS f32x4* xa = (const GAS f32x4*)(X + (size_t)m * DM) + F.lane; const GAS f32x4* xb = (const GAS f32x4*)(X + (size_t)m2 * DM) + F.lane; f32x4 a[8], b[8]; float sa = 0.f, sb = 0.f;
#pragma unroll
                for (int j = 0; j < 8; ++j) { a[j] = __builtin_nontemporal_load(xa + 64 * j); b[j] = __builtin_nontemporal_load(xb + 64 * j); }
#pragma unroll
                for (int j = 0; j < 8; ++j) { sa += (a[j].x * a[j].x + a[j].y * a[j].y) + (a[j].z * a[j].z + a[j].w * a[j].w); sb += (b[j].x * b[j].x + b[j].y * b[j].y) + (b[j].z * b[j].z + b[j].w * b[j].w); }
                const float ra = 1.0f / sqrtf(wave_sum(sa, F.lane) * (1.0f / DM) + 1e-6f), rb = 1.0f / sqrtf(wave_sum(sb, F.lane) * (1.0f / DM) + 1e-6f);
                GAS v2u* oa = (GAS v2u*)(H + (size_t)m * DM) + F.lane; GAS v2u* ob = (GAS v2u*)(H + (size_t)m2 * DM) + F.lane;
#pragma unroll
                for (int j = 0; j < 8; ++j) { const f32x4 y = a[j] * ra * gs[j] + sh[j]; v2u w; w.x = pk2(y.x, y.y); w.y = pk2(y.z, y.w); oa[64 * j] = w; }
                if (two) {
#pragma unroll
                    for (int j = 0; j < 8; ++j) { const f32x4 y = b[j] * rb * gs[j] + sh[j]; v2u w; w.x = pk2(y.x, y.y); w.y = pk2(y.z, y.w); ob[64 * j] = w; } }
            }
        } else
        for (int m = r0 + gw; m < r1; m += NGW) {
            const GAS f32x4* xr = (const GAS f32x4*)(X + (size_t)m * DM) + F.lane; f32x4 x[8]; float s = 0.f;
#pragma unroll
            for (int j = 0; j < 8; ++j) x[j] = xr[64 * j];
            if (v == 1 && nsl > 0) { const float* PART = (const float*)(F.ws + WS_PART);
                for (int sl = 0; sl < nsl; ++sl) { const GAS f32x4* pr = (const GAS f32x4*)(PART + ((size_t)sl * 256 + (m - SEQ)) * DM) + F.lane;
#pragma unroll
                    for (int j = 0; j < 8; ++j) x[j] += pr[64 * j]; }
                GAS f32x4* xw = (GAS f32x4*)((float*)(F.ws + WS_X) + (size_t)m * DM) + F.lane;
#pragma unroll
                for (int j = 0; j < 8; ++j) xw[64 * j] = x[j]; }
#pragma unroll
            for (int j = 0; j < 8; ++j) s += (x[j].x * x[j].x + x[j].y * x[j].y) + (x[j].z * x[j].z + x[j].w * x[j].w);
            const float rstd = 1.0f / sqrtf(wave_sum(s, F.lane) * (1.0f / DM) + 1e-6f);
            GAS v2u* o = (GAS v2u*)(H + (size_t)m * DM) + F.lane;
#pragma unroll
            for (int j = 0; j < 8; ++j) { const f32x4 y = x[j] * rstd * gs[j] + sh[j]; v2u w; w.x = pk2(y.x, y.y); w.y = pk2(y.z, y.w); o[64 * j] = w; }
        }
    }
}
__device__ __forceinline__ void dt_gemm(Frame& F, int l, int c, int rem) {
    if (c < rem) return;
    const int gw = (c - rem) * NWAVES + F.wave, NGW = (F.G - rem) * NWAVES;
    const bf16* H = (const bf16*)(F.ws + WS_H); const bf16* Wd = (const bf16*)(F.ws + WS_W) + (size_t)l * WL_SIZE + WL_WDT; float* DTR = (float*)(F.ws + WS_DTRAW);
    const int fr = F.lane & 15, fq = F.lane >> 4;
    for (int t = gw; t < MR / 16; t += NGW) {
        const bf16* ap = H + (size_t)(16 * t + fr) * DM + 8 * fq; const bf16* b0 = Wd + (size_t)fr * DM + 8 * fq; const bf16* b1 = Wd + (size_t)(16 + fr) * DM + 8 * fq;
        f32x4 c0 = {0.f, 0.f, 0.f, 0.f}, c1 = {0.f, 0.f, 0.f, 0.f};
#pragma unroll 4
        for (int k0 = 0; k0 < DM; k0 += 32) { const bf16x8 av = *(const bf16x8*)(ap + k0), bv0 = *(const bf16x8*)(b0 + k0), bv1 = *(const bf16x8*)(b1 + k0);
            c0 = __builtin_amdgcn_mfma_f32_16x16x32_bf16(av, bv0, c0, 0, 0, 0); c1 = __builtin_amdgcn_mfma_f32_16x16x32_bf16(av, bv1, c1, 0, 0, 0); }
#pragma unroll
        for (int r = 0; r < 4; ++r) { float* o = DTR + (size_t)(16 * t + 4 * fq + r) * 32 + fr; o[0] = c0[r]; o[16] = c1[r]; }
    }
}
struct S5Disc { float lb_re, lb_im, bb_re[16], bb_im[16]; };
__device__ __forceinline__ void s5_disc(KArgs a, int l, int dir, int g, int p, S5Disc& d) {
    const int ig = (l * 2 + dir) * 32 + g; const float a_re = AIN(I_S5ARE)[ig * 64 + p], a_im = AIN(I_S5AIM)[ig * 64 + p]; const float dt = __expf(AIN(I_S5LDT)[ig]);
    const float mag = __expf(a_re * dt); float sn, cs; sincos_hw(a_im * dt, sn, cs);
    d.lb_re = mag * cs; d.lb_im = mag * sn;
    const float den = a_re * a_re + a_im * a_im, nr = d.lb_re - 1.0f, ni = d.lb_im;
    const float f_re = (nr * a_re + ni * a_im) / den, f_im = (ni * a_re - nr * a_im) / den;
    const float* br = AIN(I_S5BRE) + (size_t)((l * 32 + g) * 64 + p) * 16; const float* bi = AIN(I_S5BIM) + (size_t)((l * 32 + g) * 64 + p) * 16;
#pragma unroll
    for (int h = 0; h < 16; ++h) { const float x = br[h], y = bi[h]; d.bb_re[h] = f_re * x - f_im * y; d.bb_im[h] = f_re * y + f_im * x; }
}
typedef float f32x16 __attribute__((ext_vector_type(16)));
struct S5Pow { float r1, i1, r2, i2, r3, i3, r4, i4; };
__device__ __forceinline__ void s5_pow(const S5Disc& d, S5Pow& p) { p.r1 = d.lb_re; p.i1 = d.lb_im; p.r2 = p.r1 * p.r1 - p.i1 * p.i1; p.i2 = 2.0f * p.r1 * p.i1; p.r3 = p.r2 * p.r1 - p.i2 * p.i1; p.i3 = p.r2 * p.i1 + p.i2 * p.r1; p.r4 = p.r2 * p.r2 - p.i2 * p.i2; p.i4 = 2.0f * p.r2 * p.i2; }
__device__ __forceinline__ bf16x8 pack8(const float (&v)[16], bool hi) { v4u w; w.x = pk2(hi ? v[8] : v[0], hi ? v[9] : v[1]); w.y = pk2(hi ? v[10] : v[2], hi ? v[11] : v[3]); w.z = pk2(hi ? v[12] : v[4], hi ? v[13] : v[5]); w.w = pk2(hi ? v[14] : v[6], hi ? v[15] : v[7]); return __builtin_bit_cast(bf16x8, w); }
template <bool FIX> __device__ __forceinline__ void s5_state_scan(f32x16& R, f32x16& I, const S5Pow& p, float& cr, float& ci, bool hi) {
#pragma unroll
    for (int k = 0; k < 4; ++k)
#pragma unroll
        for (int j = 1; j < 4; ++j) { const int x = 4 * k + j; const float nr = p.r1 * R[x - 1] - p.i1 * I[x - 1] + R[x], ni = p.r1 * I[x - 1] + p.i1 * R[x - 1] + I[x]; R[x] = nr; I[x] = ni; }
    float cinr[4], cini[4], ce_r = 0.f, ce_i = 0.f;
#pragma unroll
    for (int G = 0; G < 8; ++G) { const int k = G >> 1;
        if ((G & 1) == 0) { ce_r = cr; ce_i = ci; } else { cinr[k] = hi ? cr : ce_r; cini[k] = hi ? ci : ce_i; }
        const float vr = p.r4 * cr - p.i4 * ci + R[4 * k + 3], vi = p.r4 * ci + p.i4 * cr + I[4 * k + 3];
        const auto sr = __builtin_amdgcn_permlane32_swap(__float_as_uint(vr), __float_as_uint(vr), false, false); const auto si = __builtin_amdgcn_permlane32_swap(__float_as_uint(vi), __float_as_uint(vi), false, false);
        cr = __uint_as_float(sr[G & 1]); ci = __uint_as_float(si[G & 1]); }
    if (FIX) {
#pragma unroll
        for (int k = 0; k < 4; ++k) { const float a = cinr[k], b = cini[k];
            R[4 * k + 0] += p.r1 * a - p.i1 * b; I[4 * k + 0] += p.r1 * b + p.i1 * a; R[4 * k + 1] += p.r2 * a - p.i2 * b; I[4 * k + 1] += p.r2 * b + p.i2 * a;
            R[4 * k + 2] += p.r3 * a - p.i3 * b; I[4 * k + 2] += p.r3 * b + p.i3 * a; R[4 * k + 3] += p.r4 * a - p.i4 * b; I[4 * k + 3] += p.r4 * b + p.i4 * a; }
    }
}
template <bool PASS2> __device__ __forceinline__ void s5_pass(Frame& F, KArgs a, int l) {
    const int gw = F.vcu * NWAVES + F.wave, NGW = F.G * NWAVES;
    if (NGW % 64 != 0) return;
    const int q = gw & 63, dir = q >> 5, g = q & 31, lane = F.lane, s = lane & 31; const bool hi = lane >= 32;
    S5Pow pA, pB; bf16x8 bbf[4];
    { S5Disc dA, dB; s5_disc(a, l, dir, g, s, dA); s5_disc(a, l, dir, g, s + 32, dB); s5_pow(dA, pA); s5_pow(dB, pB);
      bbf[0] = pack8(dA.bb_re, hi); bbf[1] = pack8(dB.bb_re, hi); bbf[2] = pack8(dA.bb_im, hi); bbf[3] = pack8(dB.bb_im, hi); }
    bf16x8 cmf[4];
    if (PASS2) { const int h = lane & 15, q4 = lane >> 4;
#pragma unroll
        for (int ks = 0; ks < 4; ++ks) { const float* src = (ks < 2 ? AIN(I_S5CRE) : AIN(I_S5CIM)) + (size_t)((l * 32 + g) * 16 + h) * 64 + 32 * (ks & 1) + 8 * q4; const float sg = ks < 2 ? 1.0f : -1.0f;
            const f32x4 v0 = *(const f32x4*)src * sg, v1 = *(const f32x4*)(src + 4) * sg; v4u w; w.x = pk2(v0.x, v0.y); w.y = pk2(v0.z, v0.w); w.z = pk2(v1.x, v1.y); w.w = pk2(v1.z, v1.w); cmf[ks] = __builtin_bit_cast(bf16x8, w); } }
    float* END = (float*)(F.ws + WS_S5END); const float* SIN = (const float*)(F.ws + WS_S5IN); const bf16* P = (const bf16*)(F.ws + WS_P); bf16* YBF = (bf16*)(F.ws + WS_YBF);
    LAS bf16* Sb = (LAS bf16*)(F.lds + RING_OFF + F.wave * 8192);
    for (int cs = gw >> 6; cs < MR / 64; cs += NGW >> 6) {
        const size_t o = ((size_t)q * (MR / 64) + cs) * 128;
        float cAr = 0.f, cAi = 0.f, cBr = 0.f, cBi = 0.f;
        if (PASS2) { cAr = SIN[o + 2 * s]; cAi = SIN[o + 2 * s + 1]; cBr = SIN[o + 2 * (s + 32)]; cBi = SIN[o + 2 * (s + 32) + 1]; }
#pragma unroll 1
        for (int tt = 0; tt < 2; ++tt) {
            const bf16x8 uf = *(const GAS bf16x8*)(P + (size_t)rowof(dir, 64 * cs + 32 * tt + s) * NP + PC_U + 16 * g + (hi ? 8 : 0));
            const f32x16 z = {0.f, 0.f, 0.f, 0.f, 0.f, 0.f, 0.f, 0.f, 0.f, 0.f, 0.f, 0.f, 0.f, 0.f, 0.f, 0.f};
            f32x16 T0 = __builtin_amdgcn_mfma_f32_32x32x16_bf16(uf, bbf[0], z, 0, 0, 0), T1 = __builtin_amdgcn_mfma_f32_32x32x16_bf16(uf, bbf[1], z, 0, 0, 0);
            f32x16 T2 = __builtin_amdgcn_mfma_f32_32x32x16_bf16(uf, bbf[2], z, 0, 0, 0), T3 = __builtin_amdgcn_mfma_f32_32x32x16_bf16(uf, bbf[3], z, 0, 0, 0);
            s5_state_scan<PASS2>(T0, T2, pA, cAr, cAi, hi);
            s5_state_scan<PASS2>(T1, T3, pB, cBr, cBi, hi);
            if (PASS2) {
#pragma unroll
                for (int r = 0; r < 16; ++r) { const int tl = 8 * (r >> 2) + (hi ? 4 : 0) + (r & 3); LAS bf16* dst = Sb + tl * 128 + s;
                    dst[0] = (bf16)f2bf(T0[r]); dst[32] = (bf16)f2bf(T1[r]); dst[64] = (bf16)f2bf(T2[r]); dst[96] = (bf16)f2bf(T3[r]); }
                LDS_WAIT(); asm volatile("" ::: "memory");
                const int r16 = lane & 15, q4 = lane >> 4;
#pragma unroll
                for (int mt = 0; mt < 2; ++mt) { f32x4 acc = {0.f, 0.f, 0.f, 0.f};
#pragma unroll
                    for (int ks = 0; ks < 4; ++ks) { const bf16x8 af = *(const LAS bf16x8*)(Sb + (16 * mt + r16) * 128 + 32 * ks + 8 * q4); acc = __builtin_amdgcn_mfma_f32_16x16x32_bf16(af, cmf[ks], acc, 0, 0, 0); }
#pragma unroll
                    for (int rg = 0; rg < 4; ++rg) { const int row = rowof(dir, 64 * cs + 32 * tt + 16 * mt + 4 * q4 + rg); YBF[((size_t)dir * MR + row) * 512 + 16 * g + r16] = (bf16)f2bf(acc[rg]); } }
                LDS_WAIT(); asm volatile("" ::: "memory");
            }
        }
        if (!PASS2 && !hi) { END[o + 2 * s] = cAr; END[o + 2 * s + 1] = cAi; END[o + 2 * (s + 32)] = cBr; END[o + 2 * (s + 32) + 1] = cBi; }
    }
}
__device__ __forceinline__ void s5_carry(Frame& F, KArgs a, int l, int first_wave) {
    const int gw = F.vcu * NWAVES + F.wave - first_wave; if (gw < 0 || gw >= 64) return;
    const int q = gw, dir = q >> 5, g = q & 31, p = F.lane;
    const int ig = (l * 2 + dir) * 32 + g; const float a_re = AIN(I_S5ARE)[ig * 64 + p], a_im = AIN(I_S5AIM)[ig * 64 + p]; const float dt = __expf(AIN(I_S5LDT)[ig]);
    const float mag = __expf(a_re * dt); float sn, cs_; sincos_hw(a_im * dt, sn, cs_);
    float pr = mag * cs_, pi = mag * sn;
#pragma unroll
    for (int i = 0; i < 6; ++i) { const float nr = pr * pr - pi * pi, ni = 2.0f * pr * pi; pr = nr; pi = ni; }
    const float* END = (const float*)(F.ws + WS_S5END); float* SIN = (float*)(F.ws + WS_S5IN);
    float s_re = 0.f, s_im = 0.f;
    for (int cs = 0; cs < MR / 64; cs += 4) {
        float er[4], ei[4];
#pragma unroll
        for (int i = 0; i < 4; ++i) { const size_t o = ((size_t)q * (MR / 64) + cs + i) * 128 + 2 * p; er[i] = END[o]; ei[i] = END[o + 1]; }
#pragma unroll
        for (int i = 0; i < 4; ++i) { const size_t o = ((size_t)q * (MR / 64) + cs + i) * 128 + 2 * p; SIN[o] = s_re; SIN[o + 1] = s_im;
            const float nr = pr * s_re - pi * s_im + er[i], ni = pr * s_im + pi * s_re + ei[i]; s_re = nr; s_im = ni; }
    }
}
__device__ __forceinline__ bf16x8 ldg8(const bf16* p) { return *(const GAS bf16x8*)p; }
__device__ __forceinline__ int ssd_chunk_of(int d, int j) { return d ? (MR / 64 - 1 - j) : (j < CTXN / 64 ? SEQ / 64 + j : j - CTXN / 64); }
__device__ __forceinline__ float scan64(float v, int d, int lane) {
#pragma unroll
    for (int o = 1; o < 64; o <<= 1) { const float up = bperm(v, lane - o), dn = bperm(v, lane + o); if (d == 0) { if (lane >= o) v += up; } else { if (lane + o < 64) v += dn; } }
    return v;
}
__device__ __forceinline__ void conv_item(Frame& F, const float* cw, const float* cb_, int k, int cb) {
    LAS float* tin = (LAS float*)(F.lds + RING_OFF);
    LAS float* tout = tin + 68 * 64;
    const bf16* P = (const bf16*)(F.ws + WS_P);
    const int row0 = 64 * k, lo = k < SEQ / 64 ? 0 : SEQ, hi = k < SEQ / 64 ? SEQ : MR, c0 = 64 * cb;
    const int t = F.tid >> 3, c8 = (F.tid & 7) * 8;
    __syncthreads();
#pragma unroll
    for (int rr = t; rr < 68; rr += 64) { const int grow = row0 - 2 + rr; v4u w = (v4u){0u, 0u, 0u, 0u}; if (grow >= lo && grow < hi) w = *(const GAS v4u*)(P + (size_t)grow * NP + PC_XBC + c0 + c8);
        *(LAS f32x4*)(tin + rr * 64 + c8) = (f32x4){bflo(w.x), bfhi(w.x), bflo(w.y), bfhi(w.y)}; *(LAS f32x4*)(tin + rr * 64 + c8 + 4) = (f32x4){bflo(w.z), bfhi(w.z), bflo(w.w), bfhi(w.w)}; }
    __syncthreads();
    { f32x4 a0 = *(const f32x4*)(cb_ + c0 + c8), a1 = *(const f32x4*)(cb_ + c0 + c8 + 4);
#pragma unroll
      for (int j = 0; j < 5; ++j) { const f32x4 w0 = *(const f32x4*)(cw + j * 1280 + c0 + c8), w1 = *(const f32x4*)(cw + j * 1280 + c0 + c8 + 4);
          a0 += w0 * *(const LAS f32x4*)(tin + (t + j) * 64 + c8); a1 += w1 * *(const LAS f32x4*)(tin + (t + j) * 64 + c8 + 4); }
      float o[8];
#pragma unroll
      for (int i = 0; i < 4; ++i) { o[i] = silu_(a0[i]); o[4 + i] = silu_(a1[i]); }
#pragma unroll
      for (int i = 0; i < 8; ++i) tout[t * 65 + c8 + i] = o[i];
      v4u w; w.x = pk2(o[0], o[1]); w.y = pk2(o[2], o[3]); w.z = pk2(o[4], o[5]); w.w = pk2(o[6], o[7]);
      bf16* nat = (cb < 12) ? (bf16*)(F.ws + WS_XSN) + (size_t)(row0 + t) * 768 + c0 + c8
                : (cb < 16) ? (bf16*)(F.ws + WS_BN) + (size_t)(row0 + t) * 256 + (c0 - 768) + c8
                            : (bf16*)(F.ws + WS_CN) + (size_t)(row0 + t) * 256 + (c0 - 1024) + c8;
      *(GAS v4u*)nat = w; }
    __syncthreads();
    if (cb < 16) {
        const int c = F.tid >> 3, t8 = (F.tid & 7) * 8; float o[8];
#pragma unroll
        for (int i = 0; i < 8; ++i) o[i] = tout[(t8 + i) * 65 + c];
        v4u w; w.x = pk2(o[0], o[1]); w.y = pk2(o[2], o[3]); w.z = pk2(o[4], o[5]); w.w = pk2(o[6], o[7]);
        bf16* tr = (cb < 12) ? (bf16*)(F.ws + WS_XT) + ((size_t)(k * 12 + cb) * 64 + c) * 64 + t8
                             : (bf16*)(F.ws + WS_BT) + ((size_t)k * 256 + (c0 - 768) + c) * 64 + t8;
        *(GAS v4u*)tr = w;
    }
}
__device__ __forceinline__ void conv_wave_item(Frame& F, const float* cw, const float* cb_, int k, int c0, LAS float* buf) {
    const bf16* P = (const bf16*)(F.ws + WS_P);
    const int row0 = 64 * k, lo = k < SEQ / 64 ? 0 : SEQ, hi = k < SEQ / 64 ? SEQ : MR, t = F.lane;
    { const int g0 = row0 - 2 + t; v4u w = (v4u){0u, 0u, 0u, 0u}; if (g0 >= lo && g0 < hi) w = *(const GAS v4u*)(P + (size_t)g0 * NP + PC_XBC + c0);
      *(LAS f32x4*)(buf + t * 8) = (f32x4){bflo(w.x), bfhi(w.x), bflo(w.y), bfhi(w.y)}; *(LAS f32x4*)(buf + t * 8 + 4) = (f32x4){bflo(w.z), bfhi(w.z), bflo(w.w), bfhi(w.w)};
      if (t < 4) { const int g1 = row0 + 62 + t; v4u w1 = (v4u){0u, 0u, 0u, 0u}; if (g1 >= lo && g1 < hi) w1 = *(const GAS v4u*)(P + (size_t)g1 * NP + PC_XBC + c0);
          *(LAS f32x4*)(buf + (64 + t) * 8) = (f32x4){bflo(w1.x), bfhi(w1.x), bflo(w1.y), bfhi(w1.y)}; *(LAS f32x4*)(buf + (64 + t) * 8 + 4) = (f32x4){bflo(w1.z), bfhi(w1.z), bflo(w1.w), bfhi(w1.w)}; } }
    LDS_WAIT(); asm volatile("" ::: "memory");
    f32x4 a0 = *(const f32x4*)(cb_ + c0), a1 = *(const f32x4*)(cb_ + c0 + 4);
#pragma unroll
    for (int j = 0; j < 5; ++j) { const f32x4 w0 = *(const f32x4*)(cw + j * 1280 + c0), w1 = *(const f32x4*)(cw + j * 1280 + c0 + 4);
        a0 += w0 * *(const LAS f32x4*)(buf + (t + j) * 8); a1 += w1 * *(const LAS f32x4*)(buf + (t + j) * 8 + 4); }
    float o[8];
#pragma unroll
    for (int i = 0; i < 4; ++i) { o[i] = silu_(a0[i]); o[4 + i] = silu_(a1[i]); }
    v4u w; w.x = pk2(o[0], o[1]); w.y = pk2(o[2], o[3]); w.z = pk2(o[4], o[5]); w.w = pk2(o[6], o[7]);
    bf16* nat = (c0 < 768) ? (bf16*)(F.ws + WS_XSN) + (size_t)(row0 + t) * 768 + c0 : (c0 < 1024) ? (bf16*)(F.ws + WS_BN) + (size_t)(row0 + t) * 256 + (c0 - 768) : (bf16*)(F.ws + WS_CN) + (size_t)(row0 + t) * 256 + (c0 - 1024);
    *(GAS v4u*)nat = w;
    if (c0 < 1024) { bf16* tr = (c0 < 768) ? (bf16*)(F.ws + WS_XT) + ((size_t)(k * 12 + (c0 >> 6)) * 64 + (c0 & 63)) * 64 + t : (bf16*)(F.ws + WS_BT) + ((size_t)k * 256 + (c0 - 768)) * 64 + t;
#pragma unroll
        for (int i = 0; i < 8; ++i) tr[(size_t)i * 64] = (bf16)f2bf(o[i]); }
    LDS_WAIT(); asm volatile("" ::: "memory");
}
__device__ __forceinline__ void ssd_states(Frame& F, KArgs a, int l) {
    const int gw = F.vcu * NWAVES + F.wave, NGW = F.G * NWAVES, lane = F.lane, r = lane & 15, q = lane >> 4;
    LAS float* wb = (LAS float*)(F.lds + RING_OFF + F.wave * 2048);
    const float* DT = (const float*)(F.ws + WS_DT); const bf16* XT = (const bf16*)(F.ws + WS_XT); const bf16* BT = (const bf16*)(F.ws + WS_BT);
    bf16* ST = (bf16*)(F.ws + WS_STATES); float* CHD = (float*)(F.ws + WS_CHD); const float* alog = AIN(I_ALOG) + l * 24;
    for (int item = gw; item < (MR / 64) * 4; item += NGW) {
        const int k = item >> 2, g = (item >> 1) & 1, d = item & 1, row0 = 64 * k;
#pragma unroll
        for (int hh = 0; hh < 6; ++hh) { const int dh = d * 12 + g * 6 + hh; const float dt = DT[(size_t)(row0 + lane) * 24 + dh]; const float A = -__expf(alog[dh]);
            const float cum = scan64(A * dt, d, lane); const float tot = __int_as_float(d ? __builtin_amdgcn_readlane(__float_as_int(cum), 0) : __builtin_amdgcn_readlane(__float_as_int(cum), 63));
            wb[hh * 64 + lane] = dt * __expf(tot - cum);
            if (lane == 0) CHD[k * 24 + dh] = __expf(tot); }
        LDS_WAIT(); asm volatile("" ::: "memory");
        for (int hh = 0; hh < 6; ++hh) {
            const int h = g * 6 + hh, dh = d * 12 + h;
            bf16x8 af[4][2];
#pragma unroll
            for (int ks = 0; ks < 2; ++ks) { const f32x4 w0 = *(const LAS f32x4*)(wb + hh * 64 + 32 * ks + 8 * q), w1 = *(const LAS f32x4*)(wb + hh * 64 + 32 * ks + 8 * q + 4);
#pragma unroll
                for (int pt = 0; pt < 4; ++pt) { const v4u x = *(const GAS v4u*)(XT + ((size_t)(k * 12 + h) * 64 + 16 * pt + r) * 64 + 32 * ks + 8 * q);
                    v4u y; y.x = pk2(bflo(x.x) * w0.x, bfhi(x.x) * w0.y); y.y = pk2(bflo(x.y) * w0.z, bfhi(x.y) * w0.w); y.z = pk2(bflo(x.z) * w1.x, bfhi(x.z) * w1.y); y.w = pk2(bflo(x.w) * w1.z, bfhi(x.w) * w1.w);
                    af[pt][ks] = __builtin_bit_cast(bf16x8, y); } }
#pragma unroll
            for (int half = 0; half < 2; ++half) {
                f32x4 acc[4][4];
#pragma unroll
                for (int pt = 0; pt < 4; ++pt)
#pragma unroll
                    for (int nt = 0; nt < 4; ++nt) acc[pt][nt] = (f32x4){0.f, 0.f, 0.f, 0.f};
#pragma unroll
                for (int ks = 0; ks < 2; ++ks)
#pragma unroll
                    for (int nt = 0; nt < 4; ++nt) { const bf16x8 bv = ldg8(BT + ((size_t)(k * 2 + g) * 128 + 64 * half + 16 * nt + r) * 64 + 32 * ks + 8 * q);
#pragma unroll
                        for (int pt = 0; pt < 4; ++pt) acc[pt][nt] = __builtin_amdgcn_mfma_f32_16x16x32_bf16(af[pt][ks], bv, acc[pt][nt], 0, 0, 0); }
#pragma unroll
                for (int pt = 0; pt < 4; ++pt)
#pragma unroll
                    for (int nt = 0; nt < 4; ++nt)
#pragma unroll
                        for (int rg = 0; rg < 4; ++rg) ST[((size_t)(k * 24 + dh) * 64 + 16 * pt + 4 * q + rg) * 128 + 64 * half + 16 * nt + r] = (bf16)f2bf(acc[pt][nt][rg]);
            }
        }
        LDS_WAIT(); asm volatile("" ::: "memory");
    }
}
__device__ __forceinline__ void ssd_carry(Frame& F) {
    const bf16* ST = (const bf16*)(F.ws + WS_STATES); const float* CHD = (const float*)(F.ws + WS_CHD); bf16* SB = (bf16*)(F.ws + WS_SINB);
    for (int idx = F.vcu * 512 + F.tid; idx < 24 * 64 * 32; idx += F.G * 512) {
        const int dh = idx >> 11, rem = idx & 2047, d = dh / 12; const size_t eo = (size_t)(rem >> 5) * 128 + (rem & 31) * 4;
        f32x4 S = {0.f, 0.f, 0.f, 0.f};
        for (int j = 0; j < MR / 64; j += 4) {
            f32x4 st[4]; float dc[4]; size_t off[4];
#pragma unroll
            for (int i = 0; i < 4; ++i) { const int k = ssd_chunk_of(d, j + i); off[i] = (size_t)(k * 24 + dh) * 8192 + eo; const v2u sw = *(const GAS v2u*)(ST + off[i]); st[i] = (f32x4){bflo(sw.x), bfhi(sw.x), bflo(sw.y), bfhi(sw.y)}; dc[i] = CHD[k * 24 + dh]; }
#pragma unroll
            for (int i = 0; i < 4; ++i) { v2u w; w.x = pk2(S.x, S.y); w.y = pk2(S.z, S.w); *(GAS v2u*)(SB + off[i]) = w; S = S * dc[i] + st[i]; }
        }
    }
}
__device__ __forceinline__ void ssd_outputs(Frame& F, KArgs a, int l) {
    const int gw = F.vcu * NWAVES + F.wave, NGW = F.G * NWAVES, lane = F.lane, r = lane & 15, q = lane >> 4;
    LAS bf16* Mb = (LAS bf16*)(F.lds + RING_OFF + F.wave * 10240);
    LAS float* cumb = (LAS float*)(F.lds + RING_OFF + F.wave * 10240 + 8192);
    const float* DT = (const float*)(F.ws + WS_DT); const bf16* XT = (const bf16*)(F.ws + WS_XT); const bf16* BN = (const bf16*)(F.ws + WS_BN); const bf16* CN = (const bf16*)(F.ws + WS_CN);
    const bf16* SB = (const bf16*)(F.ws + WS_SINB); bf16* YS = (bf16*)(F.ws + WS_YS); const float* alog = AIN(I_ALOG) + l * 24;
    for (int item = gw; item < (MR / 64) * 12; item += NGW) {
        const int hp = item % 3, i4 = item / 3, k = i4 >> 2, g = (i4 >> 1) & 1, d = i4 & 1, row0 = 64 * k;
        f32x4 G[4][4];
#pragma unroll
        for (int it = 0; it < 4; ++it)
#pragma unroll
            for (int st = 0; st < 4; ++st) G[it][st] = (f32x4){0.f, 0.f, 0.f, 0.f};
#pragma unroll 1
        for (int ks = 0; ks < 4; ++ks) { bf16x8 cf[4], bfr[4];
#pragma unroll
            for (int i = 0; i < 4; ++i) { cf[i] = ldg8(CN + (size_t)(row0 + 16 * i + r) * 256 + g * 128 + 32 * ks + 8 * q); bfr[i] = ldg8(BN + (size_t)(row0 + 16 * i + r) * 256 + g * 128 + 32 * ks + 8 * q); }
#pragma unroll
            for (int it = 0; it < 4; ++it)
#pragma unroll
                for (int st = 0; st < 4; ++st) G[it][st] = __builtin_amdgcn_mfma_f32_16x16x32_bf16(cf[it], bfr[st], G[it][st], 0, 0, 0); }
        for (int hh = 2 * hp; hh < 2 * hp + 2; ++hh) {
            const int h = g * 6 + hh, dh = d * 12 + h;
            { const float dt = DT[(size_t)(row0 + lane) * 24 + dh]; const float A = -__expf(alog[dh]); const float cum = scan64(A * dt, d, lane);
              cumb[lane] = cum; cumb[64 + lane] = __expf(cum); cumb[128 + lane] = dt; }
            LDS_WAIT(); asm volatile("" ::: "memory");
            { float cs[4], ds[4];
#pragma unroll
              for (int st = 0; st < 4; ++st) { cs[st] = cumb[16 * st + r]; ds[st] = cumb[128 + 16 * st + r]; }
#pragma unroll
              for (int it = 0; it < 4; ++it)
#pragma unroll
                  for (int rg = 0; rg < 4; ++rg) { const int i = 16 * it + 4 * q + rg; const float ci = cumb[i];
#pragma unroll
                      for (int st = 0; st < 4; ++st) { const int s = 16 * st + r; const bool on = d ? (s >= i) : (s <= i);
                          const float v = on ? G[it][st][rg] * __expf(ci - cs[st]) * ds[st] : 0.f; Mb[i * 64 + s] = (bf16)f2bf(v); } } }
            f32x4 acc[4][4];
#pragma unroll
            for (int it = 0; it < 4; ++it)
#pragma unroll
                for (int pt = 0; pt < 4; ++pt) acc[it][pt] = (f32x4){0.f, 0.f, 0.f, 0.f};
#pragma unroll 1
            for (int ks = 0; ks < 4; ++ks) { bf16x8 cf[4], sf[4];
#pragma unroll
                for (int i = 0; i < 4; ++i) { cf[i] = ldg8(CN + (size_t)(row0 + 16 * i + r) * 256 + g * 128 + 32 * ks + 8 * q); sf[i] = ldg8(SB + ((size_t)(k * 24 + dh) * 64 + 16 * i + r) * 128 + 32 * ks + 8 * q); }
#pragma unroll
                for (int it = 0; it < 4; ++it)
#pragma unroll
                    for (int pt = 0; pt < 4; ++pt) acc[it][pt] = __builtin_amdgcn_mfma_f32_16x16x32_bf16(cf[it], sf[pt], acc[it][pt], 0, 0, 0); }
#pragma unroll
            for (int it = 0; it < 4; ++it)
#pragma unroll
                for (int rg = 0; rg < 4; ++rg) { const float e = cumb[64 + 16 * it + 4 * q + rg];
#pragma unroll
                    for (int pt = 0; pt < 4; ++pt) acc[it][pt][rg] *= e; }
            LDS_WAIT(); asm volatile("" ::: "memory");
#pragma unroll 1
            for (int ks = 0; ks < 2; ++ks) { bf16x8 mf[4], xf[4];
#pragma unroll
                for (int i = 0; i < 4; ++i) { mf[i] = *(const LAS bf16x8*)(Mb + (16 * i + r) * 64 + 32 * ks + 8 * q); xf[i] = ldg8(XT + ((size_t)(k * 12 + h) * 64 + 16 * i + r) * 64 + 32 * ks + 8 * q); }
#pragma unroll
                for (int it = 0; it < 4; ++it)
#pragma unroll
                    for (int pt = 0; pt < 4; ++pt) acc[it][pt] = __builtin_amdgcn_mfma_f32_16x16x32_bf16(mf[it], xf[pt], acc[it][pt], 0, 0, 0); }
#pragma unroll
            for (int it = 0; it < 4; ++it)
#pragma unroll
                for (int pt = 0; pt < 4; ++pt)
#pragma unroll
                    for (int rg = 0; rg < 4; ++rg) YS[((size_t)d * MR + row0 + 16 * it + 4 * q + rg) * 768 + h * 64 + 16 * pt + r] = (bf16)f2bf(acc[it][pt][rg]);
            LDS_WAIT(); asm volatile("" ::: "memory");
        }
    }
}
#ifndef SWA_EARLY
#define SWA_EARLY 304
#endif
#ifndef PREPDUP
#define PREPDUP 0
#endif
#ifndef PREP_REV
#define PREP_REV 0
#endif
__device__ __forceinline__ void prep_phase(Frame& F, KArgs a, int l) {
    const bf16* P = (const bf16*)(F.ws + WS_P);
    { const float* cw = AIN(I_CONVW) + (size_t)l * 5 * 1280; const float* cb = AIN(I_CONVB) + (size_t)l * 1280;
      LAS float* cbuf = (LAS float*)(F.lds + RING_OFF + F.wave * 4096);
      for (int rep_ = 0; rep_ <= (PREPDUP & 1); ++rep_)
      for (int it = F.vcu * NWAVES + F.wave; it < (MR / 64) * 160; it += F.G * NWAVES) conv_wave_item(F, cw, cb, it / 160, 8 * (it % 160), cbuf);
      __syncthreads(); }
    { const float* DTR = (const float*)(F.ws + WS_DTRAW); float* DT = (float*)(F.ws + WS_DT); const float* dtb = AIN(I_DTB) + l * 24;
      for (int i = F.vcu * 512 + F.tid; i < MR * 24; i += F.G * 512) { const int m = i / 24, j = i % 24; const float x = DTR[m * 32 + j] + dtb[j];
          DT[i] = fmaxf(x, 0.f) + __logf(1.0f + __expf(-fabsf(x))); } }
    { const int gw = F.vcu * NWAVES + F.wave, NGW = F.G * NWAVES, lane = F.lane, j8 = lane & 7;
      float inv[8];
#pragma unroll
      for (int j = 0; j < 8; ++j) inv[j] = __builtin_amdgcn_exp2f(-(float)(((j8 & 1) * 8 + j)) * (13.287712379549449f / 16.0f));
      bf16* QS = (bf16*)(F.ws + WS_QS); bf16* QG = (bf16*)(F.ws + WS_QG); bf16* KS = (bf16*)(F.ws + WS_KS); bf16* KG = (bf16*)(F.ws + WS_KG);
      const float* gsw = AIN(I_SWAG) + l * 128; const float* ggl = AIN(I_GLBG) + l * 128;
      for (int rep_ = 0; rep_ <= ((PREPDUP >> 1) & 1); ++rep_)
      for (int it = gw; it < MR * 3; it += NGW) {
          const int m = PREP_REV ? (MR - 1 - it / 3) : it / 3, part = it % 3; const bool act = part < 2 || lane < 32; const bool glb = part == 1 || (part == 2 && lane >= 16); const bool isk = part == 2;
          const int hl = isk ? ((lane >> 3) & 1) : (lane >> 3);
          const int col = (glb ? (isk ? PC_GK : PC_GQ) : (isk ? PC_SK : PC_SQ)) + 64 * hl + 8 * j8;
          v4u w = (v4u){0u, 0u, 0u, 0u}; if (act) w = *(const GAS v4u*)(P + (size_t)m * NP + col);
          float x[8] = {bflo(w.x), bfhi(w.x), bflo(w.y), bfhi(w.y), bflo(w.z), bfhi(w.z), bflo(w.w), bfhi(w.w)};
          float ss = 0.f;
#pragma unroll
          for (int j = 0; j < 8; ++j) ss += x[j] * x[j];
          ss += bperm(ss, lane ^ 1); ss += bperm(ss, lane ^ 2); ss += bperm(ss, lane ^ 4);
          const float rs = 1.0f / sqrtf(ss * (1.0f / 64.0f) + 1e-6f);
          const float* gp = (glb ? ggl : gsw) + (isk ? 64 : 0) + 8 * j8; const f32x4 g0 = *(const f32x4*)gp, g1 = *(const f32x4*)(gp + 4);
          const float gg[8] = {g0.x, g0.y, g0.z, g0.w, g1.x, g1.y, g1.z, g1.w};
#pragma unroll
          for (int j = 0; j < 8; ++j) x[j] = x[j] * rs * gg[j];
          if (m < SEQ) { const float pos = ((j8 & 3) < 2) ? (float)(m >> 6) : (float)(m & 63); const bool lo = j8 < 4;
#pragma unroll
              for (int j = 0; j < 8; ++j) { float sn, cs; sincos_hw(pos * inv[j], sn, cs); const float other = bperm(x[j], lane ^ 4); x[j] = lo ? (x[j] * cs - other * sn) : (other * sn + x[j] * cs); } }
          if (!isk) {
#pragma unroll
              for (int j = 0; j < 8; ++j) x[j] *= QSCALE; }
          v4u o; o.x = pk2(x[0], x[1]); o.y = pk2(x[2], x[3]); o.z = pk2(x[4], x[5]); o.w = pk2(x[6], x[7]);
          bf16* dst = isk ? ((glb ? KG : KS) + (size_t)m * 128 + 64 * hl + 8 * j8) : ((glb ? QG : QS) + (size_t)m * 512 + 64 * hl + 8 * j8);
          if (act) *(GAS v4u*)dst = o;
      } }
}
__device__ __forceinline__ void attn_all(Frame& F, KArgs a, int l) {
    typedef attn_body::bf16 ab;
    char* shm = (char*)(unsigned char*)(F.lds + RING_OFF);
#ifndef NO_MODE0
    for (int u = F.vcu; u < 528; u += F.G) {
        unsigned long long w_ = (unsigned long long)F.ws; asm volatile("" : "+s"(w_)); unsigned char* ws = (unsigned char*)(GAS unsigned char*)w_;
        if (u < 512) { const int kvh = u >> 8, g = (u >> 6) & 3, qb = u & 63, head = kvh * 4 + g; const size_t qo = (size_t)(qb * 256) * 512 + head * 64, oo = (size_t)(qb * 256) * YPITCH + YC_D + head * 64;
            attn_body::attn_unit<8, 0>((const ab*)(ws + WS_QG) + qo, (const ab*)(ws + WS_KG) + kvh * 64, (const ab*)(ws + WS_P) + PC_GV + kvh * 64, (ab*)(ws + WS_YALL) + oo, MR / 64, 0, 0, 0, 0, 0.f, false, shm); }
        else { const int ty = (u - 512) >> 3, head = (u - 512) & 7, kvh = head >> 2; const size_t qo = (size_t)SEQ * 512 + head * 64, oo = (size_t)SEQ * YPITCH + (ty ? YC_C : YC_D) + head * 64;
            const float s2 = ty ? (AIN(I_SINK) + l * 8)[head] * LOG2E : 0.f;
            attn_body::attn_unit<8, 0>((const ab*)(ws + (ty ? WS_QS : WS_QG)) + qo, (const ab*)(ws + (ty ? WS_KS : WS_KG)) + (size_t)SEQ * 128 + kvh * 64, (const ab*)(ws + WS_P) + (ty ? PC_SV : PC_GV) + (size_t)SEQ * NP + kvh * 64,
                                       (ab*)(ws + WS_YALL) + oo, 4, 0, 0, 0, 0, s2, ty != 0, shm); }
    }
#endif
}
__device__ __forceinline__ void attn_swa(Frame& F, KArgs a, int l, int ubeg, int uend, int bfirst, int nb) {
    typedef attn_body::bf16 ab;
    char* shm = (char*)(unsigned char*)(F.lds + RING_OFF);
    if (F.vcu < bfirst || F.vcu >= bfirst + nb) return;
    for (int u = ubeg + F.vcu - bfirst; u < uend; u += nb) {
        unsigned long long w_ = (unsigned long long)F.ws; asm volatile("" : "+s"(w_)); unsigned char* ws = (unsigned char*)(GAS unsigned char*)w_;
        const int head = u >> 6, qb = u & 63, kvh = head >> 2, q0 = qb * 256; const int wlo = q0 - 128 < 0 ? 0 : q0 - 128, whi = q0 + 384 > SEQ ? SEQ : q0 + 384; const size_t qo = (size_t)q0 * 512 + head * 64, oo = (size_t)q0 * YPITCH + YC_C + head * 64;
        attn_body::attn_unit<8, 1>((const ab*)(ws + WS_QS) + qo, (const ab*)(ws + WS_KS) + kvh * 64, (const ab*)(ws + WS_P) + PC_SV + kvh * 64, (ab*)(ws + WS_YALL) + oo, 4 + (whi - wlo) / 64, 4, SEQ, wlo, q0, (AIN(I_SINK) + l * 8)[head] * LOG2E, true, shm);
    }
}
#ifndef MIXDUP
#define MIXDUP 0
#endif
__device__ __forceinline__ void mixers_phase(Frame& F0, KArgs a, int l) {
    for (int rep_ = 0; rep_ <= ((MIXDUP >> 0) & 1); ++rep_) { Frame F = fresh(F0); attn_all(F, a, l); __syncthreads(); }
    { Frame F = fresh(F0); attn_swa(F, a, l, SWA_EARLY, 512, 0, F.G); __syncthreads(); }
#if 0
    for (int rep_ = 0; rep_ <= ((MIXDUP >> 1) & 1); ++rep_) { Frame F = fresh(F0); for (int it = F.vcu; it < 256; it += F.G) attn_simple_item(F, a, l, 1, it >> 7, it & 127); __syncthreads(); }
#endif
    for (int rep_ = 0; rep_ <= ((MIXDUP >> 2) & 1); ++rep_) { Frame F = fresh(F0); s5_pass<true>(F, a, l); __syncthreads(); }
    for (int rep_ = 0; rep_ <= ((MIXDUP >> 3) & 1); ++rep_) { Frame F = fresh(F0); ssd_outputs(F, a, l); __syncthreads(); }
}
__device__ __forceinline__ void post_phase(Frame& F, KArgs a, int l) {
    const int gw = F.vcu * NWAVES + F.wave, NGW = F.G * NWAVES;
    const bf16* P = (const bf16*)(F.ws + WS_P); const bf16* XSN = (const bf16*)(F.ws + WS_XSN); const bf16* YS = (const bf16*)(F.ws + WS_YS);
    bf16* YA = (bf16*)(F.ws + WS_YALL); const float* dsk = AIN(I_SSDD) + l * 12; const float* ng = AIN(I_SSDNG) + l * 768;
    for (int m = gw; m < MR; m += NGW) {
        float y[12]; float ss = 0.f;
#pragma unroll
        for (int j = 0; j < 3; ++j) { const int c = 4 * F.lane + 256 * j;
            const v2u yfw = *(const GAS v2u*)(YS + (size_t)m * 768 + c), ybw = *(const GAS v2u*)(YS + (size_t)(MR + m) * 768 + c); const f32x4 yf = {bflo(yfw.x), bfhi(yfw.x), bflo(yfw.y), bfhi(yfw.y)}, yb = {bflo(ybw.x), bfhi(ybw.x), bflo(ybw.y), bfhi(ybw.y)}; const v2u xw = *(const GAS v2u*)(XSN + (size_t)m * 768 + c); const f32x4 xv = {bflo(xw.x), bfhi(xw.x), bflo(xw.y), bfhi(xw.y)};
            const v2u zw = *(const GAS v2u*)(P + (size_t)m * NP + PC_Z + c); const float dd = dsk[c >> 6];
            const float z[4] = {bflo(zw.x), bfhi(zw.x), bflo(zw.y), bfhi(zw.y)};
#pragma unroll
            for (int i = 0; i < 4; ++i) { const float t = (yf[i] + yb[i] + dd * xv[i]) * silu_(z[i]); y[4 * j + i] = t; ss += t * t; } }
        const float rstd = 1.0f / sqrtf(wave_sum(ss, F.lane) * (1.0f / 768.0f) + 1e-6f);
#pragma unroll
        for (int j = 0; j < 3; ++j) { const int c = 4 * F.lane + 256 * j; const f32x4 gg = *(const f32x4*)(ng + c);
            v2u w; w.x = pk2(y[4 * j] * rstd * gg.x, y[4 * j + 1] * rstd * gg.y); w.y = pk2(y[4 * j + 2] * rstd * gg.z, y[4 * j + 3] * rstd * gg.w);
            *(GAS v2u*)(YA + (size_t)m * YPITCH + c) = w; }
    }
    const bf16* YBF = (const bf16*)(F.ws + WS_YBF); bf16* YBP = (bf16*)(F.ws + WS_YBP); const float* d5 = AIN(I_S5D) + l * 512;
    for (int i = F.vcu * 512 + F.tid; i < MR * 128; i += F.G * 512) {
        const int m = i >> 7, c = (i & 127) * 4;
        const v2u y0w = *(const GAS v2u*)(YBF + (size_t)m * 512 + c), y1w = *(const GAS v2u*)(YBF + (size_t)(MR + m) * 512 + c); const f32x4 y0 = {bflo(y0w.x), bfhi(y0w.x), bflo(y0w.y), bfhi(y0w.y)}, y1 = {bflo(y1w.x), bfhi(y1w.x), bflo(y1w.y), bfhi(y1w.y)}, dd = *(const f32x4*)(d5 + c);
        const v2u uw = *(const GAS v2u*)(P + (size_t)m * NP + PC_U + c); const float u[4] = {bflo(uw.x), bfhi(uw.x), bflo(uw.y), bfhi(uw.y)}; float r[4];
#pragma unroll
        for (int q = 0; q < 4; ++q) { const float x = y0[q] + y1[q] + dd[q] * u[q]; const float t = 0.7978845608028654f * (x + 0.044715f * x * x * x);
            const float th = 1.0f - 2.0f * __builtin_amdgcn_rcpf(1.0f + __builtin_amdgcn_exp2f(2.0f * LOG2E * t));
            r[q] = 0.5f * x * (1.0f + th); }
        v2u w; w.x = pk2(r[0], r[1]); w.y = pk2(r[2], r[3]); *(GAS v2u*)(YBP + (size_t)m * 512 + c) = w;
    }
}
#ifndef MK_PER_PHASE
#define MK_PER_PHASE 0
#endif
#ifndef REV_RES
#define REV_RES 1
#endif
#ifndef WGM_FFI
#define WGM_FFI 2
#endif
#ifndef WGM_WIN
#define WGM_WIN 2
#endif
#ifndef WGM_RES
#define WGM_RES 2
#endif
#ifndef WGM_MRG
#define WGM_MRG 2
#endif
constexpr int PH_PER_LAYER = 16, NPHASE = 2 + DEPTH * PH_PER_LAYER;
#ifndef GPA
#define GPA true
#endif
#ifndef GPS
#define GPS true
#endif
#ifndef GPAR
#define GPAR true
#endif
constexpr bool GP_ALIGN = GPA, GP_SP2 = GPS, GP_ALIGN_RESID = GPAR;
__global__ void __launch_bounds__(NWAVES * 64, 2) trunk_fwd(Args args) {
    extern __shared__ __attribute__((aligned(16))) unsigned char lds[];
    KArgs KA = (KArgs)__builtin_amdgcn_kernarg_segment_ptr();
    Frame F;
    F.lds = (LAS unsigned char*)lds;
    F.MISC = (volatile LAS unsigned*)(F.lds + MISC_OFF);
    F.tid = threadIdx.x; F.lane = F.tid & 63; F.wave = __builtin_amdgcn_readfirstlane(F.tid >> 6);
    F.G = gridDim.x; { const int bx = blockIdx.x; F.vcu = (F.G % 8 == 0) ? (bx % 8) * (F.G / 8) + bx / 8 : bx; }
    F.ws = (unsigned char*)(GAS unsigned char*)args.ws; F.ctl = (gu32*)(args.ws + WS_CTL);
    for (int u = F.tid; u < (LDS_BYTES - LDSCTL_OFF) / 4; u += NWAVES * 64) ((LAS unsigned*)(F.lds + LDSCTL_OFF))[u] = 0u;
    __syncthreads();
    XcdBarrier bar; bar.bar = (unsigned*)(F.ctl + CW_BAR); bar.x = 0; bar.st = nullptr;
    if (!MK_PER_PHASE) bar = xcd_barrier_post((unsigned*)(F.ctl + CW_BAR), F.MISC + 8);
    const int lo = args.ph_lo, hi = args.ph_hi;
#ifndef ONLY
#define ONLY -1
#endif
#define KON(i) (ONLY < 0 || ONLY == (i))
#ifndef DUPMASK
#define DUPMASK 0ull
#endif
#define DUPK(i) ((int)(((unsigned long long)(DUPMASK) >> (i)) & 1ull))
#define IN(k) (lo <= (k) && (k) < hi)
#define GEMM_PTRS() FRESH(); unsigned char* ws = Fp.ws; float* X = (float*)(ws + WS_X); bf16* H = (bf16*)(ws + WS_H); bf16* HID = (bf16*)(ws + WS_HID); bf16* P = (bf16*)(ws + WS_P); const bf16* WL = (const bf16*)(ws + WS_W) + (size_t)lp * WL_SIZE; \
    const float* modl = (const float*)(ws + WS_MOD) + (size_t)(lp * 2 + 0) * NMODV; const float* modc = (const float*)(ws + WS_MOD) + (size_t)(lp * 2 + 1) * NMODV; (void)X; (void)H; (void)HID; (void)P; (void)WL; (void)modl; (void)modc;
#define FRESH() Frame Fp = fresh(F); int lp = l; asm volatile("" : "+s"(lp));
#define SEAM(k) do { if (!MK_PER_PHASE && (k) + 1 < hi) xcd_barrier(bar); } while (0)
    PG8_LAS unsigned char* ring = (PG8_LAS unsigned char*)(F.lds + RING_OFF);

    if (KON(100) && IN(0)) { for (int rep_ = 0; rep_ <= DUPK(40); ++rep_) { if (rep_) xcd_barrier(bar); p0_prologue(F, KA); } SEAM(0); }
    if (KON(101) && IN(1)) { p1_modfinal(F, KA); SEAM(1); }
    for (int st = 0; st < 2 * DEPTH; ++st) {
        const int l = st >> 1, f = st & 1; const int pb = 2 + PH_PER_LAYER * l;
        if (f) {
            if (KON(3) && IN(pb + 3)) { FRESH(); norm_phase(Fp, KA, lp, 1, DFF / 512); SEAM(pb + 3); }
            if (KON(4) && IN(pb + 4)) { for (int rep_ = 0; rep_ <= DUPK(4); ++rep_) { if (rep_) xcd_barrier(bar); { GEMM_PTRS(); pg8::Gemm g{H, WL + WL_WIN, MR, NP, DM, DM}; pg8::StaticOrder S; S.init(MR, NP, Fp.G, (int)blockIdx.x, WGM_WIN); pg8::EpiWin E{P, NP, PC_GATE / 256, PC_GATE};
                pg8::gemm_phase<pg8::EpiWin, pg8::StaticOrder, GP_ALIGN, GP_SP2>(ring, g, S, E);
                if (HIDE_CONVERT) { convert_idle(Fp, KA, (int)blockIdx.x, (MR / 256) * (NP / 256) % Fp.G, lp, IT_GA + IT_GB, IT_GC + (lp == DEPTH - 1 ? IT_GD : IT_GD / 2)); }    dt_gemm(Fp, lp, (int)blockIdx.x, (MR / 256) * (NP / 256) % Fp.G); } } SEAM(pb + 4); }
            if (KON(5) && IN(pb + 5)) { for (int rep_ = 0; rep_ <= DUPK(5); ++rep_) { if (rep_) xcd_barrier(bar); { FRESH(); prep_phase(Fp, KA, lp); __syncthreads(); for (int r2_ = 0; r2_ <= ((PREPDUP >> 2) & 1); ++r2_) s5_pass<false>(Fp, KA, lp); } } SEAM(pb + 5); }
            if (KON(6) && IN(pb + 6)) { for (int rep_ = 0; rep_ <= DUPK(6); ++rep_) { if (rep_) xcd_barrier(bar); { { FRESH(); ssd_states(Fp, KA, lp); } } } SEAM(pb + 6); }
            if (KON(7) && IN(pb + 7)) { for (int rep_ = 0; rep_ <= DUPK(7); ++rep_) { if (rep_) xcd_barrier(bar); { { FRESH(); s5_carry(Fp, KA, lp, 96 * NWAVES); } { FRESH(); ssd_carry(Fp); } if (SWA_EARLY > 0) { FRESH(); attn_swa(Fp, KA, lp, 0, SWA_EARLY, 104, Fp.G - 104); } } } SEAM(pb + 7); }
            if (KON(8) && IN(pb + 8)) { for (int rep_ = 0; rep_ <= DUPK(8); ++rep_) { if (rep_) xcd_barrier(bar); { FRESH(); mixers_phase(Fp, KA, lp); } } SEAM(pb + 8); }
            if (KON(9) && IN(pb + 9)) { for (int rep_ = 0; rep_ <= DUPK(9); ++rep_) { if (rep_) xcd_barrier(bar); { FRESH(); post_phase(Fp, KA, lp); } } SEAM(pb + 9); }
            if (KON(10) && IN(pb + 10)) { for (int rep_ = 0; rep_ <= DUPK(10); ++rep_) { if (rep_) xcd_barrier(bar); { GEMM_PTRS(); const int Mq = (lp == DEPTH - 1) ? SEQ : MR; pg8::Gemm g{(const bf16*)(ws + WS_YBP), WL + WL_GLU, Mq, 1024, 512, 512}; pg8::StaticOrder S; S.init(Mq, 1024, Fp.G, (int)blockIdx.x);
                pg8::EpiGated<1> E{(bf16*)(ws + WS_YALL) + YC_B, YPITCH, ((const float*)(const GAS float*)KA->in[I_GLUB]) + (size_t)lp * 1024, 512};
                pg8::gemm_phase<pg8::EpiGated<1>, pg8::StaticOrder, GP_ALIGN, GP_SP2>(ring, g, S, E); } } SEAM(pb + 10); }
            if (KON(11) && IN(pb + 11)) { for (int rep_ = 0; rep_ <= DUPK(11); ++rep_) { if (rep_) xcd_barrier(bar); { GEMM_PTRS(); const int Mq = (lp == DEPTH - 1) ? SEQ : MR;
                pg8::Gemm g{(const bf16*)(ws + WS_YALL), WL + WL_BRALL, Mq, DM, YPITCH, YPITCH}; pg8::MergeOrder S; S.so.init(Mq, DM, Fp.G, (int)blockIdx.x, WGM_MRG); pg8::EpiMergeR E{P + PC_GATE, NP, (bf16*)(ws + WS_MG)};
                pg8::gemm_phase<pg8::EpiMergeR, pg8::MergeOrder, GP_ALIGN, GP_SP2>(ring, g, S, E);
                if (HIDE_CONVERT && lp < DEPTH - 1) { const int rem = (MR / 256) * (DM / 256) % Fp.G; convert_idle(Fp, KA, (int)blockIdx.x, rem, lp, IT_LAYER - IT_GD / 2, IT_GD / 2); convert_idle(Fp, KA, (int)blockIdx.x, rem, lp + 1, 0, IT_GA / 2); } } } SEAM(pb + 11); }
            if (KON(12) && IN(pb + 12)) { for (int rep_ = 0; rep_ <= DUPK(12); ++rep_) { if (rep_) xcd_barrier(bar); { GEMM_PTRS();
                { pg8::Gemm g{(const bf16*)(ws + WS_MG), WL + WL_OUT, SEQ, DM, DM, DM}; pg8::StaticOrder S; S.init(SEQ, DM, Fp.G, (int)blockIdx.x, WGM_RES, REV_RES); pg8::EpiResid E{X, (rep_ < DUPK(12)) ? (float*)(ws + WS_MGF) : X, X, modl + 5 * DM, modc + 5 * DM, 1.0f, SEQ / 256};
                  pg8::gemm_phase<pg8::EpiResid, pg8::StaticOrder, GP_ALIGN_RESID, GP_SP2>(ring, g, S, E); }
                if (lp < DEPTH - 1) { pg8::Gemm g{(const bf16*)(ws + WS_MG), WL + WL_OUT, MR, DM, 512, DM}; pg8::SplitKOrder S{SEQ / 256, DM / 256, DM / 512, Fp.G, (int)blockIdx.x}; pg8::EpiPartial E{(float*)(ws + WS_PART), modc + 5 * DM, 1.0f};
                  pg8::gemm_phase<pg8::EpiPartial, pg8::SplitKOrder, GP_ALIGN, GP_SP2>(ring, g, S, E); }
                } } SEAM(pb + 12); }
        }
        const int pf = pb + (f ? 13 : 0); const bool no_ctx = (f == 1 && l == DEPTH - 1);
        if (KON(0) && IN(pf + 0)) { FRESH(); int fp = f; asm volatile("" : "+s"(fp)); norm_phase(Fp, KA, lp, 2 * fp, fp ? (lp < DEPTH - 1 ? DM / 512 : 0) : (lp > 0 ? DFF / 512 : 0)); SEAM(pf + 0); }
        if (KON(1) && IN(pf + 1)) { GEMM_PTRS(); int fp = f; asm volatile("" : "+s"(fp)); const int Mq = no_ctx ? SEQ : MR;
            pg8::Gemm g{H, WL + WL_FFI + (size_t)fp * NFF * DM, Mq, NFF, DM, DM}; pg8::StaticOrder S; S.init(Mq, NFF, Fp.G, (int)blockIdx.x, WGM_FFI); pg8::EpiGated<0> E{HID, DFF, nullptr, 0};
            pg8::gemm_phase<pg8::EpiGated<0>, pg8::StaticOrder, GP_ALIGN, GP_SP2>(ring, g, S, E); SEAM(pf + 1); }
        if (KON(2) && IN(pf + 2)) { GEMM_PTRS(); int fp = f; asm volatile("" : "+s"(fp)); const bf16* Wo = WL + WL_FFO + (size_t)fp * DM * DFF; const int gs = (2 + 6 * fp) * DM;
            { pg8::Gemm g{HID, Wo, SEQ, DM, DFF, DFF}; pg8::StaticOrder S; S.init(SEQ, DM, Fp.G, (int)blockIdx.x, WGM_RES, REV_RES);
              pg8::EpiResid E{X, (fp == 1 && lp == DEPTH - 1) ? (float*)KA->out : X, X, modl + gs, modc + gs, 0.5f, SEQ / 256};
              pg8::gemm_phase<pg8::EpiResid, pg8::StaticOrder, GP_ALIGN_RESID, GP_SP2>(ring, g, S, E); }
            if (!no_ctx) { pg8::Gemm g{HID, Wo, MR, DM, 512, DFF}; pg8::SplitKOrder S{SEQ / 256, DM / 256, DFF / 512, Fp.G, (int)blockIdx.x}; pg8::EpiPartial E{(float*)(ws + WS_PART), modc + gs, 0.5f};
              pg8::gemm_phase<pg8::EpiPartial, pg8::SplitKOrder, GP_ALIGN, GP_SP2>(ring, g, S, E); }
            SEAM(pf + 2); }
    }
#undef IN
#undef SEAM
}

extern "C" void kernel_launch(void* const* d_in, const int* in_sizes, int n_in, void* d_out, int out_size, void* d_ws, size_t ws_size, hipStream_t stream) {
    static int grid = 0;
    if (grid == 0) {
        if (n_in != N_IN || out_size != SEQ * DM || ws_size < WS_END) { fprintf(stderr, "kernel_launch: built for %d inputs, %d outputs, >= %zu bytes of workspace; got n_in %d, out %d, ws %zu; nothing launched\n", N_IN, SEQ * DM, (size_t)WS_END, n_in, out_size, ws_size); grid = -1; return; }
        int dev = 0, cus = 0, per_cu = 0;
        if (hipGetDevice(&dev) != hipSuccess || hipDeviceGetAttribute(&cus, hipDeviceAttributeMultiprocessorCount, dev) != hipSuccess) { fprintf(stderr, "kernel_launch: hipGetDevice / hipDeviceGetAttribute failed\n"); grid = -1; return; }
        if (hipFuncSetAttribute((const void*)trunk_fwd, hipFuncAttributeMaxDynamicSharedMemorySize, LDS_BYTES) != hipSuccess) { fprintf(stderr, "kernel_launch: hipFuncSetAttribute failed\n"); grid = -1; return; }
        if (hipOccupancyMaxActiveBlocksPerMultiprocessor(&per_cu, (const void*)trunk_fwd, NWAVES * 64, LDS_BYTES) != hipSuccess || per_cu < 1)
            fprintf(stderr, "kernel_launch: note: occupancy query reports %d workgroups per CU\n", per_cu);
        (void)hipGetLastError();
        grid = cus;
        if (grid % 8 != 0 || grid < 8) { fprintf(stderr, "kernel_launch: unexpected CU count %d\n", cus); }
    }
    if (grid < 0) return;
    if (hipMemsetAsync((char*)d_ws + WS_CTL, 0, CTL_ZERO_BYTES, stream) != hipSuccess) { fprintf(stderr, "kernel_launch: hipMemsetAsync failed\n"); return; }
    Args a{};
    for (int i = 0; i < N_IN; ++i) a.in[i] = (const float*)d_in[i];
    a.out = (float*)d_out; a.ws = (unsigned char*)d_ws;
#if MK_PER_PHASE
    for (int k = 0; k < NPHASE; ++k) { a.ph_lo = k; a.ph_hi = k + 1; hipLaunchKernelGGL(trunk_fwd, dim3(grid), dim3(NWAVES * 64), LDS_BYTES, stream, a); }
#else
    a.ph_lo = 0; a.ph_hi = NPHASE;
    hipLaunchKernelGGL(trunk_fwd, dim3(grid), dim3(NWAVES * 64), LDS_BYTES, stream, a);
#endif
    const hipError_t le = hipPeekAtLastError();
    if (le != hipSuccess) fprintf(stderr, "kernel_launch: launch failed: %s\n", hipGetErrorName(le));
}
```

```cpp
#include <hip/hip_runtime.h>
#include <cstdio>
#include <cstdint>
#ifndef WGM_SEL
#define WGM_SEL 2
#endif
namespace pg8 {
#define PG8_LAS __attribute__((address_space(3)))
typedef unsigned short bf16_t;
typedef short bf16x8 __attribute__((ext_vector_type(8)));
typedef float f32x4 __attribute__((ext_vector_type(4)));
typedef unsigned u32x4 __attribute__((ext_vector_type(4)));
constexpr int BM = 256, BK = 64, HALF = 128, HTB = HALF * BK * 2  , STAGE_BYTES = 8 * HTB, NXCD = 8, WGM = WGM_SEL;

__host__ __device__ __forceinline__ int lds_byte(int r, int c) { const int st = (r >> 4) * 2 + (c >> 5), rr = r & 15, cc = c & 31, ob = rr * 64 + cc * 2; return st * 1024 + (ob ^ (((ob >> 9) & 1) << 5)); }
__host__ __device__ __forceinline__ void stage_rc(int b, int& R, int& C) { const int st = b / 1024, sb = b % 1024, swz = sb ^ (((sb >> 9) & 1) << 5); R = (st >> 1) * 16 + swz / 64; C = (st & 1) * 32 + (swz % 64) / 2; }
__host__ __device__ __forceinline__ int perm32(int rho) { const int n = rho >> 4, i = rho & 15; return 8 * (i >> 2) + 4 * n + (i & 3); }

struct Unit { int pm, pn, ks, kofs, nt, seg; };
struct Gemm { const bf16_t* A; const bf16_t* Bt; int M, N, K, ld; };

struct StaticOrder {
    int nM, nN, nwg, G, c, wgm, rev;
    __host__ __device__ void init(int M, int N, int G_, int c_, int wgm_ = WGM, int rev_ = 0) { nM = M / BM; nN = N / BM; nwg = nM * nN; G = G_; c = c_; wgm = wgm_; rev = rev_; }
    __host__ __device__ bool next(int i, Unit& u) const {
        const long L = (long)i * G + c; if (L >= nwg) return false;
        int wgid = (int)L; { const int q = nwg / NXCD, r = nwg % NXCD, xcd = wgid % NXCD, off = wgid / NXCD; wgid = (xcd < r ? xcd * (q + 1) : r * (q + 1) + (xcd - r) * q) + off; }
        const int nig = wgm * nN, gid = wgid / nig, fm = gid * wgm, gsz = (nM - fm) < wgm ? (nM - fm) : wgm;
        u.pm = fm + ((wgid % nig) % gsz); if (rev) u.pm = nM - 1 - u.pm; u.pn = (wgid % nig) / gsz; u.ks = 0; u.kofs = 0; u.nt = 0; u.seg = 0; return true;
    }
    __device__ __forceinline__ void a_ready(const Unit&) const {}
    __device__ __forceinline__ void done(const Unit&) const {}
};
struct SplitKOrder {
    int pm, nN, nS, G, c;
    __device__ __forceinline__ bool next(int i, Unit& u) const { const int L = i * G + c; if (L >= nN * nS) return false; u.pm = pm; u.pn = L % nN; u.ks = L / nN; u.kofs = 0; u.nt = 0; u.seg = 0; return true; }
    __device__ __forceinline__ void a_ready(const Unit&) const {}
    __device__ __forceinline__ void done(const Unit&) const {}
};
struct MergeOrder {
    StaticOrder so;
    __device__ __forceinline__ bool next(int i, Unit& u) const { if (!so.next(i >> 2, u)) return false; const int s = i & 3; u.seg = s; u.kofs = s ? 256 + 512 * s : 0; u.nt = s ? 8 : 12; return true; }
    __device__ __forceinline__ void a_ready(const Unit&) const {}
    __device__ __forceinline__ void done(const Unit&) const {}
};
__device__ __forceinline__ unsigned cvt_pk_bf16(float lo, float hi) { unsigned r; asm volatile("v_cvt_pk_bf16_f32 %0, %1, %2" : "=v"(r) : "v"(lo), "v"(hi)); return r; }
typedef float f32x2 __attribute__((ext_vector_type(2)));
__device__ __forceinline__ float sigm(float x) { return __builtin_amdgcn_rcpf(1.0f + __builtin_amdgcn_exp2f(-1.4426950408889634f * x)); }
__device__ __forceinline__ float silu(float x) { return x * sigm(x); }
__device__ __forceinline__ float bf2f(unsigned short h) { return __uint_as_float(((unsigned)h) << 16); }
typedef unsigned u32x2 __attribute__((ext_vector_type(2)));

struct EpiBf16 {
    static constexpr bool PERM = true, AFTER_DRAIN = false, KEEP_ACC = false;
    bf16_t* O; int ldc;
    __device__ __forceinline__ void operator()(const f32x4 (&acc)[2][2][4][2], const Unit& u, int wr, int wc, int fr, int fq) const {
        const int row0 = u.pm * BM + wr * 64 + fr; const int col0 = u.pn * BM + wc * 32 + 8 * fq;
#pragma unroll
        for (int ai = 0; ai < 2; ++ai)
#pragma unroll
            for (int m = 0; m < 4; ++m) { bf16_t* rowp = O + (size_t)(row0 + ai * HALF + m * 16) * ldc + col0;
#pragma unroll
                for (int bj = 0; bj < 2; ++bj) { const f32x4 v0 = acc[ai][bj][m][0], v1 = acc[ai][bj][m][1];
                    u32x4 w; w.x = cvt_pk_bf16(v0[0], v0[1]); w.y = cvt_pk_bf16(v0[2], v0[3]); w.z = cvt_pk_bf16(v1[0], v1[1]); w.w = cvt_pk_bf16(v1[2], v1[3]);
                    *(u32x4*)(rowp + bj * HALF) = w; } }
    }
};
template <int MODE> struct EpiGated {
    static constexpr bool PERM = true, AFTER_DRAIN = false, KEEP_ACC = false;
    bf16_t* O; int ldo; const float* bias; int half;
    __device__ __forceinline__ void operator()(const f32x4 (&acc)[2][2][4][2], const Unit& u, int wr, int wc, int fr, int fq) const {
        const int row0 = u.pm * BM + wr * 64 + fr; const int col0 = u.pn * HALF + wc * 32 + 8 * fq;
        f32x4 ba[2], bb[2];
#pragma unroll
        for (int n = 0; n < 2; ++n) { if (MODE == 1) { ba[n] = *(const f32x4*)(bias + col0 + 4 * n); bb[n] = *(const f32x4*)(bias + half + col0 + 4 * n); } else { ba[n] = (f32x4){0.f, 0.f, 0.f, 0.f}; bb[n] = ba[n]; } }
#pragma unroll
        for (int ai = 0; ai < 2; ++ai)
#pragma unroll
            for (int m = 0; m < 4; ++m) { bf16_t* rowp = O + (size_t)(row0 + ai * HALF + m * 16) * ldo + col0;
                float r[8];
#pragma unroll
                for (int n = 0; n < 2; ++n)
#pragma unroll
                    for (int i = 0; i < 4; ++i) { const float a = acc[ai][0][m][n][i] + ba[n][i], b = acc[ai][1][m][n][i] + bb[n][i]; r[4 * n + i] = (MODE == 0) ? silu(a) * b : a * sigm(b); }
                u32x4 w; w.x = cvt_pk_bf16(r[0], r[1]); w.y = cvt_pk_bf16(r[2], r[3]); w.z = cvt_pk_bf16(r[4], r[5]); w.w = cvt_pk_bf16(r[6], r[7]);
                *(u32x4*)rowp = w; }
    }
};
struct EpiResid {
    static constexpr bool PERM = false, AFTER_DRAIN = false, KEEP_ACC = false;
    const float* base; float* out_lat; float* out_ctx; const float* gate_lat; const float* gate_ctx; float coef; int ctx_pm;
    __device__ __forceinline__ void operator()(const f32x4 (&acc)[2][2][4][2], const Unit& u, int wr, int wc, int fr, int fq) const {
        const bool isctx = u.pm >= ctx_pm; const float* g = isctx ? gate_ctx : gate_lat; float* o = isctx ? out_ctx : out_lat;
        const int row0 = u.pm * BM + wr * 64 + fr, col0 = u.pn * BM + wc * 32 + 4 * fq;
        f32x4 gv[2][2];
#pragma unroll
        for (int bj = 0; bj < 2; ++bj)
#pragma unroll
            for (int n = 0; n < 2; ++n) gv[bj][n] = *(const f32x4*)(g + col0 + bj * HALF + n * 16) * coef;
#pragma unroll
        for (int ai = 0; ai < 2; ++ai)
#pragma unroll
            for (int mp = 0; mp < 2; ++mp) { f32x4 bv[2][2][2];
#pragma unroll
                for (int mm = 0; mm < 2; ++mm) { const size_t off = (size_t)(row0 + ai * HALF + (2 * mp + mm) * 16) * 2048 + col0;
#pragma unroll
                    for (int bj = 0; bj < 2; ++bj)
#pragma unroll
                        for (int n = 0; n < 2; ++n) bv[mm][bj][n] = *(const f32x4*)(base + off + bj * HALF + n * 16); }
                asm volatile("" ::: "memory");
#pragma unroll
                for (int mm = 0; mm < 2; ++mm) { const size_t off = (size_t)(row0 + ai * HALF + (2 * mp + mm) * 16) * 2048 + col0;
#pragma unroll
                    for (int bj = 0; bj < 2; ++bj)
#pragma unroll
                        for (int n = 0; n < 2; ++n) *(f32x4*)(o + off + bj * HALF + n * 16) = bv[mm][bj][n] + gv[bj][n] * acc[ai][bj][2 * mp + mm][n]; }
                asm volatile("" ::: "memory"); }
    }
};
template <int MODE> struct EpiMerge {
    static constexpr bool PERM = false, AFTER_DRAIN = false, KEEP_ACC = false;
    const bf16_t* G; int ldg; float* F; bf16_t* O;
    __device__ __forceinline__ void operator()(const f32x4 (&acc)[2][2][4][2], const Unit& u, int wr, int wc, int fr, int fq) const {
        const int row0 = u.pm * BM + wr * 64 + fr, col0 = u.pn * BM + wc * 32 + 4 * fq;
#pragma unroll
        for (int ai = 0; ai < 2; ++ai)
#pragma unroll
            for (int m = 0; m < 4; ++m) { const size_t r = (size_t)(row0 + ai * HALF + m * 16);
#pragma unroll
                for (int bj = 0; bj < 2; ++bj)
#pragma unroll
                    for (int n = 0; n < 2; ++n) { const int c = col0 + bj * HALF + n * 16;
                        const u32x2 gw = *(const u32x2*)(G + r * ldg + c);
                        f32x4 t; t[0] = sigm(__uint_as_float(gw.x << 16)); t[1] = sigm(__uint_as_float(gw.x & 0xffff0000u)); t[2] = sigm(__uint_as_float(gw.y << 16)); t[3] = sigm(__uint_as_float(gw.y & 0xffff0000u));
                        t = t * acc[ai][bj][m][n];
                        if (MODE >= 1) t = t + *(const f32x4*)(F + r * 2048 + c);
                        if (MODE <= 1) *(f32x4*)(F + r * 2048 + c) = t;
                        else { u32x2 w; w.x = cvt_pk_bf16(t[0], t[1]); w.y = cvt_pk_bf16(t[2], t[3]); *(u32x2*)(O + r * 2048 + c) = w; } } }
    }
};
struct EpiPartial {
    static constexpr bool PERM = false, AFTER_DRAIN = false, KEEP_ACC = false;
    float* part; const float* gate; float coef;
    __device__ __forceinline__ void operator()(const f32x4 (&acc)[2][2][4][2], const Unit& u, int wr, int wc, int fr, int fq) const {
        const int row0 = u.ks * BM + wr * 64 + fr, col0 = u.pn * BM + wc * 32 + 4 * fq;
        f32x4 gv[2][2];
#pragma unroll
        for (int bj = 0; bj < 2; ++bj)
#pragma unroll
            for (int n = 0; n < 2; ++n) gv[bj][n] = *(const f32x4*)(gate + col0 + bj * HALF + n * 16) * coef;
#pragma unroll
        for (int ai = 0; ai < 2; ++ai)
#pragma unroll
            for (int m = 0; m < 4; ++m) { const size_t off = (size_t)(row0 + ai * HALF + m * 16) * 2048 + col0;
#pragma unroll
                for (int bj = 0; bj < 2; ++bj)
#pragma unroll
                    for (int n = 0; n < 2; ++n) *(f32x4*)(part + off + bj * HALF + n * 16) = gv[bj][n] * acc[ai][bj][m][n]; }
    }
};
struct EpiMergeR {
    static constexpr bool PERM = false, AFTER_DRAIN = false, KEEP_ACC = true;
    const bf16_t* G; int ldg; bf16_t* O;
    __device__ __forceinline__ bool zero_after(const Unit& u) const { return u.seg == 3; }
    __device__ __forceinline__ void operator()(f32x4 (&acc)[2][2][4][2], const Unit& u, int wr, int wc, int fr, int fq) const {
        const int row0 = u.pm * BM + wr * 64 + fr, col0 = u.pn * BM + wc * 32 + 4 * fq; const bf16_t* Gs = G + 2048 * u.seg + u.pn * BM + 64 * wc + 16 * fq; const bool fin = u.seg == 3;
#pragma unroll
        for (int ai = 0; ai < 2; ++ai)
#pragma unroll
            for (int m = 0; m < 4; ++m) { const size_t r = (size_t)(row0 + ai * HALF + m * 16);
                const u32x4 w0 = *(const u32x4*)(Gs + r * ldg), w1 = *(const u32x4*)(Gs + r * ldg + 8);
                acc[ai][0][m][0] = acc[ai][0][m][0] * (f32x4){__uint_as_float(w0.x << 16), __uint_as_float(w0.x & 0xffff0000u), __uint_as_float(w0.y << 16), __uint_as_float(w0.y & 0xffff0000u)};
                acc[ai][0][m][1] = acc[ai][0][m][1] * (f32x4){__uint_as_float(w0.z << 16), __uint_as_float(w0.z & 0xffff0000u), __uint_as_float(w0.w << 16), __uint_as_float(w0.w & 0xffff0000u)};
                acc[ai][1][m][0] = acc[ai][1][m][0] * (f32x4){__uint_as_float(w1.x << 16), __uint_as_float(w1.x & 0xffff0000u), __uint_as_float(w1.y << 16), __uint_as_float(w1.y & 0xffff0000u)};
                acc[ai][1][m][1] = acc[ai][1][m][1] * (f32x4){__uint_as_float(w1.z << 16), __uint_as_float(w1.z & 0xffff0000u), __uint_as_float(w1.w << 16), __uint_as_float(w1.w & 0xffff0000u)};
                if (fin) {
#pragma unroll
                    for (int bj = 0; bj < 2; ++bj)
#pragma unroll
                        for (int n = 0; n < 2; ++n) { const f32x4 t = acc[ai][bj][m][n]; u32x2 w; w.x = cvt_pk_bf16(t[0], t[1]); w.y = cvt_pk_bf16(t[2], t[3]); *(u32x2*)(O + r * 2048 + col0 + bj * HALF + n * 16) = w; } } }
    }
};
struct EpiWin {
    static constexpr bool PERM = true, AFTER_DRAIN = false, KEEP_ACC = false;
    bf16_t* O; int ldc; int gate_pn; int gate0;
    __device__ __forceinline__ void operator()(const f32x4 (&acc)[2][2][4][2], const Unit& u, int wr, int wc, int fr, int fq) const {
        const int row0 = u.pm * BM + wr * 64 + fr;
        if (u.pn < gate_pn) { const int col0 = u.pn * BM + wc * 32 + 8 * fq;
#pragma unroll
            for (int ai = 0; ai < 2; ++ai)
#pragma unroll
                for (int m = 0; m < 4; ++m) { bf16_t* rowp = O + (size_t)(row0 + ai * HALF + m * 16) * ldc + col0;
#pragma unroll
                    for (int bj = 0; bj < 2; ++bj) { const f32x4 v0 = acc[ai][bj][m][0], v1 = acc[ai][bj][m][1];
                        u32x4 w; w.x = cvt_pk_bf16(v0[0], v0[1]); w.y = cvt_pk_bf16(v0[2], v0[3]); w.z = cvt_pk_bf16(v1[0], v1[1]); w.w = cvt_pk_bf16(v1[2], v1[3]);
                        *(u32x4*)(rowp + bj * HALF) = w; } }
        } else {
            const int c = 64 * (u.pn - gate_pn) + 16 * wc + 4 * fq;
            const int sg = (c & ~255) + 64 * ((c >> 5) & 3) + 16 * ((c >> 2) & 3) + 8 * ((c >> 7) & 1) + 4 * ((c >> 4) & 1);
#pragma unroll
            for (int ai = 0; ai < 2; ++ai)
#pragma unroll
                for (int m = 0; m < 4; ++m) { bf16_t* rowp = O + (size_t)(row0 + ai * HALF + m * 16) * ldc + gate0 + sg;
                    f32x4 d[4];
#pragma unroll
                    for (int b = 0; b < 4; ++b)
#pragma unroll
                        for (int i = 0; i < 4; ++i) d[b][i] = 1.0f + __builtin_amdgcn_exp2f(-1.4426950408889634f * fminf(fmaxf(acc[ai][b >> 1][m][b & 1][i], -30.0f), 30.0f));
#pragma unroll
                    for (int s = 0; s < 4; ++s) { f32x4 rr;
#pragma unroll
                        for (int i = 0; i < 4; ++i) rr[i] = (s < 3 ? d[s < 3 ? s + 1 : 3][i] : 1.0f) * __builtin_amdgcn_rcpf(d[s][i]);
                        u32x2 w; w.x = cvt_pk_bf16(rr[0], rr[1]); w.y = cvt_pk_bf16(rr[2], rr[3]); *(u32x2*)(rowp + 2048 * s) = w; } }
        }
    }
};
#ifndef PG8_AUX_A
#define PG8_AUX_A 0
#endif
#ifndef PG8_AUX_B
#define PG8_AUX_B 0
#endif
template <class Epi, class Sched, bool ALIGN_EPI = false, bool SP2 = false>
__device__ __forceinline__ void gemm_phase(PG8_LAS unsigned char* lds, const Gemm g, const Sched& S, const Epi& E) {
    int tid_ = threadIdx.x; asm volatile("" : "+v"(tid_)); const int tid = tid_, wid = __builtin_amdgcn_readfirstlane(tid >> 6), lane = tid & 63, wr = wid >> 2, wc = wid & 3, fr = lane & 15, fq = lane >> 4;
    const int K = g.ld, nt = g.K / BK;
    unsigned voffA[2], voffB[2];
#pragma unroll
    for (int i = 0; i < 2; ++i) { int R, C; stage_rc(tid * 16 + i * 8192, R, C); const int Rb = Epi::PERM ? ((R & ~31) + perm32(R & 31)) : R;
        voffA[i] = (unsigned)(R * K + C) * 2u; voffB[i] = (unsigned)(Rb * K + C) * 2u; }
    const size_t kstep = (size_t)(BK * 2);
    const size_t hstep = (size_t)HALF * K * 2;
    const size_t tstep = 2 * hstep;
    const unsigned ldsw = (unsigned)wid * 1024u;
    const int aoff = lds_byte(wr * 64 + fr, fq * 8), boff = lds_byte(wc * 32 + fr, fq * 8);
#define PG8_SA(b, h) (((b) * 2 + (h)) * HTB)
#define PG8_SB(b, h) ((4 + (b) * 2 + (h)) * HTB)
#define PG8_STAGE(bufoff, gbase, voff) do { _Pragma("unroll") for (int _i = 0; _i < 2; ++_i) \
        __builtin_amdgcn_global_load_lds((const unsigned*)((const char*)(gbase) + (voff)[_i]), (PG8_LAS unsigned*)(lds + (bufoff) + ldsw + _i * 8192), 16, 0, PG8_AUX_A); } while (0)
#define PG8_STAGEB(bufoff, gbase, voff) do { _Pragma("unroll") for (int _i = 0; _i < 2; ++_i) \
        __builtin_amdgcn_global_load_lds((const unsigned*)((const char*)(gbase) + (voff)[_i]), (PG8_LAS unsigned*)(lds + (bufoff) + ldsw + _i * 8192), 16, 0, PG8_AUX_B); } while (0)
#define PG8_LDA(dst, b, h) do { _Pragma("unroll") for (int m = 0; m < 4; ++m) _Pragma("unroll") for (int k = 0; k < 2; ++k) dst[m][k] = *(const PG8_LAS bf16x8*)(lds + PG8_SA(b, h) + aoff + m * 2048 + k * 1024); } while (0)
#define PG8_LDB(dst, b, h) do { _Pragma("unroll") for (int n = 0; n < 2; ++n) _Pragma("unroll") for (int k = 0; k < 2; ++k) dst[n][k] = *(const PG8_LAS bf16x8*)(lds + PG8_SB(b, h) + boff + n * 2048 + k * 1024); } while (0)
#define PG8_MMA(ai, bj, At, Bt) do { __builtin_amdgcn_s_setprio(1); _Pragma("unroll") for (int m = 0; m < 4; ++m) _Pragma("unroll") for (int n = 0; n < 2; ++n) _Pragma("unroll") for (int k = 0; k < 2; ++k) \
        acc[ai][bj][m][n] = __builtin_amdgcn_mfma_f32_16x16x32_bf16(Bt[n][k], At[m][k], acc[ai][bj][m][n], 0, 0, 0); __builtin_amdgcn_s_setprio(0); } while (0)
#define PG8_WAIT_V(n) asm volatile("s_waitcnt vmcnt(" #n ")" ::: "memory")
#define PG8_WAIT_L(n) asm volatile("s_waitcnt lgkmcnt(" #n ")" ::: "memory")
#define PG8_BAR __builtin_amdgcn_s_barrier()
#define PG8_SCHED __builtin_amdgcn_sched_barrier(0)
    Unit cur, nxt; int ui = 0;
    if (!S.next(0, cur)) return;
    f32x4 acc[2][2][4][2];
#pragma unroll
    for (int a = 0; a < 2; ++a)
#pragma unroll
        for (int b = 0; b < 2; ++b)
#pragma unroll
            for (int m = 0; m < 4; ++m)
#pragma unroll
                for (int n = 0; n < 2; ++n) acc[a][b][m][n] = (f32x4){0.f, 0.f, 0.f, 0.f};
    bf16x8 At[4][2], B0[2][2], B1[2][2];
    const size_t kslice = (size_t)g.K * 2;
    const char* cA = (const char*)g.A + (size_t)cur.pm * tstep + (size_t)cur.ks * kslice + (size_t)cur.kofs * 2; const char* cB = (const char*)g.Bt + (size_t)cur.pn * tstep + (size_t)cur.ks * kslice + (size_t)cur.kofs * 2;
    S.a_ready(cur);
    if constexpr (SP2) {
        PG8_STAGEB(PG8_SB(0, 0), cB, voffB); PG8_STAGEB(PG8_SB(0, 1), cB + hstep, voffB); PG8_STAGE(PG8_SA(0, 0), cA, voffA); PG8_STAGE(PG8_SA(0, 1), cA + hstep, voffA);
        if (wr == 1) PG8_BAR;
        PG8_WAIT_V(2); PG8_BAR;
        PG8_STAGEB(PG8_SB(1, 0), cB + kstep, voffB); PG8_STAGE(PG8_SA(1, 0), cA + kstep, voffA); PG8_STAGEB(PG8_SB(1, 1), cB + hstep + kstep, voffB);
        PG8_WAIT_V(6); PG8_BAR;
    } else {
        PG8_STAGEB(PG8_SB(0, 0), cB, voffB); PG8_STAGE(PG8_SA(0, 0), cA, voffA); PG8_STAGEB(PG8_SB(0, 1), cB + hstep, voffB); PG8_STAGE(PG8_SA(0, 1), cA + hstep, voffA);
        if (wr == 1) PG8_BAR;
        PG8_WAIT_V(4); PG8_BAR;
        PG8_STAGEB(PG8_SB(1, 0), cB + kstep, voffB); PG8_STAGE(PG8_SA(1, 0), cA + kstep, voffA); PG8_STAGEB(PG8_SB(1, 1), cB + hstep + kstep, voffB);
        PG8_WAIT_V(6); PG8_BAR;
    }
    for (;;) {
        const bool has_next = S.next(ui + 1, nxt);
        const char* nA = has_next ? (const char*)g.A + (size_t)nxt.pm * tstep + (size_t)nxt.ks * kslice + (size_t)nxt.kofs * 2 : cA; const char* nB = has_next ? (const char*)g.Bt + (size_t)nxt.pn * tstep + (size_t)nxt.ks * kslice + (size_t)nxt.kofs * 2 : cB;
        const int nt_u = cur.nt ? cur.nt : nt;
        for (int t = 0; t < nt_u; t += 2) {
            const bool last = (t == nt_u - 2);
            const char* a1 = cA + (size_t)(t + 1) * kstep;
            const char* a2 = last ? nA : cA + (size_t)(t + 2) * kstep; const char* b2 = last ? nB : cB + (size_t)(t + 2) * kstep;
            const char* a3 = a2 + kstep; const char* b3 = b2 + kstep;
            if (last && has_next) S.a_ready(nxt);
            if constexpr (SP2) {
            PG8_LDB(B0, 0, 0); PG8_LDB(B1, 0, 1); PG8_SCHED; PG8_LDA(At, 0, 0); PG8_STAGE(PG8_SA(1, 1), a1 + hstep, voffA);
            PG8_WAIT_V(8); PG8_WAIT_L(0); PG8_BAR; PG8_MMA(0, 0, At, B0); PG8_MMA(0, 1, At, B1); PG8_BAR; PG8_SCHED;
            PG8_LDA(At, 0, 1); PG8_STAGEB(PG8_SB(0, 0), b2, voffB); PG8_STAGEB(PG8_SB(0, 1), b2 + hstep, voffB); PG8_STAGE(PG8_SA(0, 0), a2, voffA);
            PG8_WAIT_V(8); PG8_WAIT_L(0); PG8_BAR; PG8_MMA(1, 0, At, B0); PG8_MMA(1, 1, At, B1); PG8_BAR; PG8_SCHED;
            PG8_LDB(B0, 1, 0); PG8_LDB(B1, 1, 1); PG8_SCHED; PG8_LDA(At, 1, 0); PG8_STAGE(PG8_SA(0, 1), a2 + hstep, voffA);
            PG8_WAIT_V(8); PG8_WAIT_L(0); PG8_BAR; PG8_MMA(0, 0, At, B0); PG8_MMA(0, 1, At, B1); PG8_BAR; PG8_SCHED;
            PG8_LDA(At, 1, 1); PG8_STAGEB(PG8_SB(1, 0), b3, voffB); PG8_STAGEB(PG8_SB(1, 1), b3 + hstep, voffB); PG8_STAGE(PG8_SA(1, 0), a3, voffA);
            PG8_WAIT_V(8); PG8_WAIT_L(0); PG8_BAR; PG8_MMA(1, 0, At, B0); PG8_MMA(1, 1, At, B1); PG8_BAR; PG8_SCHED;
            } else {
            PG8_LDB(B0, 0, 0); PG8_SCHED; PG8_LDA(At, 0, 0); PG8_STAGE(PG8_SA(1, 1), a1 + hstep, voffA);
            PG8_WAIT_L(8); PG8_BAR; PG8_WAIT_L(0); PG8_MMA(0, 0, At, B0); PG8_BAR; PG8_SCHED;
            PG8_LDB(B1, 0, 1); PG8_STAGEB(PG8_SB(0, 0), b2, voffB);
            PG8_BAR; PG8_WAIT_L(0); PG8_MMA(0, 1, At, B1); PG8_BAR;
            PG8_LDA(At, 0, 1); PG8_STAGE(PG8_SA(0, 0), a2, voffA);
            PG8_BAR; PG8_WAIT_L(0); PG8_MMA(1, 0, At, B0); PG8_BAR; PG8_SCHED;
            PG8_STAGEB(PG8_SB(0, 1), b2 + hstep, voffB);
            PG8_WAIT_V(6); PG8_BAR; PG8_MMA(1, 1, At, B1); PG8_BAR;
            PG8_LDB(B0, 1, 0); PG8_SCHED; PG8_LDA(At, 1, 0); PG8_STAGE(PG8_SA(0, 1), a2 + hstep, voffA);
            PG8_WAIT_L(8); PG8_BAR; PG8_WAIT_L(0); PG8_MMA(0, 0, At, B0); PG8_BAR; PG8_SCHED;
            PG8_LDB(B1, 1, 1); PG8_STAGEB(PG8_SB(1, 0), b3, voffB);
            PG8_BAR; PG8_WAIT_L(0); PG8_MMA(0, 1, At, B1); PG8_BAR;
            PG8_LDA(At, 1, 1); PG8_STAGE(PG8_SA(1, 0), a3, voffA);
            PG8_BAR; PG8_WAIT_L(0); PG8_MMA(1, 0, At, B0); PG8_BAR; PG8_SCHED;
            PG8_STAGEB(PG8_SB(1, 1), b3 + hstep, voffB);
            PG8_WAIT_V(6); PG8_BAR; PG8_MMA(1, 1, At, B1); PG8_BAR;
            }
        }
        if constexpr (ALIGN_EPI) { if (wr == 0) PG8_BAR; }
        if constexpr (!Epi::AFTER_DRAIN) { E(acc, cur, wr, wc, fr, fq); S.done(cur); }
        if (!has_next) break;
        bool zero_ = true; if constexpr (Epi::KEEP_ACC) zero_ = E.zero_after(cur);
        if (zero_) {
#pragma unroll
        for (int a = 0; a < 2; ++a)
#pragma unroll
            for (int b = 0; b < 2; ++b)
#pragma unroll
                for (int m = 0; m < 4; ++m)
#pragma unroll
                    for (int n = 0; n < 2; ++n) acc[a][b][m][n] = (f32x4){0.f, 0.f, 0.f, 0.f};
        }
        cur = nxt; cA = nA; cB = nB; ++ui;
        if constexpr (ALIGN_EPI) { if (wr == 1) PG8_BAR; }
    }
    PG8_WAIT_V(0);
    if constexpr (!ALIGN_EPI) { if (wr == 0) PG8_BAR; }
    PG8_BAR;
    if constexpr (Epi::AFTER_DRAIN) { E.fused(acc, cur, wr, wc, fr, fq, lds, wid, lane); S.done(cur); }
#undef PG8_SA
#undef PG8_SB
#undef PG8_STAGE
#undef PG8_STAGEB
#undef PG8_LDA
#undef PG8_LDB
#undef PG8_MMA
#undef PG8_WAIT_V
#undef PG8_WAIT_L
#undef PG8_BAR
#undef PG8_SCHED
}
}
#include <hip/hip_bf16.h>
#include <cmath>
#ifndef ATT_NEGM
#define ATT_NEGM 1
#endif
namespace attn_body {
using bf16=__hip_bfloat16;
using bf16x8=__attribute__((ext_vector_type(8)))short;
using s16x4=__attribute__((ext_vector_type(4)))short;
using f32x16=__attribute__((ext_vector_type(16)))float;
using u32x4=__attribute__((ext_vector_type(4)))unsigned;
constexpr int D=64, QP=512, KP=128, VP=12288, OP=2304;
constexpr int NW=8,QBLK=32,QB=QBLK*NW,KVBLK=64;
constexpr int ATTN_UNIT_ROWS=QB;
__device__ __forceinline__ int crow(int r,int hi){return (r&3)+8*(r>>2)+4*hi;}
#define SBAR() __builtin_amdgcn_sched_barrier(0)
__device__ __forceinline__ void swamask(f32x16&p0,f32x16&p1,int dbase){
  const float NEG=-INFINITY;
  #pragma unroll
  for(int r=0;r<16;++r){const int d=dbase+(r&3)+8*(r>>2); if(d>128||d<-128)p0[r]=NEG; if(d+32>128||d+32<-128)p1[r]=NEG;}
}

constexpr int NSLOT=3, SLOTB=8192;
constexpr int LDS_K=0, LDS_V=NSLOT*SLOTB, LDS_WS=2*NSLOT*SLOTB, LDS_OST=LDS_WS+NW*64*4, LDS_BYTES=LDS_OST+NW*4096;
constexpr float C2=0.125f*1.4426950408889634f;
__device__ __forceinline__ void glds16(const void*gsrc,unsigned lds_dst){unsigned keep;
  asm volatile("s_mov_b32 %0, m0\n\ts_mov_b32 m0, %2\n\ts_nop 0\n\tglobal_load_lds_dwordx4 %1, off\n\ts_mov_b32 m0, %0":"=&s"(keep):"v"(gsrc),"s"(lds_dst):"memory");}
__device__ __forceinline__ float max3f(float a,float b,float c){float r;asm("v_max3_f32 %0, %1, %2, %3":"=v"(r):"v"(a),"v"(b),"v"(c));return r;}
__device__ __forceinline__ float max2f(float a,float b){float r;asm("v_max_f32_e32 %0, %1, %2":"=v"(r):"v"(a),"v"(b));return r;}
__device__ __forceinline__ float fadd_s(float a,float b){float r;asm("v_add_f32_e32 %0, %1, %2":"=v"(r):"v"(a),"v"(b));return r;}
__device__ __forceinline__ float fsub_s(float a,float b){float r;asm("v_sub_f32_e32 %0, %1, %2":"=v"(r):"v"(a),"v"(b));return r;}
typedef float f32x2_t __attribute__((ext_vector_type(2))); typedef __bf16 bf16x2_t __attribute__((ext_vector_type(2)));
__device__ __forceinline__ unsigned cvtpk_s(float lo,float hi){f32x2_t v={lo,hi};bf16x2_t b=__builtin_convertvector(v,bf16x2_t);return __builtin_bit_cast(unsigned,b);}
#define WAIT_BAR(N) asm volatile("s_waitcnt vmcnt(" #N ") lgkmcnt(0)\n\ts_barrier":::"memory")

__device__ __forceinline__ void qkt(f32x16&p0,f32x16&p1,const char*Kslot,const bf16x8*qr,const f32x16&negm,int r32,int hi){
  const char*kb=Kslot+hi*1024+r32*16;
  #pragma unroll
  for(int d0=0;d0<4;++d0){
    const bf16x8 b0=*reinterpret_cast<const bf16x8*>(kb+d0*2048);
    const bf16x8 b1=*reinterpret_cast<const bf16x8*>(kb+d0*2048+512);
    if(d0==0){p0=__builtin_amdgcn_mfma_f32_32x32x16_bf16(b0,qr[0],negm,0,0,0);p1=__builtin_amdgcn_mfma_f32_32x32x16_bf16(b1,qr[0],negm,0,0,0);}
    else{p0=__builtin_amdgcn_mfma_f32_32x32x16_bf16(b0,qr[d0],p0,0,0,0);p1=__builtin_amdgcn_mfma_f32_32x32x16_bf16(b1,qr[d0],p1,0,0,0);}}
}
typedef __attribute__((address_space(3))) const char* lds_cptr;
typedef short v4i16_t __attribute__((ext_vector_type(4)));
__device__ __forceinline__ void kload8(bf16x8*kf,lds_cptr kp){
  kf[0]=*(const __attribute__((address_space(3))) bf16x8*)(kp);      kf[1]=*(const __attribute__((address_space(3))) bf16x8*)(kp+512);
  kf[2]=*(const __attribute__((address_space(3))) bf16x8*)(kp+2048); kf[3]=*(const __attribute__((address_space(3))) bf16x8*)(kp+2560);
  kf[4]=*(const __attribute__((address_space(3))) bf16x8*)(kp+4096); kf[5]=*(const __attribute__((address_space(3))) bf16x8*)(kp+4608);
  kf[6]=*(const __attribute__((address_space(3))) bf16x8*)(kp+6144); kf[7]=*(const __attribute__((address_space(3))) bf16x8*)(kp+6656);
}
__device__ __forceinline__ void kload2(bf16x8*kf,lds_cptr kp,int j){ kf[2*j]=*(const __attribute__((address_space(3))) bf16x8*)(kp+j*2048); kf[2*j+1]=*(const __attribute__((address_space(3))) bf16x8*)(kp+j*2048+512); }
__device__ __forceinline__ s16x4 vtr(lds_cptr p){ return __builtin_bit_cast(s16x4,__builtin_amdgcn_ds_read_tr16_b64_v4i16((__attribute__((address_space(3))) v4i16_t*)p)); }
__device__ __forceinline__ float rowmax(const f32x16&p0,const f32x16&p1){
  float a=max3f(p0[0],p0[1],p1[0]),b=max3f(p0[2],p0[3],p1[1]);a=max3f(a,p1[2],p1[3]);
  #pragma unroll
  for(int r=4;r<16;r+=4){a=max3f(a,p0[r],p0[r+1]);b=max3f(b,p0[r+2],p0[r+3]);a=max3f(a,p1[r],p1[r+1]);b=max3f(b,p1[r+2],p1[r+3]);}
  const float m=max2f(a,b);
  auto rr=__builtin_amdgcn_permlane32_swap(__float_as_uint(m),__float_as_uint(m),false,false);
  return max2f(__uint_as_float(rr[0]),__uint_as_float(rr[1]));
}
__device__ __forceinline__ void pv(f32x16*o,int vb,bf16x8 pa0,bf16x8 pa1,bf16x8 pa2,bf16x8 pa3){
  #pragma unroll
  for(int d0=0;d0<2;++d0){s16x4 lo[4],hi[4];
    #pragma unroll
    for(int ks=0;ks<4;++ks){
      asm volatile("ds_read_b64_tr_b16 %0,%1 offset:%c2":"=&v"(lo[ks]):"v"(vb),"i"(d0*4096+ks*1024):"memory");
      asm volatile("ds_read_b64_tr_b16 %0,%1 offset:%c2":"=&v"(hi[ks]):"v"(vb),"i"(d0*4096+ks*1024+512):"memory");}
    asm volatile("s_waitcnt lgkmcnt(0)":::"memory");SBAR();
    #define PK(k) (bf16x8){lo[k][0],lo[k][1],lo[k][2],lo[k][3],hi[k][0],hi[k][1],hi[k][2],hi[k][3]}
    o[d0]=__builtin_amdgcn_mfma_f32_32x32x16_bf16(pa0,PK(0),o[d0],0,0,0);
    o[d0]=__builtin_amdgcn_mfma_f32_32x32x16_bf16(pa1,PK(1),o[d0],0,0,0);
    o[d0]=__builtin_amdgcn_mfma_f32_32x32x16_bf16(pa2,PK(2),o[d0],0,0,0);
    o[d0]=__builtin_amdgcn_mfma_f32_32x32x16_bf16(pa3,PK(3),o[d0],0,0,0);
    #undef PK
  }
}

#ifndef ATTN_STORE16
#define ATTN_STORE16(p,v) (*(u32x4*)(p)=(v))
#endif
template<int THRL,int MODE> __device__ __forceinline__ void attn_unit(const bf16*Qu,const bf16*__restrict__ Kh,const bf16*__restrict__ Vh,bf16*Ou,int NT,int n0,int s0,int s1,int qrow0,float sink2,bool has_sink,char*shm){
  int tid_=threadIdx.x; asm volatile("":"+v"(tid_)); const int tid=tid_,lane=tid&63,r32=lane&31,hi=lane>>5; const int wid=__builtin_amdgcn_readfirstlane(tid>>6);
  const bf16*Qw=Qu+(long)(wid*QBLK)*QP;
  const unsigned lds0=(unsigned)(uintptr_t)shm;
  float*wsf=(float*)(shm+LDS_WS)+wid*64;
  const bf16*ksrc=Kh+(long)lane*KP+wid*8;
  const bf16*vsrc=Vh+(long)(16*(wid&3)+(lane>>2))*VP+(wid>>2)*32+(lane&3)*8;
  #define TROW(t) (MODE==0 ? KVBLK*(t) : ((t)<n0 ? s0+KVBLK*(t) : s1+KVBLK*((t)-n0)))
  const unsigned kdst=lds0+LDS_K+wid*1024, vdst=lds0+LDS_V+wid*1024;
  #define DMA_K(t,slot) glds16(ksrc+(long)TROW(t)*KP,(unsigned)__builtin_amdgcn_readfirstlane(kdst+(slot)))
  #define DMA_V(t,slot) glds16(vsrc+(long)TROW(t)*VP,(unsigned)__builtin_amdgcn_readfirstlane(vdst+(slot)))
  const int vb0=(int)(lds0+LDS_V)+((lane>>4)&1)*32+(lane&3)*8+(4*hi+((lane&15)>>2))*64;
  const char*Kbase=shm+LDS_K; bf16x8 kf[8];
  const lds_cptr shm3=(lds_cptr)shm; const lds_cptr kp0=shm3+LDS_K+hi*1024+r32*16; const lds_cptr vp0=shm3+LDS_V+((lane>>4)&1)*32+(lane&3)*8+(4*hi+((lane&15)>>2))*64;
  DMA_K(0,0);DMA_V(0,0);DMA_K(1,SLOTB);
  bf16x8 qr[4];
  #pragma unroll
  for(int d0=0;d0<4;++d0)qr[d0]=*reinterpret_cast<const bf16x8*>(&Qw[(long)r32*QP+d0*16+hi*8]);
  float mhat=0.f,l_reg=0.f;f32x16 o[2];o[0]=f32x16{};o[1]=f32x16{};f32x16 negm=f32x16{}; if(ATT_NEGM&&MODE==0)asm volatile("":"+v"(negm));
  const int qrow=qrow0+wid*QBLK+r32;
  #define CMASK(P0,P1,t) do{ if(MODE==1 && (t)>=n0) swamask(P0,P1,TROW(t)+4*hi-qrow); }while(0)
  bool resc=false;
  #define START(P0,P1) do{ const float rm=rowmax(P0,P1); resc=false; \
    { const float dl=rm; mhat=fadd_s(mhat,dl); \
      _Pragma("unroll") for(int r=0;r<16;++r){P0[r]=fsub_s(P0[r],dl);P1[r]=fsub_s(P1[r],dl);} \
      if(ATT_NEGM&&MODE==0){ _Pragma("unroll") for(int r=0;r<16;++r)negm[r]=-mhat; asm volatile("":"+v"(negm)); } } \
    _Pragma("unroll") for(int r=0;r<16;++r)P0[r]=__builtin_amdgcn_exp2f(P0[r]); }while(0)
  #define RESC() do{ if(resc){ asm volatile("s_waitcnt lgkmcnt(0)":::"memory"); \
      _Pragma("unroll") for(int d_=0;d_<2;++d_) _Pragma("unroll") for(int r=0;r<16;++r)o[d_][r]*=wsf[crow(r,hi)]; } }while(0)
  f32x16 pA0,pA1,pB0,pB1;
  int sl_prev=0,sl_cur=0,sl_next=SLOTB;
  #define ROT() do{sl_prev=sl_cur;sl_cur=sl_next;sl_next=(sl_next==(NSLOT-1)*SLOTB)?0:sl_next+SLOTB;}while(0)
  DMA_K(2,2*SLOTB);
  WAIT_BAR(3);
  qkt(pA0,pA1,Kbase,qr,negm,r32,hi);asm volatile("s_nop 15\n\ts_nop 7":"+v"(pA0),"+v"(pA1));CMASK(pA0,pA1,0);
  START(pA0,pA1);
  _Pragma("unroll") for(int r=0;r<16;++r)pA1[r]=__builtin_amdgcn_exp2f(pA1[r]);
  WAIT_BAR(0);
  DMA_K(3,0);DMA_V(1,SLOTB);
  ROT();
  kload8(kf,kp0+sl_cur);
  WAIT_BAR(2);
  s16x4 vlo[8],vhi[8]; u32x4 pw0,pw1,pw2,pw3;
  #define PKW(P,B) cvtpk_s(P[B],P[B+1])
  #define PAF(k) __builtin_bit_cast(bf16x8,pw##k)
  #define VFR(i) (bf16x8){vlo[i][0],vlo[i][1],vlo[i][2],vlo[i][3],vhi[i][0],vhi[i][1],vhi[i][2],vhi[i][3]}
  #define PIN(x) asm volatile("":"+v"(x))
  #define MX3(a,b,c) __builtin_fmaxf(__builtin_fmaxf((a),(b)),(c))
  #define GAPA(MF,A0,A1,A2,A3,W0,W1,PW) do{ MF; sacc+=A0; sacc+=A1; sacc+=A2; sacc+=A3; PIN(sacc); W0; W1; PIN(PW); SBAR(); }while(0)
  #define EX(v) __builtin_amdgcn_exp2f(v)
  #define GAPB(MF,X,B) do{ MF; X[B]=EX(X[B]); X[B+1]=EX(X[B+1]); X[B+2]=EX(X[B+2]); X[B+3]=EX(X[B+3]); PIN(X); SBAR(); }while(0)
  #define VRD(i) do{ vlo[i]=vtr(vp_+(((i)>>2)*4096+((i)&3)*1024)); vhi[i]=vtr(vp_+(((i)>>2)*4096+((i)&3)*1024+512)); }while(0)
  #define KRD(G,j) do{ if(G){ kload2(kf,kp0+sl_next,j); SBAR(); } }while(0)
  #define STEP(C0,C1,P0,P1,t,GK,GV,GL) do{ SBAR(); \
    const lds_cptr vp_=vp0+sl_prev; \
    VRD(0); SBAR(); float sacc=(P0[0]+P0[1]); \
    GAPA(C0=__builtin_amdgcn_mfma_f32_32x32x16_bf16(kf[0],qr[0],((ATT_NEGM&&MODE==0)?negm:f32x16{}),0,0,0), P0[2],P0[3],P0[4],P0[5],     pw0[0]=PKW(P0,0), pw0[1]=PKW(P0,2), pw0); \
    VRD(4); SBAR(); GAPA(C1=__builtin_amdgcn_mfma_f32_32x32x16_bf16(kf[1],qr[0],((ATT_NEGM&&MODE==0)?negm:f32x16{}),0,0,0), P0[6],P0[7],P0[8],P0[9],     pw0[2]=PKW(P0,4), pw0[3]=PKW(P0,6), pw0); \
    VRD(1); SBAR(); GAPA(C0=__builtin_amdgcn_mfma_f32_32x32x16_bf16(kf[2],qr[1],C0,0,0,0),   P0[10],P0[11],P0[12],P0[13], pw1[0]=PKW(P0,8), pw1[1]=PKW(P0,10), pw1); \
    VRD(5); SBAR(); GAPA(C1=__builtin_amdgcn_mfma_f32_32x32x16_bf16(kf[3],qr[1],C1,0,0,0),   P0[14],P0[15],P1[0],P1[1],   pw1[2]=PKW(P0,12),pw1[3]=PKW(P0,14), pw1); \
    VRD(2); SBAR(); GAPA(C0=__builtin_amdgcn_mfma_f32_32x32x16_bf16(kf[4],qr[2],C0,0,0,0),   P1[2],P1[3],P1[4],P1[5],     pw2[0]=PKW(P1,0), pw2[1]=PKW(P1,2), pw2); \
    VRD(6); SBAR(); GAPA(C1=__builtin_amdgcn_mfma_f32_32x32x16_bf16(kf[5],qr[2],C1,0,0,0),   P1[6],P1[7],P1[8],P1[9],     pw2[2]=PKW(P1,4), pw2[3]=PKW(P1,6), pw2); \
    VRD(3); SBAR(); GAPA(C0=__builtin_amdgcn_mfma_f32_32x32x16_bf16(kf[6],qr[3],C0,0,0,0),   P1[10],P1[11],P1[12],P1[13], pw3[0]=PKW(P1,8), pw3[1]=PKW(P1,10), pw3); \
    VRD(7); SBAR(); GAPA(C1=__builtin_amdgcn_mfma_f32_32x32x16_bf16(kf[7],qr[3],C1,0,0,0),   P1[14],P1[15],0.f,0.f,       pw3[2]=PKW(P1,12),pw3[3]=PKW(P1,14), pw3); \
    l_reg+=sacc; \
    if(GK){DMA_K((t)+3,sl_cur);} if(GV){DMA_V((t)+1,sl_next);} \
    if(!(ATT_NEGM&&MODE==0)){ _Pragma("unroll") for(int r=0;r<16;++r){C0[r]-=mhat;C1[r]-=mhat;} } \
    CMASK(C0,C1,t); \
    { float a=MX3(C0[0],C0[1],C1[0]),b=MX3(C0[2],C0[3],C1[1]); a=MX3(a,C1[2],C1[3]); \
      _Pragma("unroll") for(int r=4;r<16;r+=4){a=MX3(a,C0[r],C0[r+1]);b=MX3(b,C0[r+2],C0[r+3]);a=MX3(a,C1[r],C1[r+1]);b=MX3(b,C1[r+2],C1[r+3]);} \
      float rm=__builtin_fmaxf(a,b); { auto rr=__builtin_amdgcn_permlane32_swap(__float_as_uint(rm),__float_as_uint(rm),false,false); rm=__builtin_fmaxf(__uint_as_float(rr[0]),__uint_as_float(rr[1])); } \
      resc=false; \
      if(__builtin_expect(__any(rm>(float)THRL),0)){ const float dl=__builtin_fmaxf(rm,0.f); mhat+=dl; \
        _Pragma("unroll") for(int r=0;r<16;++r){C0[r]-=dl;C1[r]-=dl;} \
        if(ATT_NEGM&&MODE==0){ _Pragma("unroll") for(int r=0;r<16;++r)negm[r]=-mhat; asm volatile("":"+v"(negm)); } \
        const float f=__builtin_amdgcn_exp2f(-dl); l_reg*=f; if(hi==0)wsf[r32]=f; resc=true; } } \
    SBAR(); \
    GAPB(o[0]=__builtin_amdgcn_mfma_f32_32x32x16_bf16(PAF(0),VFR(0),o[0],0,0,0), C0,0); \
    GAPB(o[1]=__builtin_amdgcn_mfma_f32_32x32x16_bf16(PAF(0),VFR(4),o[1],0,0,0), C0,4); \
    KRD(GL,0); GAPB(o[0]=__builtin_amdgcn_mfma_f32_32x32x16_bf16(PAF(1),VFR(1),o[0],0,0,0), C0,8); \
    KRD(GL,1); GAPB(o[1]=__builtin_amdgcn_mfma_f32_32x32x16_bf16(PAF(1),VFR(5),o[1],0,0,0), C0,12); \
    KRD(GL,2); GAPB(o[0]=__builtin_amdgcn_mfma_f32_32x32x16_bf16(PAF(2),VFR(2),o[0],0,0,0), C1,0); \
    KRD(GL,3); GAPB(o[1]=__builtin_amdgcn_mfma_f32_32x32x16_bf16(PAF(2),VFR(6),o[1],0,0,0), C1,4); \
    GAPB(o[0]=__builtin_amdgcn_mfma_f32_32x32x16_bf16(PAF(3),VFR(3),o[0],0,0,0), C1,8); \
    GAPB(o[1]=__builtin_amdgcn_mfma_f32_32x32x16_bf16(PAF(3),VFR(7),o[1],0,0,0), C1,12); \
    }while(0)
  int t=1;
  for(;t+5<NT;t+=2){
    STEP(pB0,pB1,pA0,pA1,t,true,true,true);     WAIT_BAR(2); RESC(); ROT();
    STEP(pA0,pA1,pB0,pB1,t+1,true,true,true);   WAIT_BAR(2); RESC(); ROT();
  }
  #define ENDW(tt) do{ if((tt)+3<NT){WAIT_BAR(2);} else if((tt)+2<NT){WAIT_BAR(1);} else {WAIT_BAR(0);} }while(0)
  for(;t+1<NT;t+=2){
    STEP(pB0,pB1,pA0,pA1,t,(t+3<NT),(t+1<NT),(t+1<NT));       ENDW(t);   RESC(); ROT();
    STEP(pA0,pA1,pB0,pB1,t+1,(t+4<NT),(t+2<NT),(t+2<NT));     ENDW(t+1); RESC(); ROT();
  }
  STEP(pB0,pB1,pA0,pA1,NT-1,false,false,false); RESC();
  { float sacc=pB0[0]+pB0[1]; _Pragma("unroll") for(int r=2;r<16;++r)sacc+=pB0[r]; _Pragma("unroll") for(int r=0;r<16;++r)sacc+=pB1[r]; l_reg+=sacc;
    pw0=(u32x4){PKW(pB0,0),PKW(pB0,2),PKW(pB0,4),PKW(pB0,6)};pw1=(u32x4){PKW(pB0,8),PKW(pB0,10),PKW(pB0,12),PKW(pB0,14)};pw2=(u32x4){PKW(pB1,0),PKW(pB1,2),PKW(pB1,4),PKW(pB1,6)};pw3=(u32x4){PKW(pB1,8),PKW(pB1,10),PKW(pB1,12),PKW(pB1,14)};
    SBAR(); pv(o,vb0+sl_cur,PAF(0),PAF(1),PAF(2),PAF(3)); }
  #undef PKW
  #undef PAF
  #undef VFR
  #undef PIN
  #undef MX3
  #undef GAPA
  #undef GAPB
  #undef EX
  #undef VRD
  #undef KRD
  #undef STEP
  #undef ENDW
  {auto rr=__builtin_amdgcn_permlane32_swap(__float_as_uint(l_reg),__float_as_uint(l_reg),false,false);l_reg=__uint_as_float(rr[0])+__uint_as_float(rr[1]);}
  if(has_sink)l_reg+=__builtin_amdgcn_exp2f(sink2-mhat);
  if(hi==0)wsf[32+r32]=l_reg;asm volatile("s_waitcnt lgkmcnt(0)":::"memory");
  float rli[16];
  #pragma unroll
  for(int r=0;r<16;++r)rli[r]=__builtin_amdgcn_rcpf(wsf[32+crow(r,hi)]);
  bf16*Ow=Ou+(long)(wid*QBLK)*OP;
  { bf16*stg=(bf16*)(shm+LDS_OST)+wid*2048;
    #pragma unroll
    for(int r=0;r<16;++r){const int orow=crow(r,hi);
      #pragma unroll
      for(int d0=0;d0<2;++d0)stg[orow*64+d0*32+r32]=__float2bfloat16(o[d0][r]*rli[r]);}
    asm volatile("s_waitcnt lgkmcnt(0)":::"memory");
    #pragma unroll
    for(int i=0;i<4;++i){const int row=i*8+(lane>>3),ch=lane&7; const u32x4 v=*(const u32x4*)(stg+row*64+ch*8); ATTN_STORE16(Ow+(long)row*OP+ch*8,v);} }
  asm volatile("s_waitcnt lgkmcnt(0)\n\ts_barrier":::"memory");
  #undef TROW
  #undef DMA_K
  #undef DMA_V
  #undef CMASK
  #undef START
  #undef RESC
  #undef ROT
}
constexpr int ATTN_LDS_BYTES=LDS_BYTES;
#undef SBAR
#undef WAIT_BAR
}
constexpr int DM = 2048, SEQ = 16384, CTXN = 256, MR = SEQ + CTXN, DEPTH = 4;
constexpr int DFF = 5632, NFF = 2 * DFF, DIN = 12312, NP = 12288;
constexpr int PC_Z = 0, PC_XBC = 768, PC_U = 2048, PC_SQ = 2560, PC_SK = 3072, PC_SV = 3200, PC_GQ = 3328, PC_GK = 3840, PC_GV = 3968, PC_GATE = 4096;
constexpr int NMODV = 9 * DM;
constexpr float LOG2E = 1.4426950408889634f;
constexpr float QSCALE = 0.125f * LOG2E;
constexpr int NWAVES = 8;
enum { I_X = 0, I_C, I_CTX, I_CCTX, I_WMOD, I_BMOD, I_NORMG, I_FFIN, I_FFOUT, I_WIN, I_CONVW, I_CONVB, I_ALOG, I_DTB, I_SSDD, I_SSDNG, I_S5ARE, I_S5AIM, I_S5LDT, I_S5BRE, I_S5BIM,
       I_S5CRE, I_S5CIM, I_S5D, I_GLUW, I_GLUB, I_SWAG, I_SINK, I_GLBG, I_BRSSD, I_BRS5, I_BRSWA, I_BRGLB, I_WOUT, N_IN };

constexpr size_t al256(size_t x) { return (x + 255) & ~(size_t)255; }
constexpr size_t WS_CTL = 0, CTL_ZERO_BYTES = 64u << 10;
constexpr size_t WS_MODP = CTL_ZERO_BYTES;
constexpr size_t WS_MOD = WS_MODP + al256((size_t)DEPTH * 32 * 2 * NMODV * 4);
constexpr size_t WS_X = WS_MOD + al256((size_t)DEPTH * 2 * NMODV * 4);
constexpr size_t WS_H = WS_X + al256((size_t)MR * DM * 4);
constexpr size_t WS_HID = WS_H + al256((size_t)MR * DM * 2);
constexpr size_t WS_P = WS_HID + al256((size_t)MR * DFF * 2);
constexpr size_t WS_DTRAW = WS_P + al256((size_t)MR * NP * 2);
constexpr size_t WS_DT = WS_DTRAW + al256((size_t)MR * 32 * 4);
constexpr size_t WS_XBC = WS_DT + al256((size_t)MR * 24 * 4);
constexpr size_t WS_QS = WS_XBC + al256((size_t)MR * 1280 * 4);
constexpr size_t WS_QG = WS_QS + al256((size_t)MR * 512 * 2);
constexpr size_t WS_KS = WS_QG + al256((size_t)MR * 512 * 2);
constexpr size_t WS_KG = WS_KS + al256((size_t)MR * 128 * 2);
constexpr size_t WS_YS = WS_KG + al256((size_t)MR * 128 * 2);
constexpr size_t WS_YBF = WS_YS + al256((size_t)2 * MR * 768 * 4);
constexpr size_t WS_S5END = WS_YBF + al256((size_t)2 * MR * 512 * 4);
constexpr size_t WS_S5IN = WS_S5END + al256((size_t)64 * 260 * 128 * 4);
constexpr size_t WS_XSN = WS_S5IN + al256((size_t)64 * 260 * 128 * 4);
constexpr size_t WS_XT = WS_XSN + al256((size_t)MR * 768 * 2);
constexpr size_t WS_BN = WS_XT + al256((size_t)MR * 768 * 2);
constexpr size_t WS_CN = WS_BN + al256((size_t)MR * 256 * 2);
constexpr size_t WS_BT = WS_CN + al256((size_t)MR * 256 * 2);
constexpr size_t WS_STATES = WS_BT + al256((size_t)MR * 256 * 2);
constexpr size_t WS_SINB = WS_STATES + al256((size_t)260 * 24 * 8192 * 4);
constexpr size_t WS_CHD = WS_SINB + al256((size_t)260 * 24 * 8192 * 2);
constexpr size_t WS_YALL = WS_CHD + al256((size_t)260 * 24 * 4);
constexpr int YPITCH = 2304, YC_B = 768, YC_C = 1280, YC_D = 1792;
constexpr size_t WS_YBP = WS_YALL + al256((size_t)MR * YPITCH * 2);
constexpr size_t WS_MGF = WS_YBP + al256((size_t)MR * 512 * 2);
constexpr size_t WS_MG = WS_MGF + al256((size_t)MR * DM * 4);
constexpr size_t WS_W = WS_MG + al256((size_t)MR * DM * 2);
constexpr size_t WL_FFI = 0;
constexpr size_t WL_FFO = WL_FFI + (size_t)2 * NFF * DM;
constexpr size_t WL_WIN = WL_FFO + (size_t)2 * DM * DFF;
constexpr size_t WL_WDT = WL_WIN + (size_t)NP * DM;
constexpr size_t WL_GLU = WL_WDT + (size_t)32 * DM;
constexpr size_t WL_BRALL = WL_GLU + (size_t)1024 * 512;
constexpr size_t WL_OUT = WL_BRALL + (size_t)DM * YPITCH;
constexpr size_t WL_SIZE = WL_OUT + (size_t)DM * DM;
constexpr size_t WS_PART = WS_W + al256((size_t)DEPTH * WL_SIZE * 2);
constexpr size_t WS_END = WS_PART + al256((size_t)11 * 256 * DM * 4);
constexpr int CW_BAR = 4096;

constexpr int RING_OFF = 0, RING_BYTES = 131072;
constexpr int LDSCTL_OFF = RING_BYTES, MISC_OFF = LDSCTL_OFF + 320;
constexpr int LDS_BYTES = 147456;

#define GAS __attribute__((address_space(1)))
#define LAS __attribute__((address_space(3)))
typedef unsigned short bf16;
typedef unsigned v4u __attribute__((ext_vector_type(4)));
typedef unsigned v2u __attribute__((ext_vector_type(2)));
typedef float f32x4 __attribute__((ext_vector_type(4)));
typedef short bf16x8 __attribute__((ext_vector_type(8)));
typedef GAS unsigned gu32;
#define RLX_AGENT __ATOMIC_RELAXED, __HIP_MEMORY_SCOPE_AGENT
#define LDS_WAIT() asm volatile("s_waitcnt lgkmcnt(0)" ::: "memory")
#define VM_WAIT() asm volatile("s_waitcnt vmcnt(0)" ::: "memory")
__device__ __forceinline__ unsigned f2bf(float f) { unsigned u = __builtin_bit_cast(unsigned, f); return (u + 0x7fffu + ((u >> 16) & 1u)) >> 16; }
__device__ __forceinline__ unsigned pk2(float lo, float hi) { return f2bf(lo) | (f2bf(hi) << 16); }
__device__ __forceinline__ float bflo(unsigned w) { return __uint_as_float(w << 16); }
__device__ __forceinline__ float bfhi(unsigned w) { return __uint_as_float(w & 0xffff0000u); }
__device__ __forceinline__ float bf1(bf16 h) { return __uint_as_float(((unsigned)h) << 16); }
__device__ __forceinline__ float sigm_(float x) { return __builtin_amdgcn_rcpf(1.0f + __builtin_amdgcn_exp2f(-LOG2E * x)); }
__device__ __forceinline__ float silu_(float x) { return x * sigm_(x); }
#define XB_TMO      128
#define XB_XCNT(j)  (256  + 64 * (j))
#define XB_XSUB(j)  (1280 + 64 * (j))
#define XB_XGEN(j)  (2304 + 64 * (j))
#define XB_TOP      3328
#define XB_TOPGEN   3392
#define XCD_BAR_WORDS 3456
#define XB_SPIN_CAP (1u << 18)

__device__ __forceinline__ unsigned xb_ld(unsigned* p)              { return __hip_atomic_load(p, __ATOMIC_RELAXED, __HIP_MEMORY_SCOPE_AGENT); }
__device__ __forceinline__ unsigned xb_add(unsigned* p, unsigned v) { return __hip_atomic_fetch_add(p, v, __ATOMIC_RELAXED, __HIP_MEMORY_SCOPE_AGENT); }
__device__ __forceinline__ unsigned xb_xcc_id() { return (unsigned)__builtin_amdgcn_s_getreg((3 << 11) | 20) & 0xFu; }
#define XB_SPIN(cond, bar) do { unsigned _sp = 0; while (cond) { __builtin_amdgcn_s_sleep(1); \
    if ((++_sp & 255u) == 0u) { if (xb_ld(&(bar)[XB_TMO])) break; if (_sp > XB_SPIN_CAP) { atomicAdd(&(bar)[XB_TMO], 1u); break; } } } } while (0)

struct XcdBarrier {
    unsigned* bar; unsigned x;
    volatile LAS unsigned* st;
};

__device__ __forceinline__ XcdBarrier xcd_barrier_post(unsigned* bar, volatile LAS unsigned* st) {
    XcdBarrier b; b.bar = bar; b.x = xb_xcc_id(); b.st = st;
    if (threadIdx.x == 0) (void)xb_add(&bar[XB_XCNT(b.x)], 1u);
    return b;
}
__device__ __forceinline__ void xcd_barrier_complete(unsigned* bar, unsigned x, unsigned& nloc, unsigned& nx) {
    const unsigned G = gridDim.x * gridDim.y * gridDim.z;
    unsigned sum, cnt, mine, sp = 0u;
    for (;;) {
        sum = 0u; cnt = 0u; mine = 0u;
#pragma unroll
        for (unsigned j = 0; j < 16; ++j) { const unsigned c = xb_ld(&bar[XB_XCNT(j)]); sum += c; cnt += (c > 0u) ? 1u : 0u; }
        mine = xb_ld(&bar[XB_XCNT(x)]);
        if (sum == G) break;
        __builtin_amdgcn_s_sleep(1);
        if ((++sp & 255u) == 0u) { if (xb_ld(&bar[XB_TMO])) break; if (sp > XB_SPIN_CAP) { atomicAdd(&bar[XB_TMO], 1u); break; } }
    }
    nloc = mine > 0u ? mine : 1u; nx = cnt > 0u ? cnt : 1u;
}

__device__ __forceinline__ void xcd_barrier(const XcdBarrier& b) {
    asm volatile("s_waitcnt vmcnt(0)" ::: "memory");
    __syncthreads();
    if (threadIdx.x == 0) {
        unsigned* bar = b.bar;
        __builtin_amdgcn_s_waitcnt(0);
        unsigned nloc = b.st[0], nx = b.st[1];
        if (nloc == 0u) { xcd_barrier_complete(bar, b.x, nloc, nx); b.st[0] = nloc; b.st[1] = nx; }
        const unsigned old = xb_add(&bar[XB_XSUB(b.x)], 1u);
        const unsigned gen = old / nloc;
        if (old + 1u == (gen + 1u) * nloc) {
            __builtin_amdgcn_fence(__ATOMIC_RELEASE, "agent");
            asm volatile("s_waitcnt vmcnt(0)" ::: "memory");
            const unsigned og = xb_add(&bar[XB_TOP], 1u);
            const unsigned tg = og / nx;
            if (og + 1u == (tg + 1u) * nx) xb_add(&bar[XB_TOPGEN], 1u);
            else XB_SPIN(xb_ld(&bar[XB_TOPGEN]) == tg, bar);
            __builtin_amdgcn_fence(__ATOMIC_ACQUIRE, "agent");
            xb_add(&bar[XB_XGEN(b.x)], 1u);
            asm volatile("s_waitcnt vmcnt(0)" ::: "memory");
        } else {
            XB_SPIN(xb_ld(&bar[XB_XGEN(b.x)]) == gen, bar);
            __builtin_amdgcn_fence(__ATOMIC_ACQUIRE, "agent");
            asm volatile("s_waitcnt vmcnt(0)" ::: "memory");
        }
    }
    __syncthreads();
}
struct Args { const float* in[N_IN]; float* out; unsigned char* ws; int ph_lo, ph_hi; };
typedef const volatile __attribute__((address_space(4))) Args* KArgs;
#define AIN(i) ((const float*)(const __attribute__((address_space(1))) float*)a->in[i])
struct Frame {
    LAS unsigned char* lds;
    volatile LAS unsigned* MISC;
    gu32* ctl;
    int tid, lane, wave;
    int vcu, G;
    unsigned char* ws;
};
__device__ __forceinline__ Frame fresh(const Frame& F) { Frame Fp = F; unsigned long long w = (unsigned long long)F.ws; asm volatile("" : "+v"(Fp.tid), "+s"(Fp.vcu), "+s"(w)); Fp.ws = (unsigned char*)(GAS unsigned char*)w; Fp.lane = Fp.tid & 63; Fp.wave = __builtin_amdgcn_readfirstlane(Fp.tid >> 6); return Fp; }
__device__ __forceinline__ float bperm(float v, int srclane) { return __int_as_float(__builtin_amdgcn_ds_bpermute(srclane << 2, __float_as_int(v))); }
__device__ __forceinline__ float wave_sum(float v, int lane) {
#pragma unroll
    for (int o = 1; o < 64; o <<= 1) v += bperm(v, lane ^ o);
    return v;
}
__device__ __forceinline__ int rowof(int dir, int s) { return dir ? (MR - 1 - s) : (s < CTXN ? SEQ + s : s - CTXN); }
__device__ __forceinline__ void sincos_hw(float ang, float& s, float& c) { float r = ang * 0.15915494309189535f; r = r - floorf(r); s = __builtin_amdgcn_sinf(r); c = __builtin_amdgcn_cosf(r); }

__device__ __forceinline__ void transpose_item(const float* W, int ldw, int Nsrc, int src_c0, bf16* WT, int dst_r0, int k0, int nvalid, LAS float* scr, int lane, int my_col = -1) {
#pragma unroll 8
    for (int i = 0; i < 32; ++i) { const int kk = 2 * i + (lane >> 5); scr[kk * 33 + (lane & 31)] = __builtin_nontemporal_load(W + (size_t)(k0 + kk) * Nsrc + (my_col >= 0 ? my_col : src_c0 + (lane & 31))); }
    LDS_WAIT(); asm volatile("" ::: "memory");
    const int c = lane & 7;
#pragma unroll
    for (int j = 0; j < 4; ++j) { const int n = (lane >> 3) + 8 * j; const LAS float* s = scr + (8 * c) * 33 + n;
        v4u o; o.x = pk2(s[0 * 33], s[1 * 33]); o.y = pk2(s[2 * 33], s[3 * 33]); o.z = pk2(s[4 * 33], s[5 * 33]); o.w = pk2(s[6 * 33], s[7 * 33]);
        if (n >= nvalid) o = (v4u){0u, 0u, 0u, 0u};
        __builtin_nontemporal_store(o, (GAS v4u*)(WT + (size_t)(dst_r0 + n) * ldw + k0 + 8 * c)); }
    LDS_WAIT(); asm volatile("" ::: "memory");
}
constexpr int IT_FFI = 32 * 352, IT_FFO = 88 * 64, IT_WIN = 32 * 384, IT_GLU = 8 * 32, IT_BRA = 12 * 64, IT_BRX = 8 * 64, IT_OUT = 32 * 64, IT_WDT = 32;
constexpr int IT_LAYER = 2 * IT_FFI + 2 * IT_FFO + IT_WIN + IT_GLU + IT_BRA + 3 * IT_BRX + IT_OUT + IT_WDT;
#ifndef HIDE_CONVERT
#define HIDE_CONVERT 0
#endif
constexpr int IT_GA = IT_FFI + IT_FFO, IT_GB = IT_WIN + IT_WDT, IT_GC = IT_GLU + IT_BRA + 3 * IT_BRX + IT_OUT, IT_GD = IT_FFI + IT_FFO;
static_assert(IT_GA + IT_GB + IT_GC + IT_GD == IT_LAYER, "item groups");
__device__ __forceinline__ void convert_item(Frame& F, KArgs a, int l, int r, LAS float* scr) {
    bf16* wl = (bf16*)(F.ws + WS_W) + (size_t)l * WL_SIZE;
    int f = 0; if (r >= IT_GA + IT_GB + IT_GC) { f = 1; r -= IT_GA + IT_GB + IT_GC; }
    if (r < IT_FFI) { const int kb = r / 352, gd = r % 352, pn = gd >> 3, w = gd & 7; const int sc0 = (w < 4) ? 128 * pn + 32 * w : DFF + 128 * pn + 32 * (w - 4);
        transpose_item(AIN(I_FFIN) + (size_t)(l * 2 + f) * DM * NFF, DM, NFF, sc0, wl + WL_FFI + (size_t)f * NFF * DM, 32 * gd, 64 * kb, 32, scr, F.lane); return; } r -= IT_FFI;
    if (r < IT_FFO) { const int kb = r / 64, gd = r % 64;
        transpose_item(AIN(I_FFOUT) + (size_t)(l * 2 + f) * DFF * DM, DFF, DM, 32 * gd, wl + WL_FFO + (size_t)f * DM * DFF, 32 * gd, 64 * kb, 32, scr, F.lane); return; } r -= IT_FFO;
    if (r < IT_WIN) { const int kb = r / 384, gd = r % 384; const int d0 = 32 * gd;
        int mc = -1;
        if (d0 >= PC_GATE) { const int j = (d0 - PC_GATE) >> 8, w = (d0 >> 5) & 7, bj = w >> 2, wc = w & 3, o = F.lane & 31, fq = o >> 3, n = (o >> 2) & 1, i = o & 3;
            mc = (DIN - 4 * DM) + 2048 * (2 * bj + n) + 64 * j + 16 * wc + 4 * fq + i; }
        transpose_item(AIN(I_WIN) + (size_t)l * DM * DIN, DM, DIN, d0 < 2048 ? d0 : d0 + 24, wl + WL_WIN, d0, 64 * kb, 32, scr, F.lane, mc); return; } r -= IT_WIN;
    if (r < IT_WDT) { transpose_item(AIN(I_WIN) + (size_t)l * DM * DIN, DM, DIN, 2048, wl + WL_WDT, 0, 64 * r, 24, scr, F.lane); return; } r -= IT_WDT;
    if (r < IT_GLU) { const int kb = r / 32, gd = r % 32, pn = gd >> 3, w = gd & 7; const int sc0 = (w < 4) ? 128 * pn + 32 * w : 512 + 128 * pn + 32 * (w - 4);
        transpose_item(AIN(I_GLUW) + (size_t)l * 512 * 1024, 512, 1024, sc0, wl + WL_GLU, 32 * gd, 64 * kb, 32, scr, F.lane); return; } r -= IT_GLU;
    if (r < IT_BRA) { const int kb = r / 64, gd = r % 64;
        transpose_item(AIN(I_BRSSD) + (size_t)l * 768 * DM, YPITCH, DM, 32 * gd, wl + WL_BRALL, 32 * gd, 64 * kb, 32, scr, F.lane); return; } r -= IT_BRA;
    if (r < 3 * IT_BRX) { const int b = r / IT_BRX; r %= IT_BRX; const int kb = r / 64, gd = r % 64;
        const float* src = (b == 0 ? AIN(I_BRS5) : (b == 1 ? AIN(I_BRSWA) : AIN(I_BRGLB))) + (size_t)l * 512 * DM;
        transpose_item(src, YPITCH, DM, 32 * gd, wl + WL_BRALL + YC_B + 512 * b, 32 * gd, 64 * kb, 32, scr, F.lane); return; } r -= 3 * IT_BRX;
    { const int kb = r / 64, gd = r % 64; transpose_item(AIN(I_WOUT) + (size_t)l * DM * DM, DM, DM, 32 * gd, wl + WL_OUT, 32 * gd, 64 * kb, 32, scr, F.lane); }
}
__device__ __forceinline__ void convert_range(Frame& F, KArgs a, int l, int first, int n, int widx, int wstride) {
    LAS float* scr = (LAS float*)(F.lds + RING_OFF + F.wave * 16384);
    for (int it = first + widx; it < first + n; it += wstride) convert_item(F, a, l, it, scr);
}
__device__ __forceinline__ void convert_idle(Frame& F, KArgs a, int c, int rem, int l, int first, int n) {
    if (c < rem || l >= DEPTH) return;
    convert_range(F, a, l, first, n, (c - rem) * NWAVES + F.wave, (F.G - rem) * NWAVES);
}
__device__ __forceinline__ void p0_prologue(Frame& F, KArgs a) {
    const int gw = F.vcu * NWAVES + F.wave, NGW = F.G * NWAVES;
#if HIDE_CONVERT
    convert_range(F, a, 0, 0, IT_GA, gw, NGW);
#else
    for (int l = 0; l < DEPTH; ++l) convert_range(F, a, l, 0, IT_LAYER, gw, NGW);
#endif
    float* X = (float*)(F.ws + WS_X);
    for (int m = gw; m < MR; m += NGW) {
        const GAS f32x4* src = (const GAS f32x4*)(m < SEQ ? AIN(I_X) + (size_t)m * DM : AIN(I_CTX) + (size_t)(m - SEQ) * DM) + F.lane; GAS f32x4* dst = (GAS f32x4*)(X + (size_t)m * DM) + F.lane;
#pragma unroll
        for (int j = 0; j < 8; ++j) dst[64 * j] = src[64 * j];
    }
    __syncthreads();
    LAS float* sc = (LAS float*)(F.lds + RING_OFF);
    for (int i = F.tid; i < 2 * DM; i += NWAVES * 64) { const float c = (i < DM) ? AIN(I_C)[i] : AIN(I_CCTX)[i - DM]; sc[i] = silu_(c); }
    __syncthreads();
    float* MODP = (float*)(F.ws + WS_MODP);
    for (int it = F.vcu; it < DEPTH * 32 * 9; it += F.G) {
        const int l = it / 288, r = it % 288, s = r / 9, b = r % 9, col = b * 2048 + 4 * F.tid;
        const float* w = AIN(I_WMOD) + (size_t)l * DM * NMODV + (size_t)(64 * s) * NMODV + col;
        f32x4 a0 = {0.f, 0.f, 0.f, 0.f}, a1 = {0.f, 0.f, 0.f, 0.f};
#pragma unroll 8
        for (int k = 0; k < 64; ++k) { const f32x4 wv = __builtin_nontemporal_load((const f32x4*)(w + (size_t)k * NMODV)); a0 += wv * sc[64 * s + k]; a1 += wv * sc[DM + 64 * s + k]; }
        *(f32x4*)(MODP + (size_t)((l * 32 + s) * 2 + 0) * NMODV + col) = a0; *(f32x4*)(MODP + (size_t)((l * 32 + s) * 2 + 1) * NMODV + col) = a1;
    }
}
__device__ __forceinline__ void p1_modfinal(Frame& F, KArgs a) {
    const float* MODP = (const float*)(F.ws + WS_MODP); float* MOD = (float*)(F.ws + WS_MOD);
    for (int i = F.vcu * 512 + F.tid; i < DEPTH * 2 * NMODV; i += F.G * 512) {
        const int l = i / (2 * NMODV), v = (i / NMODV) & 1, j = i % NMODV; float s = AIN(I_BMOD)[l * NMODV + j];
#pragma unroll
        for (int q = 0; q < 32; ++q) s += MODP[(size_t)((l * 32 + q) * 2 + v) * NMODV + j];
        MOD[i] = s;
    }
}
__device__ __forceinline__ void norm_phase(Frame& F, KArgs a, int l, int k, int nsl) {
    const int gw = F.vcu * NWAVES + F.wave, NGW = F.G * NWAVES;
    const float* X = (const float*)(F.ws + WS_X); bf16* H = (bf16*)(F.ws + WS_H);
    const float* g = AIN(I_NORMG) + (size_t)(l * 3 + k) * DM;
    for (int v = 0; v < 2; ++v) {
        const float* mod = (const float*)(F.ws + WS_MOD) + (size_t)(l * 2 + v) * NMODV; const float* shift = mod + (3 * k) * DM; const float* scale = mod + (3 * k + 1) * DM;
        f32x4 gs[8], sh[8];
#pragma unroll
        for (int j = 0; j < 8; ++j) { const int c = 4 * F.lane + 256 * j; const f32x4 gg = *(const f32x4*)(g + c), ss = *(const f32x4*)(scale + c); gs[j] = gg * (ss + 1.0f); sh[j] = *(const f32x4*)(shift + c); }
        const int r0 = v ? SEQ : 0, r1 = v ? MR : SEQ;
        if (v == 0) {
            for (int m = r0 + gw; m < r1; m += 2 * NGW) {
                const bool two = m + NGW < r1; const int m2 = two ? m + NGW : m;
                const GAS f32x4* xa = (const GAS f32x4*)(X + (size_t)m * DM) + F.lane; const GAS f32x4* xb = (const GAS f32x4*)(X + (size_t)m2 * DM) + F.lane; f32x4 a[8], b[8]; float sa = 0.f, sb = 0.f;
#pragma unroll
                for (int j = 0; j < 8; ++j) { a[j] = __builtin_nontemporal_load(xa + 64 * j); b[j] = __builtin_nontemporal_load(xb + 64 * j); }
#pragma unroll
                for (int j = 0; j < 8; ++j) { sa += (a[j].x * a[j].x + a[j].y * a[j].y) + (a[j].z * a[j].z + a[j].w * a[j].w); sb += (b[j].x * b[j].x + b[j].y * b[j].y) + (b[j].z * b[j].z + b[j].w * b[j].w); }
                const float ra = 1.0f / sqrtf(wave_sum(sa, F.lane) * (1.0f / DM) + 1e-6f), rb = 1.0f / sqrtf(wave_sum(sb, F.lane) * (1.0f / DM) + 1e-6f);
                GAS v2u* oa = (GAS v2u*)(H + (size_t)m * DM) + F.lane; GAS v2u* ob = (GAS v2u*)(H + (size_t)m2 * DM) + F.lane;
#pragma unroll
                for (int j = 0; j < 8; ++j) { const f32x4 y = a[j] * ra * gs[j] + sh[j]; v2u w; w.x = pk2(y.x, y.y); w.y = pk2(y.z, y.w); oa[64 * j] = w; }
                if (two) {
#pragma unroll
                    for (int j = 0; j < 8; ++j) { const f32x4 y = b[j] * rb * gs[j] + sh[j]; v2u w; w.x = pk2(y.x, y.y); w.y = pk2(y.z, y.w); ob[64 * j] = w; } }
            }
        } else
        for (int m = r0 + gw; m < r1; m += NGW) {
            const GAS f32x4* xr = (const GAS f32x4*)(X + (size_t)m * DM) + F.lane; f32x4 x[8]; float s = 0.f;
#pragma unroll
            for (int j = 0; j < 8; ++j) x[j] = xr[64 * j];
            if (v == 1 && nsl > 0) { const float* PART = (const float*)(F.ws + WS_PART);
                for (int sl = 0; sl < nsl; ++sl) { const GAS f32x4* pr = (const GAS f32x4*)(PART + ((size_t)sl * 256 + (m - SEQ)) * DM) + F.lane;
#pragma unroll
                    for (int j = 0; j < 8; ++j) x[j] += pr[64 * j]; }
                GAS f32x4* xw = (GAS f32x4*)((float*)(F.ws + WS_X) + (size_t)m * DM) + F.lane;
#pragma unroll
                for (int j = 0; j < 8; ++j) xw[64 * j] = x[j]; }
#pragma unroll
            for (int j = 0; j < 8; ++j) s += (x[j].x * x[j].x + x[j].y * x[j].y) + (x[j].z * x[j].z + x[j].w * x[j].w);
            const float rstd = 1.0f / sqrtf(wave_sum(s, F.lane) * (1.0f / DM) + 1e-6f);
            GAS v2u* o = (GAS v2u*)(H + (size_t)m * DM) + F.lane;
#pragma unroll
            for (int j = 0; j < 8; ++j) { const f32x4 y = x[j] * rstd * gs[j] + sh[j]; v2u w; w.x = pk2(y.x, y.y); w.y = pk2(y.z, y.w); o[64 * j] = w; }
        }
    }
}
__device__ __forceinline__ void dt_gemm(Frame& F, int l, int c, int rem) {
    if (c < rem) return;
    const int gw = (c - rem) * NWAVES + F.wave, NGW = (F.G - rem) * NWAVES;
    const bf16* H = (const bf16*)(F.ws + WS_H); const bf16* Wd = (const bf16*)(F.ws + WS_W) + (size_t)l * WL_SIZE + WL_WDT; float* DTR = (float*)(F.ws + WS_DTRAW);
    const int fr = F.lane & 15, fq = F.lane >> 4;
    for (int t = gw; t < MR / 16; t += NGW) {
        const bf16* ap = H + (size_t)(16 * t + fr) * DM + 8 * fq; const bf16* b0 = Wd + (size_t)fr * DM + 8 * fq; const bf16* b1 = Wd + (size_t)(16 + fr) * DM + 8 * fq;
        f32x4 c0 = {0.f, 0.f, 0.f, 0.f}, c1 = {0.f, 0.f, 0.f, 0.f};
#pragma unroll 4
        for (int k0 = 0; k0 < DM; k0 += 32) { const bf16x8 av = *(const bf16x8*)(ap + k0), bv0 = *(const bf16x8*)(b0 + k0), bv1 = *(const bf16x8*)(b1 + k0);
            c0 = __builtin_amdgcn_mfma_f32_16x16x32_bf16(av, bv0, c0, 0, 0, 0); c1 = __builtin_amdgcn_mfma_f32_16x16x32_bf16(av, bv1, c1, 0, 0, 0); }
#pragma unroll
        for (int r = 0; r < 4; ++r) { float* o = DTR + (size_t)(16 * t + 4 * fq + r) * 32 + fr; o[0] = c0[r]; o[16] = c1[r]; }
    }
}
struct S5Disc { float lb_re, lb_im, bb_re[16], bb_im[16]; };
__device__ __forceinline__ void s5_disc(KArgs a, int l, int dir, int g, int p, S5Disc& d) {
    const int ig = (l * 2 + dir) * 32 + g; const float a_re = AIN(I_S5ARE)[ig * 64 + p], a_im = AIN(I_S5AIM)[ig * 64 + p]; const float dt = __expf(AIN(I_S5LDT)[ig]);
    const float mag = __expf(a_re * dt); float sn, cs; sincos_hw(a_im * dt, sn, cs);
    d.lb_re = mag * cs; d.lb_im = mag * sn;
    const float den = a_re * a_re + a_im * a_im, nr = d.lb_re - 1.0f, ni = d.lb_im;
    const float f_re = (nr * a_re + ni * a_im) / den, f_im = (ni * a_re - nr * a_im) / den;
    const float* br = AIN(I_S5BRE) + (size_t)((l * 32 + g) * 64 + p) * 16; const float* bi = AIN(I_S5BIM) + (size_t)((l * 32 + g) * 64 + p) * 16;
#pragma unroll
    for (int h = 0; h < 16; ++h) { const float x = br[h], y = bi[h]; d.bb_re[h] = f_re * x - f_im * y; d.bb_im[h] = f_re * y + f_im * x; }
}
typedef float f32x16 __attribute__((ext_vector_type(16)));
struct S5Pow { float r1, i1, r2, i2, r3, i3, r4, i4; };
__device__ __forceinline__ void s5_pow(const S5Disc& d, S5Pow& p) { p.r1 = d.lb_re; p.i1 = d.lb_im; p.r2 = p.r1 * p.r1 - p.i1 * p.i1; p.i2 = 2.0f * p.r1 * p.i1; p.r3 = p.r2 * p.r1 - p.i2 * p.i1; p.i3 = p.r2 * p.i1 + p.i2 * p.r1; p.r4 = p.r2 * p.r2 - p.i2 * p.i2; p.i4 = 2.0f * p.r2 * p.i2; }
__device__ __forceinline__ bf16x8 pack8(const float (&v)[16], bool hi) { v4u w; w.x = pk2(hi ? v[8] : v[0], hi ? v[9] : v[1]); w.y = pk2(hi ? v[10] : v[2], hi ? v[11] : v[3]); w.z = pk2(hi ? v[12] : v[4], hi ? v[13] : v[5]); w.w = pk2(hi ? v[14] : v[6], hi ? v[15] : v[7]); return __builtin_bit_cast(bf16x8, w); }
template <bool FIX> __device__ __forceinline__ void s5_state_scan(f32x16& R, f32x16& I, const S5Pow& p, float& cr, float& ci, bool hi) {
#pragma unroll
    for (int k = 0; k < 4; ++k)
#pragma unroll
        for (int j = 1; j < 4; ++j) { const int x = 4 * k + j; const float nr = p.r1 * R[x - 1] - p.i1 * I[x - 1] + R[x], ni = p.r1 * I[x - 1] + p.i1 * R[x - 1] + I[x]; R[x] = nr; I[x] = ni; }
    float cinr[4], cini[4], ce_r = 0.f, ce_i = 0.f;
#pragma unroll
    for (int G = 0; G < 8; ++G) { const int k = G >> 1;
        if ((G & 1) == 0) { ce_r = cr; ce_i = ci; } else { cinr[k] = hi ? cr : ce_r; cini[k] = hi ? ci : ce_i; }
        const float vr = p.r4 * cr - p.i4 * ci + R[4 * k + 3], vi = p.r4 * ci + p.i4 * cr + I[4 * k + 3];
        const auto sr = __builtin_amdgcn_permlane32_swap(__float_as_uint(vr), __float_as_uint(vr), false, false); const auto si = __builtin_amdgcn_permlane32_swap(__float_as_uint(vi), __float_as_uint(vi), false, false);
        cr = __uint_as_float(sr[G & 1]); ci = __uint_as_float(si[G & 1]); }
    if (FIX) {
#pragma unroll
        for (int k = 0; k < 4; ++k) { const float a = cinr[k], b = cini[k];
            R[4 * k + 0] += p.r1 * a - p.i1 * b; I[4 * k + 0] += p.r1 * b + p.i1 * a; R[4 * k + 1] += p.r2 * a - p.i2 * b; I[4 * k + 1] += p.r2 * b + p.i2 * a;
            R[4 * k + 2] += p.r3 * a - p.i3 * b; I[4 * k + 2] += p.r3 * b + p.i3 * a; R[4 * k + 3] += p.r4 * a - p.i4 * b; I[4 * k + 3] += p.r4 * b + p.i4 * a; }
    }
}
template <bool PASS2> __device__ __forceinline__ void s5_pass(Frame& F, KArgs a, int l) {
    const int gw = F.vcu * NWAVES + F.wave, NGW = F.G * NWAVES;
    if (NGW % 64 != 0) return;
    const int q = gw & 63, dir = q >> 5, g = q & 31, lane = F.lane, s = lane & 31; const bool hi = lane >= 32;
    S5Pow pA, pB; bf16x8 bbf[4];
    { S5Disc dA, dB; s5_disc(a, l, dir, g, s, dA); s5_disc(a, l, dir, g, s + 32, dB); s5_pow(dA, pA); s5_pow(dB, pB);
      bbf[0] = pack8(dA.bb_re, hi); bbf[1] = pack8(dB.bb_re, hi); bbf[2] = pack8(dA.bb_im, hi); bbf[3] = pack8(dB.bb_im, hi); }
    bf16x8 cmf[4];
    if (PASS2) { const int h = lane & 15, q4 = lane >> 4;
#pragma unroll
        for (int ks = 0; ks < 4; ++ks) { const float* src = (ks < 2 ? AIN(I_S5CRE) : AIN(I_S5CIM)) + (size_t)((l * 32 + g) * 16 + h) * 64 + 32 * (ks & 1) + 8 * q4; const float sg = ks < 2 ? 1.0f : -1.0f;
            const f32x4 v0 = *(const f32x4*)src * sg, v1 = *(const f32x4*)(src + 4) * sg; v4u w; w.x = pk2(v0.x, v0.y); w.y = pk2(v0.z, v0.w); w.z = pk2(v1.x, v1.y); w.w = pk2(v1.z, v1.w); cmf[ks] = __builtin_bit_cast(bf16x8, w); } }
    float* END = (float*)(F.ws + WS_S5END); const float* SIN = (const float*)(F.ws + WS_S5IN); const bf16* P = (const bf16*)(F.ws + WS_P); bf16* YBF = (bf16*)(F.ws + WS_YBF);
    LAS bf16* Sb = (LAS bf16*)(F.lds + RING_OFF + F.wave * 8192);
    for (int cs = gw >> 6; cs < MR / 64; cs += NGW >> 6) {
        const size_t o = ((size_t)q * (MR / 64) + cs) * 128;
        float cAr = 0.f, cAi = 0.f, cBr = 0.f, cBi = 0.f;
        if (PASS2) { cAr = SIN[o + 2 * s]; cAi = SIN[o + 2 * s + 1]; cBr = SIN[o + 2 * (s + 32)]; cBi = SIN[o + 2 * (s + 32) + 1]; }
#pragma unroll 1
        for (int tt = 0; tt < 2; ++tt) {
            const bf16x8 uf = *(const GAS bf16x8*)(P + (size_t)rowof(dir, 64 * cs + 32 * tt + s) * NP + PC_U + 16 * g + (hi ? 8 : 0));
            const f32x16 z = {0.f, 0.f, 0.f, 0.f, 0.f, 0.f, 0.f, 0.f, 0.f, 0.f, 0.f, 0.f, 0.f, 0.f, 0.f, 0.f};
            f32x16 T0 = __builtin_amdgcn_mfma_f32_32x32x16_bf16(uf, bbf[0], z, 0, 0, 0), T1 = __builtin_amdgcn_mfma_f32_32x32x16_bf16(uf, bbf[1], z, 0, 0, 0);
            f32x16 T2 = __builtin_amdgcn_mfma_f32_32x32x16_bf16(uf, bbf[2], z, 0, 0, 0), T3 = __builtin_amdgcn_mfma_f32_32x32x16_bf16(uf, bbf[3], z, 0, 0, 0);
            s5_state_scan<PASS2>(T0, T2, pA, cAr, cAi, hi);
            s5_state_scan<PASS2>(T1, T3, pB, cBr, cBi, hi);
            if (PASS2) {
#pragma unroll
                for (int r = 0; r < 16; ++r) { const int tl = 8 * (r >> 2) + (hi ? 4 : 0) + (r & 3); LAS bf16* dst = Sb + tl * 128 + s;
                    dst[0] = (bf16)f2bf(T0[r]); dst[32] = (bf16)f2bf(T1[r]); dst[64] = (bf16)f2bf(T2[r]); dst[96] = (bf16)f2bf(T3[r]); }
                LDS_WAIT(); asm volatile("" ::: "memory");
                const int r16 = lane & 15, q4 = lane >> 4;
#pragma unroll
                for (int mt = 0; mt < 2; ++mt) { f32x4 acc = {0.f, 0.f, 0.f, 0.f};
#pragma unroll
                    for (int ks = 0; ks < 4; ++ks) { const bf16x8 af = *(const LAS bf16x8*)(Sb + (16 * mt + r16) * 128 + 32 * ks + 8 * q4); acc = __builtin_amdgcn_mfma_f32_16x16x32_bf16(af, cmf[ks], acc, 0, 0, 0); }
#pragma unroll
                    for (int rg = 0; rg < 4; ++rg) { const int row = rowof(dir, 64 * cs + 32 * tt + 16 * mt + 4 * q4 + rg); YBF[((size_t)dir * MR + row) * 512 + 16 * g + r16] = (bf16)f2bf(acc[rg]); } }
                LDS_WAIT(); asm volatile("" ::: "memory");
            }
        }
        if (!PASS2 && !hi) { END[o + 2 * s] = cAr; END[o + 2 * s + 1] = cAi; END[o + 2 * (s + 32)] = cBr; END[o + 2 * (s + 32) + 1] = cBi; }
    }
}
__device__ __forceinline__ void s5_carry(Frame& F, KArgs a, int l, int first_wave) {
    const int gw = F.vcu * NWAVES + F.wave - first_wave; if (gw < 0 || gw >= 64) return;
    const int q = gw, dir = q >> 5, g = q & 31, p = F.lane;
    const int ig = (l * 2 + dir) * 32 + g; const float a_re = AIN(I_S5ARE)[ig * 64 + p], a_im = AIN(I_S5AIM)[ig * 64 + p]; const float dt = __expf(AIN(I_S5LDT)[ig]);
    const float mag = __expf(a_re * dt); float sn, cs_; sincos_hw(a_im * dt, sn, cs_);
    float pr = mag * cs_, pi = mag * sn;
#pragma unroll
    for (int i = 0; i < 6; ++i) { const float nr = pr * pr - pi * pi, ni = 2.0f * pr * pi; pr = nr; pi = ni; }
    const float* END = (const float*)(F.ws + WS_S5END); float* SIN = (float*)(F.ws + WS_S5IN);
    float s_re = 0.f, s_im = 0.f;
    for (int cs = 0; cs < MR / 64; cs += 4) {
        float er[4], ei[4];
#pragma unroll
        for (int i = 0; i < 4; ++i) { const size_t o = ((size_t)q * (MR / 64) + cs + i) * 128 + 2 * p; er[i] = END[o]; ei[i] = END[o + 1]; }
#pragma unroll
        for (int i = 0; i < 4; ++i) { const size_t o = ((size_t)q * (MR / 64) + cs + i) * 128 + 2 * p; SIN[o] = s_re; SIN[o + 1] = s_im;
            const float nr = pr * s_re - pi * s_im + er[i], ni = pr * s_im + pi * s_re + ei[i]; s_re = nr; s_im = ni; }
    }
}
__device__ __forceinline__ bf16x8 ldg8(const bf16* p) { return *(const GAS bf16x8*)p; }
__device__ __forceinline__ int ssd_chunk_of(int d, int j) { return d ? (MR / 64 - 1 - j) : (j < CTXN / 64 ? SEQ / 64 + j : j - CTXN / 64); }
__device__ __forceinline__ float scan64(float v, int d, int lane) {
#pragma unroll
    for (int o = 1; o < 64; o <<= 1) { const float up = bperm(v, lane - o), dn = bperm(v, lane + o); if (d == 0) { if (lane >= o) v += up; } else { if (lane + o < 64) v += dn; } }
    return v;
}
__device__ __forceinline__ void conv_item(Frame& F, const float* cw, const float* cb_, int k, int cb) {
    LAS float* tin = (LAS float*)(F.lds + RING_OFF);
    LAS float* tout = tin + 68 * 64;
    const bf16* P = (const bf16*)(F.ws + WS_P);
    const int row0 = 64 * k, lo = k < SEQ / 64 ? 0 : SEQ, hi = k < SEQ / 64 ? SEQ : MR, c0 = 64 * cb;
    const int t = F.tid >> 3, c8 = (F.tid & 7) * 8;
    __syncthreads();
#pragma unroll
    for (int rr = t; rr < 68; rr += 64) { const int grow = row0 - 2 + rr; v4u w = (v4u){0u, 0u, 0u, 0u}; if (grow >= lo && grow < hi) w = *(const GAS v4u*)(P + (size_t)grow * NP + PC_XBC + c0 + c8);
        *(LAS f32x4*)(tin + rr * 64 + c8) = (f32x4){bflo(w.x), bfhi(w.x), bflo(w.y), bfhi(w.y)}; *(LAS f32x4*)(tin + rr * 64 + c8 + 4) = (f32x4){bflo(w.z), bfhi(w.z), bflo(w.w), bfhi(w.w)}; }
    __syncthreads();
    { f32x4 a0 = *(const f32x4*)(cb_ + c0 + c8), a1 = *(const f32x4*)(cb_ + c0 + c8 + 4);
#pragma unroll
      for (int j = 0; j < 5; ++j) { const f32x4 w0 = *(const f32x4*)(cw + j * 1280 + c0 + c8), w1 = *(const f32x4*)(cw + j * 1280 + c0 + c8 + 4);
          a0 += w0 * *(const LAS f32x4*)(tin + (t + j) * 64 + c8); a1 += w1 * *(const LAS f32x4*)(tin + (t + j) * 64 + c8 + 4); }
      float o[8];
#pragma unroll
      for (int i = 0; i < 4; ++i) { o[i] = silu_(a0[i]); o[4 + i] = silu_(a1[i]); }
#pragma unroll
      for (int i = 0; i < 8; ++i) tout[t * 65 + c8 + i] = o[i];
      v4u w; w.x = pk2(o[0], o[1]); w.y = pk2(o[2], o[3]); w.z = pk2(o[4], o[5]); w.w = pk2(o[6], o[7]);
      bf16* nat = (cb < 12) ? (bf16*)(F.ws + WS_XSN) + (size_t)(row0 + t) * 768 + c0 + c8
                : (cb < 16) ? (bf16*)(F.ws + WS_BN) + (size_t)(row0 + t) * 256 + (c0 - 768) + c8
                            : (bf16*)(F.ws + WS_CN) + (size_t)(row0 + t) * 256 + (c0 - 1024) + c8;
      *(GAS v4u*)nat = w; }
    __syncthreads();
    if (cb < 16) {
        const int c = F.tid >> 3, t8 = (F.tid & 7) * 8; float o[8];
#pragma unroll
        for (int i = 0; i < 8; ++i) o[i] = tout[(t8 + i) * 65 + c];
        v4u w; w.x = pk2(o[0], o[1]); w.y = pk2(o[2], o[3]); w.z = pk2(o[4], o[5]); w.w = pk2(o[6], o[7]);
        bf16* tr = (cb < 12) ? (bf16*)(F.ws + WS_XT) + ((size_t)(k * 12 + cb) * 64 + c) * 64 + t8
                             : (bf16*)(F.ws + WS_BT) + ((size_t)k * 256 + (c0 - 768) + c) * 64 + t8;
        *(GAS v4u*)tr = w;
    }
}
__device__ __forceinline__ void conv_wave_item(Frame& F, const float* cw, const float* cb_, int k, int c0, LAS float* buf) {
    const bf16* P = (const bf16*)(F.ws + WS_P);
    const int row0 = 64 * k, lo = k < SEQ / 64 ? 0 : SEQ, hi = k < SEQ / 64 ? SEQ : MR, t = F.lane;
    { const int g0 = row0 - 2 + t; v4u w = (v4u){0u, 0u, 0u, 0u}; if (g0 >= lo && g0 < hi) w = *(const GAS v4u*)(P + (size_t)g0 * NP + PC_XBC + c0);
      *(LAS f32x4*)(buf + t * 8) = (f32x4){bflo(w.x), bfhi(w.x), bflo(w.y), bfhi(w.y)}; *(LAS f32x4*)(buf + t * 8 + 4) = (f32x4){bflo(w.z), bfhi(w.z), bflo(w.w), bfhi(w.w)};
      if (t < 4) { const int g1 = row0 + 62 + t; v4u w1 = (v4u){0u, 0u, 0u, 0u}; if (g1 >= lo && g1 < hi) w1 = *(const GAS v4u*)(P + (size_t)g1 * NP + PC_XBC + c0);
          *(LAS f32x4*)(buf + (64 + t) * 8) = (f32x4){bflo(w1.x), bfhi(w1.x), bflo(w1.y), bfhi(w1.y)}; *(LAS f32x4*)(buf + (64 + t) * 8 + 4) = (f32x4){bflo(w1.z), bfhi(w1.z), bflo(w1.w), bfhi(w1.w)}; } }
    LDS_WAIT(); asm volatile("" ::: "memory");
    f32x4 a0 = *(const f32x4*)(cb_ + c0), a1 = *(const f32x4*)(cb_ + c0 + 4);
#pragma unroll
    for (int j = 0; j < 5; ++j) { const f32x4 w0 = *(const f32x4*)(cw + j * 1280 + c0), w1 = *(const f32x4*)(cw + j * 1280 + c0 + 4);
        a0 += w0 * *(const LAS f32x4*)(buf + (t + j) * 8); a1 += w1 * *(const LAS f32x4*)(buf + (t + j) * 8 + 4); }
    float o[8];
#pragma unroll
    for (int i = 0; i < 4; ++i) { o[i] = silu_(a0[i]); o[4 + i] = silu_(a1[i]); }
    v4u w; w.x = pk2(o[0], o[1]); w.y = pk2(o[2], o[3]); w.z = pk2(o[4], o[5]); w.w = pk2(o[6], o[7]);
    if (c0 >= 768) { bf16* nat = (c0 < 1024) ? (bf16*)(F.ws + WS_BN) + (size_t)(row0 + t) * 256 + (c0 - 768) : (bf16*)(F.ws + WS_CN) + (size_t)(row0 + t) * 256 + (c0 - 1024); *(GAS v4u*)nat = w; }
    if (c0 < 1024) { bf16* tr = (c0 < 768) ? (bf16*)(F.ws + WS_XT) + ((size_t)(k * 12 + (c0 >> 6)) * 64 + (c0 & 63)) * 64 + t : (bf16*)(F.ws + WS_BT) + ((size_t)k * 256 + (c0 - 768)) * 64 + t;
#pragma unroll
        for (int i = 0; i < 8; ++i) tr[(size_t)i * 64] = (bf16)f2bf(o[i]); }
    LDS_WAIT(); asm volatile("" ::: "memory");
}
__device__ __forceinline__ void ssd_states(Frame& F, KArgs a, int l) {
    const int gw = F.vcu * NWAVES + F.wave, NGW = F.G * NWAVES, lane = F.lane, r = lane & 15, q = lane >> 4;
    LAS float* wb = (LAS float*)(F.lds + RING_OFF + F.wave * 2048);
    const float* DT = (const float*)(F.ws + WS_DT); const bf16* XT = (const bf16*)(F.ws + WS_XT); const bf16* BT = (const bf16*)(F.ws + WS_BT);
    bf16* ST = (bf16*)(F.ws + WS_STATES); float* CHD = (float*)(F.ws + WS_CHD); const float* alog = AIN(I_ALOG) + l * 24;
    for (int item = gw; item < (MR / 64) * 4; item += NGW) {
        const int k = item >> 2, g = (item >> 1) & 1, d = item & 1, row0 = 64 * k;
#pragma unroll
        for (int hh = 0; hh < 6; ++hh) { const int dh = d * 12 + g * 6 + hh; const float dt = DT[(size_t)(row0 + lane) * 24 + dh]; const float A = -__expf(alog[dh]);
            const float cum = scan64(A * dt, d, lane); const float tot = __int_as_float(d ? __builtin_amdgcn_readlane(__float_as_int(cum), 0) : __builtin_amdgcn_readlane(__float_as_int(cum), 63));
            wb[hh * 64 + lane] = dt * __expf(tot - cum);
            if (lane == 0) CHD[k * 24 + dh] = __expf(tot); }
        LDS_WAIT(); asm volatile("" ::: "memory");
        for (int hh = 0; hh < 6; ++hh) {
            const int h = g * 6 + hh, dh = d * 12 + h;
            bf16x8 af[4][2];
#pragma unroll
            for (int ks = 0; ks < 2; ++ks) { const f32x4 w0 = *(const LAS f32x4*)(wb + hh * 64 + 32 * ks + 8 * q), w1 = *(const LAS f32x4*)(wb + hh * 64 + 32 * ks + 8 * q + 4);
#pragma unroll
                for (int pt = 0; pt < 4; ++pt) { const v4u x = *(const GAS v4u*)(XT + ((size_t)(k * 12 + h) * 64 + 16 * pt + r) * 64 + 32 * ks + 8 * q);
                    v4u y; y.x = pk2(bflo(x.x) * w0.x, bfhi(x.x) * w0.y); y.y = pk2(bflo(x.y) * w0.z, bfhi(x.y) * w0.w); y.z = pk2(bflo(x.z) * w1.x, bfhi(x.z) * w1.y); y.w = pk2(bflo(x.w) * w1.z, bfhi(x.w) * w1.w);
                    af[pt][ks] = __builtin_bit_cast(bf16x8, y); } }
#pragma unroll
            for (int half = 0; half < 2; ++half) {
                f32x4 acc[4][4];
#pragma unroll
                for (int pt = 0; pt < 4; ++pt)
#pragma unroll
                    for (int nt = 0; nt < 4; ++nt) acc[pt][nt] = (f32x4){0.f, 0.f, 0.f, 0.f};
#pragma unroll
                for (int ks = 0; ks < 2; ++ks)
#pragma unroll
                    for (int nt = 0; nt < 4; ++nt) { const bf16x8 bv = ldg8(BT + ((size_t)(k * 2 + g) * 128 + 64 * half + 16 * nt + r) * 64 + 32 * ks + 8 * q);
#pragma unroll
                        for (int pt = 0; pt < 4; ++pt) acc[pt][nt] = __builtin_amdgcn_mfma_f32_16x16x32_bf16(af[pt][ks], bv, acc[pt][nt], 0, 0, 0); }
#pragma unroll
                for (int pt = 0; pt < 4; ++pt)
#pragma unroll
                    for (int nt = 0; nt < 4; ++nt)
#pragma unroll
                        for (int rg = 0; rg < 4; ++rg) ST[((size_t)(k * 24 + dh) * 64 + 16 * pt + 4 * q + rg) * 128 + 64 * half + 16 * nt + r] = (bf16)f2bf(acc[pt][nt][rg]);
            }
        }
        LDS_WAIT(); asm volatile("" ::: "memory");
    }
}
__device__ __forceinline__ void ssd_carry(Frame& F) {
    const bf16* ST = (const bf16*)(F.ws + WS_STATES); const float* CHD = (const float*)(F.ws + WS_CHD); bf16* SB = (bf16*)(F.ws + WS_SINB);
    for (int idx = F.vcu * 512 + F.tid; idx < 24 * 64 * 32; idx += F.G * 512) {
        const int dh = idx >> 11, rem = idx & 2047, d = dh / 12; const size_t eo = (size_t)(rem >> 5) * 128 + (rem & 31) * 4;
        f32x4 S = {0.f, 0.f, 0.f, 0.f};
        for (int j = 0; j < MR / 64; j += 4) {
            f32x4 st[4]; float dc[4]; size_t off[4];
#pragma unroll
            for (int i = 0; i < 4; ++i) { const int k = ssd_chunk_of(d, j + i); off[i] = (size_t)(k * 24 + dh) * 8192 + eo; const v2u sw = *(const GAS v2u*)(ST + off[i]); st[i] = (f32x4){bflo(sw.x), bfhi(sw.x), bflo(sw.y), bfhi(sw.y)}; dc[i] = CHD[k * 24 + dh]; }
#pragma unroll
            for (int i = 0; i < 4; ++i) { v2u w; w.x = pk2(S.x, S.y); w.y = pk2(S.z, S.w); *(GAS v2u*)(SB + off[i]) = w; S = S * dc[i] + st[i]; }
        }
    }
}
__device__ __forceinline__ void ssd_outputs(Frame& F, KArgs a, int l) {
    const int gw = F.vcu * NWAVES + F.wave, NGW = F.G * NWAVES, lane = F.lane, r = lane & 15, q = lane >> 4;
    LAS bf16* Mb = (LAS bf16*)(F.lds + RING_OFF + F.wave * 10240);
    LAS float* cumb = (LAS float*)(F.lds + RING_OFF + F.wave * 10240 + 8192);
    const float* DT = (const float*)(F.ws + WS_DT); const bf16* XT = (const bf16*)(F.ws + WS_XT); const bf16* BN = (const bf16*)(F.ws + WS_BN); const bf16* CN = (const bf16*)(F.ws + WS_CN);
    const bf16* SB = (const bf16*)(F.ws + WS_SINB); bf16* YS = (bf16*)(F.ws + WS_YS); const float* alog = AIN(I_ALOG) + l * 24;
    for (int item = gw; item < (MR / 64) * 12; item += NGW) {
        const int hp = item % 3, i4 = item / 3, k = i4 >> 2, g = (i4 >> 1) & 1, d = i4 & 1, row0 = 64 * k;
        f32x4 G[4][4];
#pragma unroll
        for (int it = 0; it < 4; ++it)
#pragma unroll
            for (int st = 0; st < 4; ++st) G[it][st] = (f32x4){0.f, 0.f, 0.f, 0.f};
#pragma unroll 1
        for (int ks = 0; ks < 4; ++ks) { bf16x8 cf[4], bfr[4];
#pragma unroll
            for (int i = 0; i < 4; ++i) { cf[i] = ldg8(CN + (size_t)(row0 + 16 * i + r) * 256 + g * 128 + 32 * ks + 8 * q); bfr[i] = ldg8(BN + (size_t)(row0 + 16 * i + r) * 256 + g * 128 + 32 * ks + 8 * q); }
#pragma unroll
            for (int it = 0; it < 4; ++it)
#pragma unroll
                for (int st = 0; st < 4; ++st) G[it][st] = __builtin_amdgcn_mfma_f32_16x16x32_bf16(cf[it], bfr[st], G[it][st], 0, 0, 0); }
        for (int hh = 2 * hp; hh < 2 * hp + 2; ++hh) {
            const int h = g * 6 + hh, dh = d * 12 + h; const float dskip = AIN(I_SSDD)[l * 12 + h];
            { const float dt = DT[(size_t)(row0 + lane) * 24 + dh]; const float A = -__expf(alog[dh]); const float cum = scan64(A * dt, d, lane);
              cumb[lane] = cum; cumb[64 + lane] = __expf(cum); cumb[128 + lane] = dt; }
            LDS_WAIT(); asm volatile("" ::: "memory");
            { float cs[4], ds[4];
#pragma unroll
              for (int st = 0; st < 4; ++st) { cs[st] = cumb[16 * st + r]; ds[st] = cumb[128 + 16 * st + r]; }
#pragma unroll
              for (int it = 0; it < 4; ++it)
#pragma unroll
                  for (int rg = 0; rg < 4; ++rg) { const int i = 16 * it + 4 * q + rg; const float ci = cumb[i];
#pragma unroll
                      for (int st = 0; st < 4; ++st) { const int s = 16 * st + r; const bool on = d ? (s >= i) : (s <= i);
                          float v = on ? G[it][st][rg] * __expf(ci - cs[st]) * ds[st] : 0.f; if (s == i && d == 0) v += dskip; Mb[i * 64 + s] = (bf16)f2bf(v); } } }
            f32x4 acc[4][4];
#pragma unroll
            for (int it = 0; it < 4; ++it)
#pragma unroll
                for (int pt = 0; pt < 4; ++pt) acc[it][pt] = (f32x4){0.f, 0.f, 0.f, 0.f};
#pragma unroll 1
            for (int ks = 0; ks < 4; ++ks) { bf16x8 cf[4], sf[4];
#pragma unroll
                for (int i = 0; i < 4; ++i) { cf[i] = ldg8(CN + (size_t)(row0 + 16 * i + r) * 256 + g * 128 + 32 * ks + 8 * q); sf[i] = ldg8(SB + ((size_t)(k * 24 + dh) * 64 + 16 * i + r) * 128 + 32 * ks + 8 * q); }
#pragma unroll
                for (int it = 0; it < 4; ++it)
#pragma unroll
                    for (int pt = 0; pt < 4; ++pt) acc[it][pt] = __builtin_amdgcn_mfma_f32_16x16x32_bf16(cf[it], sf[pt], acc[it][pt], 0, 0, 0); }
#pragma unroll
            for (int it = 0; it < 4; ++it)
#pragma unroll
                for (int rg = 0; rg < 4; ++rg) { const float e = cumb[64 + 16 * it + 4 * q + rg];
#pragma unroll
                    for (int pt = 0; pt < 4; ++pt) acc[it][pt][rg] *= e; }
            LDS_WAIT(); asm volatile("" ::: "memory");
#pragma unroll 1
            for (int ks = 0; ks < 2; ++ks) { bf16x8 mf[4], xf[4];
#pragma unroll
                for (int i = 0; i < 4; ++i) { mf[i] = *(const LAS bf16x8*)(Mb + (16 * i + r) * 64 + 32 * ks + 8 * q); xf[i] = ldg8(XT + ((size_t)(k * 12 + h) * 64 + 16 * i + r) * 64 + 32 * ks + 8 * q); }
#pragma unroll
                for (int it = 0; it < 4; ++it)
#pragma unroll
                    for (int pt = 0; pt < 4; ++pt) acc[it][pt] = __builtin_amdgcn_mfma_f32_16x16x32_bf16(mf[it], xf[pt], acc[it][pt], 0, 0, 0); }
#pragma unroll
            for (int it = 0; it < 4; ++it)
#pragma unroll
                for (int pt = 0; pt < 4; ++pt)
#pragma unroll
                    for (int rg = 0; rg < 4; ++rg) YS[((size_t)d * MR + row0 + 16 * it + 4 * q + rg) * 768 + h * 64 + 16 * pt + r] = (bf16)f2bf(acc[it][pt][rg]);
            LDS_WAIT(); asm volatile("" ::: "memory");
        }
    }
}
#ifndef SWA_EARLY
#define SWA_EARLY 304
#endif
#ifndef PREPDUP
#define PREPDUP 0
#endif
#ifndef PREP_REV
#define PREP_REV 0
#endif
__device__ __forceinline__ void prep_phase(Frame& F, KArgs a, int l) {
    const bf16* P = (const bf16*)(F.ws + WS_P);
    { const float* cw = AIN(I_CONVW) + (size_t)l * 5 * 1280; const float* cb = AIN(I_CONVB) + (size_t)l * 1280;
      LAS float* cbuf = (LAS float*)(F.lds + RING_OFF + F.wave * 4096);
      for (int rep_ = 0; rep_ <= (PREPDUP & 1); ++rep_)
      for (int it = F.vcu * NWAVES + F.wave; it < (MR / 64) * 160; it += F.G * NWAVES) conv_wave_item(F, cw, cb, it / 160, 8 * (it % 160), cbuf);
      __syncthreads(); }
    { const float* DTR = (const float*)(F.ws + WS_DTRAW); float* DT = (float*)(F.ws + WS_DT); const float* dtb = AIN(I_DTB) + l * 24;
      for (int i = F.vcu * 512 + F.tid; i < MR * 24; i += F.G * 512) { const int m = i / 24, j = i % 24; const float x = DTR[m * 32 + j] + dtb[j];
          DT[i] = fmaxf(x, 0.f) + __logf(1.0f + __expf(-fabsf(x))); } }
    { const int gw = F.vcu * NWAVES + F.wave, NGW = F.G * NWAVES, lane = F.lane, j8 = lane & 7;
      float inv[8];
#pragma unroll
      for (int j = 0; j < 8; ++j) inv[j] = __builtin_amdgcn_exp2f(-(float)(((j8 & 1) * 8 + j)) * (13.287712379549449f / 16.0f));
      bf16* QS = (bf16*)(F.ws + WS_QS); bf16* QG = (bf16*)(F.ws + WS_QG); bf16* KS = (bf16*)(F.ws + WS_KS); bf16* KG = (bf16*)(F.ws + WS_KG);
      const float* gsw = AIN(I_SWAG) + l * 128; const float* ggl = AIN(I_GLBG) + l * 128;
      for (int rep_ = 0; rep_ <= ((PREPDUP >> 1) & 1); ++rep_)
      for (int it = gw; it < MR * 3; it += NGW) {
          const int m = PREP_REV ? (MR - 1 - it / 3) : it / 3, part = it % 3; const bool act = part < 2 || lane < 32; const bool glb = part == 1 || (part == 2 && lane >= 16); const bool isk = part == 2;
          const int hl = isk ? ((lane >> 3) & 1) : (lane >> 3);
          const int col = (glb ? (isk ? PC_GK : PC_GQ) : (isk ? PC_SK : PC_SQ)) + 64 * hl + 8 * j8;
          v4u w = (v4u){0u, 0u, 0u, 0u}; if (act) w = *(const GAS v4u*)(P + (size_t)m * NP + col);
          float x[8] = {bflo(w.x), bfhi(w.x), bflo(w.y), bfhi(w.y), bflo(w.z), bfhi(w.z), bflo(w.w), bfhi(w.w)};
          float ss = 0.f;
#pragma unroll
          for (int j = 0; j < 8; ++j) ss += x[j] * x[j];
          ss += bperm(ss, lane ^ 1); ss += bperm(ss, lane ^ 2); ss += bperm(ss, lane ^ 4);
          const float rs = 1.0f / sqrtf(ss * (1.0f / 64.0f) + 1e-6f);
          const float* gp = (glb ? ggl : gsw) + (isk ? 64 : 0) + 8 * j8; const f32x4 g0 = *(const f32x4*)gp, g1 = *(const f32x4*)(gp + 4);
          const float gg[8] = {g0.x, g0.y, g0.z, g0.w, g1.x, g1.y, g1.z, g1.w};
#pragma unroll
          for (int j = 0; j < 8; ++j) x[j] = x[j] * rs * gg[j];
          if (m < SEQ) { const float pos = ((j8 & 3) < 2) ? (float)(m >> 6) : (float)(m & 63); const bool lo = j8 < 4;
#pragma unroll
              for (int j = 0; j < 8; ++j) { float sn, cs; sincos_hw(pos * inv[j], sn, cs); const float other = bperm(x[j], lane ^ 4); x[j] = lo ? (x[j] * cs - other * sn) : (other * sn + x[j] * cs); } }
          if (!isk) {
#pragma unroll
              for (int j = 0; j < 8; ++j) x[j] *= QSCALE; }
          v4u o; o.x = pk2(x[0], x[1]); o.y = pk2(x[2], x[3]); o.z = pk2(x[4], x[5]); o.w = pk2(x[6], x[7]);
          bf16* dst = isk ? ((glb ? KG : KS) + (size_t)m * 128 + 64 * hl + 8 * j8) : ((glb ? QG : QS) + (size_t)m * 512 + 64 * hl + 8 * j8);
          if (act) *(GAS v4u*)dst = o;
      } }
}
__device__ __forceinline__ void attn_all(Frame& F, KArgs a, int l) {
    typedef attn_body::bf16 ab;
    char* shm = (char*)(unsigned char*)(F.lds + RING_OFF);
#ifndef NO_MODE0
    for (int u = F.vcu; u < 528; u += F.G) {
        unsigned long long w_ = (unsigned long long)F.ws; asm volatile("" : "+s"(w_)); unsigned char* ws = (unsigned char*)(GAS unsigned char*)w_;
        if (u < 512) { const int kvh = u >> 8, g = (u >> 6) & 3, qb = u & 63, head = kvh * 4 + g; const size_t qo = (size_t)(qb * 256) * 512 + head * 64, oo = (size_t)(qb * 256) * YPITCH + YC_D + head * 64;
            attn_body::attn_unit<8, 0>((const ab*)(ws + WS_QG) + qo, (const ab*)(ws + WS_KG) + kvh * 64, (const ab*)(ws + WS_P) + PC_GV + kvh * 64, (ab*)(ws + WS_YALL) + oo, MR / 64, 0, 0, 0, 0, 0.f, false, shm); }
        else { const int ty = (u - 512) >> 3, head = (u - 512) & 7, kvh = head >> 2; const size_t qo = (size_t)SEQ * 512 + head * 64, oo = (size_t)SEQ * YPITCH + (ty ? YC_C : YC_D) + head * 64;
            const float s2 = ty ? (AIN(I_SINK) + l * 8)[head] * LOG2E : 0.f;
            attn_body::attn_unit<8, 0>((const ab*)(ws + (ty ? WS_QS : WS_QG)) + qo, (const ab*)(ws + (ty ? WS_KS : WS_KG)) + (size_t)SEQ * 128 + kvh * 64, (const ab*)(ws + WS_P) + (ty ? PC_SV : PC_GV) + (size_t)SEQ * NP + kvh * 64,
                                       (ab*)(ws + WS_YALL) + oo, 4, 0, 0, 0, 0, s2, ty != 0, shm); }
    }
#endif
}
__device__ __forceinline__ void attn_swa(Frame& F, KArgs a, int l, int ubeg, int uend, int bfirst, int nb) {
    typedef attn_body::bf16 ab;
    char* shm = (char*)(unsigned char*)(F.lds + RING_OFF);
    if (F.vcu < bfirst || F.vcu >= bfirst + nb) return;
    for (int u = ubeg + F.vcu - bfirst; u < uend; u += nb) {
        unsigned long long w_ = (unsigned long long)F.ws; asm volatile("" : "+s"(w_)); unsigned char* ws = (unsigned char*)(GAS unsigned char*)w_;
        const int head = u >> 6, qb = u & 63, kvh = head >> 2, q0 = qb * 256; const int wlo = q0 - 128 < 0 ? 0 : q0 - 128, whi = q0 + 384 > SEQ ? SEQ : q0 + 384; const size_t qo = (size_t)q0 * 512 + head * 64, oo = (size_t)q0 * YPITCH + YC_C + head * 64;
        attn_body::attn_unit<8, 1>((const ab*)(ws + WS_QS) + qo, (const ab*)(ws + WS_KS) + kvh * 64, (const ab*)(ws + WS_P) + PC_SV + kvh * 64, (ab*)(ws + WS_YALL) + oo, 4 + (whi - wlo) / 64, 4, SEQ, wlo, q0, (AIN(I_SINK) + l * 8)[head] * LOG2E, true, shm);
    }
}
#ifndef MIXDUP
#define MIXDUP 0
#endif
__device__ __forceinline__ void mixers_phase(Frame& F0, KArgs a, int l) {
    for (int rep_ = 0; rep_ <= ((MIXDUP >> 0) & 1); ++rep_) { Frame F = fresh(F0); attn_all(F, a, l); __syncthreads(); }
    { Frame F = fresh(F0); attn_swa(F, a, l, SWA_EARLY, 512, 0, F.G); __syncthreads(); }
#if 0
    for (int rep_ = 0; rep_ <= ((MIXDUP >> 1) & 1); ++rep_) { Frame F = fresh(F0); for (int it = F.vcu; it < 256; it += F.G) attn_simple_item(F, a, l, 1, it >> 7, it & 127); __syncthreads(); }
#endif
    for (int rep_ = 0; rep_ <= ((MIXDUP >> 2) & 1); ++rep_) { Frame F = fresh(F0); s5_pass<true>(F, a, l); __syncthreads(); }
    for (int rep_ = 0; rep_ <= ((MIXDUP >> 3) & 1); ++rep_) { Frame F = fresh(F0); ssd_outputs(F, a, l); __syncthreads(); }
}
__device__ __forceinline__ void post_phase(Frame& F, KArgs a, int l) {
    const int gw = F.vcu * NWAVES + F.wave, NGW = F.G * NWAVES;
    const bf16* P = (const bf16*)(F.ws + WS_P); const bf16* YS = (const bf16*)(F.ws + WS_YS);
    bf16* YA = (bf16*)(F.ws + WS_YALL); const float* ng = AIN(I_SSDNG) + l * 768;
    for (int m = gw; m < MR; m += NGW) {
        float y[12]; float ss = 0.f;
#pragma unroll
        for (int j = 0; j < 3; ++j) { const int c = 4 * F.lane + 256 * j;
            const v2u yfw = *(const GAS v2u*)(YS + (size_t)m * 768 + c), ybw = *(const GAS v2u*)(YS + (size_t)(MR + m) * 768 + c); const f32x4 yf = {bflo(yfw.x), bfhi(yfw.x), bflo(yfw.y), bfhi(yfw.y)}, yb = {bflo(ybw.x), bfhi(ybw.x), bflo(ybw.y), bfhi(ybw.y)};
            const v2u zw = *(const GAS v2u*)(P + (size_t)m * NP + PC_Z + c);
            const float z[4] = {bflo(zw.x), bfhi(zw.x), bflo(zw.y), bfhi(zw.y)};
#pragma unroll
            for (int i = 0; i < 4; ++i) { const float t = (yf[i] + yb[i]) * silu_(z[i]); y[4 * j + i] = t; ss += t * t; } }
        const float rstd = 1.0f / sqrtf(wave_sum(ss, F.lane) * (1.0f / 768.0f) + 1e-6f);
#pragma unroll
        for (int j = 0; j < 3; ++j) { const int c = 4 * F.lane + 256 * j; const f32x4 gg = *(const f32x4*)(ng + c);
            v2u w; w.x = pk2(y[4 * j] * rstd * gg.x, y[4 * j + 1] * rstd * gg.y); w.y = pk2(y[4 * j + 2] * rstd * gg.z, y[4 * j + 3] * rstd * gg.w);
            *(GAS v2u*)(YA + (size_t)m * YPITCH + c) = w; }
    }
    const bf16* YBF = (const bf16*)(F.ws + WS_YBF); bf16* YBP = (bf16*)(F.ws + WS_YBP); const float* d5 = AIN(I_S5D) + l * 512;
    for (int i = F.vcu * 512 + F.tid; i < MR * 128; i += F.G * 512) {
        const int m = i >> 7, c = (i & 127) * 4;
        const v2u y0w = *(const GAS v2u*)(YBF + (size_t)m * 512 + c), y1w = *(const GAS v2u*)(YBF + (size_t)(MR + m) * 512 + c); const f32x4 y0 = {bflo(y0w.x), bfhi(y0w.x), bflo(y0w.y), bfhi(y0w.y)}, y1 = {bflo(y1w.x), bfhi(y1w.x), bflo(y1w.y), bfhi(y1w.y)}, dd = *(const f32x4*)(d5 + c);
        const v2u uw = *(const GAS v2u*)(P + (size_t)m * NP + PC_U + c); const float u[4] = {bflo(uw.x), bfhi(uw.x), bflo(uw.y), bfhi(uw.y)}; float r[4];
#pragma unroll
        for (int q = 0; q < 4; ++q) { const float x = y0[q] + y1[q] + dd[q] * u[q]; const float t = 0.7978845608028654f * (x + 0.044715f * x * x * x);
            const float th = 1.0f - 2.0f * __builtin_amdgcn_rcpf(1.0f + __builtin_amdgcn_exp2f(2.0f * LOG2E * t));
            r[q] = 0.5f * x * (1.0f + th); }
        v2u w; w.x = pk2(r[0], r[1]); w.y = pk2(r[2], r[3]); *(GAS v2u*)(YBP + (size_t)m * 512 + c) = w;
    }
}
#ifndef MK_PER_PHASE
#define MK_PER_PHASE 0
#endif
#ifndef REV_RES
#define REV_RES 1
#endif
#ifndef WGM_FFI
#define WGM_FFI 2
#endif
#ifndef WGM_WIN
#define WGM_WIN 2
#endif
#ifndef WGM_RES
#define WGM_RES 2
#endif
#ifndef WGM_MRG
#define WGM_MRG 2
#endif
constexpr int PH_PER_LAYER = 16, NPHASE = 2 + DEPTH * PH_PER_LAYER;
#ifndef GPA
#define GPA true
#endif
#ifndef GPS
#define GPS true
#endif
#ifndef GPAR
#define GPAR true
#endif
constexpr bool GP_ALIGN = GPA, GP_SP2 = GPS, GP_ALIGN_RESID = GPAR;
__global__ void __launch_bounds__(NWAVES * 64, 2) trunk_fwd(Args args) {
    extern __shared__ __attribute__((aligned(16))) unsigned char lds[];
    KArgs KA = (KArgs)__builtin_amdgcn_kernarg_segment_ptr();
    Frame F;
    F.lds = (LAS unsigned char*)lds;
    F.MISC = (volatile LAS unsigned*)(F.lds + MISC_OFF);
    F.tid = threadIdx.x; F.lane = F.tid & 63; F.wave = __builtin_amdgcn_readfirstlane(F.tid >> 6);
    F.G = gridDim.x; { const int bx = blockIdx.x; F.vcu = (F.G % 8 == 0) ? (bx % 8) * (F.G / 8) + bx / 8 : bx; }
    F.ws = (unsigned char*)(GAS unsigned char*)args.ws; F.ctl = (gu32*)(args.ws + WS_CTL);
    for (int u = F.tid; u < (LDS_BYTES - LDSCTL_OFF) / 4; u += NWAVES * 64) ((LAS unsigned*)(F.lds + LDSCTL_OFF))[u] = 0u;
    __syncthreads();
    XcdBarrier bar; bar.bar = (unsigned*)(F.ctl + CW_BAR); bar.x = 0; bar.st = nullptr;
    if (!MK_PER_PHASE) bar = xcd_barrier_post((unsigned*)(F.ctl + CW_BAR), F.MISC + 8);
    const int lo = args.ph_lo, hi = args.ph_hi;
#ifndef ONLY
#define ONLY -1
#endif
#define KON(i) (ONLY < 0 || ONLY == (i))
#ifndef DUPMASK
#define DUPMASK 0ull
#endif
#define DUPK(i) ((int)(((unsigned long long)(DUPMASK) >> (i)) & 1ull))
#define IN(k) (lo <= (k) && (k) < hi)
#define GEMM_PTRS() FRESH(); unsigned char* ws = Fp.ws; float* X = (float*)(ws + WS_X); bf16* H = (bf16*)(ws + WS_H); bf16* HID = (bf16*)(ws + WS_HID); bf16* P = (bf16*)(ws + WS_P); const bf16* WL = (const bf16*)(ws + WS_W) + (size_t)lp * WL_SIZE; \
    const float* modl = (const float*)(ws + WS_MOD) + (size_t)(lp * 2 + 0) * NMODV; const float* modc = (const float*)(ws + WS_MOD) + (size_t)(lp * 2 + 1) * NMODV; (void)X; (void)H; (void)HID; (void)P; (void)WL; (void)modl; (void)modc;
#define FRESH() Frame Fp = fresh(F); int lp = l; asm volatile("" : "+s"(lp));
#define SEAM(k) do { if (!MK_PER_PHASE && (k) + 1 < hi) xcd_barrier(bar); } while (0)
    PG8_LAS unsigned char* ring = (PG8_LAS unsigned char*)(F.lds + RING_OFF);

    if (KON(100) && IN(0)) { for (int rep_ = 0; rep_ <= DUPK(40); ++rep_) { if (rep_) xcd_barrier(bar); p0_prologue(F, KA); } SEAM(0); }
    if (KON(101) && IN(1)) { p1_modfinal(F, KA); SEAM(1); }
    for (int st = 0; st < 2 * DEPTH; ++st) {
        const int l = st >> 1, f = st & 1; const int pb = 2 + PH_PER_LAYER * l;
        if (f) {
            if (KON(3) && IN(pb + 3)) { FRESH(); norm_phase(Fp, KA, lp, 1, DFF / 512); SEAM(pb + 3); }
            if (KON(4) && IN(pb + 4)) { for (int rep_ = 0; rep_ <= DUPK(4); ++rep_) { if (rep_) xcd_barrier(bar); { GEMM_PTRS(); pg8::Gemm g{H, WL + WL_WIN, MR, NP, DM, DM}; pg8::StaticOrder S; S.init(MR, NP, Fp.G, (int)blockIdx.x, WGM_WIN); pg8::EpiWin E{P, NP, PC_GATE / 256, PC_GATE};
                pg8::gemm_phase<pg8::EpiWin, pg8::StaticOrder, GP_ALIGN, GP_SP2>(ring, g, S, E);
                if (HIDE_CONVERT) { convert_idle(Fp, KA, (int)blockIdx.x, (MR / 256) * (NP / 256) % Fp.G, lp, IT_GA + IT_GB, IT_GC + (lp == DEPTH - 1 ? IT_GD : IT_GD / 2)); }    dt_gemm(Fp, lp, (int)blockIdx.x, (MR / 256) * (NP / 256) % Fp.G); } } SEAM(pb + 4); }
            if (KON(5) && IN(pb + 5)) { for (int rep_ = 0; rep_ <= DUPK(5); ++rep_) { if (rep_) xcd_barrier(bar); { FRESH(); prep_phase(Fp, KA, lp); __syncthreads(); for (int r2_ = 0; r2_ <= ((PREPDUP >> 2) & 1); ++r2_) s5_pass<false>(Fp, KA, lp); } } SEAM(pb + 5); }
            if (KON(6) && IN(pb + 6)) { for (int rep_ = 0; rep_ <= DUPK(6); ++rep_) { if (rep_) xcd_barrier(bar); { { FRESH(); ssd_states(Fp, KA, lp); } } } SEAM(pb + 6); }
            if (KON(7) && IN(pb + 7)) { for (int rep_ = 0; rep_ <= DUPK(7); ++rep_) { if (rep_) xcd_barrier(bar); { { FRESH(); s5_carry(Fp, KA, lp, 96 * NWAVES); } { FRESH(); ssd_carry(Fp); } if (SWA_EARLY > 0) { FRESH(); attn_swa(Fp, KA, lp, 0, SWA_EARLY, 104, Fp.G - 104); } } } SEAM(pb + 7); }
            if (KON(8) && IN(pb + 8)) { for (int rep_ = 0; rep_ <= DUPK(8); ++rep_) { if (rep_) xcd_barrier(bar); { FRESH(); mixers_phase(Fp, KA, lp); } } SEAM(pb + 8); }
            if (KON(9) && IN(pb + 9)) { for (int rep_ = 0; rep_ <= DUPK(9); ++rep_) { if (rep_) xcd_barrier(bar); { FRESH(); post_phase(Fp, KA, lp); } } SEAM(pb + 9); }
            if (KON(10) && IN(pb + 10)) { for (int rep_ = 0; rep_ <= DUPK(10); ++rep_) { if (rep_) xcd_barrier(bar); { GEMM_PTRS(); const int Mq = (lp == DEPTH - 1) ? SEQ : MR; pg8::Gemm g{(const bf16*)(ws + WS_YBP), WL + WL_GLU, Mq, 1024, 512, 512}; pg8::StaticOrder S; S.init(Mq, 1024, Fp.G, (int)blockIdx.x);
                pg8::EpiGated<1> E{(bf16*)(ws + WS_YALL) + YC_B, YPITCH, ((const float*)(const GAS float*)KA->in[I_GLUB]) + (size_t)lp * 1024, 512};
                pg8::gemm_phase<pg8::EpiGated<1>, pg8::StaticOrder, GP_ALIGN, GP_SP2>(ring, g, S, E); } } SEAM(pb + 10); }
            if (KON(11) && IN(pb + 11)) { for (int rep_ = 0; rep_ <= DUPK(11); ++rep_) { if (rep_) xcd_barrier(bar); { GEMM_PTRS(); const int Mq = (lp == DEPTH - 1) ? SEQ : MR;
                pg8::Gemm g{(const bf16*)(ws + WS_YALL), WL + WL_BRALL, Mq, DM, YPITCH, YPITCH}; pg8::MergeOrder S; S.so.init(Mq, DM, Fp.G, (int)blockIdx.x, WGM_MRG); pg8::EpiMergeR E{P + PC_GATE, NP, (bf16*)(ws + WS_MG)};
                pg8::gemm_phase<pg8::EpiMergeR, pg8::MergeOrder, GP_ALIGN, GP_SP2>(ring, g, S, E);
                if (HIDE_CONVERT && lp < DEPTH - 1) { const int rem = (MR / 256) * (DM / 256) % Fp.G; convert_idle(Fp, KA, (int)blockIdx.x, rem, lp, IT_LAYER - IT_GD / 2, IT_GD / 2); convert_idle(Fp, KA, (int)blockIdx.x, rem, lp + 1, 0, IT_GA / 2); } } } SEAM(pb + 11); }
            if (KON(12) && IN(pb + 12)) { for (int rep_ = 0; rep_ <= DUPK(12); ++rep_) { if (rep_) xcd_barrier(bar); { GEMM_PTRS();
                { pg8::Gemm g{(const bf16*)(ws + WS_MG), WL + WL_OUT, SEQ, DM, DM, DM}; pg8::StaticOrder S; S.init(SEQ, DM, Fp.G, (int)blockIdx.x, WGM_RES, REV_RES); pg8::EpiResid E{X, (rep_ < DUPK(12)) ? (float*)(ws + WS_MGF) : X, X, modl + 5 * DM, modc + 5 * DM, 1.0f, SEQ / 256};
                  pg8::gemm_phase<pg8::EpiResid, pg8::StaticOrder, GP_ALIGN_RESID, GP_SP2>(ring, g, S, E); }
                if (lp < DEPTH - 1) { pg8::Gemm g{(const bf16*)(ws + WS_MG), WL + WL_OUT, MR, DM, 512, DM}; pg8::SplitKOrder S{SEQ / 256, DM / 256, DM / 512, Fp.G, (int)blockIdx.x}; pg8::EpiPartial E{(float*)(ws + WS_PART), modc + 5 * DM, 1.0f};
                  pg8::gemm_phase<pg8::EpiPartial, pg8::SplitKOrder, GP_ALIGN, GP_SP2>(ring, g, S, E); }
                } } SEAM(pb + 12); }
        }
        const int pf = pb + (f ? 13 : 0); const bool no_ctx = (f == 1 && l == DEPTH - 1);
        if (KON(0) && IN(pf + 0)) { FRESH(); int fp = f; asm volatile("" : "+s"(fp)); norm_phase(Fp, KA, lp, 2 * fp, fp ? (lp < DEPTH - 1 ? DM / 512 : 0) : (lp > 0 ? DFF / 512 : 0)); SEAM(pf + 0); }
        if (KON(1) && IN(pf + 1)) { GEMM_PTRS(); int fp = f; asm volatile("" : "+s"(fp)); const int Mq = no_ctx ? SEQ : MR;
            pg8::Gemm g{H, WL + WL_FFI + (size_t)fp * NFF * DM, Mq, NFF, DM, DM}; pg8::StaticOrder S; S.init(Mq, NFF, Fp.G, (int)blockIdx.x, WGM_FFI); pg8::EpiGated<0> E{HID, DFF, nullptr, 0};
            pg8::gemm_phase<pg8::EpiGated<0>, pg8::StaticOrder, GP_ALIGN, GP_SP2>(ring, g, S, E); SEAM(pf + 1); }
        if (KON(2) && IN(pf + 2)) { GEMM_PTRS(); int fp = f; asm volatile("" : "+s"(fp)); const bf16* Wo = WL + WL_FFO + (size_t)fp * DM * DFF; const int gs = (2 + 6 * fp) * DM;
            { pg8::Gemm g{HID, Wo, SEQ, DM, DFF, DFF}; pg8::StaticOrder S; S.init(SEQ, DM, Fp.G, (int)blockIdx.x, WGM_RES, REV_RES);
              pg8::EpiResid E{X, (fp == 1 && lp == DEPTH - 1) ? (float*)KA->out : X, X, modl + gs, modc + gs, 0.5f, SEQ / 256};
              pg8::gemm_phase<pg8::EpiResid, pg8::StaticOrder, GP_ALIGN_RESID, GP_SP2>(ring, g, S, E); }
            if (!no_ctx) { pg8::Gemm g{HID, Wo, MR, DM, 512, DFF}; pg8::SplitKOrder S{SEQ / 256, DM / 256, DFF / 512, Fp.G, (int)blockIdx.x}; pg8::EpiPartial E{(float*)(ws + WS_PART), modc + gs, 0.5f};
              pg8::gemm_phase<pg8::EpiPartial, pg8::SplitKOrder, GP_ALIGN, GP_SP2>(ring, g, S, E); }
            SEAM(pf + 2); }
    }
#undef IN
#undef SEAM
}

extern "C" void kernel_launch(void* const* d_in, const int* in_sizes, int n_in, void* d_out, int out_size, void* d_ws, size_t ws_size, hipStream_t stream) {
    static int grid = 0;
    if (grid == 0) {
        if (n_in != N_IN || out_size != SEQ * DM || ws_size < WS_END) { fprintf(stderr, "kernel_launch: built for %d inputs, %d outputs, >= %zu bytes of workspace; got n_in %d, out %d, ws %zu; nothing launched\n", N_IN, SEQ * DM, (size_t)WS_END, n_in, out_size, ws_size); grid = -1; return; }
        int dev = 0, cus = 0, per_cu = 0;
        if (hipGetDevice(&dev) != hipSuccess || hipDeviceGetAttribute(&cus, hipDeviceAttributeMultiprocessorCount, dev) != hipSuccess) { fprintf(stderr, "kernel_launch: hipGetDevice / hipDeviceGetAttribute failed\n"); grid = -1; return; }
        if (hipFuncSetAttribute((const void*)trunk_fwd, hipFuncAttributeMaxDynamicSharedMemorySize, LDS_BYTES) != hipSuccess) { fprintf(stderr, "kernel_launch: hipFuncSetAttribute failed\n"); grid = -1; return; }
        if (hipOccupancyMaxActiveBlocksPerMultiprocessor(&per_cu, (const void*)trunk_fwd, NWAVES * 64, LDS_BYTES) != hipSuccess || per_cu < 1)
            fprintf(stderr, "kernel_launch: note: occupancy query reports %d workgroups per CU\n", per_cu);
        (void)hipGetLastError();
        grid = cus;
        if (grid % 8 != 0 || grid < 8) { fprintf(stderr, "kernel_launch: unexpected CU count %d\n", cus); }
    }
    if (grid < 0) return;
    if (hipMemsetAsync((char*)d_ws + WS_CTL, 0, CTL_ZERO_BYTES, stream) != hipSuccess) { fprintf(stderr, "kernel_launch: hipMemsetAsync failed\n"); return; }
    Args a{};
    for (int i = 0; i < N_IN; ++i) a.in[i] = (const float*)d_in[i];
    a.out = (float*)d_out; a.ws = (unsigned char*)d_ws;
#if MK_PER_PHASE
    for (int k = 0; k < NPHASE; ++k) { a.ph_lo = k; a.ph_hi = k + 1; hipLaunchKernelGGL(trunk_fwd, dim3(grid), dim3(NWAVES * 64), LDS_BYTES, stream, a); }
#else
    a.ph_lo = 0; a.ph_hi = NPHASE;
    hipLaunchKernelGGL(trunk_fwd, dim3(grid), dim3(NWAVES * 64), LDS_BYTES, stream, a);
#endif
    const hipError_t le = hipPeekAtLastError();
    if (le != hipSuccess) fprintf(stderr, "kernel_launch: launch failed: %s\n", hipGetErrorName(le));
}
```

```cpp
#include <hip/hip_runtime.h>
#include <cstdio>
#include <cstdint>
#ifndef WGM_SEL
#define WGM_SEL 2
#endif
namespace pg8 {
#define PG8_LAS __attribute__((address_space(3)))
typedef unsigned short bf16_t;
typedef short bf16x8 __attribute__((ext_vector_type(8)));
typedef float f32x4 __attribute__((ext_vector_type(4)));
typedef unsigned u32x4 __attribute__((ext_vector_type(4)));
constexpr int BM = 256, BK = 64, HALF = 128, HTB = HALF * BK * 2  , STAGE_BYTES = 8 * HTB, NXCD = 8, WGM = WGM_SEL;

__host__ __device__ __forceinline__ int lds_byte(int r, int c) { const int st = (r >> 4) * 2 + (c >> 5), rr = r & 15, cc = c & 31, ob = rr * 64 + cc * 2; return st * 1024 + (ob ^ (((ob >> 9) & 1) << 5)); }
__host__ __device__ __forceinline__ void stage_rc(int b, int& R, int& C) { const int st = b / 1024, sb = b % 1024, swz = sb ^ (((sb >> 9) & 1) << 5); R = (st >> 1) * 16 + swz / 64; C = (st & 1) * 32 + (swz % 64) / 2; }
__host__ __device__ __forceinline__ int perm32(int rho) { const int n = rho >> 4, i = rho & 15; return 8 * (i >> 2) + 4 * n + (i & 3); }

struct Unit { int pm, pn, ks, kofs, nt, seg; };
struct Gemm { const bf16_t* A; const bf16_t* Bt; int M, N, K, ld; };

struct StaticOrder {
    int nM, nN, nwg, G, c, wgm, rev;
    __host__ __device__ void init(int M, int N, int G_, int c_, int wgm_ = WGM, int rev_ = 0) { nM = M / BM; nN = N / BM; nwg = nM * nN; G = G_; c = c_; wgm = wgm_; rev = rev_; }
    __host__ __device__ bool next(int i, Unit& u) const {
        const long L = (long)i * G + c; if (L >= nwg) return false;
        int wgid = (int)L; { const int q = nwg / NXCD, r = nwg % NXCD, xcd = wgid % NXCD, off = wgid / NXCD; wgid = (xcd < r ? xcd * (q + 1) : r * (q + 1) + (xcd - r) * q) + off; }
        const int nig = wgm * nN, gid = wgid / nig, fm = gid * wgm, gsz = (nM - fm) < wgm ? (nM - fm) : wgm;
        u.pm = fm + ((wgid % nig) % gsz); if (rev) u.pm = nM - 1 - u.pm; u.pn = (wgid % nig) / gsz; u.ks = 0; u.kofs = 0; u.nt = 0; u.seg = 0; return true;
    }
    __device__ __forceinline__ void a_ready(const Unit&) const {}
    __device__ __forceinline__ void done(const Unit&) const {}
};
struct SplitKOrder {
    int pm, nN, nS, G, c;
    __device__ __forceinline__ bool next(int i, Unit& u) const { const int L = i * G + c; if (L >= nN * nS) return false; u.pm = pm; u.pn = L % nN; u.ks = L / nN; u.kofs = 0; u.nt = 0; u.seg = 0; return true; }
    __device__ __forceinline__ void a_ready(const Unit&) const {}
    __device__ __forceinline__ void done(const Unit&) const {}
};
struct MergeOrder {
    StaticOrder so;
    __device__ __forceinline__ bool next(int i, Unit& u) const { if (!so.next(i >> 2, u)) return false; const int s = i & 3; u.seg = s; u.kofs = s ? 256 + 512 * s : 0; u.nt = s ? 8 : 12; return true; }
    __device__ __forceinline__ void a_ready(const Unit&) const {}
    __device__ __forceinline__ void done(const Unit&) const {}
};
__device__ __forceinline__ unsigned cvt_pk_bf16(float lo, float hi) { unsigned r; asm volatile("v_cvt_pk_bf16_f32 %0, %1, %2" : "=v"(r) : "v"(lo), "v"(hi)); return r; }
typedef float f32x2 __attribute__((ext_vector_type(2)));
__device__ __forceinline__ float sigm(float x) { return __builtin_amdgcn_rcpf(1.0f + __builtin_amdgcn_exp2f(-1.4426950408889634f * x)); }
__device__ __forceinline__ float silu(float x) { return x * sigm(x); }
__device__ __forceinline__ float bf2f(unsigned short h) { return __uint_as_float(((unsigned)h) << 16); }
typedef unsigned u32x2 __attribute__((ext_vector_type(2)));

struct EpiBf16 {
    static constexpr bool PERM = true, AFTER_DRAIN = false, KEEP_ACC = false;
    bf16_t* O; int ldc;
    __device__ __forceinline__ void operator()(const f32x4 (&acc)[2][2][4][2], const Unit& u, int wr, int wc, int fr, int fq) const {
        const int row0 = u.pm * BM + wr * 64 + fr; const int col0 = u.pn * BM + wc * 32 + 8 * fq;
#pragma unroll
        for (int ai = 0; ai < 2; ++ai)
#pragma unroll
            for (int m = 0; m < 4; ++m) { bf16_t* rowp = O + (size_t)(row0 + ai * HALF + m * 16) * ldc + col0;
#pragma unroll
                for (int bj = 0; bj < 2; ++bj) { const f32x4 v0 = acc[ai][bj][m][0], v1 = acc[ai][bj][m][1];
                    u32x4 w; w.x = cvt_pk_bf16(v0[0], v0[1]); w.y = cvt_pk_bf16(v0[2], v0[3]); w.z = cvt_pk_bf16(v1[0], v1[1]); w.w = cvt_pk_bf16(v1[2], v1[3]);
                    *(u32x4*)(rowp + bj * HALF) = w; } }
    }
};
template <int MODE> struct EpiGated {
    static constexpr bool PERM = true, AFTER_DRAIN = false, KEEP_ACC = false;
    bf16_t* O; int ldo; const float* bias; int half;
    __device__ __forceinline__ void operator()(const f32x4 (&acc)[2][2][4][2], const Unit& u, int wr, int wc, int fr, int fq) const {
        const int row0 = u.pm * BM + wr * 64 + fr; const int col0 = u.pn * HALF + wc * 32 + 8 * fq;
        f32x4 ba[2], bb[2];
#pragma unroll
        for (int n = 0; n < 2; ++n) { if (MODE == 1) { ba[n] = *(const f32x4*)(bias + col0 + 4 * n); bb[n] = *(const f32x4*)(bias + half + col0 + 4 * n); } else { ba[n] = (f32x4){0.f, 0.f, 0.f, 0.f}; bb[n] = ba[n]; } }
#pragma unroll
        for (int ai = 0; ai < 2; ++ai)
#pragma unroll
            for (int m = 0; m < 4; ++m) { bf16_t* rowp = O + (size_t)(row0 + ai * HALF + m * 16) * ldo + col0;
                float r[8];
#pragma unroll
                for (int n = 0; n < 2; ++n)
#pragma unroll
                    for (int i = 0; i < 4; ++i) { const float a = acc[ai][0][m][n][i] + ba[n][i], b = acc[ai][1][m][n][i] + bb[n][i]; r[4 * n + i] = (MODE == 0) ? silu(a) * b : a * sigm(b); }
                u32x4 w; w.x = cvt_pk_bf16(r[0], r[1]); w.y = cvt_pk_bf16(r[2], r[3]); w.z = cvt_pk_bf16(r[4], r[5]); w.w = cvt_pk_bf16(r[6], r[7]);
                *(u32x4*)rowp = w; }
    }
};
struct EpiResid {
    static constexpr bool PERM = false, AFTER_DRAIN = false, KEEP_ACC = false;
    const float* base; float* out_lat; float* out_ctx; const float* gate_lat; const float* gate_ctx; float coef; int ctx_pm;
    __device__ __forceinline__ void operator()(const f32x4 (&acc)[2][2][4][2], const Unit& u, int wr, int wc, int fr, int fq) const {
        const bool isctx = u.pm >= ctx_pm; const float* g = isctx ? gate_ctx : gate_lat; float* o = isctx ? out_ctx : out_lat;
        const int row0 = u.pm * BM + wr * 64 + fr, col0 = u.pn * BM + wc * 32 + 4 * fq;
        f32x4 gv[2][2];
#pragma unroll
        for (int bj = 0; bj < 2; ++bj)
#pragma unroll
            for (int n = 0; n < 2; ++n) gv[bj][n] = *(const f32x4*)(g + col0 + bj * HALF + n * 16) * coef;
#pragma unroll
        for (int ai = 0; ai < 2; ++ai)
#pragma unroll
            for (int mp = 0; mp < 2; ++mp) { f32x4 bv[2][2][2];
#pragma unroll
                for (int mm = 0; mm < 2; ++mm) { const size_t off = (size_t)(row0 + ai * HALF + (2 * mp + mm) * 16) * 2048 + col0;
#pragma unroll
                    for (int bj = 0; bj < 2; ++bj)
#pragma unroll
                        for (int n = 0; n < 2; ++n) bv[mm][bj][n] = *(const f32x4*)(base + off + bj * HALF + n * 16); }
                asm volatile("" ::: "memory");
#pragma unroll
                for (int mm = 0; mm < 2; ++mm) { const size_t off = (size_t)(row0 + ai * HALF + (2 * mp + mm) * 16) * 2048 + col0;
#pragma unroll
                    for (int bj = 0; bj < 2; ++bj)
#pragma unroll
                        for (int n = 0; n < 2; ++n) *(f32x4*)(o + off + bj * HALF + n * 16) = bv[mm][bj][n] + gv[bj][n] * acc[ai][bj][2 * mp + mm][n]; }
                asm volatile("" ::: "memory"); }
    }
};
template <int MODE> struct EpiMerge {
    static constexpr bool PERM = false, AFTER_DRAIN = false, KEEP_ACC = false;
    const bf16_t* G; int ldg; float* F; bf16_t* O;
    __device__ __forceinline__ void operator()(const f32x4 (&acc)[2][2][4][2], const Unit& u, int wr, int wc, int fr, int fq) const {
        const int row0 = u.pm * BM + wr * 64 + fr, col0 = u.pn * BM + wc * 32 + 4 * fq;
#pragma unroll
        for (int ai = 0; ai < 2; ++ai)
#pragma unroll
            for (int m = 0; m < 4; ++m) { const size_t r = (size_t)(row0 + ai * HALF + m * 16);
#pragma unroll
                for (int bj = 0; bj < 2; ++bj)
#pragma unroll
                    for (int n = 0; n < 2; ++n) { const int c = col0 + bj * HALF + n * 16;
                        const u32x2 gw = *(const u32x2*)(G + r * ldg + c);
                        f32x4 t; t[0] = sigm(__uint_as_float(gw.x << 16)); t[1] = sigm(__uint_as_float(gw.x & 0xffff0000u)); t[2] = sigm(__uint_as_float(gw.y << 16)); t[3] = sigm(__uint_as_float(gw.y & 0xffff0000u));
                        t = t * acc[ai][bj][m][n];
                        if (MODE >= 1) t = t + *(const f32x4*)(F + r * 2048 + c);
                        if (MODE <= 1) *(f32x4*)(F + r * 2048 + c) = t;
                        else { u32x2 w; w.x = cvt_pk_bf16(t[0], t[1]); w.y = cvt_pk_bf16(t[2], t[3]); *(u32x2*)(O + r * 2048 + c) = w; } } }
    }
};
struct EpiPartial {
    static constexpr bool PERM = false, AFTER_DRAIN = false, KEEP_ACC = false;
    float* part; const float* gate; float coef;
    __device__ __forceinline__ void operator()(const f32x4 (&acc)[2][2][4][2], const Unit& u, int wr, int wc, int fr, int fq) const {
        const int row0 = u.ks * BM + wr * 64 + fr, col0 = u.pn * BM + wc * 32 + 4 * fq;
        f32x4 gv[2][2];
#pragma unroll
        for (int bj = 0; bj < 2; ++bj)
#pragma unroll
            for (int n = 0; n < 2; ++n) gv[bj][n] = *(const f32x4*)(gate + col0 + bj * HALF + n * 16) * coef;
#pragma unroll
        for (int ai = 0; ai < 2; ++ai)
#pragma unroll
            for (int m = 0; m < 4; ++m) { const size_t off = (size_t)(row0 + ai * HALF + m * 16) * 2048 + col0;
#pragma unroll
                for (int bj = 0; bj < 2; ++bj)
#pragma unroll
                    for (int n = 0; n < 2; ++n) *(f32x4*)(part + off + bj * HALF + n * 16) = gv[bj][n] * acc[ai][bj][m][n]; }
    }
};
struct EpiMergeR {
    static constexpr bool PERM = false, AFTER_DRAIN = false, KEEP_ACC = true;
    const bf16_t* G; int ldg; bf16_t* O;
    __device__ __forceinline__ bool zero_after(const Unit& u) const { return u.seg == 3; }
    __device__ __forceinline__ void operator()(f32x4 (&acc)[2][2][4][2], const Unit& u, int wr, int wc, int fr, int fq) const {
        const int row0 = u.pm * BM + wr * 64 + fr, col0 = u.pn * BM + wc * 32 + 4 * fq; const bf16_t* Gs = G + 2048 * u.seg + u.pn * BM + 64 * wc + 16 * fq; const bool fin = u.seg == 3;
#pragma unroll
        for (int ai = 0; ai < 2; ++ai)
#pragma unroll
            for (int m = 0; m < 4; ++m) { const size_t r = (size_t)(row0 + ai * HALF + m * 16);
                const u32x4 w0 = *(const u32x4*)(Gs + r * ldg), w1 = *(const u32x4*)(Gs + r * ldg + 8);
                acc[ai][0][m][0] = acc[ai][0][m][0] * (f32x4){__uint_as_float(w0.x << 16), __uint_as_float(w0.x & 0xffff0000u), __uint_as_float(w0.y << 16), __uint_as_float(w0.y & 0xffff0000u)};
                acc[ai][0][m][1] = acc[ai][0][m][1] * (f32x4){__uint_as_float(w0.z << 16), __uint_as_float(w0.z & 0xffff0000u), __uint_as_float(w0.w << 16), __uint_as_float(w0.w & 0xffff0000u)};
                acc[ai][1][m][0] = acc[ai][1][m][0] * (f32x4){__uint_as_float(w1.x << 16), __uint_as_float(w1.x & 0xffff0000u), __uint_as_float(w1.y << 16), __uint_as_float(w1.y & 0xffff0000u)};
                acc[ai][1][m][1] = acc[ai][1][m][1] * (f32x4){__uint_as_float(w1.z << 16), __uint_as_float(w1.z & 0xffff0000u), __uint_as_float(w1.w << 16), __uint_as_float(w1.w & 0xffff0000u)};
                if (fin) {
#pragma unroll
                    for (int bj = 0; bj < 2; ++bj)
#pragma unroll
                        for (int n = 0; n < 2; ++n) { const f32x4 t = acc[ai][bj][m][n]; u32x2 w; w.x = cvt_pk_bf16(t[0], t[1]); w.y = cvt_pk_bf16(t[2], t[3]); *(u32x2*)(O + r * 2048 + col0 + bj * HALF + n * 16) = w; } } }
    }
};
struct EpiWin {
    static constexpr bool PERM = true, AFTER_DRAIN = false, KEEP_ACC = false;
    bf16_t* O; int ldc; int gate_pn; int gate0;
    __device__ __forceinline__ void operator()(const f32x4 (&acc)[2][2][4][2], const Unit& u, int wr, int wc, int fr, int fq) const {
        const int row0 = u.pm * BM + wr * 64 + fr;
        if (u.pn < gate_pn) { const int col0 = u.pn * BM + wc * 32 + 8 * fq;
#pragma unroll
            for (int ai = 0; ai < 2; ++ai)
#pragma unroll
                for (int m = 0; m < 4; ++m) { bf16_t* rowp = O + (size_t)(row0 + ai * HALF + m * 16) * ldc + col0;
#pragma unroll
                    for (int bj = 0; bj < 2; ++bj) { const f32x4 v0 = acc[ai][bj][m][0], v1 = acc[ai][bj][m][1];
                        u32x4 w; w.x = cvt_pk_bf16(v0[0], v0[1]); w.y = cvt_pk_bf16(v0[2], v0[3]); w.z = cvt_pk_bf16(v1[0], v1[1]); w.w = cvt_pk_bf16(v1[2], v1[3]);
                        *(u32x4*)(rowp + bj * HALF) = w; } }
        } else {
            const int c = 64 * (u.pn - gate_pn) + 16 * wc + 4 * fq;
            const int sg = (c & ~255) + 64 * ((c >> 5) & 3) + 16 * ((c >> 2) & 3) + 8 * ((c >> 7) & 1) + 4 * ((c >> 4) & 1);
#pragma unroll
            for (int ai = 0; ai < 2; ++ai)
#pragma unroll
                for (int m = 0; m < 4; ++m) { bf16_t* rowp = O + (size_t)(row0 + ai * HALF + m * 16) * ldc + gate0 + sg;
                    f32x4 d[4];
#pragma unroll
                    for (int b = 0; b < 4; ++b)
#pragma unroll
                        for (int i = 0; i < 4; ++i) d[b][i] = 1.0f + __builtin_amdgcn_exp2f(-1.4426950408889634f * fminf(fmaxf(acc[ai][b >> 1][m][b & 1][i], -30.0f), 30.0f));
#pragma unroll
                    for (int s = 0; s < 4; ++s) { f32x4 rr;
#pragma unroll
                        for (int i = 0; i < 4; ++i) rr[i] = (s < 3 ? d[s < 3 ? s + 1 : 3][i] : 1.0f) * __builtin_amdgcn_rcpf(d[s][i]);
                        u32x2 w; w.x = cvt_pk_bf16(rr[0], rr[1]); w.y = cvt_pk_bf16(rr[2], rr[3]); *(u32x2*)(rowp + 2048 * s) = w; } }
        }
    }
};
#ifndef PG8_AUX_A
#define PG8_AUX_A 0
#endif
#ifndef PG8_AUX_B
#define PG8_AUX_B 0
#endif
template <class Epi, class Sched, bool ALIGN_EPI = false, bool SP2 = false>
__device__ __forceinline__ void gemm_phase(PG8_LAS unsigned char* lds, const Gemm g, const Sched& S, const Epi& E) {
    int tid_ = threadIdx.x; asm volatile("" : "+v"(tid_)); const int tid = tid_, wid = __builtin_amdgcn_readfirstlane(tid >> 6), lane = tid & 63, wr = wid >> 2, wc = wid & 3, fr = lane & 15, fq = lane >> 4;
    const int K = g.ld, nt = g.K / BK;
    unsigned voffA[2], voffB[2];
#pragma unroll
    for (int i = 0; i < 2; ++i) { int R, C; stage_rc(tid * 16 + i * 8192, R, C); const int Rb = Epi::PERM ? ((R & ~31) + perm32(R & 31)) : R;
        voffA[i] = (unsigned)(R * K + C) * 2u; voffB[i] = (unsigned)(Rb * K + C) * 2u; }
    const size_t kstep = (size_t)(BK * 2);
    const size_t hstep = (size_t)HALF * K * 2;
    const size_t tstep = 2 * hstep;
    const unsigned ldsw = (unsigned)wid * 1024u;
    const int aoff = lds_byte(wr * 64 + fr, fq * 8), boff = lds_byte(wc * 32 + fr, fq * 8);
#define PG8_SA(b, h) (((b) * 2 + (h)) * HTB)
#define PG8_SB(b, h) ((4 + (b) * 2 + (h)) * HTB)
#define PG8_STAGE(bufoff, gbase, voff) do { _Pragma("unroll") for (int _i = 0; _i < 2; ++_i) \
        __builtin_amdgcn_global_load_lds((const unsigned*)((const char*)(gbase) + (voff)[_i]), (PG8_LAS unsigned*)(lds + (bufoff) + ldsw + _i * 8192), 16, 0, PG8_AUX_A); } while (0)
#define PG8_STAGEB(bufoff, gbase, voff) do { _Pragma("unroll") for (int _i = 0; _i < 2; ++_i) \
        __builtin_amdgcn_global_load_lds((const unsigned*)((const char*)(gbase) + (voff)[_i]), (PG8_LAS unsigned*)(lds + (bufoff) + ldsw + _i * 8192), 16, 0, PG8_AUX_B); } while (0)
#define PG8_LDA(dst, b, h) do { _Pragma("unroll") for (int m = 0; m < 4; ++m) _Pragma("unroll") for (int k = 0; k < 2; ++k) dst[m][k] = *(const PG8_LAS bf16x8*)(lds + PG8_SA(b, h) + aoff + m * 2048 + k * 1024); } while (0)
#define PG8_LDB(dst, b, h) do { _Pragma("unroll") for (int n = 0; n < 2; ++n) _Pragma("unroll") for (int k = 0; k < 2; ++k) dst[n][k] = *(const PG8_LAS bf16x8*)(lds + PG8_SB(b, h) + boff + n * 2048 + k * 1024); } while (0)
#define PG8_MMA(ai, bj, At, Bt) do { __builtin_amdgcn_s_setprio(1); _Pragma("unroll") for (int m = 0; m < 4; ++m) _Pragma("unroll") for (int n = 0; n < 2; ++n) _Pragma("unroll") for (int k = 0; k < 2; ++k) \
        acc[ai][bj][m][n] = __builtin_amdgcn_mfma_f32_16x16x32_bf16(Bt[n][k], At[m][k], acc[ai][bj][m][n], 0, 0, 0); __builtin_amdgcn_s_setprio(0); } while (0)
#define PG8_WAIT_V(n) asm volatile("s_waitcnt vmcnt(" #n ")" ::: "memory")
#define PG8_WAIT_L(n) asm volatile("s_waitcnt lgkmcnt(" #n ")" ::: "memory")
#define PG8_BAR __builtin_amdgcn_s_barrier()
#define PG8_SCHED __builtin_amdgcn_sched_barrier(0)
    Unit cur, nxt; int ui = 0;
    if (!S.next(0, cur)) return;
    f32x4 acc[2][2][4][2];
#pragma unroll
    for (int a = 0; a < 2; ++a)
#pragma unroll
        for (int b = 0; b < 2; ++b)
#pragma unroll
            for (int m = 0; m < 4; ++m)
#pragma unroll
                for (int n = 0; n < 2; ++n) acc[a][b][m][n] = (f32x4){0.f, 0.f, 0.f, 0.f};
    bf16x8 At[4][2], B0[2][2], B1[2][2];
    const size_t kslice = (size_t)g.K * 2;
    const char* cA = (const char*)g.A + (size_t)cur.pm * tstep + (size_t)cur.ks * kslice + (size_t)cur.kofs * 2; const char* cB = (const char*)g.Bt + (size_t)cur.pn * tstep + (size_t)cur.ks * kslice + (size_t)cur.kofs * 2;
    S.a_ready(cur);
    if constexpr (SP2) {
        PG8_STAGEB(PG8_SB(0, 0), cB, voffB); PG8_STAGEB(PG8_SB(0, 1), cB + hstep, voffB); PG8_STAGE(PG8_SA(0, 0), cA, voffA); PG8_STAGE(PG8_SA(0, 1), cA + hstep, voffA);
        if (wr == 1) PG8_BAR;
        PG8_WAIT_V(2); PG8_BAR;
        PG8_STAGEB(PG8_SB(1, 0), cB + kstep, voffB); PG8_STAGE(PG8_SA(1, 0), cA + kstep, voffA); PG8_STAGEB(PG8_SB(1, 1), cB + hstep + kstep, voffB);
        PG8_WAIT_V(6); PG8_BAR;
    } else {
        PG8_STAGEB(PG8_SB(0, 0), cB, voffB); PG8_STAGE(PG8_SA(0, 0), cA, voffA); PG8_STAGEB(PG8_SB(0, 1), cB + hstep, voffB); PG8_STAGE(PG8_SA(0, 1), cA + hstep, voffA);
        if (wr == 1) PG8_BAR;
        PG8_WAIT_V(4); PG8_BAR;
        PG8_STAGEB(PG8_SB(1, 0), cB + kstep, voffB); PG8_STAGE(PG8_SA(1, 0), cA + kstep, voffA); PG8_STAGEB(PG8_SB(1, 1), cB + hstep + kstep, voffB);
        PG8_WAIT_V(6); PG8_BAR;
    }
    for (;;) {
        const bool has_next = S.next(ui + 1, nxt);
        const char* nA = has_next ? (const char*)g.A + (size_t)nxt.pm * tstep + (size_t)nxt.ks * kslice + (size_t)nxt.kofs * 2 : cA; const char* nB = has_next ? (const char*)g.Bt + (size_t)nxt.pn * tstep + (size_t)nxt.ks * kslice + (size_t)nxt.kofs * 2 : cB;
        const int nt_u = cur.nt ? cur.nt : nt;
        for (int t = 0; t < nt_u; t += 2) {
            const bool last = (t == nt_u - 2);
            const char* a1 = cA + (size_t)(t + 1) * kstep;
            const char* a2 = last ? nA : cA + (size_t)(t + 2) * kstep; const char* b2 = last ? nB : cB + (size_t)(t + 2) * kstep;
            const char* a3 = a2 + kstep; const char* b3 = b2 + kstep;
            if (last && has_next) S.a_ready(nxt);
            if constexpr (SP2) {
            PG8_LDB(B0, 0, 0); PG8_LDB(B1, 0, 1); PG8_SCHED; PG8_LDA(At, 0, 0); PG8_STAGE(PG8_SA(1, 1), a1 + hstep, voffA);
            PG8_WAIT_V(8); PG8_WAIT_L(0); PG8_BAR; PG8_MMA(0, 0, At, B0); PG8_MMA(0, 1, At, B1); PG8_BAR; PG8_SCHED;
            PG8_LDA(At, 0, 1); PG8_STAGEB(PG8_SB(0, 0), b2, voffB); PG8_STAGEB(PG8_SB(0, 1), b2 + hstep, voffB); PG8_STAGE(PG8_SA(0, 0), a2, voffA);
            PG8_WAIT_V(8); PG8_WAIT_L(0); PG8_BAR; PG8_MMA(1, 0, At, B0); PG8_MMA(1, 1, At, B1); PG8_BAR; PG8_SCHED;
            PG8_LDB(B0, 1, 0); PG8_LDB(B1, 1, 1); PG8_SCHED; PG8_LDA(At, 1, 0); PG8_STAGE(PG8_SA(0, 1), a2 + hstep, voffA);
            PG8_WAIT_V(8); PG8_WAIT_L(0); PG8_BAR; PG8_MMA(0, 0, At, B0); PG8_MMA(0, 1, At, B1); PG8_BAR; PG8_SCHED;
            PG8_LDA(At, 1, 1); PG8_STAGEB(PG8_SB(1, 0), b3, voffB); PG8_STAGEB(PG8_SB(1, 1), b3 + hstep, voffB); PG8_STAGE(PG8_SA(1, 0), a3, voffA);
            PG8_WAIT_V(8); PG8_WAIT_L(0); PG8_BAR; PG8_MMA(1, 0, At, B0); PG8_MMA(1, 1, At, B1); PG8_BAR; PG8_SCHED;
            } else {
            PG8_LDB(B0, 0, 0); PG8_SCHED; PG8_LDA(At, 0, 0); PG8_STAGE(PG8_SA(1, 1), a1 + hstep, voffA);
            PG8_WAIT_L(8); PG8_BAR; PG8_WAIT_L(0); PG8_MMA(0, 0, At, B0); PG8_BAR; PG8_SCHED;
            PG8_LDB(B1, 0, 1); PG8_STAGEB(PG8_SB(0, 0), b2, voffB);
            PG8_BAR; PG8_WAIT_L(0); PG8_MMA(0, 1, At, B1); PG8_BAR;
            PG8_LDA(At, 0, 1); PG8_STAGE(PG8_SA(0, 0), a2, voffA);
            PG8_BAR; PG8_WAIT_L(0); PG8_MMA(1, 0, At, B0); PG8_BAR; PG8_SCHED;
            PG8_STAGEB(PG8_SB(0, 1), b2 + hstep, voffB);
            PG8_WAIT_V(6); PG8_BAR; PG8_MMA(1, 1, At, B1); PG8_BAR;
            PG8_LDB(B0, 1, 0); PG8_SCHED; PG8_LDA(At, 1, 0); PG8_STAGE(PG8_SA(0, 1), a2 + hstep, voffA);
            PG8_WAIT_L(8); PG8_BAR; PG8_WAIT_L(0); PG8_MMA(0, 0, At, B0); PG8_BAR; PG8_SCHED;
            PG8_LDB(B1, 1, 1); PG8_STAGEB(PG8_SB(1, 0), b3, voffB);
            PG8_BAR; PG8_WAIT_L(0); PG8_MMA(0, 1, At, B1); PG8_BAR;
            PG8_LDA(At, 1, 1); PG8_STAGE(PG8_SA(1, 0), a3, voffA);
            PG8_BAR; PG8_WAIT_L(0); PG8_MMA(1, 0, At, B0); PG8_BAR; PG8_SCHED;
            PG8_STAGEB(PG8_SB(1, 1), b3 + hstep, voffB);
            PG8_WAIT_V(6); PG8_BAR; PG8_MMA(1, 1, At, B1); PG8_BAR;
            }
        }
        if constexpr (ALIGN_EPI) { if (wr == 0) PG8_BAR; }
        if constexpr (!Epi::AFTER_DRAIN) { E(acc, cur, wr, wc, fr, fq); S.done(cur); }
        if (!has_next) break;
        bool zero_ = true; if constexpr (Epi::KEEP_ACC) zero_ = E.zero_after(cur);
        if (zero_) {
#pragma unroll
        for (int a = 0; a < 2; ++a)
#pragma unroll
            for (int b = 0; b < 2; ++b)
#pragma unroll
                for (int m = 0; m < 4; ++m)
#pragma unroll
                    for (int n = 0; n < 2; ++n) acc[a][b][m][n] = (f32x4){0.f, 0.f, 0.f, 0.f};
        }
        cur = nxt; cA = nA; cB = nB; ++ui;
        if constexpr (ALIGN_EPI) { if (wr == 1) PG8_BAR; }
    }
    PG8_WAIT_V(0);
    if constexpr (!ALIGN_EPI) { if (wr == 0) PG8_BAR; }
    PG8_BAR;
    if constexpr (Epi::AFTER_DRAIN) { E.fused(acc, cur, wr, wc, fr, fq, lds, wid, lane); S.done(cur); }
#undef PG8_SA
#undef PG8_SB
#undef PG8_STAGE
#undef PG8_STAGEB
#undef PG8_LDA
#undef PG8_LDB
#undef PG8_MMA
#undef PG8_WAIT_V
#undef PG8_WAIT_L
#undef PG8_BAR
#undef PG8_SCHED
}
}
#include <hip/hip_bf16.h>
#include <cmath>
#ifndef ATT_NEGM
#define ATT_NEGM 1
#endif
namespace attn_body {
using bf16=__hip_bfloat16;
using bf16x8=__attribute__((ext_vector_type(8)))short;
using s16x4=__attribute__((ext_vector_type(4)))short;
using f32x16=__attribute__((ext_vector_type(16)))float;
using u32x4=__attribute__((ext_vector_type(4)))unsigned;
constexpr int D=64, QP=512, KP=128, VP=12288, OP=2304;
constexpr int NW=8,QBLK=32,QB=QBLK*NW,KVBLK=64;
constexpr int ATTN_UNIT_ROWS=QB;
__device__ __forceinline__ int crow(int r,int hi){return (r&3)+8*(r>>2)+4*hi;}
#define SBAR() __builtin_amdgcn_sched_barrier(0)
__device__ __forceinline__ void swamask(f32x16&p0,f32x16&p1,int dbase){
  const float NEG=-INFINITY;
  #pragma unroll
  for(int r=0;r<16;++r){const int d=dbase+(r&3)+8*(r>>2); if(d>128||d<-128)p0[r]=NEG; if(d+32>128||d+32<-128)p1[r]=NEG;}
}

constexpr int NSLOT=3, SLOTB=8192;
constexpr int LDS_K=0, LDS_V=NSLOT*SLOTB, LDS_WS=2*NSLOT*SLOTB, LDS_OST=LDS_WS+NW*64*4, LDS_BYTES=LDS_OST+NW*4096;
constexpr float C2=0.125f*1.4426950408889634f;
__device__ __forceinline__ void glds16(const void*gsrc,unsigned lds_dst){unsigned keep;
  asm volatile("s_mov_b32 %0, m0\n\ts_mov_b32 m0, %2\n\ts_nop 0\n\tglobal_load_lds_dwordx4 %1, off\n\ts_mov_b32 m0, %0":"=&s"(keep):"v"(gsrc),"s"(lds_dst):"memory");}
__device__ __forceinline__ float max3f(float a,float b,float c){float r;asm("v_max3_f32 %0, %1, %2, %3":"=v"(r):"v"(a),"v"(b),"v"(c));return r;}
__device__ __forceinline__ float max2f(float a,float b){float r;asm("v_max_f32_e32 %0, %1, %2":"=v"(r):"v"(a),"v"(b));return r;}
__device__ __forceinline__ float fadd_s(float a,float b){float r;asm("v_add_f32_e32 %0, %1, %2":"=v"(r):"v"(a),"v"(b));return r;}
__device__ __forceinline__ float fsub_s(float a,float b){float r;asm("v_sub_f32_e32 %0, %1, %2":"=v"(r):"v"(a),"v"(b));return r;}
typedef float f32x2_t __attribute__((ext_vector_type(2))); typedef __bf16 bf16x2_t __attribute__((ext_vector_type(2)));
__device__ __forceinline__ unsigned cvtpk_s(float lo,float hi){f32x2_t v={lo,hi};bf16x2_t b=__builtin_convertvector(v,bf16x2_t);return __builtin_bit_cast(unsigned,b);}
#define WAIT_BAR(N) asm volatile("s_waitcnt vmcnt(" #N ") lgkmcnt(0)\n\ts_barrier":::"memory")

__device__ __forceinline__ void qkt(f32x16&p0,f32x16&p1,const char*Kslot,const bf16x8*qr,const f32x16&negm,int r32,int hi){
  const char*kb=Kslot+hi*1024+r32*16;
  #pragma unroll
  for(int d0=0;d0<4;++d0){
    const bf16x8 b0=*reinterpret_cast<const bf16x8*>(kb+d0*2048);
    const bf16x8 b1=*reinterpret_cast<const bf16x8*>(kb+d0*2048+512);
    if(d0==0){p0=__builtin_amdgcn_mfma_f32_32x32x16_bf16(b0,qr[0],negm,0,0,0);p1=__builtin_amdgcn_mfma_f32_32x32x16_bf16(b1,qr[0],negm,0,0,0);}
    else{p0=__builtin_amdgcn_mfma_f32_32x32x16_bf16(b0,qr[d0],p0,0,0,0);p1=__builtin_amdgcn_mfma_f32_32x32x16_bf16(b1,qr[d0],p1,0,0,0);}}
}
typedef __attribute__((address_space(3))) const char* lds_cptr;
typedef short v4i16_t __attribute__((ext_vector_type(4)));
__device__ __forceinline__ void kload8(bf16x8*kf,lds_cptr kp){
  kf[0]=*(const __attribute__((address_space(3))) bf16x8*)(kp);      kf[1]=*(const __attribute__((address_space(3))) bf16x8*)(kp+512);
  kf[2]=*(const __attribute__((address_space(3))) bf16x8*)(kp+2048); kf[3]=*(const __attribute__((address_space(3))) bf16x8*)(kp+2560);
  kf[4]=*(const __attribute__((address_space(3))) bf16x8*)(kp+4096); kf[5]=*(const __attribute__((address_space(3))) bf16x8*)(kp+4608);
  kf[6]=*(const __attribute__((address_space(3))) bf16x8*)(kp+6144); kf[7]=*(const __attribute__((address_space(3))) bf16x8*)(kp+6656);
}
__device__ __forceinline__ void kload2(bf16x8*kf,lds_cptr kp,int j){ kf[2*j]=*(const __attribute__((address_space(3))) bf16x8*)(kp+j*2048); kf[2*j+1]=*(const __attribute__((address_space(3))) bf16x8*)(kp+j*2048+512); }
__device__ __forceinline__ s16x4 vtr(lds_cptr p){ return __builtin_bit_cast(s16x4,__builtin_amdgcn_ds_read_tr16_b64_v4i16((__attribute__((address_space(3))) v4i16_t*)p)); }
__device__ __forceinline__ float rowmax(const f32x16&p0,const f32x16&p1){
  float a=max3f(p0[0],p0[1],p1[0]),b=max3f(p0[2],p0[3],p1[1]);a=max3f(a,p1[2],p1[3]);
  #pragma unroll
  for(int r=4;r<16;r+=4){a=max3f(a,p0[r],p0[r+1]);b=max3f(b,p0[r+2],p0[r+3]);a=max3f(a,p1[r],p1[r+1]);b=max3f(b,p1[r+2],p1[r+3]);}
  const float m=max2f(a,b);
  auto rr=__builtin_amdgcn_permlane32_swap(__float_as_uint(m),__float_as_uint(m),false,false);
  return max2f(__uint_as_float(rr[0]),__uint_as_float(rr[1]));
}
__device__ __forceinline__ void pv(f32x16*o,int vb,bf16x8 pa0,bf16x8 pa1,bf16x8 pa2,bf16x8 pa3){
  #pragma unroll
  for(int d0=0;d0<2;++d0){s16x4 lo[4],hi[4];
    #pragma unroll
    for(int ks=0;ks<4;++ks){
      asm volatile("ds_read_b64_tr_b16 %0,%1 offset:%c2":"=&v"(lo[ks]):"v"(vb),"i"(d0*4096+ks*1024):"memory");
      asm volatile("ds_read_b64_tr_b16 %0,%1 offset:%c2":"=&v"(hi[ks]):"v"(vb),"i"(d0*4096+ks*1024+512):"memory");}
    asm volatile("s_waitcnt lgkmcnt(0)":::"memory");SBAR();
    #define PK(k) (bf16x8){lo[k][0],lo[k][1],lo[k][2],lo[k][3],hi[k][0],hi[k][1],hi[k][2],hi[k][3]}
    o[d0]=__builtin_amdgcn_mfma_f32_32x32x16_bf16(pa0,PK(0),o[d0],0,0,0);
    o[d0]=__builtin_amdgcn_mfma_f32_32x32x16_bf16(pa1,PK(1),o[d0],0,0,0);
    o[d0]=__builtin_amdgcn_mfma_f32_32x32x16_bf16(pa2,PK(2),o[d0],0,0,0);
    o[d0]=__builtin_amdgcn_mfma_f32_32x32x16_bf16(pa3,PK(3),o[d0],0,0,0);
    #undef PK
  }
}

#ifndef ATTN_STORE16
#define ATTN_STORE16(p,v) (*(u32x4*)(p)=(v))
#endif
template<int THRL,int MODE> __device__ __forceinline__ void attn_unit(const bf16*Qu,const bf16*__restrict__ Kh,const bf16*__restrict__ Vh,bf16*Ou,int NT,int n0,int s0,int s1,int qrow0,float sink2,bool has_sink,char*shm){
  int tid_=threadIdx.x; asm volatile("":"+v"(tid_)); const int tid=tid_,lane=tid&63,r32=lane&31,hi=lane>>5; const int wid=__builtin_amdgcn_readfirstlane(tid>>6);
  const bf16*Qw=Qu+(long)(wid*QBLK)*QP;
  const unsigned lds0=(unsigned)(uintptr_t)shm;
  float*wsf=(float*)(shm+LDS_WS)+wid*64;
  const bf16*ksrc=Kh+(long)lane*KP+wid*8;
  const bf16*vsrc=Vh+(long)(16*(wid&3)+(lane>>2))*VP+(wid>>2)*32+(lane&3)*8;
  #define TROW(t) (MODE==0 ? KVBLK*(t) : ((t)<n0 ? s0+KVBLK*(t) : s1+KVBLK*((t)-n0)))
  const unsigned kdst=lds0+LDS_K+wid*1024, vdst=lds0+LDS_V+wid*1024;
  #define DMA_K(t,slot) glds16(ksrc+(long)TROW(t)*KP,(unsigned)__builtin_amdgcn_readfirstlane(kdst+(slot)))
  #define DMA_V(t,slot) glds16(vsrc+(long)TROW(t)*VP,(unsigned)__builtin_amdgcn_readfirstlane(vdst+(slot)))
  const int vb0=(int)(lds0+LDS_V)+((lane>>4)&1)*32+(lane&3)*8+(4*hi+((lane&15)>>2))*64;
  const char*Kbase=shm+LDS_K; bf16x8 kf[8];
  const lds_cptr shm3=(lds_cptr)shm; const lds_cptr kp0=shm3+LDS_K+hi*1024+r32*16; const lds_cptr vp0=shm3+LDS_V+((lane>>4)&1)*32+(lane&3)*8+(4*hi+((lane&15)>>2))*64;
  DMA_K(0,0);DMA_V(0,0);DMA_K(1,SLOTB);
  bf16x8 qr[4];
  #pragma unroll
  for(int d0=0;d0<4;++d0)qr[d0]=*reinterpret_cast<const bf16x8*>(&Qw[(long)r32*QP+d0*16+hi*8]);
  float mhat=0.f,l_reg=0.f;f32x16 o[2];o[0]=f32x16{};o[1]=f32x16{};f32x16 negm=f32x16{}; if(ATT_NEGM&&MODE==0)asm volatile("":"+v"(negm));
  const int qrow=qrow0+wid*QBLK+r32;
  #define CMASK(P0,P1,t) do{ if(MODE==1 && (t)>=n0) swamask(P0,P1,TROW(t)+4*hi-qrow); }while(0)
  bool resc=false;
  #define START(P0,P1) do{ const float rm=rowmax(P0,P1); resc=false; \
    { const float dl=rm; mhat=fadd_s(mhat,dl); \
      _Pragma("unroll") for(int r=0;r<16;++r){P0[r]=fsub_s(P0[r],dl);P1[r]=fsub_s(P1[r],dl);} \
      if(ATT_NEGM&&MODE==0){ _Pragma("unroll") for(int r=0;r<16;++r)negm[r]=-mhat; asm volatile("":"+v"(negm)); } } \
    _Pragma("unroll") for(int r=0;r<16;++r)P0[r]=__builtin_amdgcn_exp2f(P0[r]); }while(0)
  #define RESC() do{ if(resc){ asm volatile("s_waitcnt lgkmcnt(0)":::"memory"); \
      _Pragma("unroll") for(int d_=0;d_<2;++d_) _Pragma("unroll") for(int r=0;r<16;++r)o[d_][r]*=wsf[crow(r,hi)]; } }while(0)
  f32x16 pA0,pA1,pB0,pB1;
  int sl_prev=0,sl_cur=0,sl_next=SLOTB;
  #define ROT() do{sl_prev=sl_cur;sl_cur=sl_next;sl_next=(sl_next==(NSLOT-1)*SLOTB)?0:sl_next+SLOTB;}while(0)
  DMA_K(2,2*SLOTB);
  WAIT_BAR(3);
  qkt(pA0,pA1,Kbase,qr,negm,r32,hi);asm volatile("s_nop 15\n\ts_nop 7":"+v"(pA0),"+v"(pA1));CMASK(pA0,pA1,0);
  START(pA0,pA1);
  _Pragma("unroll") for(int r=0;r<16;++r)pA1[r]=__builtin_amdgcn_exp2f(pA1[r]);
  WAIT_BAR(0);
  DMA_K(3,0);DMA_V(1,SLOTB);
  ROT();
  kload8(kf,kp0+sl_cur);
  WAIT_BAR(2);
  s16x4 vlo[8],vhi[8]; u32x4 pw0,pw1,pw2,pw3;
  #define PKW(P,B) cvtpk_s(P[B],P[B+1])
  #define PAF(k) __builtin_bit_cast(bf16x8,pw##k)
  #define VFR(i) (bf16x8){vlo[i][0],vlo[i][1],vlo[i][2],vlo[i][3],vhi[i][0],vhi[i][1],vhi[i][2],vhi[i][3]}
  #define PIN(x) asm volatile("":"+v"(x))
  #define MX3(a,b,c) __builtin_fmaxf(__builtin_fmaxf((a),(b)),(c))
  #define GAPA(MF,A0,A1,A2,A3,W0,W1,PW) do{ MF; sacc+=A0; sacc+=A1; sacc+=A2; sacc+=A3; PIN(sacc); W0; W1; PIN(PW); SBAR(); }while(0)
  #define EX(v) __builtin_amdgcn_exp2f(v)
  #define GAPB(MF,X,B) do{ MF; X[B]=EX(X[B]); X[B+1]=EX(X[B+1]); X[B+2]=EX(X[B+2]); X[B+3]=EX(X[B+3]); PIN(X); SBAR(); }while(0)
  #define VRD(i) do{ vlo[i]=vtr(vp_+(((i)>>2)*4096+((i)&3)*1024)); vhi[i]=vtr(vp_+(((i)>>2)*4096+((i)&3)*1024+512)); }while(0)
  #define KRD(G,j) do{ if(G){ kload2(kf,kp0+sl_next,j); SBAR(); } }while(0)
  #define STEP(C0,C1,P0,P1,t,GK,GV,GL) do{ SBAR(); \
    const lds_cptr vp_=vp0+sl_prev; \
    VRD(0); SBAR(); float sacc=(P0[0]+P0[1]); \
    GAPA(C0=__builtin_amdgcn_mfma_f32_32x32x16_bf16(kf[0],qr[0],((ATT_NEGM&&MODE==0)?negm:f32x16{}),0,0,0), P0[2],P0[3],P0[4],P0[5],     pw0[0]=PKW(P0,0), pw0[1]=PKW(P0,2), pw0); \
    VRD(4); SBAR(); GAPA(C1=__builtin_amdgcn_mfma_f32_32x32x16_bf16(kf[1],qr[0],((ATT_NEGM&&MODE==0)?negm:f32x16{}),0,0,0), P0[6],P0[7],P0[8],P0[9],     pw0[2]=PKW(P0,4), pw0[3]=PKW(P0,6), pw0); \
    VRD(1); SBAR(); GAPA(C0=__builtin_amdgcn_mfma_f32_32x32x16_bf16(kf[2],qr[1],C0,0,0,0),   P0[10],P0[11],P0[12],P0[13], pw1[0]=PKW(P0,8), pw1[1]=PKW(P0,10), pw1); \
    VRD(5); SBAR(); GAPA(C1=__builtin_amdgcn_mfma_f32_32x32x16_bf16(kf[3],qr[1],C1,0,0,0),   P0[14],P0[15],P1[0],P1[1],   pw1[2]=PKW(P0,12),pw1[3]=PKW(P0,14), pw1); \
    VRD(2); SBAR(); GAPA(C0=__builtin_amdgcn_mfma_f32_32x32x16_bf16(kf[4],qr[2],C0,0,0,0),   P1[2],P1[3],P1[4],P1[5],     pw2[0]=PKW(P1,0), pw2[1]=PKW(P1,2), pw2); \
    VRD(6); SBAR(); GAPA(C1=__builtin_amdgcn_mfma_f32_32x32x16_bf16(kf[5],qr[2],C1,0,0,0),   P1[6],P1[7],P1[8],P1[9],     pw2[2]=PKW(P1,4), pw2[3]=PKW(P1,6), pw2); \
    VRD(3); SBAR(); GAPA(C0=__builtin_amdgcn_mfma_f32_32x32x16_bf16(kf[6],qr[3],C0,0,0,0),   P1[10],P1[11],P1[12],P1[13], pw3[0]=PKW(P1,8), pw3[1]=PKW(P1,10), pw3); \
    VRD(7); SBAR(); GAPA(C1=__builtin_amdgcn_mfma_f32_32x32x16_bf16(kf[7],qr[3],C1,0,0,0),   P1[14],P1[15],0.f,0.f,       pw3[2]=PKW(P1,12),pw3[3]=PKW(P1,14), pw3); \
    l_reg+=sacc; \
    if(GK){DMA_K((t)+3,sl_cur);} if(GV){DMA_V((t)+1,sl_next);} \
    if(!(ATT_NEGM&&MODE==0)){ _Pragma("unroll") for(int r=0;r<16;++r){C0[r]-=mhat;C1[r]-=mhat;} } \
    CMASK(C0,C1,t); \
    { float a=MX3(C0[0],C0[1],C1[0]),b=MX3(C0[2],C0[3],C1[1]); a=MX3(a,C1[2],C1[3]); \
      _Pragma("unroll") for(int r=4;r<16;r+=4){a=MX3(a,C0[r],C0[r+1]);b=MX3(b,C0[r+2],C0[r+3]);a=MX3(a,C1[r],C1[r+1]);b=MX3(b,C1[r+2],C1[r+3]);} \
      float rm=__builtin_fmaxf(a,b); { auto rr=__builtin_amdgcn_permlane32_swap(__float_as_uint(rm),__float_as_uint(rm),false,false); rm=__builtin_fmaxf(__uint_as_float(rr[0]),__uint_as_float(rr[1])); } \
      resc=false; \
      if(__builtin_expect(__any(rm>(float)THRL),0)){ const float dl=__builtin_fmaxf(rm,0.f); mhat+=dl; \
        _Pragma("unroll") for(int r=0;r<16;++r){C0[r]-=dl;C1[r]-=dl;} \
        if(ATT_NEGM&&MODE==0){ _Pragma("unroll") for(int r=0;r<16;++r)negm[r]=-mhat; asm volatile("":"+v"(negm)); } \
        const float f=__builtin_amdgcn_exp2f(-dl); l_reg*=f; if(hi==0)wsf[r32]=f; resc=true; } } \
    SBAR(); \
    GAPB(o[0]=__builtin_amdgcn_mfma_f32_32x32x16_bf16(PAF(0),VFR(0),o[0],0,0,0), C0,0); \
    GAPB(o[1]=__builtin_amdgcn_mfma_f32_32x32x16_bf16(PAF(0),VFR(4),o[1],0,0,0), C0,4); \
    KRD(GL,0); GAPB(o[0]=__builtin_amdgcn_mfma_f32_32x32x16_bf16(PAF(1),VFR(1),o[0],0,0,0), C0,8); \
    KRD(GL,1); GAPB(o[1]=__builtin_amdgcn_mfma_f32_32x32x16_bf16(PAF(1),VFR(5),o[1],0,0,0), C0,12); \
    KRD(GL,2); GAPB(o[0]=__builtin_amdgcn_mfma_f32_32x32x16_bf16(PAF(2),VFR(2),o[0],0,0,0), C1,0); \
    KRD(GL,3); GAPB(o[1]=__builtin_amdgcn_mfma_f32_32x32x16_bf16(PAF(2),VFR(6),o[1],0,0,0), C1,4); \
    GAPB(o[0]=__builtin_amdgcn_mfma_f32_32x32x16_bf16(PAF(3),VFR(3),o[0],0,0,0), C1,8); \
    GAPB(o[1]=__builtin_amdgcn_mfma_f32_32x32x16_bf16(PAF(3),VFR(7),o[1],0,0,0), C1,12); \
    }while(0)
  int t=1;
  for(;t+5<NT;t+=2){
    STEP(pB0,pB1,pA0,pA1,t,true,true,true);     WAIT_BAR(2); RESC(); ROT();
    STEP(pA0,pA1,pB0,pB1,t+1,true,true,true);   WAIT_BAR(2); RESC(); ROT();
  }
  #define ENDW(tt) do{ if((tt)+3<NT){WAIT_BAR(2);} else if((tt)+2<NT){WAIT_BAR(1);} else {WAIT_BAR(0);} }while(0)
  for(;t+1<NT;t+=2){
    STEP(pB0,pB1,pA0,pA1,t,(t+3<NT),(t+1<NT),(t+1<NT));       ENDW(t);   RESC(); ROT();
    STEP(pA0,pA1,pB0,pB1,t+1,(t+4<NT),(t+2<NT),(t+2<NT));     ENDW(t+1); RESC(); ROT();
  }
  STEP(pB0,pB1,pA0,pA1,NT-1,false,false,false); RESC();
  { float sacc=pB0[0]+pB0[1]; _Pragma("unroll") for(int r=2;r<16;++r)sacc+=pB0[r]; _Pragma("unroll") for(int r=0;r<16;++r)sacc+=pB1[r]; l_reg+=sacc;
    pw0=(u32x4){PKW(pB0,0),PKW(pB0,2),PKW(pB0,4),PKW(pB0,6)};pw1=(u32x4){PKW(pB0,8),PKW(pB0,10),PKW(pB0,12),PKW(pB0,14)};pw2=(u32x4){PKW(pB1,0),PKW(pB1,2),PKW(pB1,4),PKW(pB1,6)};pw3=(u32x4){PKW(pB1,8),PKW(pB1,10),PKW(pB1,12),PKW(pB1,14)};
    SBAR(); pv(o,vb0+sl_cur,PAF(0),PAF(1),PAF(2),PAF(3)); }
  #undef PKW
  #undef PAF
  #undef VFR
  #undef PIN
  #undef MX3
  #undef GAPA
  #undef GAPB
  #undef EX
  #undef VRD
  #undef KRD
  #undef STEP
  #undef ENDW
  {auto rr=__builtin_amdgcn_permlane32_swap(__float_as_uint(l_reg),__float_as_uint(l_reg),false,false);l_reg=__uint_as_float(rr[0])+__uint_as_float(rr[1]);}
  if(has_sink)l_reg+=__builtin_amdgcn_exp2f(sink2-mhat);
  if(hi==0)wsf[32+r32]=l_reg;asm volatile("s_waitcnt lgkmcnt(0)":::"memory");
  float rli[16];
  #pragma unroll
  for(int r=0;r<16;++r)rli[r]=__builtin_amdgcn_rcpf(wsf[32+crow(r,hi)]);
  bf16*Ow=Ou+(long)(wid*QBLK)*OP;
  { bf16*stg=(bf16*)(shm+LDS_OST)+wid*2048;
    #pragma unroll
    for(int r=0;r<16;++r){const int orow=crow(r,hi);
      #pragma unroll
      for(int d0=0;d0<2;++d0)stg[orow*64+d0*32+r32]=__float2bfloat16(o[d0][r]*rli[r]);}
    asm volatile("s_waitcnt lgkmcnt(0)":::"memory");
    #pragma unroll
    for(int i=0;i<4;++i){const int row=i*8+(lane>>3),ch=lane&7; const u32x4 v=*(const u32x4*)(stg+row*64+ch*8); ATTN_STORE16(Ow+(long)row*OP+ch*8,v);} }
  asm volatile("s_waitcnt lgkmcnt(0)\n\ts_barrier":::"memory");
  #undef TROW
  #undef DMA_K
  #undef DMA_V
  #undef CMASK
  #undef START
  #undef RESC
  #undef ROT
}
constexpr int ATTN_LDS_BYTES=LDS_BYTES;
#undef SBAR
#undef WAIT_BAR
}
constexpr int DM = 2048, SEQ = 16384, CTXN = 256, MR = SEQ + CTXN, DEPTH = 4;
constexpr int DFF = 5632, NFF = 2 * DFF, DIN = 12312, NP = 12288;
constexpr int PC_Z = 0, PC_XBC = 768, PC_U = 2048, PC_SQ = 2560, PC_SK = 3072, PC_SV = 3200, PC_GQ = 3328, PC_GK = 3840, PC_GV = 3968, PC_GATE = 4096;
constexpr int NMODV = 9 * DM;
constexpr float LOG2E = 1.4426950408889634f;
constexpr float QSCALE = 0.125f * LOG2E;
constexpr int NWAVES = 8;
enum { I_X = 0, I_C, I_CTX, I_CCTX, I_WMOD, I_BMOD, I_NORMG, I_FFIN, I_FFOUT, I_WIN, I_CONVW, I_CONVB, I_ALOG, I_DTB, I_SSDD, I_SSDNG, I_S5ARE, I_S5AIM, I_S5LDT, I_S5BRE, I_S5BIM,
       I_S5CRE, I_S5CIM, I_S5D, I_GLUW, I_GLUB, I_SWAG, I_SINK, I_GLBG, I_BRSSD, I_BRS5, I_BRSWA, I_BRGLB, I_WOUT, N_IN };

constexpr size_t al256(size_t x) { return (x + 255) & ~(size_t)255; }
constexpr size_t WS_CTL = 0, CTL_ZERO_BYTES = 64u << 10;
constexpr size_t WS_MODP = CTL_ZERO_BYTES;
constexpr size_t WS_MOD = WS_MODP + al256((size_t)DEPTH * 32 * 2 * NMODV * 4);
constexpr size_t WS_X = WS_MOD + al256((size_t)DEPTH * 2 * NMODV * 4);
constexpr size_t WS_H = WS_X + al256((size_t)MR * DM * 4);
constexpr size_t WS_HID = WS_H + al256((size_t)MR * DM * 2);
constexpr size_t WS_P = WS_HID + al256((size_t)MR * DFF * 2);
constexpr size_t WS_DTRAW = WS_P + al256((size_t)MR * NP * 2);
constexpr size_t WS_DT = WS_DTRAW + al256((size_t)MR * 32 * 4);
constexpr size_t WS_XBC = WS_DT + al256((size_t)MR * 24 * 4);
constexpr size_t WS_QS = WS_XBC + al256((size_t)MR * 1280 * 4);
constexpr size_t WS_QG = WS_QS + al256((size_t)MR * 512 * 2);
constexpr size_t WS_KS = WS_QG + al256((size_t)MR * 512 * 2);
constexpr size_t WS_KG = WS_KS + al256((size_t)MR * 128 * 2);
constexpr size_t WS_YS = WS_KG + al256((size_t)MR * 128 * 2);
constexpr size_t WS_YBF = WS_YS + al256((size_t)2 * MR * 768 * 4);
constexpr size_t WS_S5END = WS_YBF + al256((size_t)2 * MR * 512 * 4);
constexpr size_t WS_S5IN = WS_S5END + al256((size_t)64 * 260 * 128 * 4);
constexpr size_t WS_XSN = WS_S5IN + al256((size_t)64 * 260 * 128 * 4);
constexpr size_t WS_XT = WS_XSN + al256((size_t)MR * 768 * 2);
constexpr size_t WS_BN = WS_XT + al256((size_t)MR * 768 * 2);
constexpr size_t WS_CN = WS_BN + al256((size_t)MR * 256 * 2);
constexpr size_t WS_BT = WS_CN + al256((size_t)MR * 256 * 2);
constexpr size_t WS_STATES = WS_BT + al256((size_t)MR * 256 * 2);
constexpr size_t WS_SINB = WS_STATES + al256((size_t)260 * 24 * 8192 * 4);
constexpr size_t WS_CHD = WS_SINB + al256((size_t)260 * 24 * 8192 * 2);
constexpr size_t WS_YALL = WS_CHD + al256((size_t)260 * 24 * 4);
constexpr int YPITCH = 2304, YC_B = 768, YC_C = 1280, YC_D = 1792;
constexpr size_t WS_YBP = WS_YALL + al256((size_t)MR * YPITCH * 2);
constexpr size_t WS_MGF = WS_YBP + al256((size_t)MR * 512 * 2);
constexpr size_t WS_MG = WS_MGF + al256((size_t)MR * DM * 4);
constexpr size_t WS_W = WS_MG + al256((size_t)MR * DM * 2);
constexpr size_t WL_FFI = 0;
constexpr size_t WL_FFO = WL_FFI + (size_t)2 * NFF * DM;
constexpr size_t WL_WIN = WL_FFO + (size_t)2 * DM * DFF;
constexpr size_t WL_WDT = WL_WIN + (size_t)NP * DM;
constexpr size_t WL_GLU = WL_WDT + (size_t)32 * DM;
constexpr size_t WL_BRALL = WL_GLU + (size_t)1024 * 512;
constexpr size_t WL_OUT = WL_BRALL + (size_t)DM * YPITCH;
constexpr size_t WL_SIZE = WL_OUT + (size_t)DM * DM;
constexpr size_t WS_PART = WS_W + al256((size_t)DEPTH * WL_SIZE * 2);
constexpr size_t WS_END = WS_PART + al256((size_t)11 * 256 * DM * 4);
constexpr int CW_BAR = 4096;

constexpr int RING_OFF = 0, RING_BYTES = 131072;
constexpr int LDSCTL_OFF = RING_BYTES, MISC_OFF = LDSCTL_OFF + 320;
constexpr int LDS_BYTES = 147456;

#define GAS __attribute__((address_space(1)))
#define LAS __attribute__((address_space(3)))
typedef unsigned short bf16;
typedef unsigned v4u __attribute__((ext_vector_type(4)));
typedef unsigned v2u __attribute__((ext_vector_type(2)));
typedef float f32x4 __attribute__((ext_vector_type(4)));
typedef short bf16x8 __attribute__((ext_vector_type(8)));
typedef GAS unsigned gu32;
#define RLX_AGENT __ATOMIC_RELAXED, __HIP_MEMORY_SCOPE_AGENT
#define LDS_WAIT() asm volatile("s_waitcnt lgkmcnt(0)" ::: "memory")
#define VM_WAIT() asm volatile("s_waitcnt vmcnt(0)" ::: "memory")
__device__ __forceinline__ unsigned f2bf(float f) { unsigned u = __builtin_bit_cast(unsigned, f); return (u + 0x7fffu + ((u >> 16) & 1u)) >> 16; }
__device__ __forceinline__ unsigned pk2(float lo, float hi) { return f2bf(lo) | (f2bf(hi) << 16); }
__device__ __forceinline__ float bflo(unsigned w) { return __uint_as_float(w << 16); }
__device__ __forceinline__ float bfhi(unsigned w) { return __uint_as_float(w & 0xffff0000u); }
__device__ __forceinline__ float bf1(bf16 h) { return __uint_as_float(((unsigned)h) << 16); }
__device__ __forceinline__ float sigm_(float x) { return __builtin_amdgcn_rcpf(1.0f + __builtin_amdgcn_exp2f(-LOG2E * x)); }
__device__ __forceinline__ float silu_(float x) { return x * sigm_(x); }
#define XB_TMO      128
#define XB_XCNT(j)  (256  + 64 * (j))
#define XB_XSUB(j)  (1280 + 64 * (j))
#define XB_XGEN(j)  (2304 + 64 * (j))
#define XB_TOP      3328
#define XB_TOPGEN   3392
#define XCD_BAR_WORDS 3456
#define XB_SPIN_CAP (1u << 18)

__device__ __forceinline__ unsigned xb_ld(unsigned* p)              { return __hip_atomic_load(p, __ATOMIC_RELAXED, __HIP_MEMORY_SCOPE_AGENT); }
__device__ __forceinline__ unsigned xb_add(unsigned* p, unsigned v) { return __hip_atomic_fetch_add(p, v, __ATOMIC_RELAXED, __HIP_MEMORY_SCOPE_AGENT); }
__device__ __forceinline__ unsigned xb_xcc_id() { return (unsigned)__builtin_amdgcn_s_getreg((3 << 11) | 20) & 0xFu; }
#define XB_SPIN(cond, bar) do { unsigned _sp = 0; while (cond) { __builtin_amdgcn_s_sleep(1); \
    if ((++_sp & 255u) == 0u) { if (xb_ld(&(bar)[XB_TMO])) break; if (_sp > XB_SPIN_CAP) { atomicAdd(&(bar)[XB_TMO], 1u); break; } } } } while (0)

struct XcdBarrier {
    unsigned* bar; unsigned x;
    volatile LAS unsigned* st;
};

__device__ __forceinline__ XcdBarrier xcd_barrier_post(unsigned* bar, volatile LAS unsigned* st) {
    XcdBarrier b; b.bar = bar; b.x = xb_xcc_id(); b.st = st;
    if (threadIdx.x == 0) (void)xb_add(&bar[XB_XCNT(b.x)], 1u);
    return b;
}
__device__ __forceinline__ void xcd_barrier_complete(unsigned* bar, unsigned x, unsigned& nloc, unsigned& nx) {
    const unsigned G = gridDim.x * gridDim.y * gridDim.z;
    unsigned sum, cnt, mine, sp = 0u;
    for (;;) {
        sum = 0u; cnt = 0u; mine = 0u;
#pragma unroll
        for (unsigned j = 0; j < 16; ++j) { const unsigned c = xb_ld(&bar[XB_XCNT(j)]); sum += c; cnt += (c > 0u) ? 1u : 0u; }
        mine = xb_ld(&bar[XB_XCNT(x)]);
        if (sum == G) break;
        __builtin_amdgcn_s_sleep(1);
        if ((++sp & 255u) == 0u) { if (xb_ld(&bar[XB_TMO])) break; if (sp > XB_SPIN_CAP) { atomicAdd(&bar[XB_TMO], 1u); break; } }
    }
    nloc = mine > 0u ? mine : 1u; nx = cnt > 0u ? cnt : 1u;
}

__device__ __forceinline__ void xcd_barrier(const XcdBarrier& b) {
    asm volatile("s_waitcnt vmcnt(0)" ::: "memory");
    __syncthreads();
    if (threadIdx.x == 0) {
        unsigned* bar = b.bar;
        __builtin_amdgcn_s_waitcnt(0);
        unsigned nloc = b.st[0], nx = b.st[1];
        if (nloc == 0u) { xcd_barrier_complete(bar, b.x, nloc, nx); b.st[0] = nloc; b.st[1] = nx; }
        const unsigned old = xb_add(&bar[XB_XSUB(b.x)], 1u);
        const unsigned gen = old / nloc;
        if (old + 1u == (gen + 1u) * nloc) {
            __builtin_amdgcn_fence(__ATOMIC_RELEASE, "agent");
            asm volatile("s_waitcnt vmcnt(0)" ::: "memory");
            const unsigned og = xb_add(&bar[XB_TOP], 1u);
            const unsigned tg = og / nx;
            if (og + 1u == (tg + 1u) * nx) xb_add(&bar[XB_TOPGEN], 1u);
            else XB_SPIN(xb_ld(&bar[XB_TOPGEN]) == tg, bar);
            __builtin_amdgcn_fence(__ATOMIC_ACQUIRE, "agent");
            xb_add(&bar[XB_XGEN(b.x)], 1u);
            asm volatile("s_waitcnt vmcnt(0)" ::: "memory");
        } else {
            XB_SPIN(xb_ld(&bar[XB_XGEN(b.x)]) == gen, bar);
            __builtin_amdgcn_fence(__ATOMIC_ACQUIRE, "agent");
            asm volatile("s_waitcnt vmcnt(0)" ::: "memory");
        }
    }
    __syncthreads();
}
struct Args { const float* in[N_IN]; float* out; unsigned char* ws; int ph_lo, ph_hi; };
typedef const volatile __attribute__((address_space(4))) Args* KArgs;
#define AIN(i) ((const float*)(const __attribute__((address_space(1))) float*)a->in[i])
struct Frame {
    LAS unsigned char* lds;
    volatile LAS unsigned* MISC;
    gu32* ctl;
    int tid, lane, wave;
    int vcu, G;
    unsigned char* ws;
};
__device__ __forceinline__ Frame fresh(const Frame& F) { Frame Fp = F; unsigned long long w = (unsigned long long)F.ws; asm volatile("" : "+v"(Fp.tid), "+s"(Fp.vcu), "+s"(w)); Fp.ws = (unsigned char*)(GAS unsigned char*)w; Fp.lane = Fp.tid & 63; Fp.wave = __builtin_amdgcn_readfirstlane(Fp.tid >> 6); return Fp; }
__device__ __forceinline__ float bperm(float v, int srclane) { return __int_as_float(__builtin_amdgcn_ds_bpermute(srclane << 2, __float_as_int(v))); }
__device__ __forceinline__ float wave_sum(float v, int lane) {
#pragma unroll
    for (int o = 1; o < 64; o <<= 1) v += bperm(v, lane ^ o);
    return v;
}
__device__ __forceinline__ int rowof(int dir, int s) { return dir ? (MR - 1 - s) : (s < CTXN ? SEQ + s : s - CTXN); }
__device__ __forceinline__ void sincos_hw(float ang, float& s, float& c) { float r = ang * 0.15915494309189535f; r = r - floorf(r); s = __builtin_amdgcn_sinf(r); c = __builtin_amdgcn_cosf(r); }

__device__ __forceinline__ void transpose_item(const float* W, int ldw, int Nsrc, int src_c0, bf16* WT, int dst_r0, int k0, int nvalid, LAS float* scr, int lane, int my_col = -1) {
#pragma unroll 8
    for (int i = 0; i < 32; ++i) { const int kk = 2 * i + (lane >> 5); scr[kk * 33 + (lane & 31)] = __builtin_nontemporal_load(W + (size_t)(k0 + kk) * Nsrc + (my_col >= 0 ? my_col : src_c0 + (lane & 31))); }
    LDS_WAIT(); asm volatile("" ::: "memory");
    const int c = lane & 7;
#pragma unroll
    for (int j = 0; j < 4; ++j) { const int n = (lane >> 3) + 8 * j; const LAS float* s = scr + (8 * c) * 33 + n;
        v4u o; o.x = pk2(s[0 * 33], s[1 * 33]); o.y = pk2(s[2 * 33], s[3 * 33]); o.z = pk2(s[4 * 33], s[5 * 33]); o.w = pk2(s[6 * 33], s[7 * 33]);
        if (n >= nvalid) o = (v4u){0u, 0u, 0u, 0u};
        __builtin_nontemporal_store(o, (GAS v4u*)(WT + (size_t)(dst_r0 + n) * ldw + k0 + 8 * c)); }
    LDS_WAIT(); asm volatile("" ::: "memory");
}
constexpr int IT_FFI = 32 * 352, IT_FFO = 88 * 64, IT_WIN = 32 * 384, IT_GLU = 8 * 32, IT_BRA = 12 * 64, IT_BRX = 8 * 64, IT_OUT = 32 * 64, IT_WDT = 32;
constexpr int IT_LAYER = 2 * IT_FFI + 2 * IT_FFO + IT_WIN + IT_GLU + IT_BRA + 3 * IT_BRX + IT_OUT + IT_WDT;
#ifndef HIDE_CONVERT
#define HIDE_CONVERT 0
#endif
constexpr int IT_GA = IT_FFI + IT_FFO, IT_GB = IT_WIN + IT_WDT, IT_GC = IT_GLU + IT_BRA + 3 * IT_BRX + IT_OUT, IT_GD = IT_FFI + IT_FFO;
static_assert(IT_GA + IT_GB + IT_GC + IT_GD == IT_LAYER, "item groups");
__device__ __forceinline__ void convert_item(Frame& F, KArgs a, int l, int r, LAS float* scr) {
    bf16* wl = (bf16*)(F.ws + WS_W) + (size_t)l * WL_SIZE;
    int f = 0; if (r >= IT_GA + IT_GB + IT_GC) { f = 1; r -= IT_GA + IT_GB + IT_GC; }
    if (r < IT_FFI) { const int kb = r / 352, gd = r % 352, pn = gd >> 3, w = gd & 7; const int sc0 = (w < 4) ? 128 * pn + 32 * w : DFF + 128 * pn + 32 * (w - 4);
        transpose_item(AIN(I_FFIN) + (size_t)(l * 2 + f) * DM * NFF, DM, NFF, sc0, wl + WL_FFI + (size_t)f * NFF * DM, 32 * gd, 64 * kb, 32, scr, F.lane); return; } r -= IT_FFI;
    if (r < IT_FFO) { const int kb = r / 64, gd = r % 64;
        transpose_item(AIN(I_FFOUT) + (size_t)(l * 2 + f) * DFF * DM, DFF, DM, 32 * gd, wl + WL_FFO + (size_t)f * DM * DFF, 32 * gd, 64 * kb, 32, scr, F.lane); return; } r -= IT_FFO;
    if (r < IT_WIN) { const int kb = r / 384, gd = r % 384; const int d0 = 32 * gd;
        int mc = -1;
        if (d0 >= PC_GATE) { const int j = (d0 - PC_GATE) >> 8, w = (d0 >> 5) & 7, bj = w >> 2, wc = w & 3, o = F.lane & 31, fq = o >> 3, n = (o >> 2) & 1, i = o & 3;
            mc = (DIN - 4 * DM) + 2048 * (2 * bj + n) + 64 * j + 16 * wc + 4 * fq + i; }
        transpose_item(AIN(I_WIN) + (size_t)l * DM * DIN, DM, DIN, d0 < 2048 ? d0 : d0 + 24, wl + WL_WIN, d0, 64 * kb, 32, scr, F.lane, mc); return; } r -= IT_WIN;
    if (r < IT_WDT) { transpose_item(AIN(I_WIN) + (size_t)l * DM * DIN, DM, DIN, 2048, wl + WL_WDT, 0, 64 * r, 24, scr, F.lane); return; } r -= IT_WDT;
    if (r < IT_GLU) { const int kb = r / 32, gd = r % 32, pn = gd >> 3, w = gd & 7; const int sc0 = (w < 4) ? 128 * pn + 32 * w : 512 + 128 * pn + 32 * (w - 4);
        transpose_item(AIN(I_GLUW) + (size_t)l * 512 * 1024, 512, 1024, sc0, wl + WL_GLU, 32 * gd, 64 * kb, 32, scr, F.lane); return; } r -= IT_GLU;
    if (r < IT_BRA) { const int kb = r / 64, gd = r % 64;
        transpose_item(AIN(I_BRSSD) + (size_t)l * 768 * DM, YPITCH, DM, 32 * gd, wl + WL_BRALL, 32 * gd, 64 * kb, 32, scr, F.lane); return; } r -= IT_BRA;
    if (r < 3 * IT_BRX) { const int b = r / IT_BRX; r %= IT_BRX; const int kb = r / 64, gd = r % 64;
        const float* src = (b == 0 ? AIN(I_BRS5) : (b == 1 ? AIN(I_BRSWA) : AIN(I_BRGLB))) + (size_t)l * 512 * DM;
        transpose_item(src, YPITCH, DM, 32 * gd, wl + WL_BRALL + YC_B + 512 * b, 32 * gd, 64 * kb, 32, scr, F.lane); return; } r -= 3 * IT_BRX;
    { const int kb = r / 64, gd = r % 64; transpose_item(AIN(I_WOUT) + (size_t)l * DM * DM, DM, DM, 32 * gd, wl + WL_OUT, 32 * gd, 64 * kb, 32, scr, F.lane); }
}
__device__ __forceinline__ void convert_range(Frame& F, KArgs a, int l, int first, int n, int widx, int wstride) {
    LAS float* scr = (LAS float*)(F.lds + RING_OFF + F.wave * 16384);
    for (int it = first + widx; it < first + n; it += wstride) convert_item(F, a, l, it, scr);
}
__device__ __forceinline__ void convert_idle(Frame& F, KArgs a, int c, int rem, int l, int first, int n) {
    if (c < rem || l >= DEPTH) return;
    convert_range(F, a, l, first, n, (c - rem) * NWAVES + F.wave, (F.G - rem) * NWAVES);
}
__device__ __forceinline__ void p0_prologue(Frame& F, KArgs a) {
    const int gw = F.vcu * NWAVES + F.wave, NGW = F.G * NWAVES;
#if HIDE_CONVERT
    convert_range(F, a, 0, 0, IT_GA, gw, NGW);
#else
    for (int l = 0; l < DEPTH; ++l) convert_range(F, a, l, 0, IT_LAYER, gw, NGW);
#endif
    float* X = (float*)(F.ws + WS_X);
    for (int m = gw; m < MR; m += NGW) {
        const GAS f32x4* src = (const GAS f32x4*)(m < SEQ ? AIN(I_X) + (size_t)m * DM : AIN(I_CTX) + (size_t)(m - SEQ) * DM) + F.lane; GAS f32x4* dst = (GAS f32x4*)(X + (size_t)m * DM) + F.lane;
#pragma unroll
        for (int j = 0; j < 8; ++j) dst[64 * j] = src[64 * j];
    }
    __syncthreads();
    LAS float* sc = (LAS float*)(F.lds + RING_OFF);
    for (int i = F.tid; i < 2 * DM; i += NWAVES * 64) { const float c = (i < DM) ? AIN(I_C)[i] : AIN(I_CCTX)[i - DM]; sc[i] = silu_(c); }
    __syncthreads();
    float* MODP = (float*)(F.ws + WS_MODP);
    for (int it = F.vcu; it < DEPTH * 32 * 9; it += F.G) {
        const int l = it / 288, r = it % 288, s = r / 9, b = r % 9, col = b * 2048 + 4 * F.tid;
        const float* w = AIN(I_WMOD) + (size_t)l * DM * NMODV + (size_t)(64 * s) * NMODV + col;
        f32x4 a0 = {0.f, 0.f, 0.f, 0.f}, a1 = {0.f, 0.f, 0.f, 0.f};
#pragma unroll 8
        for (int k = 0; k < 64; ++k) { const f32x4 wv = __builtin_nontemporal_load((const f32x4*)(w + (size_t)k * NMODV)); a0 += wv * sc[64 * s + k]; a1 += wv * sc[DM + 64 * s + k]; }
        *(f32x4*)(MODP + (size_t)((l * 32 + s) * 2 + 0) * NMODV + col) = a0; *(f32x4*)(MODP + (size_t)((l * 32 + s) * 2 + 1) * NMODV + col) = a1;
    }
}
__device__ __forceinline__ void p1_modfinal(Frame& F, KArgs a) {
    const float* MODP = (const float*)(F.ws + WS_MODP); float* MOD = (float*)(F.ws + WS_MOD);
    for (int i = F.vcu * 512 + F.tid; i < DEPTH * 2 * NMODV; i += F.G * 512) {
        const int l = i / (2 * NMODV), v = (i / NMODV) & 1, j = i % NMODV; float s = AIN(I_BMOD)[l * NMODV + j];
#pragma unroll
        for (int q = 0; q < 32; ++q) s += MODP[(size_t)((l * 32 + q) * 2 + v) * NMODV + j];
        MOD[i] = s;
    }
}
__device__ __forceinline__ void norm_phase(Frame& F, KArgs a, int l, int k, int nsl) {
    const int gw = F.vcu * NWAVES + F.wave, NGW = F.G * NWAVES;
    const float* X = (const float*)(F.ws + WS_X); bf16* H = (bf16*)(F.ws + WS_H);
    const float* g = AIN(I_NORMG) + (size_t)(l * 3 + k) * DM;
    for (int v = 0; v < 2; ++v) {
        const float* mod = (const float*)(F.ws + WS_MOD) + (size_t)(l * 2 + v) * NMODV; const float* shift = mod + (3 * k) * DM; const float* scale = mod + (3 * k + 1) * DM;
        f32x4 gs[8], sh[8];
#pragma unroll
        for (int j = 0; j < 8; ++j) { const int c = 4 * F.lane + 256 * j; const f32x4 gg = *(const f32x4*)(g + c), ss = *(const f32x4*)(scale + c); gs[j] = gg * (ss + 1.0f); sh[j] = *(const f32x4*)(shift + c); }
        const int r0 = v ? SEQ : 0, r1 = v ? MR : SEQ;
        if (v == 0) {
            for (int m = r0 + gw; m < r1; m += 2 * NGW) {
                const bool two = m + NGW < r1; const int m2 = two ? m + NGW : m;
                const GAS f32x4* xa = (const GAS f32x4*)(X + (size_t)m * DM) + F.lane; const GAS f32x4* xb = (const GAS f32x4*)(X + (size_t)m2 * DM) + F.lane; f32x4 a[8], b[8]; float sa = 0.f, sb = 0.f;
#pragma unroll
                for (int j = 0; j < 8; ++j) { a[j] = __builtin_nontemporal_load(xa + 64 * j); b[j] = __builtin_nontemporal_load(xb + 64 * j); }
#pragma unroll
                for (int j = 0; j < 8; ++j) { sa += (a[j].x * a[j].x + a[j].y * a[j].y) + (a[j].z * a[j].z + a[j].w * a[j].w); sb += (b[j].x * b[j].x + b[j].y * b[j].y) + (b[j].z * b[j].z + b[j].w * b[j].w); }
                const float ra = 1.0f / sqrtf(wave_sum(sa, F.lane) * (1.0f / DM) + 1e-6f), rb = 1.0f / sqrtf(wave_sum(sb, F.lane) * (1.0f / DM) + 1e-6f);
                GAS v2u* oa = (GAS v2u*)(H + (size_t)m * DM) + F.lane; GAS v2u* ob = (GAS v2u*)(H + (size_t)m2 * DM) + F.lane;
#pragma unroll
                for (int j = 0; j < 8; ++j) { const f32x4 y = a[j] * ra * gs[j] + sh[j]; v2u w; w.x = pk2(y.x, y.y); w.y = pk2(y.z, y.w); oa[64 * j] = w; }
                if (two) {
#pragma unroll
                    for (int j = 0; j < 8; ++j) { const f32x4 y = b[j] * rb * gs[j] + sh[j]; v2u w; w.x = pk2(y.x, y.y); w.y = pk2(y.z, y.w); ob[64 * j] = w; } }
            }
        } else
        for (int m = r0 + gw; m < r1; m += NGW) {
            const GAS f32x4* xr = (const GAS f32x4*)(X + (size_t)m * DM) + F.lane; f32x4 x[8]; float s = 0.f;
#pragma unroll
            for (int j = 0; j < 8; ++j) x[j] = xr[64 * j];
            if (v == 1 && nsl > 0) { const float* PART = (const float*)(F.ws + WS_PART);
                for (int sl = 0; sl < nsl; ++sl) { const GAS f32x4* pr = (const GAS f32x4*)(PART + ((size_t)sl * 256 + (m - SEQ)) * DM) + F.lane;
#pragma unroll
                    for (int j = 0; j < 8; ++j) x[j] += pr[64 * j]; }
                GAS f32x4* xw = (GAS f32x4*)((float*)(F.ws + WS_X) + (size_t)m * DM) + F.lane;
#pragma unroll
                for (int j = 0; j < 8; ++j) xw[64 * j] = x[j]; }
#pragma unroll
            for (int j = 0; j < 8; ++j) s += (x[j].x * x[j].x + x[j].y * x[j].y) + (x[j].z * x[j].z + x[j].w * x[j].w);
            const float rstd = 1.0f / sqrtf(wave_sum(s, F.lane) * (1.0f / DM) + 1e-6f);
            GAS v2u* o = (GAS v2u*)(H + (size_t)m * DM) + F.lane;
#pragma unroll
            for (int j = 0; j < 8; ++j) { const f32x4 y = x[j] * rstd * gs[j] + sh[j]; v2u w; w.x = pk2(y.x, y.y); w.y = pk2(y.z, y.w); o[64 * j] = w; }
        }
    }
}
__device__ __forceinline__ void dt_gemm(Frame& F, int l, int c, int rem) {
    if (c < rem) return;
    const int gw = (c - rem) * NWAVES + F.wave, NGW = (F.G - rem) * NWAVES;
    const bf16* H = (const bf16*)(F.ws + WS_H); const bf16* Wd = (const bf16*)(F.ws + WS_W) + (size_t)l * WL_SIZE + WL_WDT; float* DTR = (float*)(F.ws + WS_DTRAW);
    const int fr = F.lane & 15, fq = F.lane >> 4;
    for (int t = gw; t < MR / 16; t += NGW) {
        const bf16* ap = H + (size_t)(16 * t + fr) * DM + 8 * fq; const bf16* b0 = Wd + (size_t)fr * DM + 8 * fq; const bf16* b1 = Wd + (size_t)(16 + fr) * DM + 8 * fq;
        f32x4 c0 = {0.f, 0.f, 0.f, 0.f}, c1 = {0.f, 0.f, 0.f, 0.f};
#pragma unroll 4
        for (int k0 = 0; k0 < DM; k0 += 32) { const bf16x8 av = *(const bf16x8*)(ap + k0), bv0 = *(const bf16x8*)(b0 + k0), bv1 = *(const bf16x8*)(b1 + k0);
            c0 = __builtin_amdgcn_mfma_f32_16x16x32_bf16(av, bv0, c0, 0, 0, 0); c1 = __builtin_amdgcn_mfma_f32_16x16x32_bf16(av, bv1, c1, 0, 0, 0); }
#pragma unroll
        for (int r = 0; r < 4; ++r) { float* o = DTR + (size_t)(16 * t + 4 * fq + r) * 32 + fr; o[0] = c0[r]; o[16] = c1[r]; }
    }
}
struct S5Disc { float lb_re, lb_im, bb_re[16], bb_im[16]; };
__device__ __forceinline__ void s5_disc(KArgs a, int l, int dir, int g, int p, S5Disc& d) {
    const int ig = (l * 2 + dir) * 32 + g; const float a_re = AIN(I_S5ARE)[ig * 64 + p], a_im = AIN(I_S5AIM)[ig * 64 + p]; const float dt = __expf(AIN(I_S5LDT)[ig]);
    const float mag = __expf(a_re * dt); float sn, cs; sincos_hw(a_im * dt, sn, cs);
    d.lb_re = mag * cs; d.lb_im = mag * sn;
    const float den = a_re * a_re + a_im * a_im, nr = d.lb_re - 1.0f, ni = d.lb_im;
    const float f_re = (nr * a_re + ni * a_im) / den, f_im = (ni * a_re - nr * a_im) / den;
    const float* br = AIN(I_S5BRE) + (size_t)((l * 32 + g) * 64 + p) * 16; const float* bi = AIN(I_S5BIM) + (size_t)((l * 32 + g) * 64 + p) * 16;
#pragma unroll
    for (int h = 0; h < 16; ++h) { const float x = br[h], y = bi[h]; d.bb_re[h] = f_re * x - f_im * y; d.bb_im[h] = f_re * y + f_im * x; }
}
typedef float f32x16 __attribute__((ext_vector_type(16)));
struct S5Pow { float r1, i1, r2, i2, r3, i3, r4, i4; };
__device__ __forceinline__ void s5_pow(const S5Disc& d, S5Pow& p) { p.r1 = d.lb_re; p.i1 = d.lb_im; p.r2 = p.r1 * p.r1 - p.i1 * p.i1; p.i2 = 2.0f * p.r1 * p.i1; p.r3 = p.r2 * p.r1 - p.i2 * p.i1; p.i3 = p.r2 * p.i1 + p.i2 * p.r1; p.r4 = p.r2 * p.r2 - p.i2 * p.i2; p.i4 = 2.0f * p.r2 * p.i2; }
__device__ __forceinline__ bf16x8 pack8(const float (&v)[16], bool hi) { v4u w; w.x = pk2(hi ? v[8] : v[0], hi ? v[9] : v[1]); w.y = pk2(hi ? v[10] : v[2], hi ? v[11] : v[3]); w.z = pk2(hi ? v[12] : v[4], hi ? v[13] : v[5]); w.w = pk2(hi ? v[14] : v[6], hi ? v[15] : v[7]); return __builtin_bit_cast(bf16x8, w); }
template <bool FIX> __device__ __forceinline__ void s5_state_scan(f32x16& R, f32x16& I, const S5Pow& p, float& cr, float& ci, bool hi) {
#pragma unroll
    for (int k = 0; k < 4; ++k)
#pragma unroll
        for (int j = 1; j < 4; ++j) { const int x = 4 * k + j; const float nr = p.r1 * R[x - 1] - p.i1 * I[x - 1] + R[x], ni = p.r1 * I[x - 1] + p.i1 * R[x - 1] + I[x]; R[x] = nr; I[x] = ni; }
    float cinr[4], cini[4], ce_r = 0.f, ce_i = 0.f;
#pragma unroll
    for (int G = 0; G < 8; ++G) { const int k = G >> 1;
        if ((G & 1) == 0) { ce_r = cr; ce_i = ci; } else { cinr[k] = hi ? cr : ce_r; cini[k] = hi ? ci : ce_i; }
        const float vr = p.r4 * cr - p.i4 * ci + R[4 * k + 3], vi = p.r4 * ci + p.i4 * cr + I[4 * k + 3];
        const auto sr = __builtin_amdgcn_permlane32_swap(__float_as_uint(vr), __float_as_uint(vr), false, false); const auto si = __builtin_amdgcn_permlane32_swap(__float_as_uint(vi), __float_as_uint(vi), false, false);
        cr = __uint_as_float(sr[G & 1]); ci = __uint_as_float(si[G & 1]); }
    if (FIX) {
#pragma unroll
        for (int k = 0; k < 4; ++k) { const float a = cinr[k], b = cini[k];
            R[4 * k + 0] += p.r1 * a - p.i1 * b; I[4 * k + 0] += p.r1 * b + p.i1 * a; R[4 * k + 1] += p.r2 * a - p.i2 * b; I[4 * k + 1] += p.r2 * b + p.i2 * a;
            R[4 * k + 2] += p.r3 * a - p.i3 * b; I[4 * k + 2] += p.r3 * b + p.i3 * a; R[4 * k + 3] += p.r4 * a - p.i4 * b; I[4 * k + 3] += p.r4 * b + p.i4 * a; }
    }
}
#ifndef S5_NA
#define S5_NA 5
#endif
template <bool PASS2> __device__ __forceinline__ void s5_pass(Frame& F, KArgs a, int l) {
    const int gw = F.vcu * NWAVES + F.wave, NGW = F.G * NWAVES;
    if (NGW % 64 != 0) return;
    const int q = gw & 63, dir = q >> 5, g = q & 31, lane = F.lane, s = lane & 31; const bool hi = lane >= 32;
    S5Pow pA, pB; bf16x8 bbf[4];
    { S5Disc dA, dB; s5_disc(a, l, dir, g, s, dA); s5_disc(a, l, dir, g, s + 32, dB); s5_pow(dA, pA); s5_pow(dB, pB);
      bbf[0] = pack8(dA.bb_re, hi); bbf[1] = pack8(dB.bb_re, hi); bbf[2] = pack8(dA.bb_im, hi); bbf[3] = pack8(dB.bb_im, hi); }
    bf16x8 cmf[4];
    if (PASS2) { const int h = lane & 15, q4 = lane >> 4;
#pragma unroll
        for (int ks = 0; ks < 4; ++ks) { const float* src = (ks < 2 ? AIN(I_S5CRE) : AIN(I_S5CIM)) + (size_t)((l * 32 + g) * 16 + h) * 64 + 32 * (ks & 1) + 8 * q4; const float sg = ks < 2 ? 1.0f : -1.0f;
            const f32x4 v0 = *(const f32x4*)src * sg, v1 = *(const f32x4*)(src + 4) * sg; v4u w; w.x = pk2(v0.x, v0.y); w.y = pk2(v0.z, v0.w); w.z = pk2(v1.x, v1.y); w.w = pk2(v1.z, v1.w); cmf[ks] = __builtin_bit_cast(bf16x8, w); } }
    float* END = (float*)(F.ws + WS_S5END); const float* SIN = (const float*)(F.ws + WS_S5IN); const bf16* P = (const bf16*)(F.ws + WS_P); bf16* YBF = (bf16*)(F.ws + WS_YBF);
    LAS bf16* Sb = (LAS bf16*)(F.lds + RING_OFF + F.wave * 8192);
    int cs_beg = gw >> 6, cs_end = MR / 64, cs_step = NGW >> 6;
    if (PASS2 && S5_NA > 0 && NGW == 2048) {
        const int rgw = NGW - 1 - gw, rj = rgw >> 6, rq = rgw & 63, n2 = (MR / 64) * 12 - NGW;
        const int nAw = (n2 >> 6) + (rq < (n2 & 63) ? 1 : 0), nBw = 32 - nAw, rest = MR / 64 - nAw * S5_NA, bs = rest / nBw, ex = rest % nBw, jb = rj - nAw;
        cs_beg = rj < nAw ? rj * S5_NA : nAw * S5_NA + jb * bs + (jb < ex ? jb : ex);
        cs_end = cs_beg + (rj < nAw ? S5_NA : bs + (jb < ex ? 1 : 0)); cs_step = 1;
    }
    for (int cs = cs_beg; cs < cs_end; cs += cs_step) {
        const size_t o = ((size_t)q * (MR / 64) + cs) * 128;
        float cAr = 0.f, cAi = 0.f, cBr = 0.f, cBi = 0.f;
        if (PASS2) { cAr = SIN[o + 2 * s]; cAi = SIN[o + 2 * s + 1]; cBr = SIN[o + 2 * (s + 32)]; cBi = SIN[o + 2 * (s + 32) + 1]; }
#pragma unroll 1
        for (int tt = 0; tt < 2; ++tt) {
            const bf16x8 uf = *(const GAS bf16x8*)(P + (size_t)rowof(dir, 64 * cs + 32 * tt + s) * NP + PC_U + 16 * g + (hi ? 8 : 0));
            const f32x16 z = {0.f, 0.f, 0.f, 0.f, 0.f, 0.f, 0.f, 0.f, 0.f, 0.f, 0.f, 0.f, 0.f, 0.f, 0.f, 0.f};
            f32x16 T0 = __builtin_amdgcn_mfma_f32_32x32x16_bf16(uf, bbf[0], z, 0, 0, 0), T1 = __builtin_amdgcn_mfma_f32_32x32x16_bf16(uf, bbf[1], z, 0, 0, 0);
            f32x16 T2 = __builtin_amdgcn_mfma_f32_32x32x16_bf16(uf, bbf[2], z, 0, 0, 0), T3 = __builtin_amdgcn_mfma_f32_32x32x16_bf16(uf, bbf[3], z, 0, 0, 0);
            s5_state_scan<PASS2>(T0, T2, pA, cAr, cAi, hi);
            s5_state_scan<PASS2>(T1, T3, pB, cBr, cBi, hi);
            if (PASS2) {
#pragma unroll
                for (int r = 0; r < 16; ++r) { const int tl = 8 * (r >> 2) + (hi ? 4 : 0) + (r & 3); LAS bf16* dst = Sb + tl * 128 + s;
                    dst[0] = (bf16)f2bf(T0[r]); dst[32] = (bf16)f2bf(T1[r]); dst[64] = (bf16)f2bf(T2[r]); dst[96] = (bf16)f2bf(T3[r]); }
                LDS_WAIT(); asm volatile("" ::: "memory");
                const int r16 = lane & 15, q4 = lane >> 4;
#pragma unroll
                for (int mt = 0; mt < 2; ++mt) { f32x4 acc = {0.f, 0.f, 0.f, 0.f};
#pragma unroll
                    for (int ks = 0; ks < 4; ++ks) { const bf16x8 af = *(const LAS bf16x8*)(Sb + (16 * mt + r16) * 128 + 32 * ks + 8 * q4); acc = __builtin_amdgcn_mfma_f32_16x16x32_bf16(af, cmf[ks], acc, 0, 0, 0); }
#pragma unroll
                    for (int rg = 0; rg < 4; ++rg) { const int row = rowof(dir, 64 * cs + 32 * tt + 16 * mt + 4 * q4 + rg); YBF[((size_t)dir * MR + row) * 512 + 16 * g + r16] = (bf16)f2bf(acc[rg]); } }
                LDS_WAIT(); asm volatile("" ::: "memory");
            }
        }
        if (!PASS2 && !hi) { END[o + 2 * s] = cAr; END[o + 2 * s + 1] = cAi; END[o + 2 * (s + 32)] = cBr; END[o + 2 * (s + 32) + 1] = cBi; }
    }
}
#ifndef S5C_UNR
#define S5C_UNR 13
#endif
__device__ __forceinline__ void s5_carry(Frame& F, KArgs a, int l, int first_wave) {
    const int gw = F.vcu * NWAVES + F.wave - first_wave; if (gw < 0 || gw >= 64) return;
    const int q = gw, dir = q >> 5, g = q & 31, p = F.lane;
    const int ig = (l * 2 + dir) * 32 + g; const float a_re = AIN(I_S5ARE)[ig * 64 + p], a_im = AIN(I_S5AIM)[ig * 64 + p]; const float dt = __expf(AIN(I_S5LDT)[ig]);
    const float mag = __expf(a_re * dt); float sn, cs_; sincos_hw(a_im * dt, sn, cs_);
    float pr = mag * cs_, pi = mag * sn;
#pragma unroll
    for (int i = 0; i < 6; ++i) { const float nr = pr * pr - pi * pi, ni = 2.0f * pr * pi; pr = nr; pi = ni; }
    const float* END = (const float*)(F.ws + WS_S5END); float* SIN = (float*)(F.ws + WS_S5IN);
    float s_re = 0.f, s_im = 0.f;
    for (int cs = 0; cs < MR / 64; cs += S5C_UNR) {
        float er[S5C_UNR], ei[S5C_UNR];
#pragma unroll
        for (int i = 0; i < S5C_UNR; ++i) { const size_t o = ((size_t)q * (MR / 64) + cs + i) * 128 + 2 * p; er[i] = END[o]; ei[i] = END[o + 1]; }
#pragma unroll
        for (int i = 0; i < S5C_UNR; ++i) { const size_t o = ((size_t)q * (MR / 64) + cs + i) * 128 + 2 * p; SIN[o] = s_re; SIN[o + 1] = s_im;
            const float nr = pr * s_re - pi * s_im + er[i], ni = pr * s_im + pi * s_re + ei[i]; s_re = nr; s_im = ni; }
    }
}
__device__ __forceinline__ bf16x8 ldg8(const bf16* p) { return *(const GAS bf16x8*)p; }
__device__ __forceinline__ int ssd_chunk_of(int d, int j) { return d ? (MR / 64 - 1 - j) : (j < CTXN / 64 ? SEQ / 64 + j : j - CTXN / 64); }
__device__ __forceinline__ float scan64(float v, int d, int lane) {
#pragma unroll
    for (int o = 1; o < 64; o <<= 1) { const float up = bperm(v, lane - o), dn = bperm(v, lane + o); if (d == 0) { if (lane >= o) v += up; } else { if (lane + o < 64) v += dn; } }
    return v;
}
__device__ __forceinline__ void conv_item(Frame& F, const float* cw, const float* cb_, int k, int cb) {
    LAS float* tin = (LAS float*)(F.lds + RING_OFF);
    LAS float* tout = tin + 68 * 64;
    const bf16* P = (const bf16*)(F.ws + WS_P);
    const int row0 = 64 * k, lo = k < SEQ / 64 ? 0 : SEQ, hi = k < SEQ / 64 ? SEQ : MR, c0 = 64 * cb;
    const int t = F.tid >> 3, c8 = (F.tid & 7) * 8;
    __syncthreads();
#pragma unroll
    for (int rr = t; rr < 68; rr += 64) { const int grow = row0 - 2 + rr; v4u w = (v4u){0u, 0u, 0u, 0u}; if (grow >= lo && grow < hi) w = *(const GAS v4u*)(P + (size_t)grow * NP + PC_XBC + c0 + c8);
        *(LAS f32x4*)(tin + rr * 64 + c8) = (f32x4){bflo(w.x), bfhi(w.x), bflo(w.y), bfhi(w.y)}; *(LAS f32x4*)(tin + rr * 64 + c8 + 4) = (f32x4){bflo(w.z), bfhi(w.z), bflo(w.w), bfhi(w.w)}; }
    __syncthreads();
    { f32x4 a0 = *(const f32x4*)(cb_ + c0 + c8), a1 = *(const f32x4*)(cb_ + c0 + c8 + 4);
#pragma unroll
      for (int j = 0; j < 5; ++j) { const f32x4 w0 = *(const f32x4*)(cw + j * 1280 + c0 + c8), w1 = *(const f32x4*)(cw + j * 1280 + c0 + c8 + 4);
          a0 += w0 * *(const LAS f32x4*)(tin + (t + j) * 64 + c8); a1 += w1 * *(const LAS f32x4*)(tin + (t + j) * 64 + c8 + 4); }
      float o[8];
#pragma unroll
      for (int i = 0; i < 4; ++i) { o[i] = silu_(a0[i]); o[4 + i] = silu_(a1[i]); }
#pragma unroll
      for (int i = 0; i < 8; ++i) tout[t * 65 + c8 + i] = o[i];
      v4u w; w.x = pk2(o[0], o[1]); w.y = pk2(o[2], o[3]); w.z = pk2(o[4], o[5]); w.w = pk2(o[6], o[7]);
      bf16* nat = (cb < 12) ? (bf16*)(F.ws + WS_XSN) + (size_t)(row0 + t) * 768 + c0 + c8
                : (cb < 16) ? (bf16*)(F.ws + WS_BN) + (size_t)(row0 + t) * 256 + (c0 - 768) + c8
                            : (bf16*)(F.ws + WS_CN) + (size_t)(row0 + t) * 256 + (c0 - 1024) + c8;
      *(GAS v4u*)nat = w; }
    __syncthreads();
    if (cb < 16) {
        const int c = F.tid >> 3, t8 = (F.tid & 7) * 8; float o[8];
#pragma unroll
        for (int i = 0; i < 8; ++i) o[i] = tout[(t8 + i) * 65 + c];
        v4u w; w.x = pk2(o[0], o[1]); w.y = pk2(o[2], o[3]); w.z = pk2(o[4], o[5]); w.w = pk2(o[6], o[7]);
        bf16* tr = (cb < 12) ? (bf16*)(F.ws + WS_XT) + ((size_t)(k * 12 + cb) * 64 + c) * 64 + t8
                             : (bf16*)(F.ws + WS_BT) + ((size_t)k * 256 + (c0 - 768) + c) * 64 + t8;
        *(GAS v4u*)tr = w;
    }
}
__device__ __forceinline__ void conv_wave_item(Frame& F, const float* cw, const float* cb_, int k, int c0, LAS float* buf) {
    const bf16* P = (const bf16*)(F.ws + WS_P);
    const int row0 = 64 * k, lo = k < SEQ / 64 ? 0 : SEQ, hi = k < SEQ / 64 ? SEQ : MR, t = F.lane;
    { const int g0 = row0 - 2 + t; v4u w = (v4u){0u, 0u, 0u, 0u}; if (g0 >= lo && g0 < hi) w = *(const GAS v4u*)(P + (size_t)g0 * NP + PC_XBC + c0);
      *(LAS f32x4*)(buf + t * 8) = (f32x4){bflo(w.x), bfhi(w.x), bflo(w.y), bfhi(w.y)}; *(LAS f32x4*)(buf + t * 8 + 4) = (f32x4){bflo(w.z), bfhi(w.z), bflo(w.w), bfhi(w.w)};
      if (t < 4) { const int g1 = row0 + 62 + t; v4u w1 = (v4u){0u, 0u, 0u, 0u}; if (g1 >= lo && g1 < hi) w1 = *(const GAS v4u*)(P + (size_t)g1 * NP + PC_XBC + c0);
          *(LAS f32x4*)(buf + (64 + t) * 8) = (f32x4){bflo(w1.x), bfhi(w1.x), bflo(w1.y), bfhi(w1.y)}; *(LAS f32x4*)(buf + (64 + t) * 8 + 4) = (f32x4){bflo(w1.z), bfhi(w1.z), bflo(w1.w), bfhi(w1.w)}; } }
    LDS_WAIT(); asm volatile("" ::: "memory");
    f32x4 a0 = *(const f32x4*)(cb_ + c0), a1 = *(const f32x4*)(cb_ + c0 + 4);
#pragma unroll
    for (int j = 0; j < 5; ++j) { const f32x4 w0 = *(const f32x4*)(cw + j * 1280 + c0), w1 = *(const f32x4*)(cw + j * 1280 + c0 + 4);
        a0 += w0 * *(const LAS f32x4*)(buf + (t + j) * 8); a1 += w1 * *(const LAS f32x4*)(buf + (t + j) * 8 + 4); }
    float o[8];
#pragma unroll
    for (int i = 0; i < 4; ++i) { o[i] = silu_(a0[i]); o[4 + i] = silu_(a1[i]); }
    v4u w; w.x = pk2(o[0], o[1]); w.y = pk2(o[2], o[3]); w.z = pk2(o[4], o[5]); w.w = pk2(o[6], o[7]);
    if (c0 >= 768) { bf16* nat = (c0 < 1024) ? (bf16*)(F.ws + WS_BN) + (size_t)(row0 + t) * 256 + (c0 - 768) : (bf16*)(F.ws + WS_CN) + (size_t)(row0 + t) * 256 + (c0 - 1024); *(GAS v4u*)nat = w; }
    if (c0 < 1024) { bf16* tr = (c0 < 768) ? (bf16*)(F.ws + WS_XT) + ((size_t)(k * 12 + (c0 >> 6)) * 64 + (c0 & 63)) * 64 + t : (bf16*)(F.ws + WS_BT) + ((size_t)k * 256 + (c0 - 768)) * 64 + t;
#pragma unroll
        for (int i = 0; i < 8; ++i) tr[(size_t)i * 64] = (bf16)f2bf(o[i]); }
    LDS_WAIT(); asm volatile("" ::: "memory");
}
#ifndef ST_HPI
#define ST_HPI 2
#endif
#ifndef CARRY_UNR
#define CARRY_UNR 13
#endif
__device__ __forceinline__ void ssd_states(Frame& F, KArgs a, int l) {
    const int gw = F.vcu * NWAVES + F.wave, NGW = F.G * NWAVES, lane = F.lane, r = lane & 15, q = lane >> 4;
    LAS float* wb = (LAS float*)(F.lds + RING_OFF + F.wave * 2048);
    const float* DT = (const float*)(F.ws + WS_DT); const bf16* XT = (const bf16*)(F.ws + WS_XT); const bf16* BT = (const bf16*)(F.ws + WS_BT);
    bf16* ST = (bf16*)(F.ws + WS_STATES); float* CHD = (float*)(F.ws + WS_CHD); const float* alog = AIN(I_ALOG) + l * 24;
    for (int item = gw; item < (MR / 64) * 4 * (6 / ST_HPI); item += NGW) {
        const int hp = item % (6 / ST_HPI), i4 = item / (6 / ST_HPI), k = i4 >> 2, g = (i4 >> 1) & 1, d = i4 & 1, row0 = 64 * k;
#pragma unroll
        for (int hh = 0; hh < ST_HPI; ++hh) { const int dh = d * 12 + g * 6 + hp * ST_HPI + hh; const float dt = DT[(size_t)(row0 + lane) * 24 + dh]; const float A = -__expf(alog[dh]);
            const float cum = scan64(A * dt, d, lane); const float tot = __int_as_float(d ? __builtin_amdgcn_readlane(__float_as_int(cum), 0) : __builtin_amdgcn_readlane(__float_as_int(cum), 63));
            wb[hh * 64 + lane] = dt * __expf(tot - cum);
            if (lane == 0) CHD[k * 24 + dh] = __expf(tot); }
        LDS_WAIT(); asm volatile("" ::: "memory");
        for (int hh = 0; hh < ST_HPI; ++hh) {
            const int h = g * 6 + hp * ST_HPI + hh, dh = d * 12 + h;
            bf16x8 af[4][2];
#pragma unroll
            for (int ks = 0; ks < 2; ++ks) { const f32x4 w0 = *(const LAS f32x4*)(wb + hh * 64 + 32 * ks + 8 * q), w1 = *(const LAS f32x4*)(wb + hh * 64 + 32 * ks + 8 * q + 4);
#pragma unroll
                for (int pt = 0; pt < 4; ++pt) { const v4u x = *(const GAS v4u*)(XT + ((size_t)(k * 12 + h) * 64 + 16 * pt + r) * 64 + 32 * ks + 8 * q);
                    v4u y; y.x = pk2(bflo(x.x) * w0.x, bfhi(x.x) * w0.y); y.y = pk2(bflo(x.y) * w0.z, bfhi(x.y) * w0.w); y.z = pk2(bflo(x.z) * w1.x, bfhi(x.z) * w1.y); y.w = pk2(bflo(x.w) * w1.z, bfhi(x.w) * w1.w);
                    af[pt][ks] = __builtin_bit_cast(bf16x8, y); } }
#pragma unroll
            for (int half = 0; half < 2; ++half) {
                f32x4 acc[4][4];
#pragma unroll
                for (int pt = 0; pt < 4; ++pt)
#pragma unroll
                    for (int nt = 0; nt < 4; ++nt) acc[pt][nt] = (f32x4){0.f, 0.f, 0.f, 0.f};
#pragma unroll
                for (int ks = 0; ks < 2; ++ks)
#pragma unroll
                    for (int nt = 0; nt < 4; ++nt) { const bf16x8 bv = ldg8(BT + ((size_t)(k * 2 + g) * 128 + 64 * half + 16 * nt + r) * 64 + 32 * ks + 8 * q);
#pragma unroll
                        for (int pt = 0; pt < 4; ++pt) acc[pt][nt] = __builtin_amdgcn_mfma_f32_16x16x32_bf16(af[pt][ks], bv, acc[pt][nt], 0, 0, 0); }
#pragma unroll
                for (int pt = 0; pt < 4; ++pt)
#pragma unroll
                    for (int nt = 0; nt < 4; ++nt)
#pragma unroll
                        for (int rg = 0; rg < 4; ++rg) ST[((size_t)(k * 24 + dh) * 64 + 16 * pt + 4 * q + rg) * 128 + 64 * half + 16 * nt + r] = (bf16)f2bf(acc[pt][nt][rg]);
            }
        }
        LDS_WAIT(); asm volatile("" ::: "memory");
    }
}
__device__ __forceinline__ void ssd_carry(Frame& F) {
    const bf16* ST = (const bf16*)(F.ws + WS_STATES); const float* CHD = (const float*)(F.ws + WS_CHD); bf16* SB = (bf16*)(F.ws + WS_SINB);
    for (int idx = F.vcu * 512 + F.tid; idx < 24 * 64 * 32; idx += F.G * 512) {
        const int dh = idx >> 11, rem = idx & 2047, d = dh / 12; const size_t eo = (size_t)(rem >> 5) * 128 + (rem & 31) * 4;
        f32x4 S = {0.f, 0.f, 0.f, 0.f};
        for (int j = 0; j < MR / 64; j += CARRY_UNR) {
            f32x4 st[CARRY_UNR]; float dc[CARRY_UNR]; size_t off[CARRY_UNR];
#pragma unroll
            for (int i = 0; i < CARRY_UNR; ++i) { const int k = ssd_chunk_of(d, j + i); off[i] = (size_t)(k * 24 + dh) * 8192 + eo; const v2u sw = *(const GAS v2u*)(ST + off[i]); st[i] = (f32x4){bflo(sw.x), bfhi(sw.x), bflo(sw.y), bfhi(sw.y)}; dc[i] = CHD[k * 24 + dh]; }
#pragma unroll
            for (int i = 0; i < CARRY_UNR; ++i) { v2u w; w.x = pk2(S.x, S.y); w.y = pk2(S.z, S.w); *(GAS v2u*)(SB + off[i]) = w; S = S * dc[i] + st[i]; }
        }
    }
}
__device__ __forceinline__ void ssd_outputs(Frame& F, KArgs a, int l) {
    const int gw = F.vcu * NWAVES + F.wave, NGW = F.G * NWAVES, lane = F.lane, r = lane & 15, q = lane >> 4;
    LAS bf16* Mb = (LAS bf16*)(F.lds + RING_OFF + F.wave * 10240);
    LAS float* cumb = (LAS float*)(F.lds + RING_OFF + F.wave * 10240 + 8192);
    const float* DT = (const float*)(F.ws + WS_DT); const bf16* XT = (const bf16*)(F.ws + WS_XT); const bf16* BN = (const bf16*)(F.ws + WS_BN); const bf16* CN = (const bf16*)(F.ws + WS_CN);
    const bf16* SB = (const bf16*)(F.ws + WS_SINB); bf16* YS = (bf16*)(F.ws + WS_YS); const float* alog = AIN(I_ALOG) + l * 24;
    for (int base = 0, rnd = 0; base < (MR / 64) * 12; base += NGW, ++rnd) {
        const int item = base + ((rnd & 1) ? NGW - 1 - gw : gw); if (item >= (MR / 64) * 12) continue;
        const int hp = item % 3, i4 = item / 3, k = i4 >> 2, g = (i4 >> 1) & 1, d = i4 & 1, row0 = 64 * k;
        f32x4 G[4][4];
#pragma unroll
        for (int it = 0; it < 4; ++it)
#pragma unroll
            for (int st = 0; st < 4; ++st) G[it][st] = (f32x4){0.f, 0.f, 0.f, 0.f};
#pragma unroll 1
        for (int ks = 0; ks < 4; ++ks) { bf16x8 cf[4], bfr[4];
#pragma unroll
            for (int i = 0; i < 4; ++i) { cf[i] = ldg8(CN + (size_t)(row0 + 16 * i + r) * 256 + g * 128 + 32 * ks + 8 * q); bfr[i] = ldg8(BN + (size_t)(row0 + 16 * i + r) * 256 + g * 128 + 32 * ks + 8 * q); }
#pragma unroll
            for (int it = 0; it < 4; ++it)
#pragma unroll
                for (int st = 0; st < 4; ++st) G[it][st] = __builtin_amdgcn_mfma_f32_16x16x32_bf16(cf[it], bfr[st], G[it][st], 0, 0, 0); }
        for (int hh = 2 * hp; hh < 2 * hp + 2; ++hh) {
            const int h = g * 6 + hh, dh = d * 12 + h; const float dskip = AIN(I_SSDD)[l * 12 + h];
            { const float dt = DT[(size_t)(row0 + lane) * 24 + dh]; const float A = -__expf(alog[dh]); const float cum = scan64(A * dt, d, lane);
              cumb[lane] = cum; cumb[64 + lane] = __expf(cum); cumb[128 + lane] = dt; }
            LDS_WAIT(); asm volatile("" ::: "memory");
            { float cs[4], ds[4];
#pragma unroll
              for (int st = 0; st < 4; ++st) { cs[st] = cumb[16 * st + r]; ds[st] = cumb[128 + 16 * st + r]; }
#pragma unroll
              for (int it = 0; it < 4; ++it)
#pragma unroll
                  for (int rg = 0; rg < 4; ++rg) { const int i = 16 * it + 4 * q + rg; const float ci = cumb[i];
#pragma unroll
                      for (int st = 0; st < 4; ++st) { const int s = 16 * st + r; const bool on = d ? (s >= i) : (s <= i);
                          float v = on ? G[it][st][rg] * __expf(ci - cs[st]) * ds[st] : 0.f; if (s == i && d == 0) v += dskip; Mb[i * 64 + s] = (bf16)f2bf(v); } } }
            f32x4 acc[4][4];
#pragma unroll
            for (int it = 0; it < 4; ++it)
#pragma unroll
                for (int pt = 0; pt < 4; ++pt) acc[it][pt] = (f32x4){0.f, 0.f, 0.f, 0.f};
#pragma unroll 1
            for (int ks = 0; ks < 4; ++ks) { bf16x8 cf[4], sf[4];
#pragma unroll
                for (int i = 0; i < 4; ++i) { cf[i] = ldg8(CN + (size_t)(row0 + 16 * i + r) * 256 + g * 128 + 32 * ks + 8 * q); sf[i] = ldg8(SB + ((size_t)(k * 24 + dh) * 64 + 16 * i + r) * 128 + 32 * ks + 8 * q); }
#pragma unroll
                for (int it = 0; it < 4; ++it)
#pragma unroll
                    for (int pt = 0; pt < 4; ++pt) acc[it][pt] = __builtin_amdgcn_mfma_f32_16x16x32_bf16(cf[it], sf[pt], acc[it][pt], 0, 0, 0); }
#pragma unroll
            for (int it = 0; it < 4; ++it)
#pragma unroll
                for (int rg = 0; rg < 4; ++rg) { const float e = cumb[64 + 16 * it + 4 * q + rg];
#pragma unroll
                    for (int pt = 0; pt < 4; ++pt) acc[it][pt][rg] *= e; }
            LDS_WAIT(); asm volatile("" ::: "memory");
#pragma unroll 1
            for (int ks = 0; ks < 2; ++ks) { bf16x8 mf[4], xf[4];
#pragma unroll
                for (int i = 0; i < 4; ++i) { mf[i] = *(const LAS bf16x8*)(Mb + (16 * i + r) * 64 + 32 * ks + 8 * q); xf[i] = ldg8(XT + ((size_t)(k * 12 + h) * 64 + 16 * i + r) * 64 + 32 * ks + 8 * q); }
#pragma unroll
                for (int it = 0; it < 4; ++it)
#pragma unroll
                    for (int pt = 0; pt < 4; ++pt) acc[it][pt] = __builtin_amdgcn_mfma_f32_16x16x32_bf16(mf[it], xf[pt], acc[it][pt], 0, 0, 0); }
#pragma unroll
            for (int it = 0; it < 4; ++it)
#pragma unroll
                for (int pt = 0; pt < 4; ++pt)
#pragma unroll
                    for (int rg = 0; rg < 4; ++rg) YS[((size_t)d * MR + row0 + 16 * it + 4 * q + rg) * 768 + h * 64 + 16 * pt + r] = (bf16)f2bf(acc[it][pt][rg]);
            LDS_WAIT(); asm volatile("" ::: "memory");
        }
    }
}
#ifndef SWA_EARLY
#define SWA_EARLY 304
#endif
#ifndef PREPDUP
#define PREPDUP 0
#endif
#ifndef PREP_REV
#define PREP_REV 0
#endif
__device__ __forceinline__ void prep_phase(Frame& F, KArgs a, int l) {
    const bf16* P = (const bf16*)(F.ws + WS_P);
    { const float* cw = AIN(I_CONVW) + (size_t)l * 5 * 1280; const float* cb = AIN(I_CONVB) + (size_t)l * 1280;
      LAS float* cbuf = (LAS float*)(F.lds + RING_OFF + F.wave * 4096);
      for (int rep_ = 0; rep_ <= (PREPDUP & 1); ++rep_)
      for (int it = F.vcu * NWAVES + F.wave; it < (MR / 64) * 160; it += F.G * NWAVES) conv_wave_item(F, cw, cb, it / 160, 8 * (it % 160), cbuf);
      __syncthreads(); }
    { const float* DTR = (const float*)(F.ws + WS_DTRAW); float* DT = (float*)(F.ws + WS_DT); const float* dtb = AIN(I_DTB) + l * 24;
      for (int i = F.vcu * 512 + F.tid; i < MR * 24; i += F.G * 512) { const int m = i / 24, j = i % 24; const float x = DTR[m * 32 + j] + dtb[j];
          DT[i] = fmaxf(x, 0.f) + __logf(1.0f + __expf(-fabsf(x))); } }
    { const int gw = F.vcu * NWAVES + F.wave, NGW = F.G * NWAVES, lane = F.lane, j8 = lane & 7;
      float inv[8];
#pragma unroll
      for (int j = 0; j < 8; ++j) inv[j] = __builtin_amdgcn_exp2f(-(float)(((j8 & 1) * 8 + j)) * (13.287712379549449f / 16.0f));
      bf16* QS = (bf16*)(F.ws + WS_QS); bf16* QG = (bf16*)(F.ws + WS_QG); bf16* KS = (bf16*)(F.ws + WS_KS); bf16* KG = (bf16*)(F.ws + WS_KG);
      const float* gsw = AIN(I_SWAG) + l * 128; const float* ggl = AIN(I_GLBG) + l * 128;
      for (int rep_ = 0; rep_ <= ((PREPDUP >> 1) & 1); ++rep_)
      for (int it = gw; it < MR * 3; it += NGW) {
          const int m = PREP_REV ? (MR - 1 - it / 3) : it / 3, part = it % 3; const bool act = part < 2 || lane < 32; const bool glb = part == 1 || (part == 2 && lane >= 16); const bool isk = part == 2;
          const int hl = isk ? ((lane >> 3) & 1) : (lane >> 3);
          const int col = (glb ? (isk ? PC_GK : PC_GQ) : (isk ? PC_SK : PC_SQ)) + 64 * hl + 8 * j8;
          v4u w = (v4u){0u, 0u, 0u, 0u}; if (act) w = *(const GAS v4u*)(P + (size_t)m * NP + col);
          float x[8] = {bflo(w.x), bfhi(w.x), bflo(w.y), bfhi(w.y), bflo(w.z), bfhi(w.z), bflo(w.w), bfhi(w.w)};
          float ss = 0.f;
#pragma unroll
          for (int j = 0; j < 8; ++j) ss += x[j] * x[j];
          ss += bperm(ss, lane ^ 1); ss += bperm(ss, lane ^ 2); ss += bperm(ss, lane ^ 4);
          const float rs = 1.0f / sqrtf(ss * (1.0f / 64.0f) + 1e-6f);
          const float* gp = (glb ? ggl : gsw) + (isk ? 64 : 0) + 8 * j8; const f32x4 g0 = *(const f32x4*)gp, g1 = *(const f32x4*)(gp + 4);
          const float gg[8] = {g0.x, g0.y, g0.z, g0.w, g1.x, g1.y, g1.z, g1.w};
#pragma unroll
          for (int j = 0; j < 8; ++j) x[j] = x[j] * rs * gg[j];
          if (m < SEQ) { const float pos = ((j8 & 3) < 2) ? (float)(m >> 6) : (float)(m & 63); const bool lo = j8 < 4;
#pragma unroll
              for (int j = 0; j < 8; ++j) { float sn, cs; sincos_hw(pos * inv[j], sn, cs); const float other = bperm(x[j], lane ^ 4); x[j] = lo ? (x[j] * cs - other * sn) : (other * sn + x[j] * cs); } }
          if (!isk) {
#pragma unroll
              for (int j = 0; j < 8; ++j) x[j] *= QSCALE; }
          v4u o; o.x = pk2(x[0], x[1]); o.y = pk2(x[2], x[3]); o.z = pk2(x[4], x[5]); o.w = pk2(x[6], x[7]);
          bf16* dst = isk ? ((glb ? KG : KS) + (size_t)m * 128 + 64 * hl + 8 * j8) : ((glb ? QG : QS) + (size_t)m * 512 + 64 * hl + 8 * j8);
          if (act) *(GAS v4u*)dst = o;
      } }
}
__device__ __forceinline__ void attn_all(Frame& F, KArgs a, int l) {
    typedef attn_body::bf16 ab;
    char* shm = (char*)(unsigned char*)(F.lds + RING_OFF);
#ifndef NO_MODE0
    for (int u = F.vcu; u < 528; u += F.G) {
        unsigned long long w_ = (unsigned long long)F.ws; asm volatile("" : "+s"(w_)); unsigned char* ws = (unsigned char*)(GAS unsigned char*)w_;
        if (u < 512) { const int kvh = u >> 8, g = (u >> 6) & 3, qb = u & 63, head = kvh * 4 + g; const size_t qo = (size_t)(qb * 256) * 512 + head * 64, oo = (size_t)(qb * 256) * YPITCH + YC_D + head * 64;
            attn_body::attn_unit<8, 0>((const ab*)(ws + WS_QG) + qo, (const ab*)(ws + WS_KG) + kvh * 64, (const ab*)(ws + WS_P) + PC_GV + kvh * 64, (ab*)(ws + WS_YALL) + oo, MR / 64, 0, 0, 0, 0, 0.f, false, shm); }
        else { const int ty = (u - 512) >> 3, head = (u - 512) & 7, kvh = head >> 2; const size_t qo = (size_t)SEQ * 512 + head * 64, oo = (size_t)SEQ * YPITCH + (ty ? YC_C : YC_D) + head * 64;
            const float s2 = ty ? (AIN(I_SINK) + l * 8)[head] * LOG2E : 0.f;
            attn_body::attn_unit<8, 0>((const ab*)(ws + (ty ? WS_QS : WS_QG)) + qo, (const ab*)(ws + (ty ? WS_KS : WS_KG)) + (size_t)SEQ * 128 + kvh * 64, (const ab*)(ws + WS_P) + (ty ? PC_SV : PC_GV) + (size_t)SEQ * NP + kvh * 64,
                                       (ab*)(ws + WS_YALL) + oo, 4, 0, 0, 0, 0, s2, ty != 0, shm); }
    }
#endif
}
__device__ __forceinline__ void attn_swa(Frame& F, KArgs a, int l, int ubeg, int uend, int bfirst, int nb) {
    typedef attn_body::bf16 ab;
    char* shm = (char*)(unsigned char*)(F.lds + RING_OFF);
    if (F.vcu < bfirst || F.vcu >= bfirst + nb) return;
    for (int u = ubeg + F.vcu - bfirst; u < uend; u += nb) {
        unsigned long long w_ = (unsigned long long)F.ws; asm volatile("" : "+s"(w_)); unsigned char* ws = (unsigned char*)(GAS unsigned char*)w_;
        const int head = u >> 6, qb = u & 63, kvh = head >> 2, q0 = qb * 256; const int wlo = q0 - 128 < 0 ? 0 : q0 - 128, whi = q0 + 384 > SEQ ? SEQ : q0 + 384; const size_t qo = (size_t)q0 * 512 + head * 64, oo = (size_t)q0 * YPITCH + YC_C + head * 64;
        attn_body::attn_unit<8, 1>((const ab*)(ws + WS_QS) + qo, (const ab*)(ws + WS_KS) + kvh * 64, (const ab*)(ws + WS_P) + PC_SV + kvh * 64, (ab*)(ws + WS_YALL) + oo, 4 + (whi - wlo) / 64, 4, SEQ, wlo, q0, (AIN(I_SINK) + l * 8)[head] * LOG2E, true, shm);
    }
}
#ifndef MIXDUP
#define MIXDUP 0
#endif
__device__ __forceinline__ void mixers_phase(Frame& F0, KArgs a, int l) {
    for (int rep_ = 0; rep_ <= ((MIXDUP >> 0) & 1); ++rep_) { Frame F = fresh(F0); attn_all(F, a, l); __syncthreads(); }
    { Frame F = fresh(F0); attn_swa(F, a, l, SWA_EARLY, 512, 0, F.G); __syncthreads(); }
#if 0
    for (int rep_ = 0; rep_ <= ((MIXDUP >> 1) & 1); ++rep_) { Frame F = fresh(F0); for (int it = F.vcu; it < 256; it += F.G) attn_simple_item(F, a, l, 1, it >> 7, it & 127); __syncthreads(); }
#endif
    for (int rep_ = 0; rep_ <= ((MIXDUP >> 2) & 1); ++rep_) { Frame F = fresh(F0); s5_pass<true>(F, a, l); __syncthreads(); }
    for (int rep_ = 0; rep_ <= ((MIXDUP >> 3) & 1); ++rep_) { Frame F = fresh(F0); ssd_outputs(F, a, l); __syncthreads(); }
}
__device__ __forceinline__ void post_phase(Frame& F, KArgs a, int l) {
    const int gw = F.vcu * NWAVES + F.wave, NGW = F.G * NWAVES;
    const bf16* P = (const bf16*)(F.ws + WS_P); const bf16* YS = (const bf16*)(F.ws + WS_YS);
    bf16* YA = (bf16*)(F.ws + WS_YALL); const float* ng = AIN(I_SSDNG) + l * 768;
    for (int m = gw; m < MR; m += NGW) {
        float y[12]; float ss = 0.f;
#pragma unroll
        for (int j = 0; j < 3; ++j) { const int c = 4 * F.lane + 256 * j;
            const v2u yfw = *(const GAS v2u*)(YS + (size_t)m * 768 + c), ybw = *(const GAS v2u*)(YS + (size_t)(MR + m) * 768 + c); const f32x4 yf = {bflo(yfw.x), bfhi(yfw.x), bflo(yfw.y), bfhi(yfw.y)}, yb = {bflo(ybw.x), bfhi(ybw.x), bflo(ybw.y), bfhi(ybw.y)};
            const v2u zw = *(const GAS v2u*)(P + (size_t)m * NP + PC_Z + c);
            const float z[4] = {bflo(zw.x), bfhi(zw.x), bflo(zw.y), bfhi(zw.y)};
#pragma unroll
            for (int i = 0; i < 4; ++i) { const float t = (yf[i] + yb[i]) * silu_(z[i]); y[4 * j + i] = t; ss += t * t; } }
        const float rstd = 1.0f / sqrtf(wave_sum(ss, F.lane) * (1.0f / 768.0f) + 1e-6f);
#pragma unroll
        for (int j = 0; j < 3; ++j) { const int c = 4 * F.lane + 256 * j; const f32x4 gg = *(const f32x4*)(ng + c);
            v2u w; w.x = pk2(y[4 * j] * rstd * gg.x, y[4 * j + 1] * rstd * gg.y); w.y = pk2(y[4 * j + 2] * rstd * gg.z, y[4 * j + 3] * rstd * gg.w);
            *(GAS v2u*)(YA + (size_t)m * YPITCH + c) = w; }
    }
    const bf16* YBF = (const bf16*)(F.ws + WS_YBF); bf16* YBP = (bf16*)(F.ws + WS_YBP); const float* d5 = AIN(I_S5D) + l * 512;
    for (int i = F.vcu * 512 + F.tid; i < MR * 128; i += F.G * 512) {
        const int m = i >> 7, c = (i & 127) * 4;
        const v2u y0w = *(const GAS v2u*)(YBF + (size_t)m * 512 + c), y1w = *(const GAS v2u*)(YBF + (size_t)(MR + m) * 512 + c); const f32x4 y0 = {bflo(y0w.x), bfhi(y0w.x), bflo(y0w.y), bfhi(y0w.y)}, y1 = {bflo(y1w.x), bfhi(y1w.x), bflo(y1w.y), bfhi(y1w.y)}, dd = *(const f32x4*)(d5 + c);
        const v2u uw = *(const GAS v2u*)(P + (size_t)m * NP + PC_U + c); const float u[4] = {bflo(uw.x), bfhi(uw.x), bflo(uw.y), bfhi(uw.y)}; float r[4];
#pragma unroll
        for (int q = 0; q < 4; ++q) { const float x = y0[q] + y1[q] + dd[q] * u[q]; const float t = 0.7978845608028654f * (x + 0.044715f * x * x * x);
            const float th = 1.0f - 2.0f * __builtin_amdgcn_rcpf(1.0f + __builtin_amdgcn_exp2f(2.0f * LOG2E * t));
            r[q] = 0.5f * x * (1.0f + th); }
        v2u w; w.x = pk2(r[0], r[1]); w.y = pk2(r[2], r[3]); *(GAS v2u*)(YBP + (size_t)m * 512 + c) = w;
    }
}
#ifndef MK_PER_PHASE
#define MK_PER_PHASE 0
#endif
#ifndef REV_RES
#define REV_RES 1
#endif
#ifndef WGM_FFI
#define WGM_FFI 2
#endif
#ifndef WGM_WIN
#define WGM_WIN 2
#endif
#ifndef WGM_RES
#define WGM_RES 2
#endif
#ifndef WGM_MRG
#define WGM_MRG 2
#endif
constexpr int PH_PER_LAYER = 16, NPHASE = 2 + DEPTH * PH_PER_LAYER;
#ifndef GPA
#define GPA true
#endif
#ifndef GPS
#define GPS true
#endif
#ifndef GPAR
#define GPAR true
#endif
constexpr bool GP_ALIGN = GPA, GP_SP2 = GPS, GP_ALIGN_RESID = GPAR;
__global__ void __launch_bounds__(NWAVES * 64, 2) trunk_fwd(Args args) {
    extern __shared__ __attribute__((aligned(16))) unsigned char lds[];
    KArgs KA = (KArgs)__builtin_amdgcn_kernarg_segment_ptr();
    Frame F;
    F.lds = (LAS unsigned char*)lds;
    F.MISC = (volatile LAS unsigned*)(F.lds + MISC_OFF);
    F.tid = threadIdx.x; F.lane = F.tid & 63; F.wave = __builtin_amdgcn_readfirstlane(F.tid >> 6);
    F.G = gridDim.x; { const int bx = blockIdx.x; F.vcu = (F.G % 8 == 0) ? (bx % 8) * (F.G / 8) + bx / 8 : bx; }
    F.ws = (unsigned char*)(GAS unsigned char*)args.ws; F.ctl = (gu32*)(args.ws + WS_CTL);
    for (int u = F.tid; u < (LDS_BYTES - LDSCTL_OFF) / 4; u += NWAVES * 64) ((LAS unsigned*)(F.lds + LDSCTL_OFF))[u] = 0u;
    __syncthreads();
    XcdBarrier bar; bar.bar = (unsigned*)(F.ctl + CW_BAR); bar.x = 0; bar.st = nullptr;
    if (!MK_PER_PHASE) bar = xcd_barrier_post((unsigned*)(F.ctl + CW_BAR), F.MISC + 8);
    const int lo = args.ph_lo, hi = args.ph_hi;
#ifndef ONLY
#define ONLY -1
#endif
#define KON(i) (ONLY < 0 || ONLY == (i))
#ifndef DUPMASK
#define DUPMASK 0ull
#endif
#define DUPK(i) ((int)(((unsigned long long)(DUPMASK) >> (i)) & 1ull))
#define IN(k) (lo <= (k) && (k) < hi)
#define GEMM_PTRS() FRESH(); unsigned char* ws = Fp.ws; float* X = (float*)(ws + WS_X); bf16* H = (bf16*)(ws + WS_H); bf16* HID = (bf16*)(ws + WS_HID); bf16* P = (bf16*)(ws + WS_P); const bf16* WL = (const bf16*)(ws + WS_W) + (size_t)lp * WL_SIZE; \
    const float* modl = (const float*)(ws + WS_MOD) + (size_t)(lp * 2 + 0) * NMODV; const float* modc = (const float*)(ws + WS_MOD) + (size_t)(lp * 2 + 1) * NMODV; (void)X; (void)H; (void)HID; (void)P; (void)WL; (void)modl; (void)modc;
#define FRESH() Frame Fp = fresh(F); int lp = l; asm volatile("" : "+s"(lp));
#define SEAM(k) do { if (!MK_PER_PHASE && (k) + 1 < hi) xcd_barrier(bar); } while (0)
    PG8_LAS unsigned char* ring = (PG8_LAS unsigned char*)(F.lds + RING_OFF);

    if (KON(100) && IN(0)) { for (int rep_ = 0; rep_ <= DUPK(40); ++rep_) { if (rep_) xcd_barrier(bar); p0_prologue(F, KA); } SEAM(0); }
    if (KON(101) && IN(1)) { p1_modfinal(F, KA); SEAM(1); }
    for (int st = 0; st < 2 * DEPTH; ++st) {
        const int l = st >> 1, f = st & 1; const int pb = 2 + PH_PER_LAYER * l;
        if (f) {
            if (KON(3) && IN(pb + 3)) { FRESH(); norm_phase(Fp, KA, lp, 1, DFF / 512); SEAM(pb + 3); }
            if (KON(4) && IN(pb + 4)) { for (int rep_ = 0; rep_ <= DUPK(4); ++rep_) { if (rep_) xcd_barrier(bar); { GEMM_PTRS(); pg8::Gemm g{H, WL + WL_WIN, MR, NP, DM, DM}; pg8::StaticOrder S; S.init(MR, NP, Fp.G, (int)blockIdx.x, WGM_WIN); pg8::EpiWin E{P, NP, PC_GATE / 256, PC_GATE};
                pg8::gemm_phase<pg8::EpiWin, pg8::StaticOrder, GP_ALIGN, GP_SP2>(ring, g, S, E);
                if (HIDE_CONVERT) { convert_idle(Fp, KA, (int)blockIdx.x, (MR / 256) * (NP / 256) % Fp.G, lp, IT_GA + IT_GB, IT_GC + (lp == DEPTH - 1 ? IT_GD : IT_GD / 2)); }    dt_gemm(Fp, lp, (int)blockIdx.x, (MR / 256) * (NP / 256) % Fp.G); } } SEAM(pb + 4); }
            if (KON(5) && IN(pb + 5)) { for (int rep_ = 0; rep_ <= DUPK(5); ++rep_) { if (rep_) xcd_barrier(bar); { FRESH(); prep_phase(Fp, KA, lp); __syncthreads(); for (int r2_ = 0; r2_ <= ((PREPDUP >> 2) & 1); ++r2_) s5_pass<false>(Fp, KA, lp); } } SEAM(pb + 5); }
            if (KON(6) && IN(pb + 6)) { for (int rep_ = 0; rep_ <= DUPK(6); ++rep_) { if (rep_) xcd_barrier(bar); { { FRESH(); ssd_states(Fp, KA, lp); } } } SEAM(pb + 6); }
            if (KON(7) && IN(pb + 7)) { for (int rep_ = 0; rep_ <= DUPK(7); ++rep_) { if (rep_) xcd_barrier(bar); { { FRESH(); s5_carry(Fp, KA, lp, 96 * NWAVES); } { FRESH(); ssd_carry(Fp); } if (SWA_EARLY > 0) { FRESH(); attn_swa(Fp, KA, lp, 0, SWA_EARLY, 104, Fp.G - 104); } } } SEAM(pb + 7); }
            if (KON(8) && IN(pb + 8)) { for (int rep_ = 0; rep_ <= DUPK(8); ++rep_) { if (rep_) xcd_barrier(bar); { FRESH(); mixers_phase(Fp, KA, lp); } } SEAM(pb + 8); }
            if (KON(9) && IN(pb + 9)) { for (int rep_ = 0; rep_ <= DUPK(9); ++rep_) { if (rep_) xcd_barrier(bar); { FRESH(); post_phase(Fp, KA, lp); } } SEAM(pb + 9); }
            if (KON(10) && IN(pb + 10)) { for (int rep_ = 0; rep_ <= DUPK(10); ++rep_) { if (rep_) xcd_barrier(bar); { GEMM_PTRS(); const int Mq = (lp == DEPTH - 1) ? SEQ : MR; pg8::Gemm g{(const bf16*)(ws + WS_YBP), WL + WL_GLU, Mq, 1024, 512, 512}; pg8::StaticOrder S; S.init(Mq, 1024, Fp.G, (int)blockIdx.x);
                pg8::EpiGated<1> E{(bf16*)(ws + WS_YALL) + YC_B, YPITCH, ((const float*)(const GAS float*)KA->in[I_GLUB]) + (size_t)lp * 1024, 512};
                pg8::gemm_phase<pg8::EpiGated<1>, pg8::StaticOrder, GP_ALIGN, GP_SP2>(ring, g, S, E); } } SEAM(pb + 10); }
            if (KON(11) && IN(pb + 11)) { for (int rep_ = 0; rep_ <= DUPK(11); ++rep_) { if (rep_) xcd_barrier(bar); { GEMM_PTRS(); const int Mq = (lp == DEPTH - 1) ? SEQ : MR;
                pg8::Gemm g{(const bf16*)(ws + WS_YALL), WL + WL_BRALL, Mq, DM, YPITCH, YPITCH}; pg8::MergeOrder S; S.so.init(Mq, DM, Fp.G, (int)blockIdx.x, WGM_MRG); pg8::EpiMergeR E{P + PC_GATE, NP, (bf16*)(ws + WS_MG)};
                pg8::gemm_phase<pg8::EpiMergeR, pg8::MergeOrder, GP_ALIGN, GP_SP2>(ring, g, S, E);
                if (HIDE_CONVERT && lp < DEPTH - 1) { const int rem = (MR / 256) * (DM / 256) % Fp.G; convert_idle(Fp, KA, (int)blockIdx.x, rem, lp, IT_LAYER - IT_GD / 2, IT_GD / 2); convert_idle(Fp, KA, (int)blockIdx.x, rem, lp + 1, 0, IT_GA / 2); } } } SEAM(pb + 11); }
            if (KON(12) && IN(pb + 12)) { for (int rep_ = 0; rep_ <= DUPK(12); ++rep_) { if (rep_) xcd_barrier(bar); { GEMM_PTRS();
                { pg8::Gemm g{(const bf16*)(ws + WS_MG), WL + WL_OUT, SEQ, DM, DM, DM}; pg8::StaticOrder S; S.init(SEQ, DM, Fp.G, (int)blockIdx.x, WGM_RES, REV_RES); pg8::EpiResid E{X, (rep_ < DUPK(12)) ? (float*)(ws + WS_MGF) : X, X, modl + 5 * DM, modc + 5 * DM, 1.0f, SEQ / 256};
                  pg8::gemm_phase<pg8::EpiResid, pg8::StaticOrder, GP_ALIGN_RESID, GP_SP2>(ring, g, S, E); }
                if (lp < DEPTH - 1) { pg8::Gemm g{(const bf16*)(ws + WS_MG), WL + WL_OUT, MR, DM, 512, DM}; pg8::SplitKOrder S{SEQ / 256, DM / 256, DM / 512, Fp.G, (int)blockIdx.x}; pg8::EpiPartial E{(float*)(ws + WS_PART), modc + 5 * DM, 1.0f};
                  pg8::gemm_phase<pg8::EpiPartial, pg8::SplitKOrder, GP_ALIGN, GP_SP2>(ring, g, S, E); }
                } } SEAM(pb + 12); }
        }
        const int pf = pb + (f ? 13 : 0); const bool no_ctx = (f == 1 && l == DEPTH - 1);
        if (KON(0) && IN(pf + 0)) { FRESH(); int fp = f; asm volatile("" : "+s"(fp)); norm_phase(Fp, KA, lp, 2 * fp, fp ? (lp < DEPTH - 1 ? DM / 512 : 0) : (lp > 0 ? DFF / 512 : 0)); SEAM(pf + 0); }
        if (KON(1) && IN(pf + 1)) { GEMM_PTRS(); int fp = f; asm volatile("" : "+s"(fp)); const int Mq = no_ctx ? SEQ : MR;
            pg8::Gemm g{H, WL + WL_FFI + (size_t)fp * NFF * DM, Mq, NFF, DM, DM}; pg8::StaticOrder S; S.init(Mq, NFF, Fp.G, (int)blockIdx.x, WGM_FFI); pg8::EpiGated<0> E{HID, DFF, nullptr, 0};
            pg8::gemm_phase<pg8::EpiGated<0>, pg8::StaticOrder, GP_ALIGN, GP_SP2>(ring, g, S, E); SEAM(pf + 1); }
        if (KON(2) && IN(pf + 2)) { GEMM_PTRS(); int fp = f; asm volatile("" : "+s"(fp)); const bf16* Wo = WL + WL_FFO + (size_t)fp * DM * DFF; const int gs = (2 + 6 * fp) * DM;
            { pg8::Gemm g{HID, Wo, SEQ, DM, DFF, DFF}; pg8::StaticOrder S; S.init(SEQ, DM, Fp.G, (int)blockIdx.x, WGM_RES, REV_RES);
              pg8::EpiResid E{X, (fp == 1 && lp == DEPTH - 1) ? (float*)KA->out : X, X, modl + gs, modc + gs, 0.5f, SEQ / 256};
              pg8::gemm_phase<pg8::EpiResid, pg8::StaticOrder, GP_ALIGN_RESID, GP_SP2>(ring, g, S, E); }
            if (!no_ctx) { pg8::Gemm g{HID, Wo, MR, DM, 512, DFF}; pg8::SplitKOrder S{SEQ / 256, DM / 256, DFF / 512, Fp.G, (int)blockIdx.x}; pg8::EpiPartial E{(float*)(ws + WS_PART), modc + gs, 0.5f};
              pg8::gemm_phase<pg8::EpiPartial, pg8::SplitKOrder, GP_ALIGN, GP_SP2>(ring, g, S, E); }
            SEAM(pf + 2); }
    }
#undef IN
#undef SEAM
}

extern "C" void kernel_launch(void* const* d_in, const int* in_sizes, int n_in, void* d_out, int out_size, void* d_ws, size_t ws_size, hipStream_t stream) {
    static int grid = 0;
    if (grid == 0) {
        if (n_in != N_IN || out_size != SEQ * DM || ws_size < WS_END) { fprintf(stderr, "kernel_launch: built for %d inputs, %d outputs, >= %zu bytes of workspace; got n_in %d, out %d, ws %zu; nothing launched\n", N_IN, SEQ * DM, (size_t)WS_END, n_in, out_size, ws_size); grid = -1; return; }
        int dev = 0, cus = 0, per_cu = 0;
        if (hipGetDevice(&dev) != hipSuccess || hipDeviceGetAttribute(&cus, hipDeviceAttributeMultiprocessorCount, dev) != hipSuccess) { fprintf(stderr, "kernel_launch: hipGetDevice / hipDeviceGetAttribute failed\n"); grid = -1; return; }
        if (hipFuncSetAttribute((const void*)trunk_fwd, hipFuncAttributeMaxDynamicSharedMemorySize, LDS_BYTES) != hipSuccess) { fprintf(stderr, "kernel_launch: hipFuncSetAttribute failed\n"); grid = -1; return; }
        if (hipOccupancyMaxActiveBlocksPerMultiprocessor(&per_cu, (const void*)trunk_fwd, NWAVES * 64, LDS_BYTES) != hipSuccess || per_cu < 1)
            fprintf(stderr, "kernel_launch: note: occupancy query reports %d workgroups per CU\n", per_cu);
        (void)hipGetLastError();
        grid = cus;
        if (grid % 8 != 0 || grid < 8) { fprintf(stderr, "kernel_launch: unexpected CU count %d\n", cus); }
    }
    if (grid < 0) return;
    if (hipMemsetAsync((char*)d_ws + WS_CTL, 0, CTL_ZERO_BYTES, stream) != hipSuccess) { fprintf(stderr, "kernel_launch: hipMemsetAsync failed\n"); return; }
    Args a{};
    for (int i = 0; i < N_IN; ++i) a.in[i] = (const float*)d_in[i];
    a.out = (float*)d_out; a.ws = (unsigned char*)d_ws;
#if MK_PER_PHASE
    for (int k = 0; k < NPHASE; ++k) { a.ph_lo = k; a.ph_hi = k + 1; hipLaunchKernelGGL(trunk_fwd, dim3(grid), dim3(NWAVES * 64), LDS_BYTES, stream, a); }
#else
    a.ph_lo = 0; a.ph_hi = NPHASE;
    hipLaunchKernelGGL(trunk_fwd, dim3(grid), dim3(NWAVES * 64), LDS_BYTES, stream, a);
#endif
    const hipError_t le = hipPeekAtLastError();
    if (le != hipSuccess) fprintf(stderr, "kernel_launch: launch failed: %s\n", hipGetErrorName(le));
}
```

```cpp
#include <hip/hip_runtime.h>
#include <cstdio>
#include <cstdint>
#ifndef WGM_SEL
#define WGM_SEL 2
#endif
namespace pg8 {
#define PG8_LAS __attribute__((address_space(3)))
typedef unsigned short bf16_t;
typedef short bf16x8 __attribute__((ext_vector_type(8)));
typedef float f32x4 __attribute__((ext_vector_type(4)));
typedef unsigned u32x4 __attribute__((ext_vector_type(4)));
constexpr int BM = 256, BK = 64, HALF = 128, HTB = HALF * BK * 2  , STAGE_BYTES = 8 * HTB, NXCD = 8, WGM = WGM_SEL;

__host__ __device__ __forceinline__ int lds_byte(int r, int c) { const int st = (r >> 4) * 2 + (c >> 5), rr = r & 15, cc = c & 31, ob = rr * 64 + cc * 2; return st * 1024 + (ob ^ (((ob >> 9) & 1) << 5)); }
__host__ __device__ __forceinline__ void stage_rc(int b, int& R, int& C) { const int st = b / 1024, sb = b % 1024, swz = sb ^ (((sb >> 9) & 1) << 5); R = (st >> 1) * 16 + swz / 64; C = (st & 1) * 32 + (swz % 64) / 2; }
__host__ __device__ __forceinline__ int perm32(int rho) { const int n = rho >> 4, i = rho & 15; return 8 * (i >> 2) + 4 * n + (i & 3); }

struct Unit { int pm, pn, ks, kofs, nt, seg; };
struct Gemm { const bf16_t* A; const bf16_t* Bt; int M, N, K, ld; };

struct StaticOrder {
    int nM, nN, nwg, G, c, wgm, rev;
    __host__ __device__ void init(int M, int N, int G_, int c_, int wgm_ = WGM, int rev_ = 0) { nM = M / BM; nN = N / BM; nwg = nM * nN; G = G_; c = c_; wgm = wgm_; rev = rev_; }
    __host__ __device__ bool next(int i, Unit& u) const {
        const long L = (long)i * G + c; if (L >= nwg) return false;
        int wgid = (int)L; { const int q = nwg / NXCD, r = nwg % NXCD, xcd = wgid % NXCD, off = wgid / NXCD; wgid = (xcd < r ? xcd * (q + 1) : r * (q + 1) + (xcd - r) * q) + off; }
        const int nig = wgm * nN, gid = wgid / nig, fm = gid * wgm, gsz = (nM - fm) < wgm ? (nM - fm) : wgm;
        u.pm = fm + ((wgid % nig) % gsz); if (rev) u.pm = nM - 1 - u.pm; u.pn = (wgid % nig) / gsz; u.ks = 0; u.kofs = 0; u.nt = 0; u.seg = 0; return true;
    }
    __device__ __forceinline__ void a_ready(const Unit&) const {}
    __device__ __forceinline__ void done(const Unit&) const {}
};
struct SplitKOrder {
    int pm, nN, nS, G, c;
    __device__ __forceinline__ bool next(int i, Unit& u) const { const int L = i * G + c; if (L >= nN * nS) return false; u.pm = pm; u.pn = L % nN; u.ks = L / nN; u.kofs = 0; u.nt = 0; u.seg = 0; return true; }
    __device__ __forceinline__ void a_ready(const Unit&) const {}
    __device__ __forceinline__ void done(const Unit&) const {}
};
struct SplitKOrderM {
    int nP, nN, nS, G, c;
    __device__ __forceinline__ bool next(int i, Unit& u) const { const int L = i * G + c; if (L >= nP * nN * nS) return false; u.pn = L % nN; const int t = L / nN; u.ks = t % nS; u.pm = t / nS; u.kofs = 0; u.nt = 0; u.seg = u.pm; return true; }
    __device__ __forceinline__ void a_ready(const Unit&) const {}
    __device__ __forceinline__ void done(const Unit&) const {}
};
struct SegOrder {
    int pm, G, c;
    __device__ __forceinline__ bool next(int i, Unit& u) const { const int L = i * G + c; if (L >= 32) return false; const int s = L >> 3; u.pm = pm; u.pn = L & 7; u.ks = 0; u.seg = s; u.kofs = s ? 256 + 512 * s : 0; u.nt = s ? 8 : 12; return true; }
    __device__ __forceinline__ void a_ready(const Unit&) const {}
    __device__ __forceinline__ void done(const Unit&) const {}
};
struct MergeOrder {
    StaticOrder so;
    __device__ __forceinline__ bool next(int i, Unit& u) const { if (!so.next(i >> 2, u)) return false; const int s = i & 3; u.seg = s; u.kofs = s ? 256 + 512 * s : 0; u.nt = s ? 8 : 12; return true; }
    __device__ __forceinline__ void a_ready(const Unit&) const {}
    __device__ __forceinline__ void done(const Unit&) const {}
};
__device__ __forceinline__ unsigned cvt_pk_bf16(float lo, float hi) { unsigned r; asm volatile("v_cvt_pk_bf16_f32 %0, %1, %2" : "=v"(r) : "v"(lo), "v"(hi)); return r; }
typedef float f32x2 __attribute__((ext_vector_type(2)));
__device__ __forceinline__ float sigm(float x) { return __builtin_amdgcn_rcpf(1.0f + __builtin_amdgcn_exp2f(-1.4426950408889634f * x)); }
__device__ __forceinline__ float silu(float x) { return x * sigm(x); }
__device__ __forceinline__ float bf2f(unsigned short h) { return __uint_as_float(((unsigned)h) << 16); }
typedef unsigned u32x2 __attribute__((ext_vector_type(2)));

struct EpiBf16 {
    static constexpr bool PERM = true, AFTER_DRAIN = false, KEEP_ACC = false;
    bf16_t* O; int ldc;
    __device__ __forceinline__ void operator()(const f32x4 (&acc)[2][2][4][2], const Unit& u, int wr, int wc, int fr, int fq) const {
        const int row0 = u.pm * BM + wr * 64 + fr; const int col0 = u.pn * BM + wc * 32 + 8 * fq;
#pragma unroll
        for (int ai = 0; ai < 2; ++ai)
#pragma unroll
            for (int m = 0; m < 4; ++m) { bf16_t* rowp = O + (size_t)(row0 + ai * HALF + m * 16) * ldc + col0;
#pragma unroll
                for (int bj = 0; bj < 2; ++bj) { const f32x4 v0 = acc[ai][bj][m][0], v1 = acc[ai][bj][m][1];
                    u32x4 w; w.x = cvt_pk_bf16(v0[0], v0[1]); w.y = cvt_pk_bf16(v0[2], v0[3]); w.z = cvt_pk_bf16(v1[0], v1[1]); w.w = cvt_pk_bf16(v1[2], v1[3]);
                    *(u32x4*)(rowp + bj * HALF) = w; } }
    }
};
template <int MODE> struct EpiGated {
    static constexpr bool PERM = true, AFTER_DRAIN = false, KEEP_ACC = false;
    bf16_t* O; int ldo; const float* bias; int half;
    __device__ __forceinline__ void operator()(const f32x4 (&acc)[2][2][4][2], const Unit& u, int wr, int wc, int fr, int fq) const {
        const int row0 = u.pm * BM + wr * 64 + fr; const int col0 = u.pn * HALF + wc * 32 + 8 * fq;
        f32x4 ba[2], bb[2];
#pragma unroll
        for (int n = 0; n < 2; ++n) { if (MODE == 1) { ba[n] = *(const f32x4*)(bias + col0 + 4 * n); bb[n] = *(const f32x4*)(bias + half + col0 + 4 * n); } else { ba[n] = (f32x4){0.f, 0.f, 0.f, 0.f}; bb[n] = ba[n]; } }
#pragma unroll
        for (int ai = 0; ai < 2; ++ai)
#pragma unroll
            for (int m = 0; m < 4; ++m) { bf16_t* rowp = O + (size_t)(row0 + ai * HALF + m * 16) * ldo + col0;
                float r[8];
#pragma unroll
                for (int n = 0; n < 2; ++n)
#pragma unroll
                    for (int i = 0; i < 4; ++i) { const float a = acc[ai][0][m][n][i] + ba[n][i], b = acc[ai][1][m][n][i] + bb[n][i]; r[4 * n + i] = (MODE == 0) ? silu(a) * b : a * sigm(b); }
                u32x4 w; w.x = cvt_pk_bf16(r[0], r[1]); w.y = cvt_pk_bf16(r[2], r[3]); w.z = cvt_pk_bf16(r[4], r[5]); w.w = cvt_pk_bf16(r[6], r[7]);
                *(u32x4*)rowp = w; }
    }
};
struct EpiResid {
    static constexpr bool PERM = false, AFTER_DRAIN = false, KEEP_ACC = false;
    const float* base; float* out_lat; float* out_ctx; const float* gate_lat; const float* gate_ctx; float coef; int ctx_pm;
    __device__ __forceinline__ void operator()(const f32x4 (&acc)[2][2][4][2], const Unit& u, int wr, int wc, int fr, int fq) const {
        const bool isctx = u.pm >= ctx_pm; const float* g = isctx ? gate_ctx : gate_lat; float* o = isctx ? out_ctx : out_lat;
        const int row0 = u.pm * BM + wr * 64 + fr, col0 = u.pn * BM + wc * 32 + 4 * fq;
        f32x4 gv[2][2];
#pragma unroll
        for (int bj = 0; bj < 2; ++bj)
#pragma unroll
            for (int n = 0; n < 2; ++n) gv[bj][n] = *(const f32x4*)(g + col0 + bj * HALF + n * 16) * coef;
#pragma unroll
        for (int ai = 0; ai < 2; ++ai)
#pragma unroll
            for (int mp = 0; mp < 2; ++mp) { f32x4 bv[2][2][2];
#pragma unroll
                for (int mm = 0; mm < 2; ++mm) { const size_t off = (size_t)(row0 + ai * HALF + (2 * mp + mm) * 16) * 2048 + col0;
#pragma unroll
                    for (int bj = 0; bj < 2; ++bj)
#pragma unroll
                        for (int n = 0; n < 2; ++n) bv[mm][bj][n] = *(const f32x4*)(base + off + bj * HALF + n * 16); }
                asm volatile("" ::: "memory");
#pragma unroll
                for (int mm = 0; mm < 2; ++mm) { const size_t off = (size_t)(row0 + ai * HALF + (2 * mp + mm) * 16) * 2048 + col0;
#pragma unroll
                    for (int bj = 0; bj < 2; ++bj)
#pragma unroll
                        for (int n = 0; n < 2; ++n) *(f32x4*)(o + off + bj * HALF + n * 16) = bv[mm][bj][n] + gv[bj][n] * acc[ai][bj][2 * mp + mm][n]; }
                asm volatile("" ::: "memory"); }
    }
};
template <int MODE> struct EpiMerge {
    static constexpr bool PERM = false, AFTER_DRAIN = false, KEEP_ACC = false;
    const bf16_t* G; int ldg; float* F; bf16_t* O;
    __device__ __forceinline__ void operator()(const f32x4 (&acc)[2][2][4][2], const Unit& u, int wr, int wc, int fr, int fq) const {
        const int row0 = u.pm * BM + wr * 64 + fr, col0 = u.pn * BM + wc * 32 + 4 * fq;
#pragma unroll
        for (int ai = 0; ai < 2; ++ai)
#pragma unroll
            for (int m = 0; m < 4; ++m) { const size_t r = (size_t)(row0 + ai * HALF + m * 16);
#pragma unroll
                for (int bj = 0; bj < 2; ++bj)
#pragma unroll
                    for (int n = 0; n < 2; ++n) { const int c = col0 + bj * HALF + n * 16;
                        const u32x2 gw = *(const u32x2*)(G + r * ldg + c);
                        f32x4 t; t[0] = sigm(__uint_as_float(gw.x << 16)); t[1] = sigm(__uint_as_float(gw.x & 0xffff0000u)); t[2] = sigm(__uint_as_float(gw.y << 16)); t[3] = sigm(__uint_as_float(gw.y & 0xffff0000u));
                        t = t * acc[ai][bj][m][n];
                        if (MODE >= 1) t = t + *(const f32x4*)(F + r * 2048 + c);
                        if (MODE <= 1) *(f32x4*)(F + r * 2048 + c) = t;
                        else { u32x2 w; w.x = cvt_pk_bf16(t[0], t[1]); w.y = cvt_pk_bf16(t[2], t[3]); *(u32x2*)(O + r * 2048 + c) = w; } } }
    }
};
struct EpiPartial {
    static constexpr bool PERM = false, AFTER_DRAIN = false, KEEP_ACC = false;
    float* part; const float* gate; float coef;
    __device__ __forceinline__ void operator()(const f32x4 (&acc)[2][2][4][2], const Unit& u, int wr, int wc, int fr, int fq) const {
        const int row0 = (u.ks + 4 * u.seg) * BM + wr * 64 + fr, col0 = u.pn * BM + wc * 32 + 4 * fq;
        f32x4 gv[2][2];
#pragma unroll
        for (int bj = 0; bj < 2; ++bj)
#pragma unroll
            for (int n = 0; n < 2; ++n) gv[bj][n] = *(const f32x4*)(gate + col0 + bj * HALF + n * 16) * coef;
#pragma unroll
        for (int ai = 0; ai < 2; ++ai)
#pragma unroll
            for (int m = 0; m < 4; ++m) { const size_t off = (size_t)(row0 + ai * HALF + m * 16) * 2048 + col0;
#pragma unroll
                for (int bj = 0; bj < 2; ++bj)
#pragma unroll
                    for (int n = 0; n < 2; ++n) *(f32x4*)(part + off + bj * HALF + n * 16) = gv[bj][n] * acc[ai][bj][m][n]; }
    }
};
struct EpiMergeR {
    static constexpr bool PERM = false, AFTER_DRAIN = false, KEEP_ACC = true;
    const bf16_t* G; int ldg; bf16_t* O;
    __device__ __forceinline__ bool zero_after(const Unit& u) const { return u.seg == 3; }
    __device__ __forceinline__ void operator()(f32x4 (&acc)[2][2][4][2], const Unit& u, int wr, int wc, int fr, int fq) const {
        const int row0 = u.pm * BM + wr * 64 + fr, col0 = u.pn * BM + wc * 32 + 4 * fq; const bf16_t* Gs = G + 2048 * u.seg + u.pn * BM + 64 * wc + 16 * fq; const bool fin = u.seg == 3;
#pragma unroll
        for (int ai = 0; ai < 2; ++ai)
#pragma unroll
            for (int m = 0; m < 4; ++m) { const size_t r = (size_t)(row0 + ai * HALF + m * 16);
                const u32x4 w0 = *(const u32x4*)(Gs + r * ldg), w1 = *(const u32x4*)(Gs + r * ldg + 8);
                acc[ai][0][m][0] = acc[ai][0][m][0] * (f32x4){__uint_as_float(w0.x << 16), __uint_as_float(w0.x & 0xffff0000u), __uint_as_float(w0.y << 16), __uint_as_float(w0.y & 0xffff0000u)};
                acc[ai][0][m][1] = acc[ai][0][m][1] * (f32x4){__uint_as_float(w0.z << 16), __uint_as_float(w0.z & 0xffff0000u), __uint_as_float(w0.w << 16), __uint_as_float(w0.w & 0xffff0000u)};
                acc[ai][1][m][0] = acc[ai][1][m][0] * (f32x4){__uint_as_float(w1.x << 16), __uint_as_float(w1.x & 0xffff0000u), __uint_as_float(w1.y << 16), __uint_as_float(w1.y & 0xffff0000u)};
                acc[ai][1][m][1] = acc[ai][1][m][1] * (f32x4){__uint_as_float(w1.z << 16), __uint_as_float(w1.z & 0xffff0000u), __uint_as_float(w1.w << 16), __uint_as_float(w1.w & 0xffff0000u)};
                if (fin) {
#pragma unroll
                    for (int bj = 0; bj < 2; ++bj)
#pragma unroll
                        for (int n = 0; n < 2; ++n) { const f32x4 t = acc[ai][bj][m][n]; u32x2 w; w.x = cvt_pk_bf16(t[0], t[1]); w.y = cvt_pk_bf16(t[2], t[3]); *(u32x2*)(O + r * 2048 + col0 + bj * HALF + n * 16) = w; } } }
    }
};
struct EpiMergeSeg {
    static constexpr bool PERM = false, AFTER_DRAIN = false, KEEP_ACC = false;
    const bf16_t* G; int ldg; bf16_t* O;
    __device__ __forceinline__ void operator()(const f32x4 (&acc)[2][2][4][2], const Unit& u, int wr, int wc, int fr, int fq) const {
        const int rl0 = wr * 64 + fr, col0 = u.pn * BM + wc * 32 + 4 * fq; const bf16_t* Gs = G + u.pn * BM + 64 * wc + 16 * fq;
#pragma unroll
        for (int ai = 0; ai < 2; ++ai)
#pragma unroll
            for (int m = 0; m < 4; ++m) { const int rl = rl0 + ai * HALF + m * 16; const size_t r = (size_t)(u.pm * BM + rl);
                bf16_t* orow = O + (size_t)(u.seg * BM + rl) * 2048 + col0;
#pragma unroll
                for (int bj = 0; bj < 2; ++bj) { f32x4 f0 = {1.f, 1.f, 1.f, 1.f}, f1 = f0;
#pragma unroll 1
                    for (int s = u.seg; s < 4; ++s) { const u32x4 w = *(const u32x4*)(Gs + 2048 * s + r * ldg + 8 * bj);
                        f0 = f0 * (f32x4){__uint_as_float(w.x << 16), __uint_as_float(w.x & 0xffff0000u), __uint_as_float(w.y << 16), __uint_as_float(w.y & 0xffff0000u)};
                        f1 = f1 * (f32x4){__uint_as_float(w.z << 16), __uint_as_float(w.z & 0xffff0000u), __uint_as_float(w.w << 16), __uint_as_float(w.w & 0xffff0000u)}; }
                    { const f32x4 t = acc[ai][bj][m][0] * f0; u32x2 w; w.x = cvt_pk_bf16(t[0], t[1]); w.y = cvt_pk_bf16(t[2], t[3]); *(u32x2*)(orow + bj * HALF) = w; }
                    { const f32x4 t = acc[ai][bj][m][1] * f1; u32x2 w; w.x = cvt_pk_bf16(t[0], t[1]); w.y = cvt_pk_bf16(t[2], t[3]); *(u32x2*)(orow + bj * HALF + 16) = w; } } }
    }
};
struct EpiWin {
    static constexpr bool PERM = true, AFTER_DRAIN = false, KEEP_ACC = false;
    bf16_t* O; int ldc; int gate_pn; int gate0;
    __device__ __forceinline__ void operator()(const f32x4 (&acc)[2][2][4][2], const Unit& u, int wr, int wc, int fr, int fq) const {
        const int row0 = u.pm * BM + wr * 64 + fr;
        if (u.pn < gate_pn) { const int col0 = u.pn * BM + wc * 32 + 8 * fq;
#pragma unroll
            for (int ai = 0; ai < 2; ++ai)
#pragma unroll
                for (int m = 0; m < 4; ++m) { bf16_t* rowp = O + (size_t)(row0 + ai * HALF + m * 16) * ldc + col0;
#pragma unroll
                    for (int bj = 0; bj < 2; ++bj) { const f32x4 v0 = acc[ai][bj][m][0], v1 = acc[ai][bj][m][1];
                        u32x4 w; w.x = cvt_pk_bf16(v0[0], v0[1]); w.y = cvt_pk_bf16(v0[2], v0[3]); w.z = cvt_pk_bf16(v1[0], v1[1]); w.w = cvt_pk_bf16(v1[2], v1[3]);
                        *(u32x4*)(rowp + bj * HALF) = w; } }
        } else {
            const int c = 64 * (u.pn - gate_pn) + 16 * wc + 4 * fq;
            const int sg = (c & ~255) + 64 * ((c >> 5) & 3) + 16 * ((c >> 2) & 3) + 8 * ((c >> 7) & 1) + 4 * ((c >> 4) & 1);
#pragma unroll
            for (int ai = 0; ai < 2; ++ai)
#pragma unroll
                for (int m = 0; m < 4; ++m) { bf16_t* rowp = O + (size_t)(row0 + ai * HALF + m * 16) * ldc + gate0 + sg;
                    f32x4 d[4];
#pragma unroll
                    for (int b = 0; b < 4; ++b)
#pragma unroll
                        for (int i = 0; i < 4; ++i) d[b][i] = 1.0f + __builtin_amdgcn_exp2f(-1.4426950408889634f * fminf(fmaxf(acc[ai][b >> 1][m][b & 1][i], -30.0f), 30.0f));
#pragma unroll
                    for (int s = 0; s < 4; ++s) { f32x4 rr;
#pragma unroll
                        for (int i = 0; i < 4; ++i) rr[i] = (s < 3 ? d[s < 3 ? s + 1 : 3][i] : 1.0f) * __builtin_amdgcn_rcpf(d[s][i]);
                        u32x2 w; w.x = cvt_pk_bf16(rr[0], rr[1]); w.y = cvt_pk_bf16(rr[2], rr[3]); *(u32x2*)(rowp + 2048 * s) = w; } }
        }
    }
};
#ifndef PG8_AUX_A
#define PG8_AUX_A 0
#endif
#ifndef PG8_AUX_B
#define PG8_AUX_B 0
#endif
template <class Epi, class Sched, bool ALIGN_EPI = false, bool SP2 = false>
__device__ __forceinline__ void gemm_phase(PG8_LAS unsigned char* lds, const Gemm g, const Sched& S, const Epi& E) {
    int tid_ = threadIdx.x; asm volatile("" : "+v"(tid_)); const int tid = tid_, wid = __builtin_amdgcn_readfirstlane(tid >> 6), lane = tid & 63, wr = wid >> 2, wc = wid & 3, fr = lane & 15, fq = lane >> 4;
    const int K = g.ld, nt = g.K / BK;
    unsigned voffA[2], voffB[2];
#pragma unroll
    for (int i = 0; i < 2; ++i) { int R, C; stage_rc(tid * 16 + i * 8192, R, C); const int Rb = Epi::PERM ? ((R & ~31) + perm32(R & 31)) : R;
        voffA[i] = (unsigned)(R * K + C) * 2u; voffB[i] = (unsigned)(Rb * K + C) * 2u; }
    const size_t kstep = (size_t)(BK * 2);
    const size_t hstep = (size_t)HALF * K * 2;
    const size_t tstep = 2 * hstep;
    const unsigned ldsw = (unsigned)wid * 1024u;
    const int aoff = lds_byte(wr * 64 + fr, fq * 8), boff = lds_byte(wc * 32 + fr, fq * 8);
#define PG8_SA(b, h) (((b) * 2 + (h)) * HTB)
#define PG8_SB(b, h) ((4 + (b) * 2 + (h)) * HTB)
#define PG8_STAGE(bufoff, gbase, voff) do { _Pragma("unroll") for (int _i = 0; _i < 2; ++_i) \
        __builtin_amdgcn_global_load_lds((const unsigned*)((const char*)(gbase) + (voff)[_i]), (PG8_LAS unsigned*)(lds + (bufoff) + ldsw + _i * 8192), 16, 0, PG8_AUX_A); } while (0)
#define PG8_STAGEB(bufoff, gbase, voff) do { _Pragma("unroll") for (int _i = 0; _i < 2; ++_i) \
        __builtin_amdgcn_global_load_lds((const unsigned*)((const char*)(gbase) + (voff)[_i]), (PG8_LAS unsigned*)(lds + (bufoff) + ldsw + _i * 8192), 16, 0, PG8_AUX_B); } while (0)
#define PG8_LDA(dst, b, h) do { _Pragma("unroll") for (int m = 0; m < 4; ++m) _Pragma("unroll") for (int k = 0; k < 2; ++k) dst[m][k] = *(const PG8_LAS bf16x8*)(lds + PG8_SA(b, h) + aoff + m * 2048 + k * 1024); } while (0)
#define PG8_LDB(dst, b, h) do { _Pragma("unroll") for (int n = 0; n < 2; ++n) _Pragma("unroll") for (int k = 0; k < 2; ++k) dst[n][k] = *(const PG8_LAS bf16x8*)(lds + PG8_SB(b, h) + boff + n * 2048 + k * 1024); } while (0)
#define PG8_MMA(ai, bj, At, Bt) do { __builtin_amdgcn_s_setprio(1); _Pragma("unroll") for (int m = 0; m < 4; ++m) _Pragma("unroll") for (int n = 0; n < 2; ++n) _Pragma("unroll") for (int k = 0; k < 2; ++k) \
        acc[ai][bj][m][n] = __builtin_amdgcn_mfma_f32_16x16x32_bf16(Bt[n][k], At[m][k], acc[ai][bj][m][n], 0, 0, 0); __builtin_amdgcn_s_setprio(0); } while (0)
#define PG8_WAIT_V(n) asm volatile("s_waitcnt vmcnt(" #n ")" ::: "memory")
#define PG8_WAIT_L(n) asm volatile("s_waitcnt lgkmcnt(" #n ")" ::: "memory")
#define PG8_BAR __builtin_amdgcn_s_barrier()
#define PG8_SCHED __builtin_amdgcn_sched_barrier(0)
    Unit cur, nxt; int ui = 0;
    if (!S.next(0, cur)) return;
    f32x4 acc[2][2][4][2];
#pragma unroll
    for (int a = 0; a < 2; ++a)
#pragma unroll
        for (int b = 0; b < 2; ++b)
#pragma unroll
            for (int m = 0; m < 4; ++m)
#pragma unroll
                for (int n = 0; n < 2; ++n) acc[a][b][m][n] = (f32x4){0.f, 0.f, 0.f, 0.f};
    bf16x8 At[4][2], B0[2][2], B1[2][2];
    const size_t kslice = (size_t)g.K * 2;
    const char* cA = (const char*)g.A + (size_t)cur.pm * tstep + (size_t)cur.ks * kslice + (size_t)cur.kofs * 2; const char* cB = (const char*)g.Bt + (size_t)cur.pn * tstep + (size_t)cur.ks * kslice + (size_t)cur.kofs * 2;
    S.a_ready(cur);
    if constexpr (SP2) {
        PG8_STAGEB(PG8_SB(0, 0), cB, voffB); PG8_STAGEB(PG8_SB(0, 1), cB + hstep, voffB); PG8_STAGE(PG8_SA(0, 0), cA, voffA); PG8_STAGE(PG8_SA(0, 1), cA + hstep, voffA);
        if (wr == 1) PG8_BAR;
        PG8_WAIT_V(2); PG8_BAR;
        PG8_STAGEB(PG8_SB(1, 0), cB + kstep, voffB); PG8_STAGE(PG8_SA(1, 0), cA + kstep, voffA); PG8_STAGEB(PG8_SB(1, 1), cB + hstep + kstep, voffB);
        PG8_WAIT_V(6); PG8_BAR;
    } else {
        PG8_STAGEB(PG8_SB(0, 0), cB, voffB); PG8_STAGE(PG8_SA(0, 0), cA, voffA); PG8_STAGEB(PG8_SB(0, 1), cB + hstep, voffB); PG8_STAGE(PG8_SA(0, 1), cA + hstep, voffA);
        if (wr == 1) PG8_BAR;
        PG8_WAIT_V(4); PG8_BAR;
        PG8_STAGEB(PG8_SB(1, 0), cB + kstep, voffB); PG8_STAGE(PG8_SA(1, 0), cA + kstep, voffA); PG8_STAGEB(PG8_SB(1, 1), cB + hstep + kstep, voffB);
        PG8_WAIT_V(6); PG8_BAR;
    }
    for (;;) {
        const bool has_next = S.next(ui + 1, nxt);
        const char* nA = has_next ? (const char*)g.A + (size_t)nxt.pm * tstep + (size_t)nxt.ks * kslice + (size_t)nxt.kofs * 2 : cA; const char* nB = has_next ? (const char*)g.Bt + (size_t)nxt.pn * tstep + (size_t)nxt.ks * kslice + (size_t)nxt.kofs * 2 : cB;
        const int nt_u = cur.nt ? cur.nt : nt;
        for (int t = 0; t < nt_u; t += 2) {
            const bool last = (t == nt_u - 2);
            const char* a1 = cA + (size_t)(t + 1) * kstep;
            const char* a2 = last ? nA : cA + (size_t)(t + 2) * kstep; const char* b2 = last ? nB : cB + (size_t)(t + 2) * kstep;
            const char* a3 = a2 + kstep; const char* b3 = b2 + kstep;
            if (last && has_next) S.a_ready(nxt);
            if constexpr (SP2) {
            PG8_LDB(B0, 0, 0); PG8_LDB(B1, 0, 1); PG8_SCHED; PG8_LDA(At, 0, 0); PG8_STAGE(PG8_SA(1, 1), a1 + hstep, voffA);
            PG8_WAIT_V(8); PG8_WAIT_L(0); PG8_BAR; PG8_MMA(0, 0, At, B0); PG8_MMA(0, 1, At, B1); PG8_BAR; PG8_SCHED;
            PG8_LDA(At, 0, 1); PG8_STAGEB(PG8_SB(0, 0), b2, voffB); PG8_STAGEB(PG8_SB(0, 1), b2 + hstep, voffB); PG8_STAGE(PG8_SA(0, 0), a2, voffA);
            PG8_WAIT_V(8); PG8_WAIT_L(0); PG8_BAR; PG8_MMA(1, 0, At, B0); PG8_MMA(1, 1, At, B1); PG8_BAR; PG8_SCHED;
            PG8_LDB(B0, 1, 0); PG8_LDB(B1, 1, 1); PG8_SCHED; PG8_LDA(At, 1, 0); PG8_STAGE(PG8_SA(0, 1), a2 + hstep, voffA);
            PG8_WAIT_V(8); PG8_WAIT_L(0); PG8_BAR; PG8_MMA(0, 0, At, B0); PG8_MMA(0, 1, At, B1); PG8_BAR; PG8_SCHED;
            PG8_LDA(At, 1, 1); PG8_STAGEB(PG8_SB(1, 0), b3, voffB); PG8_STAGEB(PG8_SB(1, 1), b3 + hstep, voffB); PG8_STAGE(PG8_SA(1, 0), a3, voffA);
            PG8_WAIT_V(8); PG8_WAIT_L(0); PG8_BAR; PG8_MMA(1, 0, At, B0); PG8_MMA(1, 1, At, B1); PG8_BAR; PG8_SCHED;
            } else {
            PG8_LDB(B0, 0, 0); PG8_SCHED; PG8_LDA(At, 0, 0); PG8_STAGE(PG8_SA(1, 1), a1 + hstep, voffA);
            PG8_WAIT_L(8); PG8_BAR; PG8_WAIT_L(0); PG8_MMA(0, 0, At, B0); PG8_BAR; PG8_SCHED;
            PG8_LDB(B1, 0, 1); PG8_STAGEB(PG8_SB(0, 0), b2, voffB);
            PG8_BAR; PG8_WAIT_L(0); PG8_MMA(0, 1, At, B1); PG8_BAR;
            PG8_LDA(At, 0, 1); PG8_STAGE(PG8_SA(0, 0), a2, voffA);
            PG8_BAR; PG8_WAIT_L(0); PG8_MMA(1, 0, At, B0); PG8_BAR; PG8_SCHED;
            PG8_STAGEB(PG8_SB(0, 1), b2 + hstep, voffB);
            PG8_WAIT_V(6); PG8_BAR; PG8_MMA(1, 1, At, B1); PG8_BAR;
            PG8_LDB(B0, 1, 0); PG8_SCHED; PG8_LDA(At, 1, 0); PG8_STAGE(PG8_SA(0, 1), a2 + hstep, voffA);
            PG8_WAIT_L(8); PG8_BAR; PG8_WAIT_L(0); PG8_MMA(0, 0, At, B0); PG8_BAR; PG8_SCHED;
            PG8_LDB(B1, 1, 1); PG8_STAGEB(PG8_SB(1, 0), b3, voffB);
            PG8_BAR; PG8_WAIT_L(0); PG8_MMA(0, 1, At, B1); PG8_BAR;
            PG8_LDA(At, 1, 1); PG8_STAGE(PG8_SA(1, 0), a3, voffA);
            PG8_BAR; PG8_WAIT_L(0); PG8_MMA(1, 0, At, B0); PG8_BAR; PG8_SCHED;
            PG8_STAGEB(PG8_SB(1, 1), b3 + hstep, voffB);
            PG8_WAIT_V(6); PG8_BAR; PG8_MMA(1, 1, At, B1); PG8_BAR;
            }
        }
        if constexpr (ALIGN_EPI) { if (wr == 0) PG8_BAR; }
        if constexpr (!Epi::AFTER_DRAIN) { E(acc, cur, wr, wc, fr, fq); S.done(cur); }
        if (!has_next) break;
        bool zero_ = true; if constexpr (Epi::KEEP_ACC) zero_ = E.zero_after(cur);
        if (zero_) {
#pragma unroll
        for (int a = 0; a < 2; ++a)
#pragma unroll
            for (int b = 0; b < 2; ++b)
#pragma unroll
                for (int m = 0; m < 4; ++m)
#pragma unroll
                    for (int n = 0; n < 2; ++n) acc[a][b][m][n] = (f32x4){0.f, 0.f, 0.f, 0.f};
        }
        cur = nxt; cA = nA; cB = nB; ++ui;
        if constexpr (ALIGN_EPI) { if (wr == 1) PG8_BAR; }
    }
    PG8_WAIT_V(0);
    if constexpr (!ALIGN_EPI) { if (wr == 0) PG8_BAR; }
    PG8_BAR;
    if constexpr (Epi::AFTER_DRAIN) { E.fused(acc, cur, wr, wc, fr, fq, lds, wid, lane); S.done(cur); }
#undef PG8_SA
#undef PG8_SB
#undef PG8_STAGE
#undef PG8_STAGEB
#undef PG8_LDA
#undef PG8_LDB
#undef PG8_MMA
#undef PG8_WAIT_V
#undef PG8_WAIT_L
#undef PG8_BAR
#undef PG8_SCHED
}
}
#include <hip/hip_bf16.h>
#include <cmath>
#ifndef ATT_NEGM
#define ATT_NEGM 1
#endif
namespace attn_body {
using bf16=__hip_bfloat16;
using bf16x8=__attribute__((ext_vector_type(8)))short;
using s16x4=__attribute__((ext_vector_type(4)))short;
using f32x16=__attribute__((ext_vector_type(16)))float;
using u32x4=__attribute__((ext_vector_type(4)))unsigned;
constexpr int D=64, QP=512, KP=128, VP=12288, OP=2304;
constexpr int NW=8,QBLK=32,QB=QBLK*NW,KVBLK=64;
constexpr int ATTN_UNIT_ROWS=QB;
__device__ __forceinline__ int crow(int r,int hi){return (r&3)+8*(r>>2)+4*hi;}
#define SBAR() __builtin_amdgcn_sched_barrier(0)
__device__ __forceinline__ void swamask(f32x16&p0,f32x16&p1,int dbase){
  const float NEG=-INFINITY;
  #pragma unroll
  for(int r=0;r<16;++r){const int d=dbase+(r&3)+8*(r>>2); if(d>128||d<-128)p0[r]=NEG; if(d+32>128||d+32<-128)p1[r]=NEG;}
}

constexpr int NSLOT=3, SLOTB=8192;
constexpr int LDS_K=0, LDS_V=NSLOT*SLOTB, LDS_WS=2*NSLOT*SLOTB, LDS_OST=LDS_WS+NW*64*4, LDS_BYTES=LDS_OST+NW*4096;
constexpr float C2=0.125f*1.4426950408889634f;
__device__ __forceinline__ void glds16(const void*gsrc,unsigned lds_dst){unsigned keep;
  asm volatile("s_mov_b32 %0, m0\n\ts_mov_b32 m0, %2\n\ts_nop 0\n\tglobal_load_lds_dwordx4 %1, off\n\ts_mov_b32 m0, %0":"=&s"(keep):"v"(gsrc),"s"(lds_dst):"memory");}
__device__ __forceinline__ float max3f(float a,float b,float c){float r;asm("v_max3_f32 %0, %1, %2, %3":"=v"(r):"v"(a),"v"(b),"v"(c));return r;}
__device__ __forceinline__ float max2f(float a,float b){float r;asm("v_max_f32_e32 %0, %1, %2":"=v"(r):"v"(a),"v"(b));return r;}
__device__ __forceinline__ float fadd_s(float a,float b){float r;asm("v_add_f32_e32 %0, %1, %2":"=v"(r):"v"(a),"v"(b));return r;}
__device__ __forceinline__ float fsub_s(float a,float b){float r;asm("v_sub_f32_e32 %0, %1, %2":"=v"(r):"v"(a),"v"(b));return r;}
typedef float f32x2_t __attribute__((ext_vector_type(2))); typedef __bf16 bf16x2_t __attribute__((ext_vector_type(2)));
__device__ __forceinline__ unsigned cvtpk_s(float lo,float hi){f32x2_t v={lo,hi};bf16x2_t b=__builtin_convertvector(v,bf16x2_t);return __builtin_bit_cast(unsigned,b);}
#define WAIT_BAR(N) asm volatile("s_waitcnt vmcnt(" #N ") lgkmcnt(0)\n\ts_barrier":::"memory")

__device__ __forceinline__ void qkt(f32x16&p0,f32x16&p1,const char*Kslot,const bf16x8*qr,const f32x16&negm,int r32,int hi){
  const char*kb=Kslot+hi*1024+r32*16;
  #pragma unroll
  for(int d0=0;d0<4;++d0){
    const bf16x8 b0=*reinterpret_cast<const bf16x8*>(kb+d0*2048);
    const bf16x8 b1=*reinterpret_cast<const bf16x8*>(kb+d0*2048+512);
    if(d0==0){p0=__builtin_amdgcn_mfma_f32_32x32x16_bf16(b0,qr[0],negm,0,0,0);p1=__builtin_amdgcn_mfma_f32_32x32x16_bf16(b1,qr[0],negm,0,0,0);}
    else{p0=__builtin_amdgcn_mfma_f32_32x32x16_bf16(b0,qr[d0],p0,0,0,0);p1=__builtin_amdgcn_mfma_f32_32x32x16_bf16(b1,qr[d0],p1,0,0,0);}}
}
typedef __attribute__((address_space(3))) const char* lds_cptr;
typedef short v4i16_t __attribute__((ext_vector_type(4)));
__device__ __forceinline__ void kload8(bf16x8*kf,lds_cptr kp){
  kf[0]=*(const __attribute__((address_space(3))) bf16x8*)(kp);      kf[1]=*(const __attribute__((address_space(3))) bf16x8*)(kp+512);
  kf[2]=*(const __attribute__((address_space(3))) bf16x8*)(kp+2048); kf[3]=*(const __attribute__((address_space(3))) bf16x8*)(kp+2560);
  kf[4]=*(const __attribute__((address_space(3))) bf16x8*)(kp+4096); kf[5]=*(const __attribute__((address_space(3))) bf16x8*)(kp+4608);
  kf[6]=*(const __attribute__((address_space(3))) bf16x8*)(kp+6144); kf[7]=*(const __attribute__((address_space(3))) bf16x8*)(kp+6656);
}
__device__ __forceinline__ void kload2(bf16x8*kf,lds_cptr kp,int j){ kf[2*j]=*(const __attribute__((address_space(3))) bf16x8*)(kp+j*2048); kf[2*j+1]=*(const __attribute__((address_space(3))) bf16x8*)(kp+j*2048+512); }
__device__ __forceinline__ s16x4 vtr(lds_cptr p){ return __builtin_bit_cast(s16x4,__builtin_amdgcn_ds_read_tr16_b64_v4i16((__attribute__((address_space(3))) v4i16_t*)p)); }
__device__ __forceinline__ float rowmax(const f32x16&p0,const f32x16&p1){
  float a=max3f(p0[0],p0[1],p1[0]),b=max3f(p0[2],p0[3],p1[1]);a=max3f(a,p1[2],p1[3]);
  #pragma unroll
  for(int r=4;r<16;r+=4){a=max3f(a,p0[r],p0[r+1]);b=max3f(b,p0[r+2],p0[r+3]);a=max3f(a,p1[r],p1[r+1]);b=max3f(b,p1[r+2],p1[r+3]);}
  const float m=max2f(a,b);
  auto rr=__builtin_amdgcn_permlane32_swap(__float_as_uint(m),__float_as_uint(m),false,false);
  return max2f(__uint_as_float(rr[0]),__uint_as_float(rr[1]));
}
__device__ __forceinline__ void pv(f32x16*o,int vb,bf16x8 pa0,bf16x8 pa1,bf16x8 pa2,bf16x8 pa3){
  #pragma unroll
  for(int d0=0;d0<2;++d0){s16x4 lo[4],hi[4];
    #pragma unroll
    for(int ks=0;ks<4;++ks){
      asm volatile("ds_read_b64_tr_b16 %0,%1 offset:%c2":"=&v"(lo[ks]):"v"(vb),"i"(d0*4096+ks*1024):"memory");
      asm volatile("ds_read_b64_tr_b16 %0,%1 offset:%c2":"=&v"(hi[ks]):"v"(vb),"i"(d0*4096+ks*1024+512):"memory");}
    asm volatile("s_waitcnt lgkmcnt(0)":::"memory");SBAR();
    #define PK(k) (bf16x8){lo[k][0],lo[k][1],lo[k][2],lo[k][3],hi[k][0],hi[k][1],hi[k][2],hi[k][3]}
    o[d0]=__builtin_amdgcn_mfma_f32_32x32x16_bf16(pa0,PK(0),o[d0],0,0,0);
    o[d0]=__builtin_amdgcn_mfma_f32_32x32x16_bf16(pa1,PK(1),o[d0],0,0,0);
    o[d0]=__builtin_amdgcn_mfma_f32_32x32x16_bf16(pa2,PK(2),o[d0],0,0,0);
    o[d0]=__builtin_amdgcn_mfma_f32_32x32x16_bf16(pa3,PK(3),o[d0],0,0,0);
    #undef PK
  }
}

#ifndef ATTN_STORE16
#define ATTN_STORE16(p,v) (*(u32x4*)(p)=(v))
#endif
template<int THRL,int MODE> __device__ __forceinline__ void attn_unit(const bf16*Qu,const bf16*__restrict__ Kh,const bf16*__restrict__ Vh,bf16*Ou,int NT,int n0,int s0,int s1,int qrow0,float sink2,bool has_sink,char*shm){
  int tid_=threadIdx.x; asm volatile("":"+v"(tid_)); const int tid=tid_,lane=tid&63,r32=lane&31,hi=lane>>5; const int wid=__builtin_amdgcn_readfirstlane(tid>>6);
  const bf16*Qw=Qu+(long)(wid*QBLK)*QP;
  const unsigned lds0=(unsigned)(uintptr_t)shm;
  float*wsf=(float*)(shm+LDS_WS)+wid*64;
  const bf16*ksrc=Kh+(long)lane*KP+wid*8;
  const bf16*vsrc=Vh+(long)(16*(wid&3)+(lane>>2))*VP+(wid>>2)*32+(lane&3)*8;
  #define TROW(t) (MODE==0 ? KVBLK*(t) : ((t)<n0 ? s0+KVBLK*(t) : s1+KVBLK*((t)-n0)))
  const unsigned kdst=lds0+LDS_K+wid*1024, vdst=lds0+LDS_V+wid*1024;
  #define DMA_K(t,slot) glds16(ksrc+(long)TROW(t)*KP,(unsigned)__builtin_amdgcn_readfirstlane(kdst+(slot)))
  #define DMA_V(t,slot) glds16(vsrc+(long)TROW(t)*VP,(unsigned)__builtin_amdgcn_readfirstlane(vdst+(slot)))
  const int vb0=(int)(lds0+LDS_V)+((lane>>4)&1)*32+(lane&3)*8+(4*hi+((lane&15)>>2))*64;
  const char*Kbase=shm+LDS_K; bf16x8 kf[8];
  const lds_cptr shm3=(lds_cptr)shm; const lds_cptr kp0=shm3+LDS_K+hi*1024+r32*16; const lds_cptr vp0=shm3+LDS_V+((lane>>4)&1)*32+(lane&3)*8+(4*hi+((lane&15)>>2))*64;
  DMA_K(0,0);DMA_V(0,0);DMA_K(1,SLOTB);
  bf16x8 qr[4];
  #pragma unroll
  for(int d0=0;d0<4;++d0)qr[d0]=*reinterpret_cast<const bf16x8*>(&Qw[(long)r32*QP+d0*16+hi*8]);
  float mhat=0.f,l_reg=0.f;f32x16 o[2];o[0]=f32x16{};o[1]=f32x16{};f32x16 negm=f32x16{}; if(ATT_NEGM&&MODE==0)asm volatile("":"+v"(negm));
  const int qrow=qrow0+wid*QBLK+r32;
  #define CMASK(P0,P1,t) do{ if(MODE==1 && (t)>=n0) swamask(P0,P1,TROW(t)+4*hi-qrow); }while(0)
  bool resc=false;
  #define START(P0,P1) do{ const float rm=rowmax(P0,P1); resc=false; \
    { const float dl=rm; mhat=fadd_s(mhat,dl); \
      _Pragma("unroll") for(int r=0;r<16;++r){P0[r]=fsub_s(P0[r],dl);P1[r]=fsub_s(P1[r],dl);} \
      if(ATT_NEGM&&MODE==0){ _Pragma("unroll") for(int r=0;r<16;++r)negm[r]=-mhat; asm volatile("":"+v"(negm)); } } \
    _Pragma("unroll") for(int r=0;r<16;++r)P0[r]=__builtin_amdgcn_exp2f(P0[r]); }while(0)
  #define RESC() do{ if(resc){ asm volatile("s_waitcnt lgkmcnt(0)":::"memory"); \
      _Pragma("unroll") for(int d_=0;d_<2;++d_) _Pragma("unroll") for(int r=0;r<16;++r)o[d_][r]*=wsf[crow(r,hi)]; } }while(0)
  f32x16 pA0,pA1,pB0,pB1;
  int sl_prev=0,sl_cur=0,sl_next=SLOTB;
  #define ROT() do{sl_prev=sl_cur;sl_cur=sl_next;sl_next=(sl_next==(NSLOT-1)*SLOTB)?0:sl_next+SLOTB;}while(0)
  DMA_K(2,2*SLOTB);
  WAIT_BAR(3);
  qkt(pA0,pA1,Kbase,qr,negm,r32,hi);asm volatile("s_nop 15\n\ts_nop 7":"+v"(pA0),"+v"(pA1));CMASK(pA0,pA1,0);
  START(pA0,pA1);
  _Pragma("unroll") for(int r=0;r<16;++r)pA1[r]=__builtin_amdgcn_exp2f(pA1[r]);
  WAIT_BAR(0);
  DMA_K(3,0);DMA_V(1,SLOTB);
  ROT();
  kload8(kf,kp0+sl_cur);
  WAIT_BAR(2);
  s16x4 vlo[8],vhi[8]; u32x4 pw0,pw1,pw2,pw3;
  #define PKW(P,B) cvtpk_s(P[B],P[B+1])
  #define PAF(k) __builtin_bit_cast(bf16x8,pw##k)
  #define VFR(i) (bf16x8){vlo[i][0],vlo[i][1],vlo[i][2],vlo[i][3],vhi[i][0],vhi[i][1],vhi[i][2],vhi[i][3]}
  #define PIN(x) asm volatile("":"+v"(x))
  #define MX3(a,b,c) __builtin_fmaxf(__builtin_fmaxf((a),(b)),(c))
  #define GAPA(MF,A0,A1,A2,A3,W0,W1,PW) do{ MF; sacc+=A0; sacc+=A1; sacc+=A2; sacc+=A3; PIN(sacc); W0; W1; PIN(PW); SBAR(); }while(0)
  #define EX(v) __builtin_amdgcn_exp2f(v)
  #define GAPB(MF,X,B) do{ MF; X[B]=EX(X[B]); X[B+1]=EX(X[B+1]); X[B+2]=EX(X[B+2]); X[B+3]=EX(X[B+3]); PIN(X); SBAR(); }while(0)
  #define VRD(i) do{ vlo[i]=vtr(vp_+(((i)>>2)*4096+((i)&3)*1024)); vhi[i]=vtr(vp_+(((i)>>2)*4096+((i)&3)*1024+512)); }while(0)
  #define KRD(G,j) do{ if(G){ kload2(kf,kp0+sl_next,j); SBAR(); } }while(0)
  #define STEP(C0,C1,P0,P1,t,GK,GV,GL) do{ SBAR(); \
    const lds_cptr vp_=vp0+sl_prev; \
    VRD(0); SBAR(); float sacc=(P0[0]+P0[1]); \
    GAPA(C0=__builtin_amdgcn_mfma_f32_32x32x16_bf16(kf[0],qr[0],((ATT_NEGM&&MODE==0)?negm:f32x16{}),0,0,0), P0[2],P0[3],P0[4],P0[5],     pw0[0]=PKW(P0,0), pw0[1]=PKW(P0,2), pw0); \
    VRD(4); SBAR(); GAPA(C1=__builtin_amdgcn_mfma_f32_32x32x16_bf16(kf[1],qr[0],((ATT_NEGM&&MODE==0)?negm:f32x16{}),0,0,0), P0[6],P0[7],P0[8],P0[9],     pw0[2]=PKW(P0,4), pw0[3]=PKW(P0,6), pw0); \
    VRD(1); SBAR(); GAPA(C0=__builtin_amdgcn_mfma_f32_32x32x16_bf16(kf[2],qr[1],C0,0,0,0),   P0[10],P0[11],P0[12],P0[13], pw1[0]=PKW(P0,8), pw1[1]=PKW(P0,10), pw1); \
    VRD(5); SBAR(); GAPA(C1=__builtin_amdgcn_mfma_f32_32x32x16_bf16(kf[3],qr[1],C1,0,0,0),   P0[14],P0[15],P1[0],P1[1],   pw1[2]=PKW(P0,12),pw1[3]=PKW(P0,14), pw1); \
    VRD(2); SBAR(); GAPA(C0=__builtin_amdgcn_mfma_f32_32x32x16_bf16(kf[4],qr[2],C0,0,0,0),   P1[2],P1[3],P1[4],P1[5],     pw2[0]=PKW(P1,0), pw2[1]=PKW(P1,2), pw2); \
    VRD(6); SBAR(); GAPA(C1=__builtin_amdgcn_mfma_f32_32x32x16_bf16(kf[5],qr[2],C1,0,0,0),   P1[6],P1[7],P1[8],P1[9],     pw2[2]=PKW(P1,4), pw2[3]=PKW(P1,6), pw2); \
    VRD(3); SBAR(); GAPA(C0=__builtin_amdgcn_mfma_f32_32x32x16_bf16(kf[6],qr[3],C0,0,0,0),   P1[10],P1[11],P1[12],P1[13], pw3[0]=PKW(P1,8), pw3[1]=PKW(P1,10), pw3); \
    VRD(7); SBAR(); GAPA(C1=__builtin_amdgcn_mfma_f32_32x32x16_bf16(kf[7],qr[3],C1,0,0,0),   P1[14],P1[15],0.f,0.f,       pw3[2]=PKW(P1,12),pw3[3]=PKW(P1,14), pw3); \
    l_reg+=sacc; \
    if(GK){DMA_K((t)+3,sl_cur);} if(GV){DMA_V((t)+1,sl_next);} \
    if(!(ATT_NEGM&&MODE==0)){ _Pragma("unroll") for(int r=0;r<16;++r){C0[r]-=mhat;C1[r]-=mhat;} } \
    CMASK(C0,C1,t); \
    { float a=MX3(C0[0],C0[1],C1[0]),b=MX3(C0[2],C0[3],C1[1]); a=MX3(a,C1[2],C1[3]); \
      _Pragma("unroll") for(int r=4;r<16;r+=4){a=MX3(a,C0[r],C0[r+1]);b=MX3(b,C0[r+2],C0[r+3]);a=MX3(a,C1[r],C1[r+1]);b=MX3(b,C1[r+2],C1[r+3]);} \
      float rm=__builtin_fmaxf(a,b); { auto rr=__builtin_amdgcn_permlane32_swap(__float_as_uint(rm),__float_as_uint(rm),false,false); rm=__builtin_fmaxf(__uint_as_float(rr[0]),__uint_as_float(rr[1])); } \
      resc=false; \
      if(__builtin_expect(__any(rm>(float)THRL),0)){ const float dl=__builtin_fmaxf(rm,0.f); mhat+=dl; \
        _Pragma("unroll") for(int r=0;r<16;++r){C0[r]-=dl;C1[r]-=dl;} \
        if(ATT_NEGM&&MODE==0){ _Pragma("unroll") for(int r=0;r<16;++r)negm[r]=-mhat; asm volatile("":"+v"(negm)); } \
        const float f=__builtin_amdgcn_exp2f(-dl); l_reg*=f; if(hi==0)wsf[r32]=f; resc=true; } } \
    SBAR(); \
    GAPB(o[0]=__builtin_amdgcn_mfma_f32_32x32x16_bf16(PAF(0),VFR(0),o[0],0,0,0), C0,0); \
    GAPB(o[1]=__builtin_amdgcn_mfma_f32_32x32x16_bf16(PAF(0),VFR(4),o[1],0,0,0), C0,4); \
    KRD(GL,0); GAPB(o[0]=__builtin_amdgcn_mfma_f32_32x32x16_bf16(PAF(1),VFR(1),o[0],0,0,0), C0,8); \
    KRD(GL,1); GAPB(o[1]=__builtin_amdgcn_mfma_f32_32x32x16_bf16(PAF(1),VFR(5),o[1],0,0,0), C0,12); \
    KRD(GL,2); GAPB(o[0]=__builtin_amdgcn_mfma_f32_32x32x16_bf16(PAF(2),VFR(2),o[0],0,0,0), C1,0); \
    KRD(GL,3); GAPB(o[1]=__builtin_amdgcn_mfma_f32_32x32x16_bf16(PAF(2),VFR(6),o[1],0,0,0), C1,4); \
    GAPB(o[0]=__builtin_amdgcn_mfma_f32_32x32x16_bf16(PAF(3),VFR(3),o[0],0,0,0), C1,8); \
    GAPB(o[1]=__builtin_amdgcn_mfma_f32_32x32x16_bf16(PAF(3),VFR(7),o[1],0,0,0), C1,12); \
    }while(0)
  int t=1;
  for(;t+5<NT;t+=2){
    STEP(pB0,pB1,pA0,pA1,t,true,true,true);     WAIT_BAR(2); RESC(); ROT();
    STEP(pA0,pA1,pB0,pB1,t+1,true,true,true);   WAIT_BAR(2); RESC(); ROT();
  }
  #define ENDW(tt) do{ if((tt)+3<NT){WAIT_BAR(2);} else if((tt)+2<NT){WAIT_BAR(1);} else {WAIT_BAR(0);} }while(0)
  for(;t+1<NT;t+=2){
    STEP(pB0,pB1,pA0,pA1,t,(t+3<NT),(t+1<NT),(t+1<NT));       ENDW(t);   RESC(); ROT();
    STEP(pA0,pA1,pB0,pB1,t+1,(t+4<NT),(t+2<NT),(t+2<NT));     ENDW(t+1); RESC(); ROT();
  }
  STEP(pB0,pB1,pA0,pA1,NT-1,false,false,false); RESC();
  { float sacc=pB0[0]+pB0[1]; _Pragma("unroll") for(int r=2;r<16;++r)sacc+=pB0[r]; _Pragma("unroll") for(int r=0;r<16;++r)sacc+=pB1[r]; l_reg+=sacc;
    pw0=(u32x4){PKW(pB0,0),PKW(pB0,2),PKW(pB0,4),PKW(pB0,6)};pw1=(u32x4){PKW(pB0,8),PKW(pB0,10),PKW(pB0,12),PKW(pB0,14)};pw2=(u32x4){PKW(pB1,0),PKW(pB1,2),PKW(pB1,4),PKW(pB1,6)};pw3=(u32x4){PKW(pB1,8),PKW(pB1,10),PKW(pB1,12),PKW(pB1,14)};
    SBAR(); pv(o,vb0+sl_cur,PAF(0),PAF(1),PAF(2),PAF(3)); }
  #undef PKW
  #undef PAF
  #undef VFR
  #undef PIN
  #undef MX3
  #undef GAPA
  #undef GAPB
  #undef EX
  #undef VRD
  #undef KRD
  #undef STEP
  #undef ENDW
  {auto rr=__builtin_amdgcn_permlane32_swap(__float_as_uint(l_reg),__float_as_uint(l_reg),false,false);l_reg=__uint_as_float(rr[0])+__uint_as_float(rr[1]);}
  if(has_sink)l_reg+=__builtin_amdgcn_exp2f(sink2-mhat);
  if(hi==0)wsf[32+r32]=l_reg;asm volatile("s_waitcnt lgkmcnt(0)":::"memory");
  float rli[16];
  #pragma unroll
  for(int r=0;r<16;++r)rli[r]=__builtin_amdgcn_rcpf(wsf[32+crow(r,hi)]);
  bf16*Ow=Ou+(long)(wid*QBLK)*OP;
  { bf16*stg=(bf16*)(shm+LDS_OST)+wid*2048;
    #pragma unroll
    for(int r=0;r<16;++r){const int orow=crow(r,hi);
      #pragma unroll
      for(int d0=0;d0<2;++d0)stg[orow*64+d0*32+r32]=__float2bfloat16(o[d0][r]*rli[r]);}
    asm volatile("s_waitcnt lgkmcnt(0)":::"memory");
    #pragma unroll
    for(int i=0;i<4;++i){const int row=i*8+(lane>>3),ch=lane&7; const u32x4 v=*(const u32x4*)(stg+row*64+ch*8); ATTN_STORE16(Ow+(long)row*OP+ch*8,v);} }
  asm volatile("s_waitcnt lgkmcnt(0)\n\ts_barrier":::"memory");
  #undef TROW
  #undef DMA_K
  #undef DMA_V
  #undef CMASK
  #undef START
  #undef RESC
  #undef ROT
}
constexpr int ATTN_LDS_BYTES=LDS_BYTES;
#undef SBAR
#undef WAIT_BAR
}
constexpr int DM = 2048, SEQ = 16384, CTXN = 256, MR = SEQ + CTXN, DEPTH = 4;
constexpr int DFF = 5632, NFF = 2 * DFF, DIN = 12312, NP = 12288;
constexpr int PC_Z = 0, PC_XBC = 768, PC_U = 2048, PC_SQ = 2560, PC_SK = 3072, PC_SV = 3200, PC_GQ = 3328, PC_GK = 3840, PC_GV = 3968, PC_GATE = 4096;
constexpr int NMODV = 9 * DM;
constexpr float LOG2E = 1.4426950408889634f;
constexpr float QSCALE = 0.125f * LOG2E;
constexpr int NWAVES = 8;
enum { I_X = 0, I_C, I_CTX, I_CCTX, I_WMOD, I_BMOD, I_NORMG, I_FFIN, I_FFOUT, I_WIN, I_CONVW, I_CONVB, I_ALOG, I_DTB, I_SSDD, I_SSDNG, I_S5ARE, I_S5AIM, I_S5LDT, I_S5BRE, I_S5BIM,
       I_S5CRE, I_S5CIM, I_S5D, I_GLUW, I_GLUB, I_SWAG, I_SINK, I_GLBG, I_BRSSD, I_BRS5, I_BRSWA, I_BRGLB, I_WOUT, N_IN };

constexpr size_t al256(size_t x) { return (x + 255) & ~(size_t)255; }
constexpr size_t WS_CTL = 0, CTL_ZERO_BYTES = 64u << 10;
constexpr size_t WS_MODP = CTL_ZERO_BYTES;
constexpr size_t WS_MOD = WS_MODP + al256((size_t)DEPTH * 32 * 2 * NMODV * 4);
constexpr size_t WS_X = WS_MOD + al256((size_t)DEPTH * 2 * NMODV * 4);
constexpr size_t WS_H = WS_X + al256((size_t)MR * DM * 4);
constexpr size_t WS_HID = WS_H + al256((size_t)MR * DM * 2);
constexpr size_t WS_P = WS_HID + al256((size_t)MR * DFF * 2);
constexpr size_t WS_DTRAW = WS_P + al256((size_t)MR * NP * 2);
constexpr size_t WS_DT = WS_DTRAW + al256((size_t)MR * 32 * 4);
constexpr size_t WS_XBC = WS_DT + al256((size_t)MR * 24 * 4);
constexpr size_t WS_QS = WS_XBC + al256((size_t)MR * 1280 * 4);
constexpr size_t WS_QG = WS_QS + al256((size_t)MR * 512 * 2);
constexpr size_t WS_KS = WS_QG + al256((size_t)MR * 512 * 2);
constexpr size_t WS_KG = WS_KS + al256((size_t)MR * 128 * 2);
constexpr size_t WS_YS = WS_KG + al256((size_t)MR * 128 * 2);
constexpr size_t WS_YBF = WS_YS + al256((size_t)2 * MR * 768 * 4);
constexpr size_t WS_S5END = WS_YBF + al256((size_t)2 * MR * 512 * 4);
constexpr size_t WS_S5IN = WS_S5END + al256((size_t)64 * 260 * 128 * 4);
constexpr size_t WS_XSN = WS_S5IN + al256((size_t)64 * 260 * 128 * 4);
constexpr size_t WS_XT = WS_XSN + al256((size_t)MR * 768 * 2);
constexpr size_t WS_BN = WS_XT + al256((size_t)MR * 768 * 2);
constexpr size_t WS_CN = WS_BN + al256((size_t)MR * 256 * 2);
constexpr size_t WS_BT = WS_CN + al256((size_t)MR * 256 * 2);
constexpr size_t WS_STATES = WS_BT + al256((size_t)MR * 256 * 2);
constexpr size_t WS_SINB = WS_STATES + al256((size_t)260 * 24 * 8192 * 4);
constexpr size_t WS_CHD = WS_SINB + al256((size_t)260 * 24 * 8192 * 2);
constexpr size_t WS_YALL = WS_CHD + al256((size_t)260 * 24 * 4);
constexpr int YPITCH = 2304, YC_B = 768, YC_C = 1280, YC_D = 1792;
constexpr size_t WS_YBP = WS_YALL + al256((size_t)MR * YPITCH * 2);
constexpr size_t WS_MGF = WS_YBP + al256((size_t)MR * 512 * 2);
constexpr size_t WS_MG = WS_MGF + al256((size_t)MR * DM * 4);
constexpr size_t WS_W = WS_MG + al256((size_t)MR * DM * 2);
constexpr size_t WL_FFI = 0;
constexpr size_t WL_FFO = WL_FFI + (size_t)2 * NFF * DM;
constexpr size_t WL_WIN = WL_FFO + (size_t)2 * DM * DFF;
constexpr size_t WL_WDT = WL_WIN + (size_t)NP * DM;
constexpr size_t WL_GLU = WL_WDT + (size_t)32 * DM;
constexpr size_t WL_BRALL = WL_GLU + (size_t)1024 * 512;
constexpr size_t WL_OUT = WL_BRALL + (size_t)DM * YPITCH;
constexpr size_t WL_SIZE = WL_OUT + (size_t)DM * DM;
constexpr size_t WS_PART = WS_W + al256((size_t)DEPTH * WL_SIZE * 2);
constexpr size_t WS_MGC = WS_PART + al256((size_t)16 * 256 * DM * 4);
constexpr size_t WS_END = WS_MGC + al256((size_t)4 * 256 * DM * 2);
constexpr int CW_BAR = 4096;

constexpr int RING_OFF = 0, RING_BYTES = 131072;
constexpr int LDSCTL_OFF = RING_BYTES, MISC_OFF = LDSCTL_OFF + 320;
constexpr int LDS_BYTES = 147456;

#define GAS __attribute__((address_space(1)))
#define LAS __attribute__((address_space(3)))
typedef unsigned short bf16;
typedef unsigned v4u __attribute__((ext_vector_type(4)));
typedef unsigned v2u __attribute__((ext_vector_type(2)));
typedef float f32x4 __attribute__((ext_vector_type(4)));
typedef short bf16x8 __attribute__((ext_vector_type(8)));
typedef GAS unsigned gu32;
#define RLX_AGENT __ATOMIC_RELAXED, __HIP_MEMORY_SCOPE_AGENT
#define LDS_WAIT() asm volatile("s_waitcnt lgkmcnt(0)" ::: "memory")
#define VM_WAIT() asm volatile("s_waitcnt vmcnt(0)" ::: "memory")
__device__ __forceinline__ unsigned f2bf(float f) { unsigned u = __builtin_bit_cast(unsigned, f); return (u + 0x7fffu + ((u >> 16) & 1u)) >> 16; }
__device__ __forceinline__ unsigned pk2(float lo, float hi) { return f2bf(lo) | (f2bf(hi) << 16); }
__device__ __forceinline__ float bflo(unsigned w) { return __uint_as_float(w << 16); }
__device__ __forceinline__ float bfhi(unsigned w) { return __uint_as_float(w & 0xffff0000u); }
__device__ __forceinline__ float bf1(bf16 h) { return __uint_as_float(((unsigned)h) << 16); }
__device__ __forceinline__ float sigm_(float x) { return __builtin_amdgcn_rcpf(1.0f + __builtin_amdgcn_exp2f(-LOG2E * x)); }
__device__ __forceinline__ float silu_(float x) { return x * sigm_(x); }
#define XB_TMO      128
#define XB_XCNT(j)  (256  + 64 * (j))
#define XB_XSUB(j)  (1280 + 64 * (j))
#define XB_XGEN(j)  (2304 + 64 * (j))
#define XB_TOP      3328
#define XB_TOPGEN   3392
#define XCD_BAR_WORDS 3456
#define XB_SPIN_CAP (1u << 18)

__device__ __forceinline__ unsigned xb_ld(unsigned* p)              { return __hip_atomic_load(p, __ATOMIC_RELAXED, __HIP_MEMORY_SCOPE_AGENT); }
__device__ __forceinline__ unsigned xb_add(unsigned* p, unsigned v) { return __hip_atomic_fetch_add(p, v, __ATOMIC_RELAXED, __HIP_MEMORY_SCOPE_AGENT); }
__device__ __forceinline__ unsigned xb_xcc_id() { return (unsigned)__builtin_amdgcn_s_getreg((3 << 11) | 20) & 0xFu; }
#define XB_SPIN(cond, bar) do { unsigned _sp = 0; while (cond) { __builtin_amdgcn_s_sleep(1); \
    if ((++_sp & 255u) == 0u) { if (xb_ld(&(bar)[XB_TMO])) break; if (_sp > XB_SPIN_CAP) { atomicAdd(&(bar)[XB_TMO], 1u); break; } } } } while (0)

struct XcdBarrier {
    unsigned* bar; unsigned x;
    volatile LAS unsigned* st;
};

__device__ __forceinline__ XcdBarrier xcd_barrier_post(unsigned* bar, volatile LAS unsigned* st) {
    XcdBarrier b; b.bar = bar; b.x = xb_xcc_id(); b.st = st;
    if (threadIdx.x == 0) (void)xb_add(&bar[XB_XCNT(b.x)], 1u);
    return b;
}
__device__ __forceinline__ void xcd_barrier_complete(unsigned* bar, unsigned x, unsigned& nloc, unsigned& nx) {
    const unsigned G = gridDim.x * gridDim.y * gridDim.z;
    unsigned sum, cnt, mine, sp = 0u;
    for (;;) {
        sum = 0u; cnt = 0u; mine = 0u;
#pragma unroll
        for (unsigned j = 0; j < 16; ++j) { const unsigned c = xb_ld(&bar[XB_XCNT(j)]); sum += c; cnt += (c > 0u) ? 1u : 0u; }
        mine = xb_ld(&bar[XB_XCNT(x)]);
        if (sum == G) break;
        __builtin_amdgcn_s_sleep(1);
        if ((++sp & 255u) == 0u) { if (xb_ld(&bar[XB_TMO])) break; if (sp > XB_SPIN_CAP) { atomicAdd(&bar[XB_TMO], 1u); break; } }
    }
    nloc = mine > 0u ? mine : 1u; nx = cnt > 0u ? cnt : 1u;
}

__device__ __forceinline__ void xcd_barrier(const XcdBarrier& b) {
    asm volatile("s_waitcnt vmcnt(0)" ::: "memory");
    __syncthreads();
    if (threadIdx.x == 0) {
        unsigned* bar = b.bar;
        __builtin_amdgcn_s_waitcnt(0);
        unsigned nloc = b.st[0], nx = b.st[1];
        if (nloc == 0u) { xcd_barrier_complete(bar, b.x, nloc, nx); b.st[0] = nloc; b.st[1] = nx; }
        const unsigned old = xb_add(&bar[XB_XSUB(b.x)], 1u);
        const unsigned gen = old / nloc;
        if (old + 1u == (gen + 1u) * nloc) {
            __builtin_amdgcn_fence(__ATOMIC_RELEASE, "agent");
            asm volatile("s_waitcnt vmcnt(0)" ::: "memory");
            const unsigned og = xb_add(&bar[XB_TOP], 1u);
            const unsigned tg = og / nx;
            if (og + 1u == (tg + 1u) * nx) xb_add(&bar[XB_TOPGEN], 1u);
            else XB_SPIN(xb_ld(&bar[XB_TOPGEN]) == tg, bar);
            __builtin_amdgcn_fence(__ATOMIC_ACQUIRE, "agent");
            xb_add(&bar[XB_XGEN(b.x)], 1u);
            asm volatile("s_waitcnt vmcnt(0)" ::: "memory");
        } else {
            XB_SPIN(xb_ld(&bar[XB_XGEN(b.x)]) == gen, bar);
            __builtin_amdgcn_fence(__ATOMIC_ACQUIRE, "agent");
            asm volatile("s_waitcnt vmcnt(0)" ::: "memory");
        }
    }
    __syncthreads();
}
struct Args { const float* in[N_IN]; float* out; unsigned char* ws; int ph_lo, ph_hi; };
typedef const volatile __attribute__((address_space(4))) Args* KArgs;
#define AIN(i) ((const float*)(const __attribute__((address_space(1))) float*)a->in[i])
struct Frame {
    LAS unsigned char* lds;
    volatile LAS unsigned* MISC;
    gu32* ctl;
    int tid, lane, wave;
    int vcu, G;
    unsigned char* ws;
};
__device__ __forceinline__ Frame fresh(const Frame& F) { Frame Fp = F; unsigned long long w = (unsigned long long)F.ws; asm volatile("" : "+v"(Fp.tid), "+s"(Fp.vcu), "+s"(w)); Fp.ws = (unsigned char*)(GAS unsigned char*)w; Fp.lane = Fp.tid & 63; Fp.wave = __builtin_amdgcn_readfirstlane(Fp.tid >> 6); return Fp; }
__device__ __forceinline__ float bperm(float v, int srclane) { return __int_as_float(__builtin_amdgcn_ds_bpermute(srclane << 2, __float_as_int(v))); }
__device__ __forceinline__ float wave_sum(float v, int lane) {
#pragma unroll
    for (int o = 1; o < 64; o <<= 1) v += bperm(v, lane ^ o);
    return v;
}
__device__ __forceinline__ int rowof(int dir, int s) { return dir ? (MR - 1 - s) : (s < CTXN ? SEQ + s : s - CTXN); }
__device__ __forceinline__ void sincos_hw(float ang, float& s, float& c) { float r = ang * 0.15915494309189535f; r = r - floorf(r); s = __builtin_amdgcn_sinf(r); c = __builtin_amdgcn_cosf(r); }

__device__ __forceinline__ void transpose_item(const float* W, int ldw, int Nsrc, int src_c0, bf16* WT, int dst_r0, int k0, int nvalid, LAS float* scr, int lane, int my_col = -1) {
#pragma unroll 8
    for (int i = 0; i < 32; ++i) { const int kk = 2 * i + (lane >> 5); scr[kk * 33 + (lane & 31)] = __builtin_nontemporal_load(W + (size_t)(k0 + kk) * Nsrc + (my_col >= 0 ? my_col : src_c0 + (lane & 31))); }
    LDS_WAIT(); asm volatile("" ::: "memory");
    const int c = lane & 7;
#pragma unroll
    for (int j = 0; j < 4; ++j) { const int n = (lane >> 3) + 8 * j; const LAS float* s = scr + (8 * c) * 33 + n;
        v4u o; o.x = pk2(s[0 * 33], s[1 * 33]); o.y = pk2(s[2 * 33], s[3 * 33]); o.z = pk2(s[4 * 33], s[5 * 33]); o.w = pk2(s[6 * 33], s[7 * 33]);
        if (n >= nvalid) o = (v4u){0u, 0u, 0u, 0u};
        __builtin_nontemporal_store(o, (GAS v4u*)(WT + (size_t)(dst_r0 + n) * ldw + k0 + 8 * c)); }
    LDS_WAIT(); asm volatile("" ::: "memory");
}
constexpr int IT_FFI = 32 * 352, IT_FFO = 88 * 64, IT_WIN = 32 * 384, IT_GLU = 8 * 32, IT_BRA = 12 * 64, IT_BRX = 8 * 64, IT_OUT = 32 * 64, IT_WDT = 32;
constexpr int IT_LAYER = 2 * IT_FFI + 2 * IT_FFO + IT_WIN + IT_GLU + IT_BRA + 3 * IT_BRX + IT_OUT + IT_WDT;
#ifndef HIDE_CONVERT
#define HIDE_CONVERT 0
#endif
constexpr int IT_GA = IT_FFI + IT_FFO, IT_GB = IT_WIN + IT_WDT, IT_GC = IT_GLU + IT_BRA + 3 * IT_BRX + IT_OUT, IT_GD = IT_FFI + IT_FFO;
static_assert(IT_GA + IT_GB + IT_GC + IT_GD == IT_LAYER, "item groups");
__device__ __forceinline__ void convert_item(Frame& F, KArgs a, int l, int r, LAS float* scr) {
    bf16* wl = (bf16*)(F.ws + WS_W) + (size_t)l * WL_SIZE;
    int f = 0; if (r >= IT_GA + IT_GB + IT_GC) { f = 1; r -= IT_GA + IT_GB + IT_GC; }
    if (r < IT_FFI) { const int kb = r / 352, gd = r % 352, pn = gd >> 3, w = gd & 7; const int sc0 = (w < 4) ? 128 * pn + 32 * w : DFF + 128 * pn + 32 * (w - 4);
        transpose_item(AIN(I_FFIN) + (size_t)(l * 2 + f) * DM * NFF, DM, NFF, sc0, wl + WL_FFI + (size_t)f * NFF * DM, 32 * gd, 64 * kb, 32, scr, F.lane); return; } r -= IT_FFI;
    if (r < IT_FFO) { const int kb = r / 64, gd = r % 64;
        transpose_item(AIN(I_FFOUT) + (size_t)(l * 2 + f) * DFF * DM, DFF, DM, 32 * gd, wl + WL_FFO + (size_t)f * DM * DFF, 32 * gd, 64 * kb, 32, scr, F.lane); return; } r -= IT_FFO;
    if (r < IT_WIN) { const int kb = r / 384, gd = r % 384; const int d0 = 32 * gd;
        int mc = -1;
        if (d0 >= PC_GATE) { const int j = (d0 - PC_GATE) >> 8, w = (d0 >> 5) & 7, bj = w >> 2, wc = w & 3, o = F.lane & 31, fq = o >> 3, n = (o >> 2) & 1, i = o & 3;
            mc = (DIN - 4 * DM) + 2048 * (2 * bj + n) + 64 * j + 16 * wc + 4 * fq + i; }
        transpose_item(AIN(I_WIN) + (size_t)l * DM * DIN, DM, DIN, d0 < 2048 ? d0 : d0 + 24, wl + WL_WIN, d0, 64 * kb, 32, scr, F.lane, mc); return; } r -= IT_WIN;
    if (r < IT_WDT) { transpose_item(AIN(I_WIN) + (size_t)l * DM * DIN, DM, DIN, 2048, wl + WL_WDT, 0, 64 * r, 24, scr, F.lane); return; } r -= IT_WDT;
    if (r < IT_GLU) { const int kb = r / 32, gd = r % 32, pn = gd >> 3, w = gd & 7; const int sc0 = (w < 4) ? 128 * pn + 32 * w : 512 + 128 * pn + 32 * (w - 4);
        transpose_item(AIN(I_GLUW) + (size_t)l * 512 * 1024, 512, 1024, sc0, wl + WL_GLU, 32 * gd, 64 * kb, 32, scr, F.lane); return; } r -= IT_GLU;
    if (r < IT_BRA) { const int kb = r / 64, gd = r % 64;
        transpose_item(AIN(I_BRSSD) + (size_t)l * 768 * DM, YPITCH, DM, 32 * gd, wl + WL_BRALL, 32 * gd, 64 * kb, 32, scr, F.lane); return; } r -= IT_BRA;
    if (r < 3 * IT_BRX) { const int b = r / IT_BRX; r %= IT_BRX; const int kb = r / 64, gd = r % 64;
        const float* src = (b == 0 ? AIN(I_BRS5) : (b == 1 ? AIN(I_BRSWA) : AIN(I_BRGLB))) + (size_t)l * 512 * DM;
        transpose_item(src, YPITCH, DM, 32 * gd, wl + WL_BRALL + YC_B + 512 * b, 32 * gd, 64 * kb, 32, scr, F.lane); return; } r -= 3 * IT_BRX;
    { const int kb = r / 64, gd = r % 64; transpose_item(AIN(I_WOUT) + (size_t)l * DM * DM, DM, DM, 32 * gd, wl + WL_OUT, 32 * gd, 64 * kb, 32, scr, F.lane); }
}
__device__ __forceinline__ void convert_range(Frame& F, KArgs a, int l, int first, int n, int widx, int wstride) {
    LAS float* scr = (LAS float*)(F.lds + RING_OFF + F.wave * 16384);
    for (int it = first + widx; it < first + n; it += wstride) convert_item(F, a, l, it, scr);
}
__device__ __forceinline__ void convert_idle(Frame& F, KArgs a, int c, int rem, int l, int first, int n) {
    if (c < rem || l >= DEPTH) return;
    convert_range(F, a, l, first, n, (c - rem) * NWAVES + F.wave, (F.G - rem) * NWAVES);
}
__device__ __forceinline__ void p0_prologue(Frame& F, KArgs a) {
    const int gw = F.vcu * NWAVES + F.wave, NGW = F.G * NWAVES;
#if HIDE_CONVERT
    convert_range(F, a, 0, 0, IT_GA, gw, NGW);
#else
    for (int l = 0; l < DEPTH; ++l) convert_range(F, a, l, 0, IT_LAYER, gw, NGW);
#endif
    float* X = (float*)(F.ws + WS_X);
    for (int m = gw; m < MR; m += NGW) {
        const GAS f32x4* src = (const GAS f32x4*)(m < SEQ ? AIN(I_X) + (size_t)m * DM : AIN(I_CTX) + (size_t)(m - SEQ) * DM) + F.lane; GAS f32x4* dst = (GAS f32x4*)(X + (size_t)m * DM) + F.lane;
#pragma unroll
        for (int j = 0; j < 8; ++j) dst[64 * j] = src[64 * j];
    }
    __syncthreads();
    LAS float* sc = (LAS float*)(F.lds + RING_OFF);
    for (int i = F.tid; i < 2 * DM; i += NWAVES * 64) { const float c = (i < DM) ? AIN(I_C)[i] : AIN(I_CCTX)[i - DM]; sc[i] = silu_(c); }
    __syncthreads();
    float* MODP = (float*)(F.ws + WS_MODP);
    for (int it = F.vcu; it < DEPTH * 32 * 9; it += F.G) {
        const int l = it / 288, r = it % 288, s = r / 9, b = r % 9, col = b * 2048 + 4 * F.tid;
        const float* w = AIN(I_WMOD) + (size_t)l * DM * NMODV + (size_t)(64 * s) * NMODV + col;
        f32x4 a0 = {0.f, 0.f, 0.f, 0.f}, a1 = {0.f, 0.f, 0.f, 0.f};
#pragma unroll 8
        for (int k = 0; k < 64; ++k) { const f32x4 wv = __builtin_nontemporal_load((const f32x4*)(w + (size_t)k * NMODV)); a0 += wv * sc[64 * s + k]; a1 += wv * sc[DM + 64 * s + k]; }
        *(f32x4*)(MODP + (size_t)((l * 32 + s) * 2 + 0) * NMODV + col) = a0; *(f32x4*)(MODP + (size_t)((l * 32 + s) * 2 + 1) * NMODV + col) = a1;
    }
}
__device__ __forceinline__ void p1_modfinal(Frame& F, KArgs a) {
    const float* MODP = (const float*)(F.ws + WS_MODP); float* MOD = (float*)(F.ws + WS_MOD);
    for (int i = F.vcu * 512 + F.tid; i < DEPTH * 2 * NMODV; i += F.G * 512) {
        const int l = i / (2 * NMODV), v = (i / NMODV) & 1, j = i % NMODV; float s = AIN(I_BMOD)[l * NMODV + j];
#pragma unroll
        for (int q = 0; q < 32; ++q) s += MODP[(size_t)((l * 32 + q) * 2 + v) * NMODV + j];
        MOD[i] = s;
    }
}
__device__ __forceinline__ void norm_phase(Frame& F, KArgs a, int l, int k, int nsl) {
    const int gw = F.vcu * NWAVES + F.wave, NGW = F.G * NWAVES;
    const float* X = (const float*)(F.ws + WS_X); bf16* H = (bf16*)(F.ws + WS_H);
    const float* g = AIN(I_NORMG) + (size_t)(l * 3 + k) * DM;
    { const int v = 0;
        const float* mod = (const float*)(F.ws + WS_MOD) + (size_t)(l * 2 + v) * NMODV; const float* shift = mod + (3 * k) * DM; const float* scale = mod + (3 * k + 1) * DM;
        f32x4 gs[8], sh[8];
#pragma unroll
        for (int j = 0; j < 8; ++j) { const int c = 4 * F.lane + 256 * j; const f32x4 gg = *(const f32x4*)(g + c), ss = *(const f32x4*)(scale + c); gs[j] = gg * (ss + 1.0f); sh[j] = *(const f32x4*)(shift + c); }
        const int r0 = v ? SEQ : 0, r1 = v ? MR : SEQ;
        if (v == 0) {
            for (int m = r0 + gw; m < r1; m += 2 * NGW) {
                const bool two = m + NGW < r1; const int m2 = two ? m + NGW : m;
                const GAS f32x4* xa = (const GAS f32x4*)(X + (size_t)m * DM) + F.lane; const GAS f32x4* xb = (const GAS f32x4*)(X + (size_t)m2 * DM) + F.lane; f32x4 a[8], b[8]; float sa = 0.f, sb = 0.f;
#pragma unroll
                for (int j = 0; j < 8; ++j) { a[j] = __builtin_nontemporal_load(xa + 64 * j); b[j] = __builtin_nontemporal_load(xb + 64 * j); }
#pragma unroll
                for (int j = 0; j < 8; ++j) { sa += (a[j].x * a[j].x + a[j].y * a[j].y) + (a[j].z * a[j].z + a[j].w * a[j].w); sb += (b[j].x * b[j].x + b[j].y * b[j].y) + (b[j].z * b[j].z + b[j].w * b[j].w); }
                const float ra = 1.0f / sqrtf(wave_sum(sa, F.lane) * (1.0f / DM) + 1e-6f), rb = 1.0f / sqrtf(wave_sum(sb, F.lane) * (1.0f / DM) + 1e-6f);
                GAS v2u* oa = (GAS v2u*)(H + (size_t)m * DM) + F.lane; GAS v2u* ob = (GAS v2u*)(H + (size_t)m2 * DM) + F.lane;
#pragma unroll
                for (int j = 0; j < 8; ++j) { const f32x4 y = a[j] * ra * gs[j] + sh[j]; v2u w; w.x = pk2(y.x, y.y); w.y = pk2(y.z, y.w); oa[64 * j] = w; }
                if (two) {
#pragma unroll
                    for (int j = 0; j < 8; ++j) { const f32x4 y = b[j] * rb * gs[j] + sh[j]; v2u w; w.x = pk2(y.x, y.y); w.y = pk2(y.z, y.w); ob[64 * j] = w; } }
            }
        }
    }
    {
        const float* mod = (const float*)(F.ws + WS_MOD) + (size_t)(l * 2 + 1) * NMODV; const int c = 256 * F.wave + 4 * F.lane;
        const f32x4 gsc = *(const f32x4*)(g + c) * (*(const f32x4*)(mod + (3 * k + 1) * DM + c) + 1.0f), shc = *(const f32x4*)(mod + (3 * k) * DM + c);
        LAS float* red = (LAS float*)(F.lds + RING_OFF);
        for (int m = SEQ + F.vcu; m < MR; m += F.G) {
            f32x4 x = *(const GAS f32x4*)(X + (size_t)m * DM + c);
            if (nsl > 0) { const float* PART = (const float*)(F.ws + WS_PART) + (size_t)(m - SEQ) * DM + c;
#pragma unroll 4
                for (int sl = 0; sl < nsl; ++sl) x += *(const GAS f32x4*)(PART + (size_t)sl * 256 * DM);
                *(GAS f32x4*)((float*)(F.ws + WS_X) + (size_t)m * DM + c) = x; }
            const float s = wave_sum((x.x * x.x + x.y * x.y) + (x.z * x.z + x.w * x.w), F.lane);
            if (F.lane == 0) red[F.wave] = s;
            __syncthreads();
            float tot = 0.f;
#pragma unroll
            for (int w = 0; w < NWAVES; ++w) tot += red[w];
            __syncthreads();
            const float rstd = 1.0f / sqrtf(tot * (1.0f / DM) + 1e-6f);
            const f32x4 y = x * rstd * gsc + shc; v2u w; w.x = pk2(y.x, y.y); w.y = pk2(y.z, y.w); *(GAS v2u*)(H + (size_t)m * DM + c) = w;
        }
    }
}
__device__ __forceinline__ void dt_gemm(Frame& F, int l, int c, int rem) {
    if (c < rem) return;
    const int gw = (c - rem) * NWAVES + F.wave, NGW = (F.G - rem) * NWAVES;
    const bf16* H = (const bf16*)(F.ws + WS_H); const bf16* Wd = (const bf16*)(F.ws + WS_W) + (size_t)l * WL_SIZE + WL_WDT; float* DTR = (float*)(F.ws + WS_DTRAW);
    const int fr = F.lane & 15, fq = F.lane >> 4;
    for (int t = gw; t < MR / 16; t += NGW) {
        const bf16* ap = H + (size_t)(16 * t + fr) * DM + 8 * fq; const bf16* b0 = Wd + (size_t)fr * DM + 8 * fq; const bf16* b1 = Wd + (size_t)(16 + fr) * DM + 8 * fq;
        f32x4 c0 = {0.f, 0.f, 0.f, 0.f}, c1 = {0.f, 0.f, 0.f, 0.f};
#pragma unroll 4
        for (int k0 = 0; k0 < DM; k0 += 32) { const bf16x8 av = *(const bf16x8*)(ap + k0), bv0 = *(const bf16x8*)(b0 + k0), bv1 = *(const bf16x8*)(b1 + k0);
            c0 = __builtin_amdgcn_mfma_f32_16x16x32_bf16(av, bv0, c0, 0, 0, 0); c1 = __builtin_amdgcn_mfma_f32_16x16x32_bf16(av, bv1, c1, 0, 0, 0); }
#pragma unroll
        for (int r = 0; r < 4; ++r) { float* o = DTR + (size_t)(16 * t + 4 * fq + r) * 32 + fr; o[0] = c0[r]; o[16] = c1[r]; }
    }
}
struct S5Disc { float lb_re, lb_im, bb_re[16], bb_im[16]; };
__device__ __forceinline__ void s5_disc(KArgs a, int l, int dir, int g, int p, S5Disc& d) {
    const int ig = (l * 2 + dir) * 32 + g; const float a_re = AIN(I_S5ARE)[ig * 64 + p], a_im = AIN(I_S5AIM)[ig * 64 + p]; const float dt = __expf(AIN(I_S5LDT)[ig]);
    const float mag = __expf(a_re * dt); float sn, cs; sincos_hw(a_im * dt, sn, cs);
    d.lb_re = mag * cs; d.lb_im = mag * sn;
    const float den = a_re * a_re + a_im * a_im, nr = d.lb_re - 1.0f, ni = d.lb_im;
    const float f_re = (nr * a_re + ni * a_im) / den, f_im = (ni * a_re - nr * a_im) / den;
    const float* br = AIN(I_S5BRE) + (size_t)((l * 32 + g) * 64 + p) * 16; const float* bi = AIN(I_S5BIM) + (size_t)((l * 32 + g) * 64 + p) * 16;
#pragma unroll
    for (int h = 0; h < 16; ++h) { const float x = br[h], y = bi[h]; d.bb_re[h] = f_re * x - f_im * y; d.bb_im[h] = f_re * y + f_im * x; }
}
typedef float f32x16 __attribute__((ext_vector_type(16)));
struct S5Pow { float r1, i1, r2, i2, r3, i3, r4, i4; };
__device__ __forceinline__ void s5_pow(const S5Disc& d, S5Pow& p) { p.r1 = d.lb_re; p.i1 = d.lb_im; p.r2 = p.r1 * p.r1 - p.i1 * p.i1; p.i2 = 2.0f * p.r1 * p.i1; p.r3 = p.r2 * p.r1 - p.i2 * p.i1; p.i3 = p.r2 * p.i1 + p.i2 * p.r1; p.r4 = p.r2 * p.r2 - p.i2 * p.i2; p.i4 = 2.0f * p.r2 * p.i2; }
__device__ __forceinline__ bf16x8 pack8(const float (&v)[16], bool hi) { v4u w; w.x = pk2(hi ? v[8] : v[0], hi ? v[9] : v[1]); w.y = pk2(hi ? v[10] : v[2], hi ? v[11] : v[3]); w.z = pk2(hi ? v[12] : v[4], hi ? v[13] : v[5]); w.w = pk2(hi ? v[14] : v[6], hi ? v[15] : v[7]); return __builtin_bit_cast(bf16x8, w); }
template <bool FIX> __device__ __forceinline__ void s5_state_scan(f32x16& R, f32x16& I, const S5Pow& p, float& cr, float& ci, bool hi) {
#pragma unroll
    for (int k = 0; k < 4; ++k)
#pragma unroll
        for (int j = 1; j < 4; ++j) { const int x = 4 * k + j; const float nr = p.r1 * R[x - 1] - p.i1 * I[x - 1] + R[x], ni = p.r1 * I[x - 1] + p.i1 * R[x - 1] + I[x]; R[x] = nr; I[x] = ni; }
    float cinr[4], cini[4], ce_r = 0.f, ce_i = 0.f;
#pragma unroll
    for (int G = 0; G < 8; ++G) { const int k = G >> 1;
        if ((G & 1) == 0) { ce_r = cr; ce_i = ci; } else { cinr[k] = hi ? cr : ce_r; cini[k] = hi ? ci : ce_i; }
        const float vr = p.r4 * cr - p.i4 * ci + R[4 * k + 3], vi = p.r4 * ci + p.i4 * cr + I[4 * k + 3];
        const auto sr = __builtin_amdgcn_permlane32_swap(__float_as_uint(vr), __float_as_uint(vr), false, false); const auto si = __builtin_amdgcn_permlane32_swap(__float_as_uint(vi), __float_as_uint(vi), false, false);
        cr = __uint_as_float(sr[G & 1]); ci = __uint_as_float(si[G & 1]); }
    if (FIX) {
#pragma unroll
        for (int k = 0; k < 4; ++k) { const float a = cinr[k], b = cini[k];
            R[4 * k + 0] += p.r1 * a - p.i1 * b; I[4 * k + 0] += p.r1 * b + p.i1 * a; R[4 * k + 1] += p.r2 * a - p.i2 * b; I[4 * k + 1] += p.r2 * b + p.i2 * a;
            R[4 * k + 2] += p.r3 * a - p.i3 * b; I[4 * k + 2] += p.r3 * b + p.i3 * a; R[4 * k + 3] += p.r4 * a - p.i4 * b; I[4 * k + 3] += p.r4 * b + p.i4 * a; }
    }
}
#ifndef S5_NA
#define S5_NA 5
#endif
template <bool PASS2> __device__ __forceinline__ void s5_pass(Frame& F, KArgs a, int l) {
    const int gw = F.vcu * NWAVES + F.wave, NGW = F.G * NWAVES;
    if (NGW % 64 != 0) return;
    const int q = gw & 63, dir = q >> 5, g = q & 31, lane = F.lane, s = lane & 31; const bool hi = lane >= 32;
    S5Pow pA, pB; bf16x8 bbf[4];
    { S5Disc dA, dB; s5_disc(a, l, dir, g, s, dA); s5_disc(a, l, dir, g, s + 32, dB); s5_pow(dA, pA); s5_pow(dB, pB);
      bbf[0] = pack8(dA.bb_re, hi); bbf[1] = pack8(dB.bb_re, hi); bbf[2] = pack8(dA.bb_im, hi); bbf[3] = pack8(dB.bb_im, hi); }
    bf16x8 cmf[4];
    if (PASS2) { const int h = lane & 15, q4 = lane >> 4;
#pragma unroll
        for (int ks = 0; ks < 4; ++ks) { const float* src = (ks < 2 ? AIN(I_S5CRE) : AIN(I_S5CIM)) + (size_t)((l * 32 + g) * 16 + h) * 64 + 32 * (ks & 1) + 8 * q4; const float sg = ks < 2 ? 1.0f : -1.0f;
            const f32x4 v0 = *(const f32x4*)src * sg, v1 = *(const f32x4*)(src + 4) * sg; v4u w; w.x = pk2(v0.x, v0.y); w.y = pk2(v0.z, v0.w); w.z = pk2(v1.x, v1.y); w.w = pk2(v1.z, v1.w); cmf[ks] = __builtin_bit_cast(bf16x8, w); } }
    float* END = (float*)(F.ws + WS_S5END); const float* SIN = (const float*)(F.ws + WS_S5IN); const bf16* P = (const bf16*)(F.ws + WS_P); bf16* YBF = (bf16*)(F.ws + WS_YBF);
    LAS bf16* Sb = (LAS bf16*)(F.lds + RING_OFF + F.wave * 8192);
    int cs_beg = gw >> 6, cs_end = MR / 64, cs_step = NGW >> 6;
    if (PASS2 && S5_NA > 0 && NGW == 2048) {
        const int rgw = NGW - 1 - gw, rj = rgw >> 6, rq = rgw & 63, n2 = (MR / 64) * 12 - NGW;
        const int nAw = (n2 >> 6) + (rq < (n2 & 63) ? 1 : 0), nBw = 32 - nAw, rest = MR / 64 - nAw * S5_NA, bs = rest / nBw, ex = rest % nBw, jb = rj - nAw;
        cs_beg = rj < nAw ? rj * S5_NA : nAw * S5_NA + jb * bs + (jb < ex ? jb : ex);
        cs_end = cs_beg + (rj < nAw ? S5_NA : bs + (jb < ex ? 1 : 0)); cs_step = 1;
    }
    for (int cs = cs_beg; cs < cs_end; cs += cs_step) {
        const size_t o = ((size_t)q * (MR / 64) + cs) * 128;
        float cAr = 0.f, cAi = 0.f, cBr = 0.f, cBi = 0.f;
        if (PASS2) { cAr = SIN[o + 2 * s]; cAi = SIN[o + 2 * s + 1]; cBr = SIN[o + 2 * (s + 32)]; cBi = SIN[o + 2 * (s + 32) + 1]; }
#pragma unroll 1
        for (int tt = 0; tt < 2; ++tt) {
            const bf16x8 uf = *(const GAS bf16x8*)(P + (size_t)rowof(dir, 64 * cs + 32 * tt + s) * NP + PC_U + 16 * g + (hi ? 8 : 0));
            const f32x16 z = {0.f, 0.f, 0.f, 0.f, 0.f, 0.f, 0.f, 0.f, 0.f, 0.f, 0.f, 0.f, 0.f, 0.f, 0.f, 0.f};
            f32x16 T0 = __builtin_amdgcn_mfma_f32_32x32x16_bf16(uf, bbf[0], z, 0, 0, 0), T1 = __builtin_amdgcn_mfma_f32_32x32x16_bf16(uf, bbf[1], z, 0, 0, 0);
            f32x16 T2 = __builtin_amdgcn_mfma_f32_32x32x16_bf16(uf, bbf[2], z, 0, 0, 0), T3 = __builtin_amdgcn_mfma_f32_32x32x16_bf16(uf, bbf[3], z, 0, 0, 0);
            s5_state_scan<PASS2>(T0, T2, pA, cAr, cAi, hi);
            s5_state_scan<PASS2>(T1, T3, pB, cBr, cBi, hi);
            if (PASS2) {
#pragma unroll
                for (int r = 0; r < 16; ++r) { const int tl = 8 * (r >> 2) + (hi ? 4 : 0) + (r & 3); LAS bf16* dst = Sb + tl * 128 + s;
                    dst[0] = (bf16)f2bf(T0[r]); dst[32] = (bf16)f2bf(T1[r]); dst[64] = (bf16)f2bf(T2[r]); dst[96] = (bf16)f2bf(T3[r]); }
                LDS_WAIT(); asm volatile("" ::: "memory");
                const int r16 = lane & 15, q4 = lane >> 4;
#pragma unroll
                for (int mt = 0; mt < 2; ++mt) { f32x4 acc = {0.f, 0.f, 0.f, 0.f};
#pragma unroll
                    for (int ks = 0; ks < 4; ++ks) { const bf16x8 af = *(const LAS bf16x8*)(Sb + (16 * mt + r16) * 128 + 32 * ks + 8 * q4); acc = __builtin_amdgcn_mfma_f32_16x16x32_bf16(af, cmf[ks], acc, 0, 0, 0); }
#pragma unroll
                    for (int rg = 0; rg < 4; ++rg) { const int row = rowof(dir, 64 * cs + 32 * tt + 16 * mt + 4 * q4 + rg); YBF[((size_t)dir * MR + row) * 512 + 16 * g + r16] = (bf16)f2bf(acc[rg]); } }
                LDS_WAIT(); asm volatile("" ::: "memory");
            }
        }
        if (!PASS2 && !hi) { END[o + 2 * s] = cAr; END[o + 2 * s + 1] = cAi; END[o + 2 * (s + 32)] = cBr; END[o + 2 * (s + 32) + 1] = cBi; }
    }
}
#ifndef S5C_UNR
#define S5C_UNR 13
#endif
__device__ __forceinline__ void s5_carry(Frame& F, KArgs a, int l, int first_wave) {
    const int gw = F.vcu * NWAVES + F.wave - first_wave; if (gw < 0 || gw >= 64) return;
    const int q = gw, dir = q >> 5, g = q & 31, p = F.lane;
    const int ig = (l * 2 + dir) * 32 + g; const float a_re = AIN(I_S5ARE)[ig * 64 + p], a_im = AIN(I_S5AIM)[ig * 64 + p]; const float dt = __expf(AIN(I_S5LDT)[ig]);
    const float mag = __expf(a_re * dt); float sn, cs_; sincos_hw(a_im * dt, sn, cs_);
    float pr = mag * cs_, pi = mag * sn;
#pragma unroll
    for (int i = 0; i < 6; ++i) { const float nr = pr * pr - pi * pi, ni = 2.0f * pr * pi; pr = nr; pi = ni; }
    const float* END = (const float*)(F.ws + WS_S5END); float* SIN = (float*)(F.ws + WS_S5IN);
    float s_re = 0.f, s_im = 0.f;
    for (int cs = 0; cs < MR / 64; cs += S5C_UNR) {
        float er[S5C_UNR], ei[S5C_UNR];
#pragma unroll
        for (int i = 0; i < S5C_UNR; ++i) { const size_t o = ((size_t)q * (MR / 64) + cs + i) * 128 + 2 * p; er[i] = END[o]; ei[i] = END[o + 1]; }
#pragma unroll
        for (int i = 0; i < S5C_UNR; ++i) { const size_t o = ((size_t)q * (MR / 64) + cs + i) * 128 + 2 * p; SIN[o] = s_re; SIN[o + 1] = s_im;
            const float nr = pr * s_re - pi * s_im + er[i], ni = pr * s_im + pi * s_re + ei[i]; s_re = nr; s_im = ni; }
    }
}
__device__ __forceinline__ bf16x8 ldg8(const bf16* p) { return *(const GAS bf16x8*)p; }
__device__ __forceinline__ int ssd_chunk_of(int d, int j) { return d ? (MR / 64 - 1 - j) : (j < CTXN / 64 ? SEQ / 64 + j : j - CTXN / 64); }
__device__ __forceinline__ float scan64(float v, int d, int lane) {
#pragma unroll
    for (int o = 1; o < 64; o <<= 1) { const float up = bperm(v, lane - o), dn = bperm(v, lane + o); if (d == 0) { if (lane >= o) v += up; } else { if (lane + o < 64) v += dn; } }
    return v;
}
__device__ __forceinline__ void conv_item(Frame& F, const float* cw, const float* cb_, int k, int cb) {
    LAS float* tin = (LAS float*)(F.lds + RING_OFF);
    LAS float* tout = tin + 68 * 64;
    const bf16* P = (const bf16*)(F.ws + WS_P);
    const int row0 = 64 * k, lo = k < SEQ / 64 ? 0 : SEQ, hi = k < SEQ / 64 ? SEQ : MR, c0 = 64 * cb;
    const int t = F.tid >> 3, c8 = (F.tid & 7) * 8;
    __syncthreads();
#pragma unroll
    for (int rr = t; rr < 68; rr += 64) { const int grow = row0 - 2 + rr; v4u w = (v4u){0u, 0u, 0u, 0u}; if (grow >= lo && grow < hi) w = *(const GAS v4u*)(P + (size_t)grow * NP + PC_XBC + c0 + c8);
        *(LAS f32x4*)(tin + rr * 64 + c8) = (f32x4){bflo(w.x), bfhi(w.x), bflo(w.y), bfhi(w.y)}; *(LAS f32x4*)(tin + rr * 64 + c8 + 4) = (f32x4){bflo(w.z), bfhi(w.z), bflo(w.w), bfhi(w.w)}; }
    __syncthreads();
    { f32x4 a0 = *(const f32x4*)(cb_ + c0 + c8), a1 = *(const f32x4*)(cb_ + c0 + c8 + 4);
#pragma unroll
      for (int j = 0; j < 5; ++j) { const f32x4 w0 = *(const f32x4*)(cw + j * 1280 + c0 + c8), w1 = *(const f32x4*)(cw + j * 1280 + c0 + c8 + 4);
          a0 += w0 * *(const LAS f32x4*)(tin + (t + j) * 64 + c8); a1 += w1 * *(const LAS f32x4*)(tin + (t + j) * 64 + c8 + 4); }
      float o[8];
#pragma unroll
      for (int i = 0; i < 4; ++i) { o[i] = silu_(a0[i]); o[4 + i] = silu_(a1[i]); }
#pragma unroll
      for (int i = 0; i < 8; ++i) tout[t * 65 + c8 + i] = o[i];
      v4u w; w.x = pk2(o[0], o[1]); w.y = pk2(o[2], o[3]); w.z = pk2(o[4], o[5]); w.w = pk2(o[6], o[7]);
      bf16* nat = (cb < 12) ? (bf16*)(F.ws + WS_XSN) + (size_t)(row0 + t) * 768 + c0 + c8
                : (cb < 16) ? (bf16*)(F.ws + WS_BN) + (size_t)(row0 + t) * 256 + (c0 - 768) + c8
                            : (bf16*)(F.ws + WS_CN) + (size_t)(row0 + t) * 256 + (c0 - 1024) + c8;
      *(GAS v4u*)nat = w; }
    __syncthreads();
    if (cb < 16) {
        const int c = F.tid >> 3, t8 = (F.tid & 7) * 8; float o[8];
#pragma unroll
        for (int i = 0; i < 8; ++i) o[i] = tout[(t8 + i) * 65 + c];
        v4u w; w.x = pk2(o[0], o[1]); w.y = pk2(o[2], o[3]); w.z = pk2(o[4], o[5]); w.w = pk2(o[6], o[7]);
        bf16* tr = (cb < 12) ? (bf16*)(F.ws + WS_XT) + ((size_t)(k * 12 + cb) * 64 + c) * 64 + t8
                             : (bf16*)(F.ws + WS_BT) + ((size_t)k * 256 + (c0 - 768) + c) * 64 + t8;
        *(GAS v4u*)tr = w;
    }
}
__device__ __forceinline__ void conv_wave_item(Frame& F, const float* cw, const float* cb_, int k, int c0, LAS float* buf) {
    const bf16* P = (const bf16*)(F.ws + WS_P);
    const int row0 = 64 * k, lo = k < SEQ / 64 ? 0 : SEQ, hi = k < SEQ / 64 ? SEQ : MR, t = F.lane;
    { const int g0 = row0 - 2 + t; v4u w = (v4u){0u, 0u, 0u, 0u}; if (g0 >= lo && g0 < hi) w = *(const GAS v4u*)(P + (size_t)g0 * NP + PC_XBC + c0);
      *(LAS f32x4*)(buf + t * 8) = (f32x4){bflo(w.x), bfhi(w.x), bflo(w.y), bfhi(w.y)}; *(LAS f32x4*)(buf + t * 8 + 4) = (f32x4){bflo(w.z), bfhi(w.z), bflo(w.w), bfhi(w.w)};
      if (t < 4) { const int g1 = row0 + 62 + t; v4u w1 = (v4u){0u, 0u, 0u, 0u}; if (g1 >= lo && g1 < hi) w1 = *(const GAS v4u*)(P + (size_t)g1 * NP + PC_XBC + c0);
          *(LAS f32x4*)(buf + (64 + t) * 8) = (f32x4){bflo(w1.x), bfhi(w1.x), bflo(w1.y), bfhi(w1.y)}; *(LAS f32x4*)(buf + (64 + t) * 8 + 4) = (f32x4){bflo(w1.z), bfhi(w1.z), bflo(w1.w), bfhi(w1.w)}; } }
    LDS_WAIT(); asm volatile("" ::: "memory");
    f32x4 a0 = *(const f32x4*)(cb_ + c0), a1 = *(const f32x4*)(cb_ + c0 + 4);
#pragma unroll
    for (int j = 0; j < 5; ++j) { const f32x4 w0 = *(const f32x4*)(cw + j * 1280 + c0), w1 = *(const f32x4*)(cw + j * 1280 + c0 + 4);
        a0 += w0 * *(const LAS f32x4*)(buf + (t + j) * 8); a1 += w1 * *(const LAS f32x4*)(buf + (t + j) * 8 + 4); }
    float o[8];
#pragma unroll
    for (int i = 0; i < 4; ++i) { o[i] = silu_(a0[i]); o[4 + i] = silu_(a1[i]); }
    v4u w; w.x = pk2(o[0], o[1]); w.y = pk2(o[2], o[3]); w.z = pk2(o[4], o[5]); w.w = pk2(o[6], o[7]);
    if (c0 >= 768) { bf16* nat = (c0 < 1024) ? (bf16*)(F.ws + WS_BN) + (size_t)(row0 + t) * 256 + (c0 - 768) : (bf16*)(F.ws + WS_CN) + (size_t)(row0 + t) * 256 + (c0 - 1024); *(GAS v4u*)nat = w; }
    if (c0 < 1024) { bf16* tr = (c0 < 768) ? (bf16*)(F.ws + WS_XT) + ((size_t)(k * 12 + (c0 >> 6)) * 64 + (c0 & 63)) * 64 + t : (bf16*)(F.ws + WS_BT) + ((size_t)k * 256 + (c0 - 768)) * 64 + t;
#pragma unroll
        for (int i = 0; i < 8; ++i) tr[(size_t)i * 64] = (bf16)f2bf(o[i]); }
    LDS_WAIT(); asm volatile("" ::: "memory");
}
#ifndef ST_HPI
#define ST_HPI 2
#endif
#ifndef CARRY_UNR
#define CARRY_UNR 13
#endif
__device__ __forceinline__ void ssd_states(Frame& F, KArgs a, int l) {
    const int gw = F.vcu * NWAVES + F.wave, NGW = F.G * NWAVES, lane = F.lane, r = lane & 15, q = lane >> 4;
    LAS float* wb = (LAS float*)(F.lds + RING_OFF + F.wave * 2048);
    const float* DT = (const float*)(F.ws + WS_DT); const bf16* XT = (const bf16*)(F.ws + WS_XT); const bf16* BT = (const bf16*)(F.ws + WS_BT);
    bf16* ST = (bf16*)(F.ws + WS_STATES); float* CHD = (float*)(F.ws + WS_CHD); const float* alog = AIN(I_ALOG) + l * 24;
    for (int item = gw; item < (MR / 64) * 4 * (6 / ST_HPI); item += NGW) {
        const int hp = item % (6 / ST_HPI), i4 = item / (6 / ST_HPI), k = i4 >> 2, g = (i4 >> 1) & 1, d = i4 & 1, row0 = 64 * k;
#pragma unroll
        for (int hh = 0; hh < ST_HPI; ++hh) { const int dh = d * 12 + g * 6 + hp * ST_HPI + hh; const float dt = DT[(size_t)(row0 + lane) * 24 + dh]; const float A = -__expf(alog[dh]);
            const float cum = scan64(A * dt, d, lane); const float tot = __int_as_float(d ? __builtin_amdgcn_readlane(__float_as_int(cum), 0) : __builtin_amdgcn_readlane(__float_as_int(cum), 63));
            wb[hh * 64 + lane] = dt * __expf(tot - cum);
            if (lane == 0) CHD[k * 24 + dh] = __expf(tot); }
        LDS_WAIT(); asm volatile("" ::: "memory");
        for (int hh = 0; hh < ST_HPI; ++hh) {
            const int h = g * 6 + hp * ST_HPI + hh, dh = d * 12 + h;
            bf16x8 af[4][2];
#pragma unroll
            for (int ks = 0; ks < 2; ++ks) { const f32x4 w0 = *(const LAS f32x4*)(wb + hh * 64 + 32 * ks + 8 * q), w1 = *(const LAS f32x4*)(wb + hh * 64 + 32 * ks + 8 * q + 4);
#pragma unroll
                for (int pt = 0; pt < 4; ++pt) { const v4u x = *(const GAS v4u*)(XT + ((size_t)(k * 12 + h) * 64 + 16 * pt + r) * 64 + 32 * ks + 8 * q);
                    v4u y; y.x = pk2(bflo(x.x) * w0.x, bfhi(x.x) * w0.y); y.y = pk2(bflo(x.y) * w0.z, bfhi(x.y) * w0.w); y.z = pk2(bflo(x.z) * w1.x, bfhi(x.z) * w1.y); y.w = pk2(bflo(x.w) * w1.z, bfhi(x.w) * w1.w);
                    af[pt][ks] = __builtin_bit_cast(bf16x8, y); } }
#pragma unroll
            for (int half = 0; half < 2; ++half) {
                f32x4 acc[4][4];
#pragma unroll
                for (int pt = 0; pt < 4; ++pt)
#pragma unroll
                    for (int nt = 0; nt < 4; ++nt) acc[pt][nt] = (f32x4){0.f, 0.f, 0.f, 0.f};
#pragma unroll
                for (int ks = 0; ks < 2; ++ks)
#pragma unroll
                    for (int nt = 0; nt < 4; ++nt) { const bf16x8 bv = ldg8(BT + ((size_t)(k * 2 + g) * 128 + 64 * half + 16 * nt + r) * 64 + 32 * ks + 8 * q);
#pragma unroll
                        for (int pt = 0; pt < 4; ++pt) acc[pt][nt] = __builtin_amdgcn_mfma_f32_16x16x32_bf16(af[pt][ks], bv, acc[pt][nt], 0, 0, 0); }
#pragma unroll
                for (int pt = 0; pt < 4; ++pt)
#pragma unroll
                    for (int nt = 0; nt < 4; ++nt)
#pragma unroll
                        for (int rg = 0; rg < 4; ++rg) ST[((size_t)(k * 24 + dh) * 64 + 16 * pt + 4 * q + rg) * 128 + 64 * half + 16 * nt + r] = (bf16)f2bf(acc[pt][nt][rg]);
            }
        }
        LDS_WAIT(); asm volatile("" ::: "memory");
    }
}
__device__ __forceinline__ void ssd_carry(Frame& F) {
    const bf16* ST = (const bf16*)(F.ws + WS_STATES); const float* CHD = (const float*)(F.ws + WS_CHD); bf16* SB = (bf16*)(F.ws + WS_SINB);
    for (int idx = F.vcu * 512 + F.tid; idx < 24 * 64 * 32; idx += F.G * 512) {
        const int dh = idx >> 11, rem = idx & 2047, d = dh / 12; const size_t eo = (size_t)(rem >> 5) * 128 + (rem & 31) * 4;
        f32x4 S = {0.f, 0.f, 0.f, 0.f};
        for (int j = 0; j < MR / 64; j += CARRY_UNR) {
            f32x4 st[CARRY_UNR]; float dc[CARRY_UNR]; size_t off[CARRY_UNR];
#pragma unroll
            for (int i = 0; i < CARRY_UNR; ++i) { const int k = ssd_chunk_of(d, j + i); off[i] = (size_t)(k * 24 + dh) * 8192 + eo; const v2u sw = *(const GAS v2u*)(ST + off[i]); st[i] = (f32x4){bflo(sw.x), bfhi(sw.x), bflo(sw.y), bfhi(sw.y)}; dc[i] = CHD[k * 24 + dh]; }
#pragma unroll
            for (int i = 0; i < CARRY_UNR; ++i) { v2u w; w.x = pk2(S.x, S.y); w.y = pk2(S.z, S.w); *(GAS v2u*)(SB + off[i]) = w; S = S * dc[i] + st[i]; }
        }
    }
}
__device__ __forceinline__ void ssd_outputs(Frame& F, KArgs a, int l) {
    const int gw = F.vcu * NWAVES + F.wave, NGW = F.G * NWAVES, lane = F.lane, r = lane & 15, q = lane >> 4;
    LAS bf16* Mb = (LAS bf16*)(F.lds + RING_OFF + F.wave * 10240);
    LAS float* cumb = (LAS float*)(F.lds + RING_OFF + F.wave * 10240 + 8192);
    const float* DT = (const float*)(F.ws + WS_DT); const bf16* XT = (const bf16*)(F.ws + WS_XT); const bf16* BN = (const bf16*)(F.ws + WS_BN); const bf16* CN = (const bf16*)(F.ws + WS_CN);
    const bf16* SB = (const bf16*)(F.ws + WS_SINB); bf16* YS = (bf16*)(F.ws + WS_YS); const float* alog = AIN(I_ALOG) + l * 24;
    for (int base = 0, rnd = 0; base < (MR / 64) * 12; base += NGW, ++rnd) {
        const int item = base + ((rnd & 1) ? NGW - 1 - gw : gw); if (item >= (MR / 64) * 12) continue;
        const int hp = item % 3, i4 = item / 3, k = i4 >> 2, g = (i4 >> 1) & 1, d = i4 & 1, row0 = 64 * k;
        f32x4 G[4][4];
#pragma unroll
        for (int it = 0; it < 4; ++it)
#pragma unroll
            for (int st = 0; st < 4; ++st) G[it][st] = (f32x4){0.f, 0.f, 0.f, 0.f};
#pragma unroll 1
        for (int ks = 0; ks < 4; ++ks) { bf16x8 cf[4], bfr[4];
#pragma unroll
            for (int i = 0; i < 4; ++i) { cf[i] = ldg8(CN + (size_t)(row0 + 16 * i + r) * 256 + g * 128 + 32 * ks + 8 * q); bfr[i] = ldg8(BN + (size_t)(row0 + 16 * i + r) * 256 + g * 128 + 32 * ks + 8 * q); }
#pragma unroll
            for (int it = 0; it < 4; ++it)
#pragma unroll
                for (int st = 0; st < 4; ++st) G[it][st] = __builtin_amdgcn_mfma_f32_16x16x32_bf16(cf[it], bfr[st], G[it][st], 0, 0, 0); }
        for (int hh = 2 * hp; hh < 2 * hp + 2; ++hh) {
            const int h = g * 6 + hh, dh = d * 12 + h; const float dskip = AIN(I_SSDD)[l * 12 + h];
            { const float dt = DT[(size_t)(row0 + lane) * 24 + dh]; const float A = -__expf(alog[dh]); const float cum = scan64(A * dt, d, lane);
              cumb[lane] = cum; cumb[64 + lane] = __expf(cum); cumb[128 + lane] = dt; }
            LDS_WAIT(); asm volatile("" ::: "memory");
            { float cs[4], ds[4];
#pragma unroll
              for (int st = 0; st < 4; ++st) { cs[st] = cumb[16 * st + r]; ds[st] = cumb[128 + 16 * st + r]; }
#pragma unroll
              for (int it = 0; it < 4; ++it)
#pragma unroll
                  for (int rg = 0; rg < 4; ++rg) { const int i = 16 * it + 4 * q + rg; const float ci = cumb[i];
#pragma unroll
                      for (int st = 0; st < 4; ++st) { const int s = 16 * st + r; const bool on = d ? (s >= i) : (s <= i);
                          float v = on ? G[it][st][rg] * __expf(ci - cs[st]) * ds[st] : 0.f; if (s == i && d == 0) v += dskip; Mb[i * 64 + s] = (bf16)f2bf(v); } } }
            f32x4 acc[4][4];
#pragma unroll
            for (int it = 0; it < 4; ++it)
#pragma unroll
                for (int pt = 0; pt < 4; ++pt) acc[it][pt] = (f32x4){0.f, 0.f, 0.f, 0.f};
#pragma unroll 1
            for (int ks = 0; ks < 4; ++ks) { bf16x8 cf[4], sf[4];
#pragma unroll
                for (int i = 0; i < 4; ++i) { cf[i] = ldg8(CN + (size_t)(row0 + 16 * i + r) * 256 + g * 128 + 32 * ks + 8 * q); sf[i] = ldg8(SB + ((size_t)(k * 24 + dh) * 64 + 16 * i + r) * 128 + 32 * ks + 8 * q); }
#pragma unroll
                for (int it = 0; it < 4; ++it)
#pragma unroll
                    for (int pt = 0; pt < 4; ++pt) acc[it][pt] = __builtin_amdgcn_mfma_f32_16x16x32_bf16(cf[it], sf[pt], acc[it][pt], 0, 0, 0); }
#pragma unroll
            for (int it = 0; it < 4; ++it)
#pragma unroll
                for (int rg = 0; rg < 4; ++rg) { const float e = cumb[64 + 16 * it + 4 * q + rg];
#pragma unroll
                    for (int pt = 0; pt < 4; ++pt) acc[it][pt][rg] *= e; }
            LDS_WAIT(); asm volatile("" ::: "memory");
#pragma unroll 1
            for (int ks = 0; ks < 2; ++ks) { bf16x8 mf[4], xf[4];
#pragma unroll
                for (int i = 0; i < 4; ++i) { mf[i] = *(const LAS bf16x8*)(Mb + (16 * i + r) * 64 + 32 * ks + 8 * q); xf[i] = ldg8(XT + ((size_t)(k * 12 + h) * 64 + 16 * i + r) * 64 + 32 * ks + 8 * q); }
#pragma unroll
                for (int it = 0; it < 4; ++it)
#pragma unroll
                    for (int pt = 0; pt < 4; ++pt) acc[it][pt] = __builtin_amdgcn_mfma_f32_16x16x32_bf16(mf[it], xf[pt], acc[it][pt], 0, 0, 0); }
#pragma unroll
            for (int it = 0; it < 4; ++it)
#pragma unroll
                for (int pt = 0; pt < 4; ++pt)
#pragma unroll
                    for (int rg = 0; rg < 4; ++rg) YS[((size_t)d * MR + row0 + 16 * it + 4 * q + rg) * 768 + h * 64 + 16 * pt + r] = (bf16)f2bf(acc[it][pt][rg]);
            LDS_WAIT(); asm volatile("" ::: "memory");
        }
    }
}
#ifndef SWA_EARLY
#define SWA_EARLY 304
#endif
#ifndef PREPDUP
#define PREPDUP 0
#endif
#ifndef PREP_REV
#define PREP_REV 0
#endif
__device__ __forceinline__ void prep_phase(Frame& F, KArgs a, int l) {
    const bf16* P = (const bf16*)(F.ws + WS_P);
    { const float* cw = AIN(I_CONVW) + (size_t)l * 5 * 1280; const float* cb = AIN(I_CONVB) + (size_t)l * 1280;
      LAS float* cbuf = (LAS float*)(F.lds + RING_OFF + F.wave * 4096);
      for (int rep_ = 0; rep_ <= (PREPDUP & 1); ++rep_)
      for (int it = F.vcu * NWAVES + F.wave; it < (MR / 64) * 160; it += F.G * NWAVES) conv_wave_item(F, cw, cb, it / 160, 8 * (it % 160), cbuf);
      __syncthreads(); }
    { const float* DTR = (const float*)(F.ws + WS_DTRAW); float* DT = (float*)(F.ws + WS_DT); const float* dtb = AIN(I_DTB) + l * 24;
      for (int i = F.vcu * 512 + F.tid; i < MR * 24; i += F.G * 512) { const int m = i / 24, j = i % 24; const float x = DTR[m * 32 + j] + dtb[j];
          DT[i] = fmaxf(x, 0.f) + __logf(1.0f + __expf(-fabsf(x))); } }
    { const int gw = F.vcu * NWAVES + F.wave, NGW = F.G * NWAVES, lane = F.lane, j8 = lane & 7;
      float inv[8];
#pragma unroll
      for (int j = 0; j < 8; ++j) inv[j] = __builtin_amdgcn_exp2f(-(float)(((j8 & 1) * 8 + j)) * (13.287712379549449f / 16.0f));
      bf16* QS = (bf16*)(F.ws + WS_QS); bf16* QG = (bf16*)(F.ws + WS_QG); bf16* KS = (bf16*)(F.ws + WS_KS); bf16* KG = (bf16*)(F.ws + WS_KG);
      const float* gsw = AIN(I_SWAG) + l * 128; const float* ggl = AIN(I_GLBG) + l * 128;
      for (int rep_ = 0; rep_ <= ((PREPDUP >> 1) & 1); ++rep_)
      for (int it = gw; it < MR * 3; it += NGW) {
          const int m = PREP_REV ? (MR - 1 - it / 3) : it / 3, part = it % 3; const bool act = part < 2 || lane < 32; const bool glb = part == 1 || (part == 2 && lane >= 16); const bool isk = part == 2;
          const int hl = isk ? ((lane >> 3) & 1) : (lane >> 3);
          const int col = (glb ? (isk ? PC_GK : PC_GQ) : (isk ? PC_SK : PC_SQ)) + 64 * hl + 8 * j8;
          v4u w = (v4u){0u, 0u, 0u, 0u}; if (act) w = *(const GAS v4u*)(P + (size_t)m * NP + col);
          float x[8] = {bflo(w.x), bfhi(w.x), bflo(w.y), bfhi(w.y), bflo(w.z), bfhi(w.z), bflo(w.w), bfhi(w.w)};
          float ss = 0.f;
#pragma unroll
          for (int j = 0; j < 8; ++j) ss += x[j] * x[j];
          ss += bperm(ss, lane ^ 1); ss += bperm(ss, lane ^ 2); ss += bperm(ss, lane ^ 4);
          const float rs = 1.0f / sqrtf(ss * (1.0f / 64.0f) + 1e-6f);
          const float* gp = (glb ? ggl : gsw) + (isk ? 64 : 0) + 8 * j8; const f32x4 g0 = *(const f32x4*)gp, g1 = *(const f32x4*)(gp + 4);
          const float gg[8] = {g0.x, g0.y, g0.z, g0.w, g1.x, g1.y, g1.z, g1.w};
#pragma unroll
          for (int j = 0; j < 8; ++j) x[j] = x[j] * rs * gg[j];
          if (m < SEQ) { const float pos = ((j8 & 3) < 2) ? (float)(m >> 6) : (float)(m & 63); const bool lo = j8 < 4;
#pragma unroll
              for (int j = 0; j < 8; ++j) { float sn, cs; sincos_hw(pos * inv[j], sn, cs); const float other = bperm(x[j], lane ^ 4); x[j] = lo ? (x[j] * cs - other * sn) : (other * sn + x[j] * cs); } }
          if (!isk) {
#pragma unroll
              for (int j = 0; j < 8; ++j) x[j] *= QSCALE; }
          v4u o; o.x = pk2(x[0], x[1]); o.y = pk2(x[2], x[3]); o.z = pk2(x[4], x[5]); o.w = pk2(x[6], x[7]);
          bf16* dst = isk ? ((glb ? KG : KS) + (size_t)m * 128 + 64 * hl + 8 * j8) : ((glb ? QG : QS) + (size_t)m * 512 + 64 * hl + 8 * j8);
          if (act) *(GAS v4u*)dst = o;
      } }
}
__device__ __forceinline__ void attn_all(Frame& F, KArgs a, int l) {
    typedef attn_body::bf16 ab;
    char* shm = (char*)(unsigned char*)(F.lds + RING_OFF);
#ifndef NO_MODE0
    for (int u = F.vcu; u < 528; u += F.G) {
        unsigned long long w_ = (unsigned long long)F.ws; asm volatile("" : "+s"(w_)); unsigned char* ws = (unsigned char*)(GAS unsigned char*)w_;
        if (u < 512) { const int kvh = u >> 8, g = (u >> 6) & 3, qb = u & 63, head = kvh * 4 + g; const size_t qo = (size_t)(qb * 256) * 512 + head * 64, oo = (size_t)(qb * 256) * YPITCH + YC_D + head * 64;
            attn_body::attn_unit<8, 0>((const ab*)(ws + WS_QG) + qo, (const ab*)(ws + WS_KG) + kvh * 64, (const ab*)(ws + WS_P) + PC_GV + kvh * 64, (ab*)(ws + WS_YALL) + oo, MR / 64, 0, 0, 0, 0, 0.f, false, shm); }
        else { const int ty = (u - 512) >> 3, head = (u - 512) & 7, kvh = head >> 2; const size_t qo = (size_t)SEQ * 512 + head * 64, oo = (size_t)SEQ * YPITCH + (ty ? YC_C : YC_D) + head * 64;
            const float s2 = ty ? (AIN(I_SINK) + l * 8)[head] * LOG2E : 0.f;
            attn_body::attn_unit<8, 0>((const ab*)(ws + (ty ? WS_QS : WS_QG)) + qo, (const ab*)(ws + (ty ? WS_KS : WS_KG)) + (size_t)SEQ * 128 + kvh * 64, (const ab*)(ws + WS_P) + (ty ? PC_SV : PC_GV) + (size_t)SEQ * NP + kvh * 64,
                                       (ab*)(ws + WS_YALL) + oo, 4, 0, 0, 0, 0, s2, ty != 0, shm); }
    }
#endif
}
__device__ __forceinline__ void attn_swa(Frame& F, KArgs a, int l, int ubeg, int uend, int bfirst, int nb) {
    typedef attn_body::bf16 ab;
    char* shm = (char*)(unsigned char*)(F.lds + RING_OFF);
    if (F.vcu < bfirst || F.vcu >= bfirst + nb) return;
    for (int u = ubeg + F.vcu - bfirst; u < uend; u += nb) {
        unsigned long long w_ = (unsigned long long)F.ws; asm volatile("" : "+s"(w_)); unsigned char* ws = (unsigned char*)(GAS unsigned char*)w_;
        const int head = u >> 6, qb = u & 63, kvh = head >> 2, q0 = qb * 256; const int wlo = q0 - 128 < 0 ? 0 : q0 - 128, whi = q0 + 384 > SEQ ? SEQ : q0 + 384; const size_t qo = (size_t)q0 * 512 + head * 64, oo = (size_t)q0 * YPITCH + YC_C + head * 64;
        attn_body::attn_unit<8, 1>((const ab*)(ws + WS_QS) + qo, (const ab*)(ws + WS_KS) + kvh * 64, (const ab*)(ws + WS_P) + PC_SV + kvh * 64, (ab*)(ws + WS_YALL) + oo, 4 + (whi - wlo) / 64, 4, SEQ, wlo, q0, (AIN(I_SINK) + l * 8)[head] * LOG2E, true, shm);
    }
}
#ifndef MIXDUP
#define MIXDUP 0
#endif
__device__ __forceinline__ void mixers_phase(Frame& F0, KArgs a, int l) {
    for (int rep_ = 0; rep_ <= ((MIXDUP >> 0) & 1); ++rep_) { Frame F = fresh(F0); attn_all(F, a, l); __syncthreads(); }
    { Frame F = fresh(F0); attn_swa(F, a, l, SWA_EARLY, 512, 0, F.G); __syncthreads(); }
#if 0
    for (int rep_ = 0; rep_ <= ((MIXDUP >> 1) & 1); ++rep_) { Frame F = fresh(F0); for (int it = F.vcu; it < 256; it += F.G) attn_simple_item(F, a, l, 1, it >> 7, it & 127); __syncthreads(); }
#endif
    for (int rep_ = 0; rep_ <= ((MIXDUP >> 2) & 1); ++rep_) { Frame F = fresh(F0); s5_pass<true>(F, a, l); __syncthreads(); }
    for (int rep_ = 0; rep_ <= ((MIXDUP >> 3) & 1); ++rep_) { Frame F = fresh(F0); ssd_outputs(F, a, l); __syncthreads(); }
}
__device__ __forceinline__ void post_phase(Frame& F, KArgs a, int l) {
    const int gw = F.vcu * NWAVES + F.wave, NGW = F.G * NWAVES;
    const bf16* P = (const bf16*)(F.ws + WS_P); const bf16* YS = (const bf16*)(F.ws + WS_YS);
    bf16* YA = (bf16*)(F.ws + WS_YALL); const float* ng = AIN(I_SSDNG) + l * 768;
    for (int m = gw; m < MR; m += NGW) {
        float y[12]; float ss = 0.f;
#pragma unroll
        for (int j = 0; j < 3; ++j) { const int c = 4 * F.lane + 256 * j;
            const v2u yfw = *(const GAS v2u*)(YS + (size_t)m * 768 + c), ybw = *(const GAS v2u*)(YS + (size_t)(MR + m) * 768 + c); const f32x4 yf = {bflo(yfw.x), bfhi(yfw.x), bflo(yfw.y), bfhi(yfw.y)}, yb = {bflo(ybw.x), bfhi(ybw.x), bflo(ybw.y), bfhi(ybw.y)};
            const v2u zw = *(const GAS v2u*)(P + (size_t)m * NP + PC_Z + c);
            const float z[4] = {bflo(zw.x), bfhi(zw.x), bflo(zw.y), bfhi(zw.y)};
#pragma unroll
            for (int i = 0; i < 4; ++i) { const float t = (yf[i] + yb[i]) * silu_(z[i]); y[4 * j + i] = t; ss += t * t; } }
        const float rstd = 1.0f / sqrtf(wave_sum(ss, F.lane) * (1.0f / 768.0f) + 1e-6f);
#pragma unroll
        for (int j = 0; j < 3; ++j) { const int c = 4 * F.lane + 256 * j; const f32x4 gg = *(const f32x4*)(ng + c);
            v2u w; w.x = pk2(y[4 * j] * rstd * gg.x, y[4 * j + 1] * rstd * gg.y); w.y = pk2(y[4 * j + 2] * rstd * gg.z, y[4 * j + 3] * rstd * gg.w);
            *(GAS v2u*)(YA + (size_t)m * YPITCH + c) = w; }
    }
    const bf16* YBF = (const bf16*)(F.ws + WS_YBF); bf16* YBP = (bf16*)(F.ws + WS_YBP); const float* d5 = AIN(I_S5D) + l * 512;
    for (int i = F.vcu * 512 + F.tid; i < MR * 128; i += F.G * 512) {
        const int m = i >> 7, c = (i & 127) * 4;
        const v2u y0w = *(const GAS v2u*)(YBF + (size_t)m * 512 + c), y1w = *(const GAS v2u*)(YBF + (size_t)(MR + m) * 512 + c); const f32x4 y0 = {bflo(y0w.x), bfhi(y0w.x), bflo(y0w.y), bfhi(y0w.y)}, y1 = {bflo(y1w.x), bfhi(y1w.x), bflo(y1w.y), bfhi(y1w.y)}, dd = *(const f32x4*)(d5 + c);
        const v2u uw = *(const GAS v2u*)(P + (size_t)m * NP + PC_U + c); const float u[4] = {bflo(uw.x), bfhi(uw.x), bflo(uw.y), bfhi(uw.y)}; float r[4];
#pragma unroll
        for (int q = 0; q < 4; ++q) { const float x = y0[q] + y1[q] + dd[q] * u[q]; const float t = 0.7978845608028654f * (x + 0.044715f * x * x * x);
            const float th = 1.0f - 2.0f * __builtin_amdgcn_rcpf(1.0f + __builtin_amdgcn_exp2f(2.0f * LOG2E * t));
            r[q] = 0.5f * x * (1.0f + th); }
        v2u w; w.x = pk2(r[0], r[1]); w.y = pk2(r[2], r[3]); *(GAS v2u*)(YBP + (size_t)m * 512 + c) = w;
    }
}
#ifndef MK_PER_PHASE
#define MK_PER_PHASE 0
#endif
#ifndef REV_RES
#define REV_RES 1
#endif
#ifndef WGM_FFI
#define WGM_FFI 2
#endif
#ifndef WGM_WIN
#define WGM_WIN 2
#endif
#ifndef WGM_RES
#define WGM_RES 2
#endif
#ifndef WGM_MRG
#define WGM_MRG 2
#endif
constexpr int PH_PER_LAYER = 16, NPHASE = 2 + DEPTH * PH_PER_LAYER;
#ifndef GPA
#define GPA true
#endif
#ifndef GPS
#define GPS true
#endif
#ifndef GPAR
#define GPAR true
#endif
constexpr bool GP_ALIGN = GPA, GP_SP2 = GPS, GP_ALIGN_RESID = GPAR;
__global__ void __launch_bounds__(NWAVES * 64, 2) trunk_fwd(Args args) {
    extern __shared__ __attribute__((aligned(16))) unsigned char lds[];
    KArgs KA = (KArgs)__builtin_amdgcn_kernarg_segment_ptr();
    Frame F;
    F.lds = (LAS unsigned char*)lds;
    F.MISC = (volatile LAS unsigned*)(F.lds + MISC_OFF);
    F.tid = threadIdx.x; F.lane = F.tid & 63; F.wave = __builtin_amdgcn_readfirstlane(F.tid >> 6);
    F.G = gridDim.x; { const int bx = blockIdx.x; F.vcu = (F.G % 8 == 0) ? (bx % 8) * (F.G / 8) + bx / 8 : bx; }
    F.ws = (unsigned char*)(GAS unsigned char*)args.ws; F.ctl = (gu32*)(args.ws + WS_CTL);
    for (int u = F.tid; u < (LDS_BYTES - LDSCTL_OFF) / 4; u += NWAVES * 64) ((LAS unsigned*)(F.lds + LDSCTL_OFF))[u] = 0u;
    __syncthreads();
    XcdBarrier bar; bar.bar = (unsigned*)(F.ctl + CW_BAR); bar.x = 0; bar.st = nullptr;
    if (!MK_PER_PHASE) bar = xcd_barrier_post((unsigned*)(F.ctl + CW_BAR), F.MISC + 8);
    const int lo = args.ph_lo, hi = args.ph_hi;
#ifndef ONLY
#define ONLY -1
#endif
#define KON(i) (ONLY < 0 || ONLY == (i))
#ifndef MERGE_SEG
#define MERGE_SEG 1
#endif
#ifndef MERGE_SEG_LAST
#define MERGE_SEG_LAST 0
#endif
#ifndef DUPMASK
#define DUPMASK 0ull
#endif
#define DUPK(i) ((int)(((unsigned long long)(DUPMASK) >> (i)) & 1ull))
#define IN(k) (lo <= (k) && (k) < hi)
#define GEMM_PTRS() FRESH(); unsigned char* ws = Fp.ws; float* X = (float*)(ws + WS_X); bf16* H = (bf16*)(ws + WS_H); bf16* HID = (bf16*)(ws + WS_HID); bf16* P = (bf16*)(ws + WS_P); const bf16* WL = (const bf16*)(ws + WS_W) + (size_t)lp * WL_SIZE; \
    const float* modl = (const float*)(ws + WS_MOD) + (size_t)(lp * 2 + 0) * NMODV; const float* modc = (const float*)(ws + WS_MOD) + (size_t)(lp * 2 + 1) * NMODV; (void)X; (void)H; (void)HID; (void)P; (void)WL; (void)modl; (void)modc;
#define FRESH() Frame Fp = fresh(F); int lp = l; asm volatile("" : "+s"(lp));
#define SEAM(k) do { if (!MK_PER_PHASE && (k) + 1 < hi) xcd_barrier(bar); } while (0)
    PG8_LAS unsigned char* ring = (PG8_LAS unsigned char*)(F.lds + RING_OFF);

    if (KON(100) && IN(0)) { for (int rep_ = 0; rep_ <= DUPK(40); ++rep_) { if (rep_) xcd_barrier(bar); p0_prologue(F, KA); } SEAM(0); }
    if (KON(101) && IN(1)) { p1_modfinal(F, KA); SEAM(1); }
    for (int st = 0; st < 2 * DEPTH; ++st) {
        const int l = st >> 1, f = st & 1; const int pb = 2 + PH_PER_LAYER * l;
        if (f) {
            if (KON(3) && IN(pb + 3)) { FRESH(); norm_phase(Fp, KA, lp, 1, DFF / 512); SEAM(pb + 3); }
            if (KON(4) && IN(pb + 4)) { for (int rep_ = 0; rep_ <= DUPK(4); ++rep_) { if (rep_) xcd_barrier(bar); { GEMM_PTRS(); pg8::Gemm g{H, WL + WL_WIN, MR, NP, DM, DM}; pg8::StaticOrder S; S.init(MR, NP, Fp.G, (int)blockIdx.x, WGM_WIN); pg8::EpiWin E{P, NP, PC_GATE / 256, PC_GATE};
                pg8::gemm_phase<pg8::EpiWin, pg8::StaticOrder, GP_ALIGN, GP_SP2>(ring, g, S, E);
                if (HIDE_CONVERT) { convert_idle(Fp, KA, (int)blockIdx.x, (MR / 256) * (NP / 256) % Fp.G, lp, IT_GA + IT_GB, IT_GC + (lp == DEPTH - 1 ? IT_GD : IT_GD / 2)); }    dt_gemm(Fp, lp, (int)blockIdx.x, (MR / 256) * (NP / 256) % Fp.G); } } SEAM(pb + 4); }
            if (KON(5) && IN(pb + 5)) { for (int rep_ = 0; rep_ <= DUPK(5); ++rep_) { if (rep_) xcd_barrier(bar); { FRESH(); prep_phase(Fp, KA, lp); __syncthreads(); for (int r2_ = 0; r2_ <= ((PREPDUP >> 2) & 1); ++r2_) s5_pass<false>(Fp, KA, lp); } } SEAM(pb + 5); }
            if (KON(6) && IN(pb + 6)) { for (int rep_ = 0; rep_ <= DUPK(6); ++rep_) { if (rep_) xcd_barrier(bar); { { FRESH(); ssd_states(Fp, KA, lp); } } } SEAM(pb + 6); }
            if (KON(7) && IN(pb + 7)) { for (int rep_ = 0; rep_ <= DUPK(7); ++rep_) { if (rep_) xcd_barrier(bar); { { FRESH(); s5_carry(Fp, KA, lp, 96 * NWAVES); } { FRESH(); ssd_carry(Fp); } if (SWA_EARLY > 0) { FRESH(); attn_swa(Fp, KA, lp, 0, SWA_EARLY, 104, Fp.G - 104); } } } SEAM(pb + 7); }
            if (KON(8) && IN(pb + 8)) { for (int rep_ = 0; rep_ <= DUPK(8); ++rep_) { if (rep_) xcd_barrier(bar); { FRESH(); mixers_phase(Fp, KA, lp); } } SEAM(pb + 8); }
            if (KON(9) && IN(pb + 9)) { for (int rep_ = 0; rep_ <= DUPK(9); ++rep_) { if (rep_) xcd_barrier(bar); { FRESH(); post_phase(Fp, KA, lp); } } SEAM(pb + 9); }
            if (KON(10) && IN(pb + 10)) { for (int rep_ = 0; rep_ <= DUPK(10); ++rep_) { if (rep_) xcd_barrier(bar); { GEMM_PTRS(); const int Mq = (lp == DEPTH - 1) ? SEQ : MR; pg8::Gemm g{(const bf16*)(ws + WS_YBP), WL + WL_GLU, Mq, 1024, 512, 512}; pg8::StaticOrder S; S.init(Mq, 1024, Fp.G, (int)blockIdx.x);
                pg8::EpiGated<1> E{(bf16*)(ws + WS_YALL) + YC_B, YPITCH, ((const float*)(const GAS float*)KA->in[I_GLUB]) + (size_t)lp * 1024, 512};
                pg8::gemm_phase<pg8::EpiGated<1>, pg8::StaticOrder, GP_ALIGN, GP_SP2>(ring, g, S, E); } } SEAM(pb + 10); }
            if (KON(11) && IN(pb + 11)) { for (int rep_ = 0; rep_ <= DUPK(11); ++rep_) { if (rep_) xcd_barrier(bar); { GEMM_PTRS(); const int Mq = (MERGE_SEG || lp == DEPTH - 1) ? SEQ : MR;
                if (MERGE_SEG && lp < DEPTH - 1) { pg8::Gemm g2{(const bf16*)(ws + WS_YALL), WL + WL_BRALL, MR, DM, YPITCH, YPITCH}; pg8::SegOrder S2{SEQ / 256, Fp.G, (MERGE_SEG_LAST ? Fp.G - 1 - (int)blockIdx.x : (int)blockIdx.x)}; pg8::EpiMergeSeg E2{P + PC_GATE, NP, (bf16*)(ws + WS_MGC)};
                  pg8::gemm_phase<pg8::EpiMergeSeg, pg8::SegOrder, GP_ALIGN, GP_SP2>(ring, g2, S2, E2); }
                pg8::Gemm g{(const bf16*)(ws + WS_YALL), WL + WL_BRALL, Mq, DM, YPITCH, YPITCH}; pg8::MergeOrder S; S.so.init(Mq, DM, Fp.G, (int)blockIdx.x, WGM_MRG); pg8::EpiMergeR E{P + PC_GATE, NP, (bf16*)(ws + WS_MG)};
                pg8::gemm_phase<pg8::EpiMergeR, pg8::MergeOrder, GP_ALIGN, GP_SP2>(ring, g, S, E);
                if (HIDE_CONVERT && lp < DEPTH - 1) { const int rem = (MR / 256) * (DM / 256) % Fp.G; convert_idle(Fp, KA, (int)blockIdx.x, rem, lp, IT_LAYER - IT_GD / 2, IT_GD / 2); convert_idle(Fp, KA, (int)blockIdx.x, rem, lp + 1, 0, IT_GA / 2); } } } SEAM(pb + 11); }
            if (KON(12) && IN(pb + 12)) { for (int rep_ = 0; rep_ <= DUPK(12); ++rep_) { if (rep_) xcd_barrier(bar); { GEMM_PTRS();
                { pg8::Gemm g{(const bf16*)(ws + WS_MG), WL + WL_OUT, SEQ, DM, DM, DM}; pg8::StaticOrder S; S.init(SEQ, DM, Fp.G, (int)blockIdx.x, WGM_RES, REV_RES); pg8::EpiResid E{X, (rep_ < DUPK(12)) ? (float*)(ws + WS_MGF) : X, X, modl + 5 * DM, modc + 5 * DM, 1.0f, SEQ / 256};
                  pg8::gemm_phase<pg8::EpiResid, pg8::StaticOrder, GP_ALIGN_RESID, GP_SP2>(ring, g, S, E); }
                if (!MERGE_SEG && lp < DEPTH - 1) { pg8::Gemm g{(const bf16*)(ws + WS_MG), WL + WL_OUT, MR, DM, 512, DM}; pg8::SplitKOrder S{SEQ / 256, DM / 256, DM / 512, Fp.G, (int)blockIdx.x}; pg8::EpiPartial E{(float*)(ws + WS_PART), modc + 5 * DM, 1.0f};
                  pg8::gemm_phase<pg8::EpiPartial, pg8::SplitKOrder, GP_ALIGN, GP_SP2>(ring, g, S, E); }
                if (MERGE_SEG && lp < DEPTH - 1) { pg8::Gemm g{(const bf16*)(ws + WS_MGC), WL + WL_OUT, 1024, DM, 512, DM}; pg8::SplitKOrderM S{4, DM / 256, DM / 512, Fp.G, (int)blockIdx.x}; pg8::EpiPartial E{(float*)(ws + WS_PART), modc + 5 * DM, 1.0f};
                  pg8::gemm_phase<pg8::EpiPartial, pg8::SplitKOrderM, GP_ALIGN, GP_SP2>(ring, g, S, E); }
                } } SEAM(pb + 12); }
        }
        const int pf = pb + (f ? 13 : 0); const bool no_ctx = (f == 1 && l == DEPTH - 1);
        if (KON(0) && IN(pf + 0)) { FRESH(); int fp = f; asm volatile("" : "+s"(fp)); norm_phase(Fp, KA, lp, 2 * fp, fp ? (lp < DEPTH - 1 ? (MERGE_SEG ? 16 : DM / 512) : 0) : (lp > 0 ? DFF / 512 : 0)); SEAM(pf + 0); }
        if (KON(1) && IN(pf + 1)) { GEMM_PTRS(); int fp = f; asm volatile("" : "+s"(fp)); const int Mq = no_ctx ? SEQ : MR;
            pg8::Gemm g{H, WL + WL_FFI + (size_t)fp * NFF * DM, Mq, NFF, DM, DM}; pg8::StaticOrder S; S.init(Mq, NFF, Fp.G, (int)blockIdx.x, WGM_FFI); pg8::EpiGated<0> E{HID, DFF, nullptr, 0};
            pg8::gemm_phase<pg8::EpiGated<0>, pg8::StaticOrder, GP_ALIGN, GP_SP2>(ring, g, S, E); SEAM(pf + 1); }
        if (KON(2) && IN(pf + 2)) { GEMM_PTRS(); int fp = f; asm volatile("" : "+s"(fp)); const bf16* Wo = WL + WL_FFO + (size_t)fp * DM * DFF; const int gs = (2 + 6 * fp) * DM;
            { pg8::Gemm g{HID, Wo, SEQ, DM, DFF, DFF}; pg8::StaticOrder S; S.init(SEQ, DM, Fp.G, (int)blockIdx.x, WGM_RES, REV_RES);
              pg8::EpiResid E{X, (fp == 1 && lp == DEPTH - 1) ? (float*)KA->out : X, X, modl + gs, modc + gs, 0.5f, SEQ / 256};
              pg8::gemm_phase<pg8::EpiResid, pg8::StaticOrder, GP_ALIGN_RESID, GP_SP2>(ring, g, S, E); }
            if (!no_ctx) { pg8::Gemm g{HID, Wo, MR, DM, 512, DFF}; pg8::SplitKOrder S{SEQ / 256, DM / 256, DFF / 512, Fp.G, (int)blockIdx.x}; pg8::EpiPartial E{(float*)(ws + WS_PART), modc + gs, 0.5f};
              pg8::gemm_phase<pg8::EpiPartial, pg8::SplitKOrder, GP_ALIGN, GP_SP2>(ring, g, S, E); }
            SEAM(pf + 2); }
    }
#undef IN
#undef SEAM
}

extern "C" void kernel_launch(void* const* d_in, const int* in_sizes, int n_in, void* d_out, int out_size, void* d_ws, size_t ws_size, hipStream_t stream) {
    static int grid = 0;
    if (grid == 0) {
        if (n_in != N_IN || out_size != SEQ * DM || ws_size < WS_END) { fprintf(stderr, "kernel_launch: built for %d inputs, %d outputs, >= %zu bytes of workspace; got n_in %d, out %d, ws %zu; nothing launched\n", N_IN, SEQ * DM, (size_t)WS_END, n_in, out_size, ws_size); grid = -1; return; }
        int dev = 0, cus = 0, per_cu = 0;
        if (hipGetDevice(&dev) != hipSuccess || hipDeviceGetAttribute(&cus, hipDeviceAttributeMultiprocessorCount, dev) != hipSuccess) { fprintf(stderr, "kernel_launch: hipGetDevice / hipDeviceGetAttribute failed\n"); grid = -1; return; }
        if (hipFuncSetAttribute((const void*)trunk_fwd, hipFuncAttributeMaxDynamicSharedMemorySize, LDS_BYTES) != hipSuccess) { fprintf(stderr, "kernel_launch: hipFuncSetAttribute failed\n"); grid = -1; return; }
        if (hipOccupancyMaxActiveBlocksPerMultiprocessor(&per_cu, (const void*)trunk_fwd, NWAVES * 64, LDS_BYTES) != hipSuccess || per_cu < 1)
            fprintf(stderr, "kernel_launch: note: occupancy query reports %d workgroups per CU\n", per_cu);
        (void)hipGetLastError();
        grid = cus;
        if (grid % 8 != 0 || grid < 8) { fprintf(stderr, "kernel_launch: unexpected CU count %d\n", cus); }
    }
    if (grid < 0) return;
    if (hipMemsetAsync((char*)d_ws + WS_CTL, 0, CTL_ZERO_BYTES, stream) != hipSuccess) { fprintf(stderr, "kernel_launch: hipMemsetAsync failed\n"); return; }
    Args a{};
    for (int i = 0; i < N_IN; ++i) a.in[i] = (const float*)d_in[i];
    a.out = (float*)d_out; a.ws = (unsigned char*)d_ws;
#if MK_PER_PHASE
    for (int k = 0; k < NPHASE; ++k) { a.ph_lo = k; a.ph_hi = k + 1; hipLaunchKernelGGL(trunk_fwd, dim3(grid), dim3(NWAVES * 64), LDS_BYTES, stream, a); }
#else
    a.ph_lo = 0; a.ph_hi = NPHASE;
    hipLaunchKernelGGL(trunk_fwd, dim3(grid), dim3(NWAVES * 64), LDS_BYTES, stream, a);
#endif
    const hipError_t le = hipPeekAtLastError();
    if (le != hipSuccess) fprintf(stderr, "kernel_launch: launch failed: %s\n", hipGetErrorName(le));
}
```

```cpp
#include <hip/hip_runtime.h>
#include <cstdio>
#include <cstdint>
#ifndef WGM_SEL
#define WGM_SEL 2
#endif
namespace pg8 {
#define PG8_LAS __attribute__((address_space(3)))
typedef unsigned short bf16_t;
typedef short bf16x8 __attribute__((ext_vector_type(8)));
typedef float f32x4 __attribute__((ext_vector_type(4)));
typedef unsigned u32x4 __attribute__((ext_vector_type(4)));
constexpr int BM = 256, BK = 64, HALF = 128, HTB = HALF * BK * 2  , STAGE_BYTES = 8 * HTB, NXCD = 8, WGM = WGM_SEL;

__host__ __device__ __forceinline__ int lds_byte(int r, int c) { const int st = (r >> 4) * 2 + (c >> 5), rr = r & 15, cc = c & 31, ob = rr * 64 + cc * 2; return st * 1024 + (ob ^ (((ob >> 9) & 1) << 5)); }
__host__ __device__ __forceinline__ void stage_rc(int b, int& R, int& C) { const int st = b / 1024, sb = b % 1024, swz = sb ^ (((sb >> 9) & 1) << 5); R = (st >> 1) * 16 + swz / 64; C = (st & 1) * 32 + (swz % 64) / 2; }
__host__ __device__ __forceinline__ int perm32(int rho) { const int n = rho >> 4, i = rho & 15; return 8 * (i >> 2) + 4 * n + (i & 3); }

struct Unit { int pm, pn, ks, kofs, nt, seg; };
struct Gemm { const bf16_t* A; const bf16_t* Bt; int M, N, K, ld; };

struct StaticOrder {
    int nM, nN, nwg, G, c, wgm, rev;
    __host__ __device__ void init(int M, int N, int G_, int c_, int wgm_ = WGM, int rev_ = 0) { nM = M / BM; nN = N / BM; nwg = nM * nN; G = G_; c = c_; wgm = wgm_; rev = rev_; }
    __host__ __device__ bool next(int i, Unit& u) const {
        const long L = (long)i * G + c; if (L >= nwg) return false;
        int wgid = (int)L; { const int q = nwg / NXCD, r = nwg % NXCD, xcd = wgid % NXCD, off = wgid / NXCD; wgid = (xcd < r ? xcd * (q + 1) : r * (q + 1) + (xcd - r) * q) + off; }
        const int nig = wgm * nN, gid = wgid / nig, fm = gid * wgm, gsz = (nM - fm) < wgm ? (nM - fm) : wgm;
        u.pm = fm + ((wgid % nig) % gsz); if (rev) u.pm = nM - 1 - u.pm; u.pn = (wgid % nig) / gsz; u.ks = 0; u.kofs = 0; u.nt = 0; u.seg = 0; return true;
    }
    __device__ __forceinline__ void a_ready(const Unit&) const {}
    __device__ __forceinline__ void done(const Unit&) const {}
};
struct SplitKOrder {
    int pm, nN, nS, G, c;
    __device__ __forceinline__ bool next(int i, Unit& u) const { const int L = i * G + c; if (L >= nN * nS) return false; u.pm = pm; u.pn = L % nN; u.ks = L / nN; u.kofs = 0; u.nt = 0; u.seg = 0; return true; }
    __device__ __forceinline__ void a_ready(const Unit&) const {}
    __device__ __forceinline__ void done(const Unit&) const {}
};
struct SplitKOrderM {
    int nP, nN, nS, G, c;
    __device__ __forceinline__ bool next(int i, Unit& u) const { const int L = i * G + c; if (L >= nP * nN * nS) return false; u.pn = L % nN; const int t = L / nN; u.ks = t % nS; u.pm = t / nS; u.kofs = 0; u.nt = 0; u.seg = u.pm; return true; }
    __device__ __forceinline__ void a_ready(const Unit&) const {}
    __device__ __forceinline__ void done(const Unit&) const {}
};
struct SegOrder {
    int pm, G, c;
    __device__ __forceinline__ bool next(int i, Unit& u) const { const int L = i * G + c; if (L >= 32) return false; const int s = L >> 3; u.pm = pm; u.pn = L & 7; u.ks = 0; u.seg = s; u.kofs = s ? 256 + 512 * s : 0; u.nt = s ? 8 : 12; return true; }
    __device__ __forceinline__ void a_ready(const Unit&) const {}
    __device__ __forceinline__ void done(const Unit&) const {}
};
struct MergeOrder {
    StaticOrder so;
    __device__ __forceinline__ bool next(int i, Unit& u) const { if (!so.next(i >> 2, u)) return false; const int s = i & 3; u.seg = s; u.kofs = s ? 256 + 512 * s : 0; u.nt = s ? 8 : 12; return true; }
    __device__ __forceinline__ void a_ready(const Unit&) const {}
    __device__ __forceinline__ void done(const Unit&) const {}
};
__device__ __forceinline__ unsigned cvt_pk_bf16(float lo, float hi) { unsigned r; asm volatile("v_cvt_pk_bf16_f32 %0, %1, %2" : "=v"(r) : "v"(lo), "v"(hi)); return r; }
typedef float f32x2 __attribute__((ext_vector_type(2)));
__device__ __forceinline__ float sigm(float x) { return __builtin_amdgcn_rcpf(1.0f + __builtin_amdgcn_exp2f(-1.4426950408889634f * x)); }
__device__ __forceinline__ float silu(float x) { return x * sigm(x); }
__device__ __forceinline__ float bf2f(unsigned short h) { return __uint_as_float(((unsigned)h) << 16); }
typedef unsigned u32x2 __attribute__((ext_vector_type(2)));

struct EpiBf16 {
    static constexpr bool PERM = true, AFTER_DRAIN = false, KEEP_ACC = false;
    bf16_t* O; int ldc;
    __device__ __forceinline__ void operator()(const f32x4 (&acc)[2][2][4][2], const Unit& u, int wr, int wc, int fr, int fq) const {
        const int row0 = u.pm * BM + wr * 64 + fr; const int col0 = u.pn * BM + wc * 32 + 8 * fq;
#pragma unroll
        for (int ai = 0; ai < 2; ++ai)
#pragma unroll
            for (int m = 0; m < 4; ++m) { bf16_t* rowp = O + (size_t)(row0 + ai * HALF + m * 16) * ldc + col0;
#pragma unroll
                for (int bj = 0; bj < 2; ++bj) { const f32x4 v0 = acc[ai][bj][m][0], v1 = acc[ai][bj][m][1];
                    u32x4 w; w.x = cvt_pk_bf16(v0[0], v0[1]); w.y = cvt_pk_bf16(v0[2], v0[3]); w.z = cvt_pk_bf16(v1[0], v1[1]); w.w = cvt_pk_bf16(v1[2], v1[3]);
                    *(u32x4*)(rowp + bj * HALF) = w; } }
    }
};
template <int MODE> struct EpiGated {
    static constexpr bool PERM = true, AFTER_DRAIN = false, KEEP_ACC = false;
    bf16_t* O; int ldo; const float* bias; int half;
    __device__ __forceinline__ void operator()(const f32x4 (&acc)[2][2][4][2], const Unit& u, int wr, int wc, int fr, int fq) const {
        const int row0 = u.pm * BM + wr * 64 + fr; const int col0 = u.pn * HALF + wc * 32 + 8 * fq;
        f32x4 ba[2], bb[2];
#pragma unroll
        for (int n = 0; n < 2; ++n) { if (MODE == 1) { ba[n] = *(const f32x4*)(bias + col0 + 4 * n); bb[n] = *(const f32x4*)(bias + half + col0 + 4 * n); } else { ba[n] = (f32x4){0.f, 0.f, 0.f, 0.f}; bb[n] = ba[n]; } }
#pragma unroll
        for (int ai = 0; ai < 2; ++ai)
#pragma unroll
            for (int m = 0; m < 4; ++m) { bf16_t* rowp = O + (size_t)(row0 + ai * HALF + m * 16) * ldo + col0;
                float r[8];
#pragma unroll
                for (int n = 0; n < 2; ++n)
#pragma unroll
                    for (int i = 0; i < 4; ++i) { const float a = acc[ai][0][m][n][i] + ba[n][i], b = acc[ai][1][m][n][i] + bb[n][i]; r[4 * n + i] = (MODE == 0) ? silu(a) * b : a * sigm(b); }
                u32x4 w; w.x = cvt_pk_bf16(r[0], r[1]); w.y = cvt_pk_bf16(r[2], r[3]); w.z = cvt_pk_bf16(r[4], r[5]); w.w = cvt_pk_bf16(r[6], r[7]);
                *(u32x4*)rowp = w; }
    }
};
struct EpiResid {
    static constexpr bool PERM = false, AFTER_DRAIN = false, KEEP_ACC = false;
    const float* base; float* out_lat; float* out_ctx; const float* gate_lat; const float* gate_ctx; float coef; int ctx_pm;
    __device__ __forceinline__ void operator()(const f32x4 (&acc)[2][2][4][2], const Unit& u, int wr, int wc, int fr, int fq) const {
        const bool isctx = u.pm >= ctx_pm; const float* g = isctx ? gate_ctx : gate_lat; float* o = isctx ? out_ctx : out_lat;
        const int row0 = u.pm * BM + wr * 64 + fr, col0 = u.pn * BM + wc * 32 + 4 * fq;
        f32x4 gv[2][2];
#pragma unroll
        for (int bj = 0; bj < 2; ++bj)
#pragma unroll
            for (int n = 0; n < 2; ++n) gv[bj][n] = *(const f32x4*)(g + col0 + bj * HALF + n * 16) * coef;
#pragma unroll
        for (int ai = 0; ai < 2; ++ai)
#pragma unroll
            for (int mp = 0; mp < 2; ++mp) { f32x4 bv[2][2][2];
#pragma unroll
                for (int mm = 0; mm < 2; ++mm) { const size_t off = (size_t)(row0 + ai * HALF + (2 * mp + mm) * 16) * 2048 + col0;
#pragma unroll
                    for (int bj = 0; bj < 2; ++bj)
#pragma unroll
                        for (int n = 0; n < 2; ++n) bv[mm][bj][n] = *(const f32x4*)(base + off + bj * HALF + n * 16); }
                asm volatile("" ::: "memory");
#pragma unroll
                for (int mm = 0; mm < 2; ++mm) { const size_t off = (size_t)(row0 + ai * HALF + (2 * mp + mm) * 16) * 2048 + col0;
#pragma unroll
                    for (int bj = 0; bj < 2; ++bj)
#pragma unroll
                        for (int n = 0; n < 2; ++n) *(f32x4*)(o + off + bj * HALF + n * 16) = bv[mm][bj][n] + gv[bj][n] * acc[ai][bj][2 * mp + mm][n]; }
                asm volatile("" ::: "memory"); }
    }
};
template <int MODE> struct EpiMerge {
    static constexpr bool PERM = false, AFTER_DRAIN = false, KEEP_ACC = false;
    const bf16_t* G; int ldg; float* F; bf16_t* O;
    __device__ __forceinline__ void operator()(const f32x4 (&acc)[2][2][4][2], const Unit& u, int wr, int wc, int fr, int fq) const {
        const int row0 = u.pm * BM + wr * 64 + fr, col0 = u.pn * BM + wc * 32 + 4 * fq;
#pragma unroll
        for (int ai = 0; ai < 2; ++ai)
#pragma unroll
            for (int m = 0; m < 4; ++m) { const size_t r = (size_t)(row0 + ai * HALF + m * 16);
#pragma unroll
                for (int bj = 0; bj < 2; ++bj)
#pragma unroll
                    for (int n = 0; n < 2; ++n) { const int c = col0 + bj * HALF + n * 16;
                        const u32x2 gw = *(const u32x2*)(G + r * ldg + c);
                        f32x4 t; t[0] = sigm(__uint_as_float(gw.x << 16)); t[1] = sigm(__uint_as_float(gw.x & 0xffff0000u)); t[2] = sigm(__uint_as_float(gw.y << 16)); t[3] = sigm(__uint_as_float(gw.y & 0xffff0000u));
                        t = t * acc[ai][bj][m][n];
                        if (MODE >= 1) t = t + *(const f32x4*)(F + r * 2048 + c);
                        if (MODE <= 1) *(f32x4*)(F + r * 2048 + c) = t;
                        else { u32x2 w; w.x = cvt_pk_bf16(t[0], t[1]); w.y = cvt_pk_bf16(t[2], t[3]); *(u32x2*)(O + r * 2048 + c) = w; } } }
    }
};
struct EpiPartial {
    static constexpr bool PERM = false, AFTER_DRAIN = false, KEEP_ACC = false;
    float* part; const float* gate; float coef;
    __device__ __forceinline__ void operator()(const f32x4 (&acc)[2][2][4][2], const Unit& u, int wr, int wc, int fr, int fq) const {
        const int row0 = (u.ks + 4 * u.seg) * BM + wr * 64 + fr, col0 = u.pn * BM + wc * 32 + 4 * fq;
        f32x4 gv[2][2];
#pragma unroll
        for (int bj = 0; bj < 2; ++bj)
#pragma unroll
            for (int n = 0; n < 2; ++n) gv[bj][n] = *(const f32x4*)(gate + col0 + bj * HALF + n * 16) * coef;
#pragma unroll
        for (int ai = 0; ai < 2; ++ai)
#pragma unroll
            for (int m = 0; m < 4; ++m) { const size_t off = (size_t)(row0 + ai * HALF + m * 16) * 2048 + col0;
#pragma unroll
                for (int bj = 0; bj < 2; ++bj)
#pragma unroll
                    for (int n = 0; n < 2; ++n) *(f32x4*)(part + off + bj * HALF + n * 16) = gv[bj][n] * acc[ai][bj][m][n]; }
    }
};
struct EpiMergeR {
    static constexpr bool PERM = false, AFTER_DRAIN = false, KEEP_ACC = true;
    const bf16_t* G; int ldg; bf16_t* O;
    __device__ __forceinline__ bool zero_after(const Unit& u) const { return u.seg == 3; }
    __device__ __forceinline__ void operator()(f32x4 (&acc)[2][2][4][2], const Unit& u, int wr, int wc, int fr, int fq) const {
        const int row0 = u.pm * BM + wr * 64 + fr, col0 = u.pn * BM + wc * 32 + 4 * fq; const bf16_t* Gs = G + 2048 * u.seg + u.pn * BM + 64 * wc + 16 * fq; const bool fin = u.seg == 3;
#pragma unroll
        for (int ai = 0; ai < 2; ++ai)
#pragma unroll
            for (int m = 0; m < 4; ++m) { const size_t r = (size_t)(row0 + ai * HALF + m * 16);
                const u32x4 w0 = *(const u32x4*)(Gs + r * ldg), w1 = *(const u32x4*)(Gs + r * ldg + 8);
                acc[ai][0][m][0] = acc[ai][0][m][0] * (f32x4){__uint_as_float(w0.x << 16), __uint_as_float(w0.x & 0xffff0000u), __uint_as_float(w0.y << 16), __uint_as_float(w0.y & 0xffff0000u)};
                acc[ai][0][m][1] = acc[ai][0][m][1] * (f32x4){__uint_as_float(w0.z << 16), __uint_as_float(w0.z & 0xffff0000u), __uint_as_float(w0.w << 16), __uint_as_float(w0.w & 0xffff0000u)};
                acc[ai][1][m][0] = acc[ai][1][m][0] * (f32x4){__uint_as_float(w1.x << 16), __uint_as_float(w1.x & 0xffff0000u), __uint_as_float(w1.y << 16), __uint_as_float(w1.y & 0xffff0000u)};
                acc[ai][1][m][1] = acc[ai][1][m][1] * (f32x4){__uint_as_float(w1.z << 16), __uint_as_float(w1.z & 0xffff0000u), __uint_as_float(w1.w << 16), __uint_as_float(w1.w & 0xffff0000u)};
                if (fin) {
#pragma unroll
                    for (int bj = 0; bj < 2; ++bj)
#pragma unroll
                        for (int n = 0; n < 2; ++n) { const f32x4 t = acc[ai][bj][m][n]; u32x2 w; w.x = cvt_pk_bf16(t[0], t[1]); w.y = cvt_pk_bf16(t[2], t[3]); *(u32x2*)(O + r * 2048 + col0 + bj * HALF + n * 16) = w; } } }
    }
};
struct EpiMergeSeg {
    static constexpr bool PERM = false, AFTER_DRAIN = false, KEEP_ACC = false;
    const bf16_t* G; int ldg; bf16_t* O;
    __device__ __forceinline__ void operator()(const f32x4 (&acc)[2][2][4][2], const Unit& u, int wr, int wc, int fr, int fq) const {
        const int rl0 = wr * 64 + fr, col0 = u.pn * BM + wc * 32 + 4 * fq; const bf16_t* Gs = G + u.pn * BM + 64 * wc + 16 * fq;
#pragma unroll
        for (int ai = 0; ai < 2; ++ai)
#pragma unroll
            for (int m = 0; m < 4; ++m) { const int rl = rl0 + ai * HALF + m * 16; const size_t r = (size_t)(u.pm * BM + rl);
                bf16_t* orow = O + (size_t)(u.seg * BM + rl) * 2048 + col0;
#pragma unroll
                for (int bj = 0; bj < 2; ++bj) { f32x4 f0 = {1.f, 1.f, 1.f, 1.f}, f1 = f0;
#pragma unroll 1
                    for (int s = u.seg; s < 4; ++s) { const u32x4 w = *(const u32x4*)(Gs + 2048 * s + r * ldg + 8 * bj);
                        f0 = f0 * (f32x4){__uint_as_float(w.x << 16), __uint_as_float(w.x & 0xffff0000u), __uint_as_float(w.y << 16), __uint_as_float(w.y & 0xffff0000u)};
                        f1 = f1 * (f32x4){__uint_as_float(w.z << 16), __uint_as_float(w.z & 0xffff0000u), __uint_as_float(w.w << 16), __uint_as_float(w.w & 0xffff0000u)}; }
                    { const f32x4 t = acc[ai][bj][m][0] * f0; u32x2 w; w.x = cvt_pk_bf16(t[0], t[1]); w.y = cvt_pk_bf16(t[2], t[3]); *(u32x2*)(orow + bj * HALF) = w; }
                    { const f32x4 t = acc[ai][bj][m][1] * f1; u32x2 w; w.x = cvt_pk_bf16(t[0], t[1]); w.y = cvt_pk_bf16(t[2], t[3]); *(u32x2*)(orow + bj * HALF + 16) = w; } } }
    }
};
struct EpiWin {
    static constexpr bool PERM = true, AFTER_DRAIN = false, KEEP_ACC = false;
    bf16_t* O; int ldc; int gate_pn; int gate0;
    __device__ __forceinline__ void operator()(const f32x4 (&acc)[2][2][4][2], const Unit& u, int wr, int wc, int fr, int fq) const {
        const int row0 = u.pm * BM + wr * 64 + fr;
        if (u.pn < gate_pn) { const int col0 = u.pn * BM + wc * 32 + 8 * fq;
#pragma unroll
            for (int ai = 0; ai < 2; ++ai)
#pragma unroll
                for (int m = 0; m < 4; ++m) { bf16_t* rowp = O + (size_t)(row0 + ai * HALF + m * 16) * ldc + col0;
#pragma unroll
                    for (int bj = 0; bj < 2; ++bj) { const f32x4 v0 = acc[ai][bj][m][0], v1 = acc[ai][bj][m][1];
                        u32x4 w; w.x = cvt_pk_bf16(v0[0], v0[1]); w.y = cvt_pk_bf16(v0[2], v0[3]); w.z = cvt_pk_bf16(v1[0], v1[1]); w.w = cvt_pk_bf16(v1[2], v1[3]);
                        *(u32x4*)(rowp + bj * HALF) = w; } }
        } else {
            const int c = 64 * (u.pn - gate_pn) + 16 * wc + 4 * fq;
            const int sg = (c & ~255) + 64 * ((c >> 5) & 3) + 16 * ((c >> 2) & 3) + 8 * ((c >> 7) & 1) + 4 * ((c >> 4) & 1);
#pragma unroll
            for (int ai = 0; ai < 2; ++ai)
#pragma unroll
                for (int m = 0; m < 4; ++m) { bf16_t* rowp = O + (size_t)(row0 + ai * HALF + m * 16) * ldc + gate0 + sg;
                    f32x4 d[4];
#pragma unroll
                    for (int b = 0; b < 4; ++b)
#pragma unroll
                        for (int i = 0; i < 4; ++i) d[b][i] = 1.0f + __builtin_amdgcn_exp2f(-1.4426950408889634f * __builtin_amdgcn_fmed3f(acc[ai][b >> 1][m][b & 1][i], -30.0f, 30.0f));
#pragma unroll
                    for (int s = 0; s < 4; ++s) { f32x4 rr;
#pragma unroll
                        for (int i = 0; i < 4; ++i) rr[i] = (s < 3 ? d[s < 3 ? s + 1 : 3][i] : 1.0f) * __builtin_amdgcn_rcpf(d[s][i]);
                        u32x2 w; w.x = cvt_pk_bf16(rr[0], rr[1]); w.y = cvt_pk_bf16(rr[2], rr[3]); *(u32x2*)(rowp + 2048 * s) = w; } }
        }
    }
};
#ifndef PG8_AUX_A
#define PG8_AUX_A 0
#endif
#ifndef PG8_AUX_B
#define PG8_AUX_B 0
#endif
template <class Epi, class Sched, bool ALIGN_EPI = false, bool SP2 = false>
__device__ __forceinline__ void gemm_phase(PG8_LAS unsigned char* lds, const Gemm g, const Sched& S, const Epi& E) {
    int tid_ = threadIdx.x; asm volatile("" : "+v"(tid_)); const int tid = tid_, wid = __builtin_amdgcn_readfirstlane(tid >> 6), lane = tid & 63, wr = wid >> 2, wc = wid & 3, fr = lane & 15, fq = lane >> 4;
    const int K = g.ld, nt = g.K / BK;
    unsigned voffA[2], voffB[2];
#pragma unroll
    for (int i = 0; i < 2; ++i) { int R, C; stage_rc(tid * 16 + i * 8192, R, C); const int Rb = Epi::PERM ? ((R & ~31) + perm32(R & 31)) : R;
        voffA[i] = (unsigned)(R * K + C) * 2u; voffB[i] = (unsigned)(Rb * K + C) * 2u; }
    const size_t kstep = (size_t)(BK * 2);
    const size_t hstep = (size_t)HALF * K * 2;
    const size_t tstep = 2 * hstep;
    const unsigned ldsw = (unsigned)wid * 1024u;
    const int aoff = lds_byte(wr * 64 + fr, fq * 8), boff = lds_byte(wc * 32 + fr, fq * 8);
#define PG8_SA(b, h) (((b) * 2 + (h)) * HTB)
#define PG8_SB(b, h) ((4 + (b) * 2 + (h)) * HTB)
#define PG8_STAGE(bufoff, gbase, voff) do { _Pragma("unroll") for (int _i = 0; _i < 2; ++_i) \
        __builtin_amdgcn_global_load_lds((const unsigned*)((const char*)(gbase) + (voff)[_i]), (PG8_LAS unsigned*)(lds + (bufoff) + ldsw + _i * 8192), 16, 0, PG8_AUX_A); } while (0)
#define PG8_STAGEB(bufoff, gbase, voff) do { _Pragma("unroll") for (int _i = 0; _i < 2; ++_i) \
        __builtin_amdgcn_global_load_lds((const unsigned*)((const char*)(gbase) + (voff)[_i]), (PG8_LAS unsigned*)(lds + (bufoff) + ldsw + _i * 8192), 16, 0, PG8_AUX_B); } while (0)
#define PG8_LDA(dst, b, h) do { _Pragma("unroll") for (int m = 0; m < 4; ++m) _Pragma("unroll") for (int k = 0; k < 2; ++k) dst[m][k] = *(const PG8_LAS bf16x8*)(lds + PG8_SA(b, h) + aoff + m * 2048 + k * 1024); } while (0)
#define PG8_LDB(dst, b, h) do { _Pragma("unroll") for (int n = 0; n < 2; ++n) _Pragma("unroll") for (int k = 0; k < 2; ++k) dst[n][k] = *(const PG8_LAS bf16x8*)(lds + PG8_SB(b, h) + boff + n * 2048 + k * 1024); } while (0)
#define PG8_MMA(ai, bj, At, Bt) do { __builtin_amdgcn_s_setprio(1); _Pragma("unroll") for (int m = 0; m < 4; ++m) _Pragma("unroll") for (int n = 0; n < 2; ++n) _Pragma("unroll") for (int k = 0; k < 2; ++k) \
        acc[ai][bj][m][n] = __builtin_amdgcn_mfma_f32_16x16x32_bf16(Bt[n][k], At[m][k], acc[ai][bj][m][n], 0, 0, 0); __builtin_amdgcn_s_setprio(0); } while (0)
#define PG8_WAIT_V(n) asm volatile("s_waitcnt vmcnt(" #n ")" ::: "memory")
#define PG8_WAIT_L(n) asm volatile("s_waitcnt lgkmcnt(" #n ")" ::: "memory")
#define PG8_BAR __builtin_amdgcn_s_barrier()
#define PG8_SCHED __builtin_amdgcn_sched_barrier(0)
    Unit cur, nxt; int ui = 0;
    if (!S.next(0, cur)) return;
    f32x4 acc[2][2][4][2];
#pragma unroll
    for (int a = 0; a < 2; ++a)
#pragma unroll
        for (int b = 0; b < 2; ++b)
#pragma unroll
            for (int m = 0; m < 4; ++m)
#pragma unroll
                for (int n = 0; n < 2; ++n) acc[a][b][m][n] = (f32x4){0.f, 0.f, 0.f, 0.f};
    bf16x8 At[4][2], B0[2][2], B1[2][2];
    const size_t kslice = (size_t)g.K * 2;
    const char* cA = (const char*)g.A + (size_t)cur.pm * tstep + (size_t)cur.ks * kslice + (size_t)cur.kofs * 2; const char* cB = (const char*)g.Bt + (size_t)cur.pn * tstep + (size_t)cur.ks * kslice + (size_t)cur.kofs * 2;
    S.a_ready(cur);
    if constexpr (SP2) {
        PG8_STAGEB(PG8_SB(0, 0), cB, voffB); PG8_STAGEB(PG8_SB(0, 1), cB + hstep, voffB); PG8_STAGE(PG8_SA(0, 0), cA, voffA); PG8_STAGE(PG8_SA(0, 1), cA + hstep, voffA);
        if (wr == 1) PG8_BAR;
        PG8_WAIT_V(2); PG8_BAR;
        PG8_STAGEB(PG8_SB(1, 0), cB + kstep, voffB); PG8_STAGE(PG8_SA(1, 0), cA + kstep, voffA); PG8_STAGEB(PG8_SB(1, 1), cB + hstep + kstep, voffB);
        PG8_WAIT_V(6); PG8_BAR;
    } else {
        PG8_STAGEB(PG8_SB(0, 0), cB, voffB); PG8_STAGE(PG8_SA(0, 0), cA, voffA); PG8_STAGEB(PG8_SB(0, 1), cB + hstep, voffB); PG8_STAGE(PG8_SA(0, 1), cA + hstep, voffA);
        if (wr == 1) PG8_BAR;
        PG8_WAIT_V(4); PG8_BAR;
        PG8_STAGEB(PG8_SB(1, 0), cB + kstep, voffB); PG8_STAGE(PG8_SA(1, 0), cA + kstep, voffA); PG8_STAGEB(PG8_SB(1, 1), cB + hstep + kstep, voffB);
        PG8_WAIT_V(6); PG8_BAR;
    }
    for (;;) {
        const bool has_next = S.next(ui + 1, nxt);
        const char* nA = has_next ? (const char*)g.A + (size_t)nxt.pm * tstep + (size_t)nxt.ks * kslice + (size_t)nxt.kofs * 2 : cA; const char* nB = has_next ? (const char*)g.Bt + (size_t)nxt.pn * tstep + (size_t)nxt.ks * kslice + (size_t)nxt.kofs * 2 : cB;
        const int nt_u = cur.nt ? cur.nt : nt;
        for (int t = 0; t < nt_u; t += 2) {
            const bool last = (t == nt_u - 2);
            const char* a1 = cA + (size_t)(t + 1) * kstep;
            const char* a2 = last ? nA : cA + (size_t)(t + 2) * kstep; const char* b2 = last ? nB : cB + (size_t)(t + 2) * kstep;
            const char* a3 = a2 + kstep; const char* b3 = b2 + kstep;
            if (last && has_next) S.a_ready(nxt);
            if constexpr (SP2) {
            PG8_LDB(B0, 0, 0); PG8_LDB(B1, 0, 1); PG8_SCHED; PG8_LDA(At, 0, 0); PG8_STAGE(PG8_SA(1, 1), a1 + hstep, voffA);
            PG8_WAIT_V(8); PG8_WAIT_L(0); PG8_BAR; PG8_MMA(0, 0, At, B0); PG8_MMA(0, 1, At, B1); PG8_BAR; PG8_SCHED;
            PG8_LDA(At, 0, 1); PG8_STAGEB(PG8_SB(0, 0), b2, voffB); PG8_STAGEB(PG8_SB(0, 1), b2 + hstep, voffB); PG8_STAGE(PG8_SA(0, 0), a2, voffA);
            PG8_WAIT_V(8); PG8_WAIT_L(0); PG8_BAR; PG8_MMA(1, 0, At, B0); PG8_MMA(1, 1, At, B1); PG8_BAR; PG8_SCHED;
            PG8_LDB(B0, 1, 0); PG8_LDB(B1, 1, 1); PG8_SCHED; PG8_LDA(At, 1, 0); PG8_STAGE(PG8_SA(0, 1), a2 + hstep, voffA);
            PG8_WAIT_V(8); PG8_WAIT_L(0); PG8_BAR; PG8_MMA(0, 0, At, B0); PG8_MMA(0, 1, At, B1); PG8_BAR; PG8_SCHED;
            PG8_LDA(At, 1, 1); PG8_STAGEB(PG8_SB(1, 0), b3, voffB); PG8_STAGEB(PG8_SB(1, 1), b3 + hstep, voffB); PG8_STAGE(PG8_SA(1, 0), a3, voffA);
            PG8_WAIT_V(8); PG8_WAIT_L(0); PG8_BAR; PG8_MMA(1, 0, At, B0); PG8_MMA(1, 1, At, B1); PG8_BAR; PG8_SCHED;
            } else {
            PG8_LDB(B0, 0, 0); PG8_SCHED; PG8_LDA(At, 0, 0); PG8_STAGE(PG8_SA(1, 1), a1 + hstep, voffA);
            PG8_WAIT_L(8); PG8_BAR; PG8_WAIT_L(0); PG8_MMA(0, 0, At, B0); PG8_BAR; PG8_SCHED;
            PG8_LDB(B1, 0, 1); PG8_STAGEB(PG8_SB(0, 0), b2, voffB);
            PG8_BAR; PG8_WAIT_L(0); PG8_MMA(0, 1, At, B1); PG8_BAR;
            PG8_LDA(At, 0, 1); PG8_STAGE(PG8_SA(0, 0), a2, voffA);
            PG8_BAR; PG8_WAIT_L(0); PG8_MMA(1, 0, At, B0); PG8_BAR; PG8_SCHED;
            PG8_STAGEB(PG8_SB(0, 1), b2 + hstep, voffB);
            PG8_WAIT_V(6); PG8_BAR; PG8_MMA(1, 1, At, B1); PG8_BAR;
            PG8_LDB(B0, 1, 0); PG8_SCHED; PG8_LDA(At, 1, 0); PG8_STAGE(PG8_SA(0, 1), a2 + hstep, voffA);
            PG8_WAIT_L(8); PG8_BAR; PG8_WAIT_L(0); PG8_MMA(0, 0, At, B0); PG8_BAR; PG8_SCHED;
            PG8_LDB(B1, 1, 1); PG8_STAGEB(PG8_SB(1, 0), b3, voffB);
            PG8_BAR; PG8_WAIT_L(0); PG8_MMA(0, 1, At, B1); PG8_BAR;
            PG8_LDA(At, 1, 1); PG8_STAGE(PG8_SA(1, 0), a3, voffA);
            PG8_BAR; PG8_WAIT_L(0); PG8_MMA(1, 0, At, B0); PG8_BAR; PG8_SCHED;
            PG8_STAGEB(PG8_SB(1, 1), b3 + hstep, voffB);
            PG8_WAIT_V(6); PG8_BAR; PG8_MMA(1, 1, At, B1); PG8_BAR;
            }
        }
        if constexpr (ALIGN_EPI) { if (wr == 0) PG8_BAR; }
        if constexpr (!Epi::AFTER_DRAIN) { E(acc, cur, wr, wc, fr, fq); S.done(cur); }
        if (!has_next) break;
        bool zero_ = true; if constexpr (Epi::KEEP_ACC) zero_ = E.zero_after(cur);
        if (zero_) {
#pragma unroll
        for (int a = 0; a < 2; ++a)
#pragma unroll
            for (int b = 0; b < 2; ++b)
#pragma unroll
                for (int m = 0; m < 4; ++m)
#pragma unroll
                    for (int n = 0; n < 2; ++n) acc[a][b][m][n] = (f32x4){0.f, 0.f, 0.f, 0.f};
        }
        cur = nxt; cA = nA; cB = nB; ++ui;
        if constexpr (ALIGN_EPI) { if (wr == 1) PG8_BAR; }
    }
    PG8_WAIT_V(0);
    if constexpr (!ALIGN_EPI) { if (wr == 0) PG8_BAR; }
    PG8_BAR;
    if constexpr (Epi::AFTER_DRAIN) { E.fused(acc, cur, wr, wc, fr, fq, lds, wid, lane); S.done(cur); }
#undef PG8_SA
#undef PG8_SB
#undef PG8_STAGE
#undef PG8_STAGEB
#undef PG8_LDA
#undef PG8_LDB
#undef PG8_MMA
#undef PG8_WAIT_V
#undef PG8_WAIT_L
#undef PG8_BAR
#undef PG8_SCHED
}
}
#include <hip/hip_bf16.h>
#include <cmath>
#ifndef ATT_NEGM
#define ATT_NEGM 1
#endif
namespace attn_body {
using bf16=__hip_bfloat16;
using bf16x8=__attribute__((ext_vector_type(8)))short;
using s16x4=__attribute__((ext_vector_type(4)))short;
using f32x16=__attribute__((ext_vector_type(16)))float;
using u32x4=__attribute__((ext_vector_type(4)))unsigned;
constexpr int D=64, QP=512, KP=128, VP=12288, OP=2304;
constexpr int NW=8,QBLK=32,QB=QBLK*NW,KVBLK=64;
constexpr int ATTN_UNIT_ROWS=QB;
__device__ __forceinline__ int crow(int r,int hi){return (r&3)+8*(r>>2)+4*hi;}
#define SBAR() __builtin_amdgcn_sched_barrier(0)
__device__ __forceinline__ void swamask(f32x16&p0,f32x16&p1,int dbase){
  const float NEG=-INFINITY;
  #pragma unroll
  for(int r=0;r<16;++r){const int d=dbase+(r&3)+8*(r>>2); if(d>128||d<-128)p0[r]=NEG; if(d+32>128||d+32<-128)p1[r]=NEG;}
}

constexpr int NSLOT=3, SLOTB=8192;
constexpr int LDS_K=0, LDS_V=NSLOT*SLOTB, LDS_WS=2*NSLOT*SLOTB, LDS_OST=LDS_WS+NW*64*4, LDS_BYTES=LDS_OST+NW*4096;
constexpr float C2=0.125f*1.4426950408889634f;
__device__ __forceinline__ void glds16(const void*gsrc,unsigned lds_dst){unsigned keep;
  asm volatile("s_mov_b32 %0, m0\n\ts_mov_b32 m0, %2\n\ts_nop 0\n\tglobal_load_lds_dwordx4 %1, off\n\ts_mov_b32 m0, %0":"=&s"(keep):"v"(gsrc),"s"(lds_dst):"memory");}
__device__ __forceinline__ float max3f(float a,float b,float c){float r;asm("v_max3_f32 %0, %1, %2, %3":"=v"(r):"v"(a),"v"(b),"v"(c));return r;}
__device__ __forceinline__ float max2f(float a,float b){float r;asm("v_max_f32_e32 %0, %1, %2":"=v"(r):"v"(a),"v"(b));return r;}
__device__ __forceinline__ float fadd_s(float a,float b){float r;asm("v_add_f32_e32 %0, %1, %2":"=v"(r):"v"(a),"v"(b));return r;}
__device__ __forceinline__ float fsub_s(float a,float b){float r;asm("v_sub_f32_e32 %0, %1, %2":"=v"(r):"v"(a),"v"(b));return r;}
typedef float f32x2_t __attribute__((ext_vector_type(2))); typedef __bf16 bf16x2_t __attribute__((ext_vector_type(2)));
__device__ __forceinline__ unsigned cvtpk_s(float lo,float hi){f32x2_t v={lo,hi};bf16x2_t b=__builtin_convertvector(v,bf16x2_t);return __builtin_bit_cast(unsigned,b);}
#define WAIT_BAR(N) asm volatile("s_waitcnt vmcnt(" #N ") lgkmcnt(0)\n\ts_barrier":::"memory")

__device__ __forceinline__ void qkt(f32x16&p0,f32x16&p1,const char*Kslot,const bf16x8*qr,const f32x16&negm,int r32,int hi){
  const char*kb=Kslot+hi*1024+r32*16;
  #pragma unroll
  for(int d0=0;d0<4;++d0){
    const bf16x8 b0=*reinterpret_cast<const bf16x8*>(kb+d0*2048);
    const bf16x8 b1=*reinterpret_cast<const bf16x8*>(kb+d0*2048+512);
    if(d0==0){p0=__builtin_amdgcn_mfma_f32_32x32x16_bf16(b0,qr[0],negm,0,0,0);p1=__builtin_amdgcn_mfma_f32_32x32x16_bf16(b1,qr[0],negm,0,0,0);}
    else{p0=__builtin_amdgcn_mfma_f32_32x32x16_bf16(b0,qr[d0],p0,0,0,0);p1=__builtin_amdgcn_mfma_f32_32x32x16_bf16(b1,qr[d0],p1,0,0,0);}}
}
typedef __attribute__((address_space(3))) const char* lds_cptr;
typedef short v4i16_t __attribute__((ext_vector_type(4)));
__device__ __forceinline__ void kload8(bf16x8*kf,lds_cptr kp){
  kf[0]=*(const __attribute__((address_space(3))) bf16x8*)(kp);      kf[1]=*(const __attribute__((address_space(3))) bf16x8*)(kp+512);
  kf[2]=*(const __attribute__((address_space(3))) bf16x8*)(kp+2048); kf[3]=*(const __attribute__((address_space(3))) bf16x8*)(kp+2560);
  kf[4]=*(const __attribute__((address_space(3))) bf16x8*)(kp+4096); kf[5]=*(const __attribute__((address_space(3))) bf16x8*)(kp+4608);
  kf[6]=*(const __attribute__((address_space(3))) bf16x8*)(kp+6144); kf[7]=*(const __attribute__((address_space(3))) bf16x8*)(kp+6656);
}
__device__ __forceinline__ void kload2(bf16x8*kf,lds_cptr kp,int j){ kf[2*j]=*(const __attribute__((address_space(3))) bf16x8*)(kp+j*2048); kf[2*j+1]=*(const __attribute__((address_space(3))) bf16x8*)(kp+j*2048+512); }
__device__ __forceinline__ s16x4 vtr(lds_cptr p){ return __builtin_bit_cast(s16x4,__builtin_amdgcn_ds_read_tr16_b64_v4i16((__attribute__((address_space(3))) v4i16_t*)p)); }
__device__ __forceinline__ float rowmax(const f32x16&p0,const f32x16&p1){
  float a=max3f(p0[0],p0[1],p1[0]),b=max3f(p0[2],p0[3],p1[1]);a=max3f(a,p1[2],p1[3]);
  #pragma unroll
  for(int r=4;r<16;r+=4){a=max3f(a,p0[r],p0[r+1]);b=max3f(b,p0[r+2],p0[r+3]);a=max3f(a,p1[r],p1[r+1]);b=max3f(b,p1[r+2],p1[r+3]);}
  const float m=max2f(a,b);
  auto rr=__builtin_amdgcn_permlane32_swap(__float_as_uint(m),__float_as_uint(m),false,false);
  return max2f(__uint_as_float(rr[0]),__uint_as_float(rr[1]));
}
__device__ __forceinline__ void pv(f32x16*o,int vb,bf16x8 pa0,bf16x8 pa1,bf16x8 pa2,bf16x8 pa3){
  #pragma unroll
  for(int d0=0;d0<2;++d0){s16x4 lo[4],hi[4];
    #pragma unroll
    for(int ks=0;ks<4;++ks){
      asm volatile("ds_read_b64_tr_b16 %0,%1 offset:%c2":"=&v"(lo[ks]):"v"(vb),"i"(d0*4096+ks*1024):"memory");
      asm volatile("ds_read_b64_tr_b16 %0,%1 offset:%c2":"=&v"(hi[ks]):"v"(vb),"i"(d0*4096+ks*1024+512):"memory");}
    asm volatile("s_waitcnt lgkmcnt(0)":::"memory");SBAR();
    #define PK(k) (bf16x8){lo[k][0],lo[k][1],lo[k][2],lo[k][3],hi[k][0],hi[k][1],hi[k][2],hi[k][3]}
    o[d0]=__builtin_amdgcn_mfma_f32_32x32x16_bf16(pa0,PK(0),o[d0],0,0,0);
    o[d0]=__builtin_amdgcn_mfma_f32_32x32x16_bf16(pa1,PK(1),o[d0],0,0,0);
    o[d0]=__builtin_amdgcn_mfma_f32_32x32x16_bf16(pa2,PK(2),o[d0],0,0,0);
    o[d0]=__builtin_amdgcn_mfma_f32_32x32x16_bf16(pa3,PK(3),o[d0],0,0,0);
    #undef PK
  }
}

#ifndef ATTN_STORE16
#define ATTN_STORE16(p,v) (*(u32x4*)(p)=(v))
#endif
template<int THRL,int MODE> __device__ __forceinline__ void attn_unit(const bf16*Qu,const bf16*__restrict__ Kh,const bf16*__restrict__ Vh,bf16*Ou,int NT,int n0,int s0,int s1,int qrow0,float sink2,bool has_sink,char*shm){
  int tid_=threadIdx.x; asm volatile("":"+v"(tid_)); const int tid=tid_,lane=tid&63,r32=lane&31,hi=lane>>5; const int wid=__builtin_amdgcn_readfirstlane(tid>>6);
  const bf16*Qw=Qu+(long)(wid*QBLK)*QP;
  const unsigned lds0=(unsigned)(uintptr_t)shm;
  float*wsf=(float*)(shm+LDS_WS)+wid*64;
  const bf16*ksrc=Kh+(long)lane*KP+wid*8;
  const bf16*vsrc=Vh+(long)(16*(wid&3)+(lane>>2))*VP+(wid>>2)*32+(lane&3)*8;
  #define TROW(t) (MODE==0 ? KVBLK*(t) : ((t)<n0 ? s0+KVBLK*(t) : s1+KVBLK*((t)-n0)))
  const unsigned kdst=lds0+LDS_K+wid*1024, vdst=lds0+LDS_V+wid*1024;
  #define DMA_K(t,slot) glds16(ksrc+(long)TROW(t)*KP,(unsigned)__builtin_amdgcn_readfirstlane(kdst+(slot)))
  #define DMA_V(t,slot) glds16(vsrc+(long)TROW(t)*VP,(unsigned)__builtin_amdgcn_readfirstlane(vdst+(slot)))
  const int vb0=(int)(lds0+LDS_V)+((lane>>4)&1)*32+(lane&3)*8+(4*hi+((lane&15)>>2))*64;
  const char*Kbase=shm+LDS_K; bf16x8 kf[8];
  const lds_cptr shm3=(lds_cptr)shm; const lds_cptr kp0=shm3+LDS_K+hi*1024+r32*16; const lds_cptr vp0=shm3+LDS_V+((lane>>4)&1)*32+(lane&3)*8+(4*hi+((lane&15)>>2))*64;
  DMA_K(0,0);DMA_V(0,0);DMA_K(1,SLOTB);
  bf16x8 qr[4];
  #pragma unroll
  for(int d0=0;d0<4;++d0)qr[d0]=*reinterpret_cast<const bf16x8*>(&Qw[(long)r32*QP+d0*16+hi*8]);
  float mhat=0.f,l_reg=0.f;f32x16 o[2];o[0]=f32x16{};o[1]=f32x16{};f32x16 negm=f32x16{}; if(ATT_NEGM&&MODE==0)asm volatile("":"+v"(negm));
  const int qrow=qrow0+wid*QBLK+r32;
  #define CMASK(P0,P1,t) do{ if(MODE==1 && (t)>=n0) swamask(P0,P1,TROW(t)+4*hi-qrow); }while(0)
  bool resc=false;
  #define START(P0,P1) do{ const float rm=rowmax(P0,P1); resc=false; \
    { const float dl=rm; mhat=fadd_s(mhat,dl); \
      _Pragma("unroll") for(int r=0;r<16;++r){P0[r]=fsub_s(P0[r],dl);P1[r]=fsub_s(P1[r],dl);} \
      if(ATT_NEGM&&MODE==0){ _Pragma("unroll") for(int r=0;r<16;++r)negm[r]=-mhat; asm volatile("":"+v"(negm)); } } \
    _Pragma("unroll") for(int r=0;r<16;++r)P0[r]=__builtin_amdgcn_exp2f(P0[r]); }while(0)
  #define RESC() do{ if(resc){ asm volatile("s_waitcnt lgkmcnt(0)":::"memory"); \
      _Pragma("unroll") for(int d_=0;d_<2;++d_) _Pragma("unroll") for(int r=0;r<16;++r)o[d_][r]*=wsf[crow(r,hi)]; } }while(0)
  f32x16 pA0,pA1,pB0,pB1;
  int sl_prev=0,sl_cur=0,sl_next=SLOTB;
  #define ROT() do{sl_prev=sl_cur;sl_cur=sl_next;sl_next=(sl_next==(NSLOT-1)*SLOTB)?0:sl_next+SLOTB;}while(0)
  DMA_K(2,2*SLOTB);
  WAIT_BAR(3);
  qkt(pA0,pA1,Kbase,qr,negm,r32,hi);asm volatile("s_nop 15\n\ts_nop 7":"+v"(pA0),"+v"(pA1));CMASK(pA0,pA1,0);
  START(pA0,pA1);
  _Pragma("unroll") for(int r=0;r<16;++r)pA1[r]=__builtin_amdgcn_exp2f(pA1[r]);
  WAIT_BAR(0);
  DMA_K(3,0);DMA_V(1,SLOTB);
  ROT();
  kload8(kf,kp0+sl_cur);
  WAIT_BAR(2);
  s16x4 vlo[8],vhi[8]; u32x4 pw0,pw1,pw2,pw3;
  #define PKW(P,B) cvtpk_s(P[B],P[B+1])
  #define PAF(k) __builtin_bit_cast(bf16x8,pw##k)
  #define VFR(i) (bf16x8){vlo[i][0],vlo[i][1],vlo[i][2],vlo[i][3],vhi[i][0],vhi[i][1],vhi[i][2],vhi[i][3]}
  #define PIN(x) asm volatile("":"+v"(x))
  #define MX3(a,b,c) __builtin_fmaxf(__builtin_fmaxf((a),(b)),(c))
  #define GAPA(MF,A0,A1,A2,A3,W0,W1,PW) do{ MF; sacc+=A0; sacc+=A1; sacc+=A2; sacc+=A3; PIN(sacc); W0; W1; PIN(PW); SBAR(); }while(0)
  #define EX(v) __builtin_amdgcn_exp2f(v)
  #define GAPB(MF,X,B) do{ MF; X[B]=EX(X[B]); X[B+1]=EX(X[B+1]); X[B+2]=EX(X[B+2]); X[B+3]=EX(X[B+3]); PIN(X); SBAR(); }while(0)
  #define VRD(i) do{ vlo[i]=vtr(vp_+(((i)>>2)*4096+((i)&3)*1024)); vhi[i]=vtr(vp_+(((i)>>2)*4096+((i)&3)*1024+512)); }while(0)
  #define KRD(G,j) do{ if(G){ kload2(kf,kp0+sl_next,j); SBAR(); } }while(0)
  #define STEP(C0,C1,P0,P1,t,GK,GV,GL) do{ SBAR(); \
    const lds_cptr vp_=vp0+sl_prev; \
    VRD(0); SBAR(); float sacc=(P0[0]+P0[1]); \
    GAPA(C0=__builtin_amdgcn_mfma_f32_32x32x16_bf16(kf[0],qr[0],((ATT_NEGM&&MODE==0)?negm:f32x16{}),0,0,0), P0[2],P0[3],P0[4],P0[5],     pw0[0]=PKW(P0,0), pw0[1]=PKW(P0,2), pw0); \
    VRD(4); SBAR(); GAPA(C1=__builtin_amdgcn_mfma_f32_32x32x16_bf16(kf[1],qr[0],((ATT_NEGM&&MODE==0)?negm:f32x16{}),0,0,0), P0[6],P0[7],P0[8],P0[9],     pw0[2]=PKW(P0,4), pw0[3]=PKW(P0,6), pw0); \
    VRD(1); SBAR(); GAPA(C0=__builtin_amdgcn_mfma_f32_32x32x16_bf16(kf[2],qr[1],C0,0,0,0),   P0[10],P0[11],P0[12],P0[13], pw1[0]=PKW(P0,8), pw1[1]=PKW(P0,10), pw1); \
    VRD(5); SBAR(); GAPA(C1=__builtin_amdgcn_mfma_f32_32x32x16_bf16(kf[3],qr[1],C1,0,0,0),   P0[14],P0[15],P1[0],P1[1],   pw1[2]=PKW(P0,12),pw1[3]=PKW(P0,14), pw1); \
    VRD(2); SBAR(); GAPA(C0=__builtin_amdgcn_mfma_f32_32x32x16_bf16(kf[4],qr[2],C0,0,0,0),   P1[2],P1[3],P1[4],P1[5],     pw2[0]=PKW(P1,0), pw2[1]=PKW(P1,2), pw2); \
    VRD(6); SBAR(); GAPA(C1=__builtin_amdgcn_mfma_f32_32x32x16_bf16(kf[5],qr[2],C1,0,0,0),   P1[6],P1[7],P1[8],P1[9],     pw2[2]=PKW(P1,4), pw2[3]=PKW(P1,6), pw2); \
    VRD(3); SBAR(); GAPA(C0=__builtin_amdgcn_mfma_f32_32x32x16_bf16(kf[6],qr[3],C0,0,0,0),   P1[10],P1[11],P1[12],P1[13], pw3[0]=PKW(P1,8), pw3[1]=PKW(P1,10), pw3); \
    VRD(7); SBAR(); GAPA(C1=__builtin_amdgcn_mfma_f32_32x32x16_bf16(kf[7],qr[3],C1,0,0,0),   P1[14],P1[15],0.f,0.f,       pw3[2]=PKW(P1,12),pw3[3]=PKW(P1,14), pw3); \
    l_reg+=sacc; \
    if(GK){DMA_K((t)+3,sl_cur);} if(GV){DMA_V((t)+1,sl_next);} \
    if(!(ATT_NEGM&&MODE==0)){ _Pragma("unroll") for(int r=0;r<16;++r){C0[r]-=mhat;C1[r]-=mhat;} } \
    CMASK(C0,C1,t); \
    { float a=MX3(C0[0],C0[1],C1[0]),b=MX3(C0[2],C0[3],C1[1]); a=MX3(a,C1[2],C1[3]); \
      _Pragma("unroll") for(int r=4;r<16;r+=4){a=MX3(a,C0[r],C0[r+1]);b=MX3(b,C0[r+2],C0[r+3]);a=MX3(a,C1[r],C1[r+1]);b=MX3(b,C1[r+2],C1[r+3]);} \
      float rm=__builtin_fmaxf(a,b); { auto rr=__builtin_amdgcn_permlane32_swap(__float_as_uint(rm),__float_as_uint(rm),false,false); rm=__builtin_fmaxf(__uint_as_float(rr[0]),__uint_as_float(rr[1])); } \
      resc=false; \
      if(__builtin_expect(__any(rm>(float)THRL),0)){ const float dl=__builtin_fmaxf(rm,0.f); mhat+=dl; \
        _Pragma("unroll") for(int r=0;r<16;++r){C0[r]-=dl;C1[r]-=dl;} \
        if(ATT_NEGM&&MODE==0){ _Pragma("unroll") for(int r=0;r<16;++r)negm[r]=-mhat; asm volatile("":"+v"(negm)); } \
        const float f=__builtin_amdgcn_exp2f(-dl); l_reg*=f; if(hi==0)wsf[r32]=f; resc=true; } } \
    SBAR(); \
    GAPB(o[0]=__builtin_amdgcn_mfma_f32_32x32x16_bf16(PAF(0),VFR(0),o[0],0,0,0), C0,0); \
    GAPB(o[1]=__builtin_amdgcn_mfma_f32_32x32x16_bf16(PAF(0),VFR(4),o[1],0,0,0), C0,4); \
    KRD(GL,0); GAPB(o[0]=__builtin_amdgcn_mfma_f32_32x32x16_bf16(PAF(1),VFR(1),o[0],0,0,0), C0,8); \
    KRD(GL,1); GAPB(o[1]=__builtin_amdgcn_mfma_f32_32x32x16_bf16(PAF(1),VFR(5),o[1],0,0,0), C0,12); \
    KRD(GL,2); GAPB(o[0]=__builtin_amdgcn_mfma_f32_32x32x16_bf16(PAF(2),VFR(2),o[0],0,0,0), C1,0); \
    KRD(GL,3); GAPB(o[1]=__builtin_amdgcn_mfma_f32_32x32x16_bf16(PAF(2),VFR(6),o[1],0,0,0), C1,4); \
    GAPB(o[0]=__builtin_amdgcn_mfma_f32_32x32x16_bf16(PAF(3),VFR(3),o[0],0,0,0), C1,8); \
    GAPB(o[1]=__builtin_amdgcn_mfma_f32_32x32x16_bf16(PAF(3),VFR(7),o[1],0,0,0), C1,12); \
    }while(0)
  int t=1;
  for(;t+5<NT;t+=2){
    STEP(pB0,pB1,pA0,pA1,t,true,true,true);     WAIT_BAR(2); RESC(); ROT();
    STEP(pA0,pA1,pB0,pB1,t+1,true,true,true);   WAIT_BAR(2); RESC(); ROT();
  }
  #define ENDW(tt) do{ if((tt)+3<NT){WAIT_BAR(2);} else if((tt)+2<NT){WAIT_BAR(1);} else {WAIT_BAR(0);} }while(0)
  for(;t+1<NT;t+=2){
    STEP(pB0,pB1,pA0,pA1,t,(t+3<NT),(t+1<NT),(t+1<NT));       ENDW(t);   RESC(); ROT();
    STEP(pA0,pA1,pB0,pB1,t+1,(t+4<NT),(t+2<NT),(t+2<NT));     ENDW(t+1); RESC(); ROT();
  }
  STEP(pB0,pB1,pA0,pA1,NT-1,false,false,false); RESC();
  { float sacc=pB0[0]+pB0[1]; _Pragma("unroll") for(int r=2;r<16;++r)sacc+=pB0[r]; _Pragma("unroll") for(int r=0;r<16;++r)sacc+=pB1[r]; l_reg+=sacc;
    pw0=(u32x4){PKW(pB0,0),PKW(pB0,2),PKW(pB0,4),PKW(pB0,6)};pw1=(u32x4){PKW(pB0,8),PKW(pB0,10),PKW(pB0,12),PKW(pB0,14)};pw2=(u32x4){PKW(pB1,0),PKW(pB1,2),PKW(pB1,4),PKW(pB1,6)};pw3=(u32x4){PKW(pB1,8),PKW(pB1,10),PKW(pB1,12),PKW(pB1,14)};
    SBAR(); pv(o,vb0+sl_cur,PAF(0),PAF(1),PAF(2),PAF(3)); }
  #undef PKW
  #undef PAF
  #undef VFR
  #undef PIN
  #undef MX3
  #undef GAPA
  #undef GAPB
  #undef EX
  #undef VRD
  #undef KRD
  #undef STEP
  #undef ENDW
  {auto rr=__builtin_amdgcn_permlane32_swap(__float_as_uint(l_reg),__float_as_uint(l_reg),false,false);l_reg=__uint_as_float(rr[0])+__uint_as_float(rr[1]);}
  if(has_sink)l_reg+=__builtin_amdgcn_exp2f(sink2-mhat);
  if(hi==0)wsf[32+r32]=l_reg;asm volatile("s_waitcnt lgkmcnt(0)":::"memory");
  float rli[16];
  #pragma unroll
  for(int r=0;r<16;++r)rli[r]=__builtin_amdgcn_rcpf(wsf[32+crow(r,hi)]);
  bf16*Ow=Ou+(long)(wid*QBLK)*OP;
  { bf16*stg=(bf16*)(shm+LDS_OST)+wid*2048;
    #pragma unroll
    for(int r=0;r<16;++r){const int orow=crow(r,hi);
      #pragma unroll
      for(int d0=0;d0<2;++d0)stg[orow*64+d0*32+r32]=__float2bfloat16(o[d0][r]*rli[r]);}
    asm volatile("s_waitcnt lgkmcnt(0)":::"memory");
    #pragma unroll
    for(int i=0;i<4;++i){const int row=i*8+(lane>>3),ch=lane&7; const u32x4 v=*(const u32x4*)(stg+row*64+ch*8); ATTN_STORE16(Ow+(long)row*OP+ch*8,v);} }
  asm volatile("s_waitcnt lgkmcnt(0)\n\ts_barrier":::"memory");
  #undef TROW
  #undef DMA_K
  #undef DMA_V
  #undef CMASK
  #undef START
  #undef RESC
  #undef ROT
}
constexpr int ATTN_LDS_BYTES=LDS_BYTES;
#undef SBAR
#undef WAIT_BAR
}
constexpr int DM = 2048, SEQ = 16384, CTXN = 256, MR = SEQ + CTXN, DEPTH = 4;
constexpr int DFF = 5632, NFF = 2 * DFF, DIN = 12312, NP = 12288;
constexpr int PC_Z = 0, PC_XBC = 768, PC_U = 2048, PC_SQ = 2560, PC_SK = 3072, PC_SV = 3200, PC_GQ = 3328, PC_GK = 3840, PC_GV = 3968, PC_GATE = 4096;
constexpr int NMODV = 9 * DM;
constexpr float LOG2E = 1.4426950408889634f;
constexpr float QSCALE = 0.125f * LOG2E;
constexpr int NWAVES = 8;
enum { I_X = 0, I_C, I_CTX, I_CCTX, I_WMOD, I_BMOD, I_NORMG, I_FFIN, I_FFOUT, I_WIN, I_CONVW, I_CONVB, I_ALOG, I_DTB, I_SSDD, I_SSDNG, I_S5ARE, I_S5AIM, I_S5LDT, I_S5BRE, I_S5BIM,
       I_S5CRE, I_S5CIM, I_S5D, I_GLUW, I_GLUB, I_SWAG, I_SINK, I_GLBG, I_BRSSD, I_BRS5, I_BRSWA, I_BRGLB, I_WOUT, N_IN };

constexpr size_t al256(size_t x) { return (x + 255) & ~(size_t)255; }
constexpr size_t WS_CTL = 0, CTL_ZERO_BYTES = 64u << 10;
constexpr size_t WS_MODP = CTL_ZERO_BYTES;
constexpr size_t WS_MOD = WS_MODP + al256((size_t)DEPTH * 32 * 2 * NMODV * 4);
constexpr size_t WS_X = WS_MOD + al256((size_t)DEPTH * 2 * NMODV * 4);
constexpr size_t WS_H = WS_X + al256((size_t)MR * DM * 4);
constexpr size_t WS_HID = WS_H + al256((size_t)MR * DM * 2);
constexpr size_t WS_P = WS_HID + al256((size_t)MR * DFF * 2);
constexpr size_t WS_DTRAW = WS_P + al256((size_t)MR * NP * 2);
constexpr size_t WS_DT = WS_DTRAW + al256((size_t)MR * 32 * 4);
constexpr size_t WS_XBC = WS_DT + al256((size_t)MR * 24 * 4);
constexpr size_t WS_QS = WS_XBC + al256((size_t)MR * 1280 * 4);
constexpr size_t WS_QG = WS_QS + al256((size_t)MR * 512 * 2);
constexpr size_t WS_KS = WS_QG + al256((size_t)MR * 512 * 2);
constexpr size_t WS_KG = WS_KS + al256((size_t)MR * 128 * 2);
constexpr size_t WS_YS = WS_KG + al256((size_t)MR * 128 * 2);
constexpr size_t WS_YBF = WS_YS + al256((size_t)2 * MR * 768 * 4);
constexpr size_t WS_S5END = WS_YBF + al256((size_t)2 * MR * 512 * 4);
constexpr size_t WS_S5IN = WS_S5END + al256((size_t)64 * 260 * 128 * 4);
constexpr size_t WS_XSN = WS_S5IN + al256((size_t)64 * 260 * 128 * 4);
constexpr size_t WS_XT = WS_XSN + al256((size_t)MR * 768 * 2);
constexpr size_t WS_BN = WS_XT + al256((size_t)MR * 768 * 2);
constexpr size_t WS_CN = WS_BN + al256((size_t)MR * 256 * 2);
constexpr size_t WS_BT = WS_CN + al256((size_t)MR * 256 * 2);
constexpr size_t WS_STATES = WS_BT + al256((size_t)MR * 256 * 2);
constexpr size_t WS_SINB = WS_STATES + al256((size_t)260 * 24 * 8192 * 4);
constexpr size_t WS_CHD = WS_SINB + al256((size_t)260 * 24 * 8192 * 2);
constexpr size_t WS_YALL = WS_CHD + al256((size_t)260 * 24 * 4);
constexpr int YPITCH = 2304, YC_B = 768, YC_C = 1280, YC_D = 1792;
constexpr size_t WS_YBP = WS_YALL + al256((size_t)MR * YPITCH * 2);
constexpr size_t WS_MGF = WS_YBP + al256((size_t)MR * 512 * 2);
constexpr size_t WS_MG = WS_MGF + al256((size_t)MR * DM * 4);
constexpr size_t WS_W = WS_MG + al256((size_t)MR * DM * 2);
constexpr size_t WL_FFI = 0;
constexpr size_t WL_FFO = WL_FFI + (size_t)2 * NFF * DM;
constexpr size_t WL_WIN = WL_FFO + (size_t)2 * DM * DFF;
constexpr size_t WL_WDT = WL_WIN + (size_t)NP * DM;
constexpr size_t WL_GLU = WL_WDT + (size_t)32 * DM;
constexpr size_t WL_BRALL = WL_GLU + (size_t)1024 * 512;
constexpr size_t WL_OUT = WL_BRALL + (size_t)DM * YPITCH;
constexpr size_t WL_SIZE = WL_OUT + (size_t)DM * DM;
constexpr size_t WS_PART = WS_W + al256((size_t)DEPTH * WL_SIZE * 2);
constexpr size_t WS_MGC = WS_PART + al256((size_t)16 * 256 * DM * 4);
constexpr size_t WS_END = WS_MGC + al256((size_t)4 * 256 * DM * 2);
constexpr int CW_BAR = 4096;

constexpr int RING_OFF = 0, RING_BYTES = 131072;
constexpr int LDSCTL_OFF = RING_BYTES, MISC_OFF = LDSCTL_OFF + 320;
constexpr int LDS_BYTES = 147456;

#define GAS __attribute__((address_space(1)))
#define LAS __attribute__((address_space(3)))
typedef unsigned short bf16;
typedef unsigned v4u __attribute__((ext_vector_type(4)));
typedef unsigned v2u __attribute__((ext_vector_type(2)));
typedef float f32x4 __attribute__((ext_vector_type(4)));
typedef short bf16x8 __attribute__((ext_vector_type(8)));
typedef GAS unsigned gu32;
#define RLX_AGENT __ATOMIC_RELAXED, __HIP_MEMORY_SCOPE_AGENT
#define LDS_WAIT() asm volatile("s_waitcnt lgkmcnt(0)" ::: "memory")
#define VM_WAIT() asm volatile("s_waitcnt vmcnt(0)" ::: "memory")
#ifndef HW_CVT
#define HW_CVT 1
#endif
typedef float f32x2v __attribute__((ext_vector_type(2))); typedef __bf16 bf16x2v __attribute__((ext_vector_type(2)));
#if HW_CVT
__device__ __forceinline__ unsigned pk2(float lo, float hi) { f32x2v v = {lo, hi}; bf16x2v b = __builtin_convertvector(v, bf16x2v); return __builtin_bit_cast(unsigned, b); }
__device__ __forceinline__ unsigned f2bf(float f) { return pk2(f, 0.0f) & 0xffffu; }
#else
__device__ __forceinline__ unsigned f2bf(float f) { unsigned u = __builtin_bit_cast(unsigned, f); return (u + 0x7fffu + ((u >> 16) & 1u)) >> 16; }
__device__ __forceinline__ unsigned pk2(float lo, float hi) { return f2bf(lo) | (f2bf(hi) << 16); }
#endif
__device__ __forceinline__ float bflo(unsigned w) { return __uint_as_float(w << 16); }
__device__ __forceinline__ float bfhi(unsigned w) { return __uint_as_float(w & 0xffff0000u); }
__device__ __forceinline__ float bf1(bf16 h) { return __uint_as_float(((unsigned)h) << 16); }
__device__ __forceinline__ float sigm_(float x) { return __builtin_amdgcn_rcpf(1.0f + __builtin_amdgcn_exp2f(-LOG2E * x)); }
__device__ __forceinline__ float silu_(float x) { return x * sigm_(x); }
#define XB_TMO      128
#define XB_XCNT(j)  (256  + 64 * (j))
#define XB_XSUB(j)  (1280 + 64 * (j))
#define XB_XGEN(j)  (2304 + 64 * (j))
#define XB_TOP      3328
#define XB_TOPGEN   3392
#define XCD_BAR_WORDS 3456
#define XB_SPIN_CAP (1u << 18)

__device__ __forceinline__ unsigned xb_ld(unsigned* p)              { return __hip_atomic_load(p, __ATOMIC_RELAXED, __HIP_MEMORY_SCOPE_AGENT); }
__device__ __forceinline__ unsigned xb_add(unsigned* p, unsigned v) { return __hip_atomic_fetch_add(p, v, __ATOMIC_RELAXED, __HIP_MEMORY_SCOPE_AGENT); }
__device__ __forceinline__ unsigned xb_xcc_id() { return (unsigned)__builtin_amdgcn_s_getreg((3 << 11) | 20) & 0xFu; }
#define XB_SPIN(cond, bar) do { unsigned _sp = 0; while (cond) { __builtin_amdgcn_s_sleep(1); \
    if ((++_sp & 255u) == 0u) { if (xb_ld(&(bar)[XB_TMO])) break; if (_sp > XB_SPIN_CAP) { atomicAdd(&(bar)[XB_TMO], 1u); break; } } } } while (0)

struct XcdBarrier {
    unsigned* bar; unsigned x;
    volatile LAS unsigned* st;
};

__device__ __forceinline__ XcdBarrier xcd_barrier_post(unsigned* bar, volatile LAS unsigned* st) {
    XcdBarrier b; b.bar = bar; b.x = xb_xcc_id(); b.st = st;
    if (threadIdx.x == 0) (void)xb_add(&bar[XB_XCNT(b.x)], 1u);
    return b;
}
__device__ __forceinline__ void xcd_barrier_complete(unsigned* bar, unsigned x, unsigned& nloc, unsigned& nx) {
    const unsigned G = gridDim.x * gridDim.y * gridDim.z;
    unsigned sum, cnt, mine, sp = 0u;
    for (;;) {
        sum = 0u; cnt = 0u; mine = 0u;
#pragma unroll
        for (unsigned j = 0; j < 16; ++j) { const unsigned c = xb_ld(&bar[XB_XCNT(j)]); sum += c; cnt += (c > 0u) ? 1u : 0u; }
        mine = xb_ld(&bar[XB_XCNT(x)]);
        if (sum == G) break;
        __builtin_amdgcn_s_sleep(1);
        if ((++sp & 255u) == 0u) { if (xb_ld(&bar[XB_TMO])) break; if (sp > XB_SPIN_CAP) { atomicAdd(&bar[XB_TMO], 1u); break; } }
    }
    nloc = mine > 0u ? mine : 1u; nx = cnt > 0u ? cnt : 1u;
}

__device__ __forceinline__ void xcd_barrier(const XcdBarrier& b) {
    asm volatile("s_waitcnt vmcnt(0)" ::: "memory");
    __syncthreads();
    if (threadIdx.x == 0) {
        unsigned* bar = b.bar;
        __builtin_amdgcn_s_waitcnt(0);
        unsigned nloc = b.st[0], nx = b.st[1];
        if (nloc == 0u) { xcd_barrier_complete(bar, b.x, nloc, nx); b.st[0] = nloc; b.st[1] = nx; }
        const unsigned old = xb_add(&bar[XB_XSUB(b.x)], 1u);
        const unsigned gen = old / nloc;
        if (old + 1u == (gen + 1u) * nloc) {
            __builtin_amdgcn_fence(__ATOMIC_RELEASE, "agent");
            asm volatile("s_waitcnt vmcnt(0)" ::: "memory");
            const unsigned og = xb_add(&bar[XB_TOP], 1u);
            const unsigned tg = og / nx;
            if (og + 1u == (tg + 1u) * nx) xb_add(&bar[XB_TOPGEN], 1u);
            else XB_SPIN(xb_ld(&bar[XB_TOPGEN]) == tg, bar);
            __builtin_amdgcn_fence(__ATOMIC_ACQUIRE, "agent");
            xb_add(&bar[XB_XGEN(b.x)], 1u);
            asm volatile("s_waitcnt vmcnt(0)" ::: "memory");
        } else {
            XB_SPIN(xb_ld(&bar[XB_XGEN(b.x)]) == gen, bar);
            __builtin_amdgcn_fence(__ATOMIC_ACQUIRE, "agent");
            asm volatile("s_waitcnt vmcnt(0)" ::: "memory");
        }
    }
    __syncthreads();
}
struct Args { const float* in[N_IN]; float* out; unsigned char* ws; int ph_lo, ph_hi; };
typedef const volatile __attribute__((address_space(4))) Args* KArgs;
#define AIN(i) ((const float*)(const __attribute__((address_space(1))) float*)a->in[i])
struct Frame {
    LAS unsigned char* lds;
    volatile LAS unsigned* MISC;
    gu32* ctl;
    int tid, lane, wave;
    int vcu, G;
    unsigned char* ws;
};
__device__ __forceinline__ Frame fresh(const Frame& F) { Frame Fp = F; unsigned long long w = (unsigned long long)F.ws; asm volatile("" : "+v"(Fp.tid), "+s"(Fp.vcu), "+s"(w)); Fp.ws = (unsigned char*)(GAS unsigned char*)w; Fp.lane = Fp.tid & 63; Fp.wave = __builtin_amdgcn_readfirstlane(Fp.tid >> 6); return Fp; }
__device__ __forceinline__ float bperm(float v, int srclane) { return __int_as_float(__builtin_amdgcn_ds_bpermute(srclane << 2, __float_as_int(v))); }
__device__ __forceinline__ float wave_sum(float v, int lane) {
#pragma unroll
    for (int o = 1; o < 64; o <<= 1) v += bperm(v, lane ^ o);
    return v;
}
__device__ __forceinline__ int rowof(int dir, int s) { return dir ? (MR - 1 - s) : (s < CTXN ? SEQ + s : s - CTXN); }
__device__ __forceinline__ void sincos_hw(float ang, float& s, float& c) { float r = ang * 0.15915494309189535f; r = r - floorf(r); s = __builtin_amdgcn_sinf(r); c = __builtin_amdgcn_cosf(r); }

__device__ __forceinline__ void transpose_item(const float* W, int ldw, int Nsrc, int src_c0, bf16* WT, int dst_r0, int k0, int nvalid, LAS float* scr, int lane, int my_col = -1) {
#pragma unroll 8
    for (int i = 0; i < 32; ++i) { const int kk = 2 * i + (lane >> 5); scr[kk * 33 + (lane & 31)] = __builtin_nontemporal_load(W + (size_t)(k0 + kk) * Nsrc + (my_col >= 0 ? my_col : src_c0 + (lane & 31))); }
    LDS_WAIT(); asm volatile("" ::: "memory");
    const int c = lane & 7;
#pragma unroll
    for (int j = 0; j < 4; ++j) { const int n = (lane >> 3) + 8 * j; const LAS float* s = scr + (8 * c) * 33 + n;
        v4u o; o.x = pk2(s[0 * 33], s[1 * 33]); o.y = pk2(s[2 * 33], s[3 * 33]); o.z = pk2(s[4 * 33], s[5 * 33]); o.w = pk2(s[6 * 33], s[7 * 33]);
        if (n >= nvalid) o = (v4u){0u, 0u, 0u, 0u};
        __builtin_nontemporal_store(o, (GAS v4u*)(WT + (size_t)(dst_r0 + n) * ldw + k0 + 8 * c)); }
    LDS_WAIT(); asm volatile("" ::: "memory");
}
constexpr int IT_FFI = 32 * 352, IT_FFO = 88 * 64, IT_WIN = 32 * 384, IT_GLU = 8 * 32, IT_BRA = 12 * 64, IT_BRX = 8 * 64, IT_OUT = 32 * 64, IT_WDT = 32;
constexpr int IT_LAYER = 2 * IT_FFI + 2 * IT_FFO + IT_WIN + IT_GLU + IT_BRA + 3 * IT_BRX + IT_OUT + IT_WDT;
#ifndef HIDE_CONVERT
#define HIDE_CONVERT 0
#endif
constexpr int IT_GA = IT_FFI + IT_FFO, IT_GB = IT_WIN + IT_WDT, IT_GC = IT_GLU + IT_BRA + 3 * IT_BRX + IT_OUT, IT_GD = IT_FFI + IT_FFO;
static_assert(IT_GA + IT_GB + IT_GC + IT_GD == IT_LAYER, "item groups");
__device__ __forceinline__ void convert_item(Frame& F, KArgs a, int l, int r, LAS float* scr) {
    bf16* wl = (bf16*)(F.ws + WS_W) + (size_t)l * WL_SIZE;
    int f = 0; if (r >= IT_GA + IT_GB + IT_GC) { f = 1; r -= IT_GA + IT_GB + IT_GC; }
    if (r < IT_FFI) { const int kb = r / 352, gd = r % 352, pn = gd >> 3, w = gd & 7; const int sc0 = (w < 4) ? 128 * pn + 32 * w : DFF + 128 * pn + 32 * (w - 4);
        transpose_item(AIN(I_FFIN) + (size_t)(l * 2 + f) * DM * NFF, DM, NFF, sc0, wl + WL_FFI + (size_t)f * NFF * DM, 32 * gd, 64 * kb, 32, scr, F.lane); return; } r -= IT_FFI;
    if (r < IT_FFO) { const int kb = r / 64, gd = r % 64;
        transpose_item(AIN(I_FFOUT) + (size_t)(l * 2 + f) * DFF * DM, DFF, DM, 32 * gd, wl + WL_FFO + (size_t)f * DM * DFF, 32 * gd, 64 * kb, 32, scr, F.lane); return; } r -= IT_FFO;
    if (r < IT_WIN) { const int kb = r / 384, gd = r % 384; const int d0 = 32 * gd;
        int mc = -1;
        if (d0 >= PC_GATE) { const int j = (d0 - PC_GATE) >> 8, w = (d0 >> 5) & 7, bj = w >> 2, wc = w & 3, o = F.lane & 31, fq = o >> 3, n = (o >> 2) & 1, i = o & 3;
            mc = (DIN - 4 * DM) + 2048 * (2 * bj + n) + 64 * j + 16 * wc + 4 * fq + i; }
        transpose_item(AIN(I_WIN) + (size_t)l * DM * DIN, DM, DIN, d0 < 2048 ? d0 : d0 + 24, wl + WL_WIN, d0, 64 * kb, 32, scr, F.lane, mc); return; } r -= IT_WIN;
    if (r < IT_WDT) { transpose_item(AIN(I_WIN) + (size_t)l * DM * DIN, DM, DIN, 2048, wl + WL_WDT, 0, 64 * r, 24, scr, F.lane); return; } r -= IT_WDT;
    if (r < IT_GLU) { const int kb = r / 32, gd = r % 32, pn = gd >> 3, w = gd & 7; const int sc0 = (w < 4) ? 128 * pn + 32 * w : 512 + 128 * pn + 32 * (w - 4);
        transpose_item(AIN(I_GLUW) + (size_t)l * 512 * 1024, 512, 1024, sc0, wl + WL_GLU, 32 * gd, 64 * kb, 32, scr, F.lane); return; } r -= IT_GLU;
    if (r < IT_BRA) { const int kb = r / 64, gd = r % 64;
        transpose_item(AIN(I_BRSSD) + (size_t)l * 768 * DM, YPITCH, DM, 32 * gd, wl + WL_BRALL, 32 * gd, 64 * kb, 32, scr, F.lane); return; } r -= IT_BRA;
    if (r < 3 * IT_BRX) { const int b = r / IT_BRX; r %= IT_BRX; const int kb = r / 64, gd = r % 64;
        const float* src = (b == 0 ? AIN(I_BRS5) : (b == 1 ? AIN(I_BRSWA) : AIN(I_BRGLB))) + (size_t)l * 512 * DM;
        transpose_item(src, YPITCH, DM, 32 * gd, wl + WL_BRALL + YC_B + 512 * b, 32 * gd, 64 * kb, 32, scr, F.lane); return; } r -= 3 * IT_BRX;
    { const int kb = r / 64, gd = r % 64; transpose_item(AIN(I_WOUT) + (size_t)l * DM * DM, DM, DM, 32 * gd, wl + WL_OUT, 32 * gd, 64 * kb, 32, scr, F.lane); }
}
__device__ __forceinline__ void convert_range(Frame& F, KArgs a, int l, int first, int n, int widx, int wstride) {
    LAS float* scr = (LAS float*)(F.lds + RING_OFF + F.wave * 16384);
    for (int it = first + widx; it < first + n; it += wstride) convert_item(F, a, l, it, scr);
}
__device__ __forceinline__ void convert_idle(Frame& F, KArgs a, int c, int rem, int l, int first, int n) {
    if (c < rem || l >= DEPTH) return;
    convert_range(F, a, l, first, n, (c - rem) * NWAVES + F.wave, (F.G - rem) * NWAVES);
}
__device__ __forceinline__ void p0_prologue(Frame& F, KArgs a) {
    const int gw = F.vcu * NWAVES + F.wave, NGW = F.G * NWAVES;
#if HIDE_CONVERT
    convert_range(F, a, 0, 0, IT_GA, gw, NGW);
#else
    for (int l = 0; l < DEPTH; ++l) convert_range(F, a, l, 0, IT_LAYER, gw, NGW);
#endif
    float* X = (float*)(F.ws + WS_X);
    for (int m = gw; m < MR; m += NGW) {
        const GAS f32x4* src = (const GAS f32x4*)(m < SEQ ? AIN(I_X) + (size_t)m * DM : AIN(I_CTX) + (size_t)(m - SEQ) * DM) + F.lane; GAS f32x4* dst = (GAS f32x4*)(X + (size_t)m * DM) + F.lane;
#pragma unroll
        for (int j = 0; j < 8; ++j) dst[64 * j] = src[64 * j];
    }
    __syncthreads();
    LAS float* sc = (LAS float*)(F.lds + RING_OFF);
    for (int i = F.tid; i < 2 * DM; i += NWAVES * 64) { const float c = (i < DM) ? AIN(I_C)[i] : AIN(I_CCTX)[i - DM]; sc[i] = silu_(c); }
    __syncthreads();
    float* MODP = (float*)(F.ws + WS_MODP);
    for (int it = F.vcu; it < DEPTH * 32 * 9; it += F.G) {
        const int l = it / 288, r = it % 288, s = r / 9, b = r % 9, col = b * 2048 + 4 * F.tid;
        const float* w = AIN(I_WMOD) + (size_t)l * DM * NMODV + (size_t)(64 * s) * NMODV + col;
        f32x4 a0 = {0.f, 0.f, 0.f, 0.f}, a1 = {0.f, 0.f, 0.f, 0.f};
#pragma unroll 8
        for (int k = 0; k < 64; ++k) { const f32x4 wv = __builtin_nontemporal_load((const f32x4*)(w + (size_t)k * NMODV)); a0 += wv * sc[64 * s + k]; a1 += wv * sc[DM + 64 * s + k]; }
        *(f32x4*)(MODP + (size_t)((l * 32 + s) * 2 + 0) * NMODV + col) = a0; *(f32x4*)(MODP + (size_t)((l * 32 + s) * 2 + 1) * NMODV + col) = a1;
    }
}
__device__ __forceinline__ void p1_modfinal(Frame& F, KArgs a) {
    const float* MODP = (const float*)(F.ws + WS_MODP); float* MOD = (float*)(F.ws + WS_MOD);
    for (int i = F.vcu * 512 + F.tid; i < DEPTH * 2 * NMODV; i += F.G * 512) {
        const int l = i / (2 * NMODV), v = (i / NMODV) & 1, j = i % NMODV; float s = AIN(I_BMOD)[l * NMODV + j];
#pragma unroll
        for (int q = 0; q < 32; ++q) s += MODP[(size_t)((l * 32 + q) * 2 + v) * NMODV + j];
        MOD[i] = s;
    }
}
__device__ __forceinline__ void norm_phase(Frame& F, KArgs a, int l, int k, int nsl) {
    const int gw = F.vcu * NWAVES + F.wave, NGW = F.G * NWAVES;
    const float* X = (const float*)(F.ws + WS_X); bf16* H = (bf16*)(F.ws + WS_H);
    const float* g = AIN(I_NORMG) + (size_t)(l * 3 + k) * DM;
    { const int v = 0;
        const float* mod = (const float*)(F.ws + WS_MOD) + (size_t)(l * 2 + v) * NMODV; const float* shift = mod + (3 * k) * DM; const float* scale = mod + (3 * k + 1) * DM;
        f32x4 gs[8], sh[8];
#pragma unroll
        for (int j = 0; j < 8; ++j) { const int c = 4 * F.lane + 256 * j; const f32x4 gg = *(const f32x4*)(g + c), ss = *(const f32x4*)(scale + c); gs[j] = gg * (ss + 1.0f); sh[j] = *(const f32x4*)(shift + c); }
        const int r0 = v ? SEQ : 0, r1 = v ? MR : SEQ;
        if (v == 0) {
            for (int m = r0 + gw; m < r1; m += 2 * NGW) {
                const bool two = m + NGW < r1; const int m2 = two ? m + NGW : m;
                const GAS f32x4* xa = (const GAS f32x4*)(X + (size_t)m * DM) + F.lane; const GAS f32x4* xb = (const GAS f32x4*)(X + (size_t)m2 * DM) + F.lane; f32x4 a[8], b[8]; float sa = 0.f, sb = 0.f;
#pragma unroll
                for (int j = 0; j < 8; ++j) { a[j] = __builtin_nontemporal_load(xa + 64 * j); b[j] = __builtin_nontemporal_load(xb + 64 * j); }
#pragma unroll
                for (int j = 0; j < 8; ++j) { sa += (a[j].x * a[j].x + a[j].y * a[j].y) + (a[j].z * a[j].z + a[j].w * a[j].w); sb += (b[j].x * b[j].x + b[j].y * b[j].y) + (b[j].z * b[j].z + b[j].w * b[j].w); }
                const float ra = 1.0f / sqrtf(wave_sum(sa, F.lane) * (1.0f / DM) + 1e-6f), rb = 1.0f / sqrtf(wave_sum(sb, F.lane) * (1.0f / DM) + 1e-6f);
                GAS v2u* oa = (GAS v2u*)(H + (size_t)m * DM) + F.lane; GAS v2u* ob = (GAS v2u*)(H + (size_t)m2 * DM) + F.lane;
#pragma unroll
                for (int j = 0; j < 8; ++j) { const f32x4 y = a[j] * ra * gs[j] + sh[j]; v2u w; w.x = pk2(y.x, y.y); w.y = pk2(y.z, y.w); oa[64 * j] = w; }
                if (two) {
#pragma unroll
                    for (int j = 0; j < 8; ++j) { const f32x4 y = b[j] * rb * gs[j] + sh[j]; v2u w; w.x = pk2(y.x, y.y); w.y = pk2(y.z, y.w); ob[64 * j] = w; } }
            }
        }
    }
    {
        const float* mod = (const float*)(F.ws + WS_MOD) + (size_t)(l * 2 + 1) * NMODV; const int c = 256 * F.wave + 4 * F.lane;
        const f32x4 gsc = *(const f32x4*)(g + c) * (*(const f32x4*)(mod + (3 * k + 1) * DM + c) + 1.0f), shc = *(const f32x4*)(mod + (3 * k) * DM + c);
        LAS float* red = (LAS float*)(F.lds + RING_OFF);
        for (int m = SEQ + F.vcu; m < MR; m += F.G) {
            f32x4 x = *(const GAS f32x4*)(X + (size_t)m * DM + c);
            if (nsl > 0) { const float* PART = (const float*)(F.ws + WS_PART) + (size_t)(m - SEQ) * DM + c;
#pragma unroll 4
                for (int sl = 0; sl < nsl; ++sl) x += *(const GAS f32x4*)(PART + (size_t)sl * 256 * DM);
                *(GAS f32x4*)((float*)(F.ws + WS_X) + (size_t)m * DM + c) = x; }
            const float s = wave_sum((x.x * x.x + x.y * x.y) + (x.z * x.z + x.w * x.w), F.lane);
            if (F.lane == 0) red[F.wave] = s;
            __syncthreads();
            float tot = 0.f;
#pragma unroll
            for (int w = 0; w < NWAVES; ++w) tot += red[w];
            __syncthreads();
            const float rstd = 1.0f / sqrtf(tot * (1.0f / DM) + 1e-6f);
            const f32x4 y = x * rstd * gsc + shc; v2u w; w.x = pk2(y.x, y.y); w.y = pk2(y.z, y.w); *(GAS v2u*)(H + (size_t)m * DM + c) = w;
        }
    }
}
__device__ __forceinline__ void dt_gemm(Frame& F, int l, int c, int rem) {
    if (c < rem) return;
    const int gw = (c - rem) * NWAVES + F.wave, NGW = (F.G - rem) * NWAVES;
    const bf16* H = (const bf16*)(F.ws + WS_H); const bf16* Wd = (const bf16*)(F.ws + WS_W) + (size_t)l * WL_SIZE + WL_WDT; float* DTR = (float*)(F.ws + WS_DTRAW);
    const int fr = F.lane & 15, fq = F.lane >> 4;
    for (int t = gw; t < MR / 16; t += NGW) {
        const bf16* ap = H + (size_t)(16 * t + fr) * DM + 8 * fq; const bf16* b0 = Wd + (size_t)fr * DM + 8 * fq; const bf16* b1 = Wd + (size_t)(16 + fr) * DM + 8 * fq;
        f32x4 c0 = {0.f, 0.f, 0.f, 0.f}, c1 = {0.f, 0.f, 0.f, 0.f};
#pragma unroll 4
        for (int k0 = 0; k0 < DM; k0 += 32) { const bf16x8 av = *(const bf16x8*)(ap + k0), bv0 = *(const bf16x8*)(b0 + k0), bv1 = *(const bf16x8*)(b1 + k0);
            c0 = __builtin_amdgcn_mfma_f32_16x16x32_bf16(av, bv0, c0, 0, 0, 0); c1 = __builtin_amdgcn_mfma_f32_16x16x32_bf16(av, bv1, c1, 0, 0, 0); }
#pragma unroll
        for (int r = 0; r < 4; ++r) { float* o = DTR + (size_t)(16 * t + 4 * fq + r) * 32 + fr; o[0] = c0[r]; o[16] = c1[r]; }
    }
}
struct S5Disc { float lb_re, lb_im, bb_re[16], bb_im[16]; };
__device__ __forceinline__ void s5_disc(KArgs a, int l, int dir, int g, int p, S5Disc& d) {
    const int ig = (l * 2 + dir) * 32 + g; const float a_re = AIN(I_S5ARE)[ig * 64 + p], a_im = AIN(I_S5AIM)[ig * 64 + p]; const float dt = __expf(AIN(I_S5LDT)[ig]);
    const float mag = __expf(a_re * dt); float sn, cs; sincos_hw(a_im * dt, sn, cs);
    d.lb_re = mag * cs; d.lb_im = mag * sn;
    const float den = a_re * a_re + a_im * a_im, nr = d.lb_re - 1.0f, ni = d.lb_im;
    const float f_re = (nr * a_re + ni * a_im) / den, f_im = (ni * a_re - nr * a_im) / den;
    const float* br = AIN(I_S5BRE) + (size_t)((l * 32 + g) * 64 + p) * 16; const float* bi = AIN(I_S5BIM) + (size_t)((l * 32 + g) * 64 + p) * 16;
#pragma unroll
    for (int h = 0; h < 16; ++h) { const float x = br[h], y = bi[h]; d.bb_re[h] = f_re * x - f_im * y; d.bb_im[h] = f_re * y + f_im * x; }
}
typedef float f32x16 __attribute__((ext_vector_type(16)));
struct S5Pow { float r1, i1, r2, i2, r3, i3, r4, i4; };
__device__ __forceinline__ void s5_pow(const S5Disc& d, S5Pow& p) { p.r1 = d.lb_re; p.i1 = d.lb_im; p.r2 = p.r1 * p.r1 - p.i1 * p.i1; p.i2 = (p.r1 + p.r1) * p.i1; p.r3 = p.r2 * p.r1 - p.i2 * p.i1; p.i3 = p.r2 * p.i1 + p.i2 * p.r1; p.r4 = p.r2 * p.r2 - p.i2 * p.i2; p.i4 = (p.r2 + p.r2) * p.i2; }
__device__ __forceinline__ bf16x8 pack8(const float (&v)[16], bool hi) { v4u w; w.x = pk2(hi ? v[8] : v[0], hi ? v[9] : v[1]); w.y = pk2(hi ? v[10] : v[2], hi ? v[11] : v[3]); w.z = pk2(hi ? v[12] : v[4], hi ? v[13] : v[5]); w.w = pk2(hi ? v[14] : v[6], hi ? v[15] : v[7]); return __builtin_bit_cast(bf16x8, w); }
template <bool FIX> __device__ __forceinline__ void s5_state_scan(f32x16& R, f32x16& I, const S5Pow& p, float& cr, float& ci, bool hi) {
#pragma unroll
    for (int k = 0; k < 4; ++k)
#pragma unroll
        for (int j = 1; j < 4; ++j) { const int x = 4 * k + j; const float nr = p.r1 * R[x - 1] - p.i1 * I[x - 1] + R[x], ni = p.r1 * I[x - 1] + p.i1 * R[x - 1] + I[x]; R[x] = nr; I[x] = ni; }
    float cinr[4], cini[4], ce_r = 0.f, ce_i = 0.f;
#pragma unroll
    for (int G = 0; G < 8; ++G) { const int k = G >> 1;
        if ((G & 1) == 0) { ce_r = cr; ce_i = ci; } else { cinr[k] = hi ? cr : ce_r; cini[k] = hi ? ci : ce_i; }
        const float vr = p.r4 * cr - p.i4 * ci + R[4 * k + 3], vi = p.r4 * ci + p.i4 * cr + I[4 * k + 3];
        const auto sr = __builtin_amdgcn_permlane32_swap(__float_as_uint(vr), __float_as_uint(vr), false, false); const auto si = __builtin_amdgcn_permlane32_swap(__float_as_uint(vi), __float_as_uint(vi), false, false);
        cr = __uint_as_float(sr[G & 1]); ci = __uint_as_float(si[G & 1]); }
    if (FIX) {
#pragma unroll
        for (int k = 0; k < 4; ++k) { const float a = cinr[k], b = cini[k];
            R[4 * k + 0] += p.r1 * a - p.i1 * b; I[4 * k + 0] += p.r1 * b + p.i1 * a; R[4 * k + 1] += p.r2 * a - p.i2 * b; I[4 * k + 1] += p.r2 * b + p.i2 * a;
            R[4 * k + 2] += p.r3 * a - p.i3 * b; I[4 * k + 2] += p.r3 * b + p.i3 * a; R[4 * k + 3] += p.r4 * a - p.i4 * b; I[4 * k + 3] += p.r4 * b + p.i4 * a; }
    }
}
#ifndef S5_TOKPERM
#define S5_TOKPERM 1
#endif
struct S5W { float wr[4], wi[4], r32, i32, r8, i8, r12, i12, r16, i16; };
__device__ __forceinline__ void s5_w(const S5Pow& p, bool hi, S5W& w) {
    float pr[9], pi[9]; pr[0] = 1.0f; pi[0] = 0.0f; pr[1] = p.r4; pi[1] = p.i4;
#pragma unroll
    for (int j = 2; j < 9; ++j) { pr[j] = pr[j - 1] * p.r4 - pi[j - 1] * p.i4; pi[j] = pr[j - 1] * p.i4 + pi[j - 1] * p.r4; }
#pragma unroll
    for (int k = 0; k < 4; ++k) {
        if (S5_TOKPERM) { w.wr[k] = hi ? pr[3 - k] : pr[7 - k]; w.wi[k] = hi ? pi[3 - k] : pi[7 - k]; }
        else { w.wr[k] = hi ? pr[6 - 2 * k] : pr[7 - 2 * k]; w.wi[k] = hi ? pi[6 - 2 * k] : pi[7 - 2 * k]; } }
    w.r8 = pr[2]; w.i8 = pi[2]; w.r12 = pr[3]; w.i12 = pi[3]; w.r16 = pr[4]; w.i16 = pi[4];
    w.r32 = pr[8]; w.i32 = pi[8];
}
__device__ __forceinline__ void s5_end_acc(f32x16& R, f32x16& I, const S5Pow& p, const S5W& w, float& cr, float& ci) {
#pragma unroll
    for (int k = 0; k < 4; ++k)
#pragma unroll
        for (int j = 1; j < 4; ++j) { const int x = 4 * k + j; const float nr = p.r1 * R[x - 1] - p.i1 * I[x - 1] + R[x], ni = p.r1 * I[x - 1] + p.i1 * R[x - 1] + I[x]; R[x] = nr; I[x] = ni; }
    float ar = 0.f, ai = 0.f;
#pragma unroll
    for (int k = 0; k < 4; ++k) { const float er = R[4 * k + 3], ei = I[4 * k + 3]; ar += w.wr[k] * er - w.wi[k] * ei; ai += w.wr[k] * ei + w.wi[k] * er; }
    const auto sr = __builtin_amdgcn_permlane32_swap(__float_as_uint(ar), __float_as_uint(ar), false, false); const auto si = __builtin_amdgcn_permlane32_swap(__float_as_uint(ai), __float_as_uint(ai), false, false);
    ar = __uint_as_float(sr[0]) + __uint_as_float(sr[1]); ai = __uint_as_float(si[0]) + __uint_as_float(si[1]);
    const float nr = w.r32 * cr - w.i32 * ci + ar, ni = w.r32 * ci + w.i32 * cr + ai; cr = nr; ci = ni;
}
__device__ __forceinline__ void s5_scan_perm(f32x16& R, f32x16& I, const S5Pow& p, const S5W& w, float& cr, float& ci, bool hi) {
#pragma unroll
    for (int k = 0; k < 4; ++k)
#pragma unroll
        for (int j = 1; j < 4; ++j) { const int x = 4 * k + j; const float nr = p.r1 * R[x - 1] - p.i1 * I[x - 1] + R[x], ni = p.r1 * I[x - 1] + p.i1 * R[x - 1] + I[x]; R[x] = nr; I[x] = ni; }
    float zr[5], zi[5]; zr[0] = 0.f; zi[0] = 0.f; zr[1] = R[3]; zi[1] = I[3];
#pragma unroll
    for (int k = 1; k < 4; ++k) { zr[k + 1] = p.r4 * zr[k] - p.i4 * zi[k] + R[4 * k + 3]; zi[k + 1] = p.r4 * zi[k] + p.i4 * zr[k] + I[4 * k + 3]; }
    const auto sr = __builtin_amdgcn_permlane32_swap(__float_as_uint(zr[4]), __float_as_uint(zr[4]), false, false); const auto si = __builtin_amdgcn_permlane32_swap(__float_as_uint(zi[4]), __float_as_uint(zi[4]), false, false);
    const float elr = __uint_as_float(sr[0]), ehr = __uint_as_float(sr[1]), eli = __uint_as_float(si[0]), ehi = __uint_as_float(si[1]);
    const float mr = w.r16 * cr - w.i16 * ci + elr, mi = w.r16 * ci + w.i16 * cr + eli;
    const float s0r = hi ? mr : cr, s0i = hi ? mi : ci;
    const float pwr[4] = {1.0f, p.r4, w.r8, w.r12}, pwi[4] = {0.0f, p.i4, w.i8, w.i12};
#pragma unroll
    for (int k = 0; k < 4; ++k) { const float a = pwr[k] * s0r - pwi[k] * s0i + zr[k], b = pwr[k] * s0i + pwi[k] * s0r + zi[k];
        R[4 * k + 0] += p.r1 * a - p.i1 * b; I[4 * k + 0] += p.r1 * b + p.i1 * a; R[4 * k + 1] += p.r2 * a - p.i2 * b; I[4 * k + 1] += p.r2 * b + p.i2 * a;
        R[4 * k + 2] += p.r3 * a - p.i3 * b; I[4 * k + 2] += p.r3 * b + p.i3 * a; R[4 * k + 3] += p.r4 * a - p.i4 * b; I[4 * k + 3] += p.r4 * b + p.i4 * a; }
    const float nr = w.r16 * mr - w.i16 * mi + ehr, ni = w.r16 * mi + w.i16 * mr + ehi; cr = nr; ci = ni;
}
#ifndef S5_DIRECT
#define S5_DIRECT 1
#endif
#ifndef S5P1_REV
#define S5P1_REV 1
#endif
#ifndef S5_NA
#define S5_NA 5
#endif
template <bool PASS2> __device__ __forceinline__ void s5_pass(Frame& F, KArgs a, int l) {
    const int gw = F.vcu * NWAVES + F.wave, NGW = F.G * NWAVES;
    if (NGW % 64 != 0) return;
    const int q = gw & 63, dir = q >> 5, g = q & 31, lane = F.lane, s = lane & 31; const bool hi = lane >= 32;
    S5Pow pA, pB; bf16x8 bbf[4];
    { S5Disc dA, dB; s5_disc(a, l, dir, g, s, dA); s5_disc(a, l, dir, g, s + 32, dB); s5_pow(dA, pA); s5_pow(dB, pB);
      bbf[0] = pack8(dA.bb_re, hi); bbf[1] = pack8(dB.bb_re, hi); bbf[2] = pack8(dA.bb_im, hi); bbf[3] = pack8(dB.bb_im, hi); }
    S5W wA, wB; if ((!PASS2 && S5_DIRECT) || (PASS2 && S5_TOKPERM)) { s5_w(pA, hi, wA); s5_w(pB, hi, wB); }
    bf16x8 cmf[4];
    if (PASS2) { const int h = lane & 15, q4 = lane >> 4;
#pragma unroll
        for (int ks = 0; ks < 4; ++ks) { const float* src = (ks < 2 ? AIN(I_S5CRE) : AIN(I_S5CIM)) + (size_t)((l * 32 + g) * 16 + h) * 64 + 32 * (ks & 1) + 8 * q4; const float sg = ks < 2 ? 1.0f : -1.0f;
            const f32x4 v0 = *(const f32x4*)src * sg, v1 = *(const f32x4*)(src + 4) * sg; v4u w; w.x = pk2(v0.x, v0.y); w.y = pk2(v0.z, v0.w); w.z = pk2(v1.x, v1.y); w.w = pk2(v1.z, v1.w); cmf[ks] = __builtin_bit_cast(bf16x8, w); } }
    float* END = (float*)(F.ws + WS_S5END); const float* SIN = (const float*)(F.ws + WS_S5IN); const bf16* P = (const bf16*)(F.ws + WS_P); bf16* YBF = (bf16*)(F.ws + WS_YBF);
    LAS bf16* Sb = (LAS bf16*)(F.lds + RING_OFF + F.wave * 8192);
    int cs_beg = (!PASS2 && S5P1_REV) ? (NGW >> 6) - 1 - (gw >> 6) : (gw >> 6), cs_end = MR / 64, cs_step = NGW >> 6;
    if (PASS2 && S5_NA > 0 && NGW == 2048) {
        const int rgw = NGW - 1 - gw, rj = rgw >> 6, rq = rgw & 63, n2 = (MR / 64) * 12 - NGW;
        const int nAw = (n2 >> 6) + (rq < (n2 & 63) ? 1 : 0), nBw = 32 - nAw, rest = MR / 64 - nAw * S5_NA, bs = rest / nBw, ex = rest % nBw, jb = rj - nAw;
        cs_beg = rj < nAw ? rj * S5_NA : nAw * S5_NA + jb * bs + (jb < ex ? jb : ex);
        cs_end = cs_beg + (rj < nAw ? S5_NA : bs + (jb < ex ? 1 : 0)); cs_step = 1;
    }
    for (int cs = cs_beg; cs < cs_end; cs += cs_step) {
        const size_t o = ((size_t)q * (MR / 64) + cs) * 128;
        float cAr = 0.f, cAi = 0.f, cBr = 0.f, cBi = 0.f;
        if (PASS2) { cAr = SIN[o + 2 * s]; cAi = SIN[o + 2 * s + 1]; cBr = SIN[o + 2 * (s + 32)]; cBi = SIN[o + 2 * (s + 32) + 1]; }
#pragma unroll 1
        for (int tt = 0; tt < 2; ++tt) {
            const bf16x8 uf = *(const GAS bf16x8*)(P + (size_t)rowof(dir, 64 * cs + 32 * tt + (S5_TOKPERM ? 16 * ((s >> 2) & 1) + 4 * (s >> 3) + (s & 3) : s)) * NP + PC_U + 16 * g + (hi ? 8 : 0));
            const f32x16 z = {0.f, 0.f, 0.f, 0.f, 0.f, 0.f, 0.f, 0.f, 0.f, 0.f, 0.f, 0.f, 0.f, 0.f, 0.f, 0.f};
            f32x16 T0 = __builtin_amdgcn_mfma_f32_32x32x16_bf16(uf, bbf[0], z, 0, 0, 0), T1 = __builtin_amdgcn_mfma_f32_32x32x16_bf16(uf, bbf[1], z, 0, 0, 0);
            f32x16 T2 = __builtin_amdgcn_mfma_f32_32x32x16_bf16(uf, bbf[2], z, 0, 0, 0), T3 = __builtin_amdgcn_mfma_f32_32x32x16_bf16(uf, bbf[3], z, 0, 0, 0);
            if (!PASS2 && S5_DIRECT) { s5_end_acc(T0, T2, pA, wA, cAr, cAi); s5_end_acc(T1, T3, pB, wB, cBr, cBi); }
            else if (PASS2 && S5_TOKPERM) { s5_scan_perm(T0, T2, pA, wA, cAr, cAi, hi); s5_scan_perm(T1, T3, pB, wB, cBr, cBi, hi); }
            else { s5_state_scan<PASS2>(T0, T2, pA, cAr, cAi, hi); s5_state_scan<PASS2>(T1, T3, pB, cBr, cBi, hi); }
            if (PASS2) {
#pragma unroll
                for (int r = 0; r < 16; ++r) { const int tl = S5_TOKPERM ? (hi ? 16 : 0) + r : 8 * (r >> 2) + (hi ? 4 : 0) + (r & 3); LAS bf16* dst = Sb + tl * 128 + s;
                    dst[0] = (bf16)f2bf(T0[r]); dst[32] = (bf16)f2bf(T1[r]); dst[64] = (bf16)f2bf(T2[r]); dst[96] = (bf16)f2bf(T3[r]); }
                LDS_WAIT(); asm volatile("" ::: "memory");
                const int r16 = lane & 15, q4 = lane >> 4;
#pragma unroll
                for (int mt = 0; mt < 2; ++mt) { f32x4 acc = {0.f, 0.f, 0.f, 0.f};
#pragma unroll
                    for (int ks = 0; ks < 4; ++ks) { const bf16x8 af = *(const LAS bf16x8*)(Sb + (16 * mt + r16) * 128 + 32 * ks + 8 * q4); acc = __builtin_amdgcn_mfma_f32_16x16x32_bf16(af, cmf[ks], acc, 0, 0, 0); }
#pragma unroll
                    for (int rg = 0; rg < 4; ++rg) { const int row = rowof(dir, 64 * cs + 32 * tt + 16 * mt + 4 * q4 + rg); YBF[((size_t)dir * MR + row) * 512 + 16 * g + r16] = (bf16)f2bf(acc[rg]); } }
                LDS_WAIT(); asm volatile("" ::: "memory");
            }
        }
        if (!PASS2 && !hi) { END[o + 2 * s] = cAr; END[o + 2 * s + 1] = cAi; END[o + 2 * (s + 32)] = cBr; END[o + 2 * (s + 32) + 1] = cBi; }
    }
}
#ifndef S5C_UNR
#define S5C_UNR 13
#endif
__device__ __forceinline__ void s5_carry(Frame& F, KArgs a, int l, int first_wave) {
    const int gw = F.vcu * NWAVES + F.wave - first_wave; if (gw < 0 || gw >= 64) return;
    const int q = gw, dir = q >> 5, g = q & 31, p = F.lane;
    const int ig = (l * 2 + dir) * 32 + g; const float a_re = AIN(I_S5ARE)[ig * 64 + p], a_im = AIN(I_S5AIM)[ig * 64 + p]; const float dt = __expf(AIN(I_S5LDT)[ig]);
    const float mag = __expf(a_re * dt); float sn, cs_; sincos_hw(a_im * dt, sn, cs_);
    float pr = mag * cs_, pi = mag * sn;
#pragma unroll
    for (int i = 0; i < 6; ++i) { const float nr = pr * pr - pi * pi, ni = (pr + pr) * pi; pr = nr; pi = ni; }
    const float* END = (const float*)(F.ws + WS_S5END); float* SIN = (float*)(F.ws + WS_S5IN);
    float s_re = 0.f, s_im = 0.f;
    for (int cs = 0; cs < MR / 64; cs += S5C_UNR) {
        float er[S5C_UNR], ei[S5C_UNR];
#pragma unroll
        for (int i = 0; i < S5C_UNR; ++i) { const size_t o = ((size_t)q * (MR / 64) + cs + i) * 128 + 2 * p; er[i] = END[o]; ei[i] = END[o + 1]; }
#pragma unroll
        for (int i = 0; i < S5C_UNR; ++i) { const size_t o = ((size_t)q * (MR / 64) + cs + i) * 128 + 2 * p; SIN[o] = s_re; SIN[o + 1] = s_im;
            const float nr = pr * s_re - pi * s_im + er[i], ni = pr * s_im + pi * s_re + ei[i]; s_re = nr; s_im = ni; }
    }
}
__device__ __forceinline__ bf16x8 ldg8(const bf16* p) { return *(const GAS bf16x8*)p; }
__device__ __forceinline__ int ssd_chunk_of(int d, int j) { return d ? (MR / 64 - 1 - j) : (j < CTXN / 64 ? SEQ / 64 + j : j - CTXN / 64); }
__device__ __forceinline__ float scan64(float v, int d, int lane) {
#pragma unroll
    for (int o = 1; o < 64; o <<= 1) { const float up = bperm(v, lane - o), dn = bperm(v, lane + o); if (d == 0) { if (lane >= o) v += up; } else { if (lane + o < 64) v += dn; } }
    return v;
}
__device__ __forceinline__ void conv_item(Frame& F, const float* cw, const float* cb_, int k, int cb) {
    LAS float* tin = (LAS float*)(F.lds + RING_OFF);
    LAS float* tout = tin + 68 * 64;
    const bf16* P = (const bf16*)(F.ws + WS_P);
    const int row0 = 64 * k, lo = k < SEQ / 64 ? 0 : SEQ, hi = k < SEQ / 64 ? SEQ : MR, c0 = 64 * cb;
    const int t = F.tid >> 3, c8 = (F.tid & 7) * 8;
    __syncthreads();
#pragma unroll
    for (int rr = t; rr < 68; rr += 64) { const int grow = row0 - 2 + rr; v4u w = (v4u){0u, 0u, 0u, 0u}; if (grow >= lo && grow < hi) w = *(const GAS v4u*)(P + (size_t)grow * NP + PC_XBC + c0 + c8);
        *(LAS f32x4*)(tin + rr * 64 + c8) = (f32x4){bflo(w.x), bfhi(w.x), bflo(w.y), bfhi(w.y)}; *(LAS f32x4*)(tin + rr * 64 + c8 + 4) = (f32x4){bflo(w.z), bfhi(w.z), bflo(w.w), bfhi(w.w)}; }
    __syncthreads();
    { f32x4 a0 = *(const f32x4*)(cb_ + c0 + c8), a1 = *(const f32x4*)(cb_ + c0 + c8 + 4);
#pragma unroll
      for (int j = 0; j < 5; ++j) { const f32x4 w0 = *(const f32x4*)(cw + j * 1280 + c0 + c8), w1 = *(const f32x4*)(cw + j * 1280 + c0 + c8 + 4);
          a0 += w0 * *(const LAS f32x4*)(tin + (t + j) * 64 + c8); a1 += w1 * *(const LAS f32x4*)(tin + (t + j) * 64 + c8 + 4); }
      float o[8];
#pragma unroll
      for (int i = 0; i < 4; ++i) { o[i] = silu_(a0[i]); o[4 + i] = silu_(a1[i]); }
#pragma unroll
      for (int i = 0; i < 8; ++i) tout[t * 65 + c8 + i] = o[i];
      v4u w; w.x = pk2(o[0], o[1]); w.y = pk2(o[2], o[3]); w.z = pk2(o[4], o[5]); w.w = pk2(o[6], o[7]);
      bf16* nat = (cb < 12) ? (bf16*)(F.ws + WS_XSN) + (size_t)(row0 + t) * 768 + c0 + c8
                : (cb < 16) ? (bf16*)(F.ws + WS_BN) + (size_t)(row0 + t) * 256 + (c0 - 768) + c8
                            : (bf16*)(F.ws + WS_CN) + (size_t)(row0 + t) * 256 + (c0 - 1024) + c8;
      *(GAS v4u*)nat = w; }
    __syncthreads();
    if (cb < 16) {
        const int c = F.tid >> 3, t8 = (F.tid & 7) * 8; float o[8];
#pragma unroll
        for (int i = 0; i < 8; ++i) o[i] = tout[(t8 + i) * 65 + c];
        v4u w; w.x = pk2(o[0], o[1]); w.y = pk2(o[2], o[3]); w.z = pk2(o[4], o[5]); w.w = pk2(o[6], o[7]);
        bf16* tr = (cb < 12) ? (bf16*)(F.ws + WS_XT) + ((size_t)(k * 12 + cb) * 64 + c) * 64 + t8
                             : (bf16*)(F.ws + WS_BT) + ((size_t)k * 256 + (c0 - 768) + c) * 64 + t8;
        *(GAS v4u*)tr = w;
    }
}
__device__ __forceinline__ void conv_wave_item(Frame& F, const float* cw, const float* cb_, int k, int c0, LAS float* buf) {
    const bf16* P = (const bf16*)(F.ws + WS_P);
    const int row0 = 64 * k, lo = k < SEQ / 64 ? 0 : SEQ, hi = k < SEQ / 64 ? SEQ : MR, t = F.lane;
    { const int g0 = row0 - 2 + t; v4u w = (v4u){0u, 0u, 0u, 0u}; if (g0 >= lo && g0 < hi) w = *(const GAS v4u*)(P + (size_t)g0 * NP + PC_XBC + c0);
      *(LAS f32x4*)(buf + t * 8) = (f32x4){bflo(w.x), bfhi(w.x), bflo(w.y), bfhi(w.y)}; *(LAS f32x4*)(buf + t * 8 + 4) = (f32x4){bflo(w.z), bfhi(w.z), bflo(w.w), bfhi(w.w)};
      if (t < 4) { const int g1 = row0 + 62 + t; v4u w1 = (v4u){0u, 0u, 0u, 0u}; if (g1 >= lo && g1 < hi) w1 = *(const GAS v4u*)(P + (size_t)g1 * NP + PC_XBC + c0);
          *(LAS f32x4*)(buf + (64 + t) * 8) = (f32x4){bflo(w1.x), bfhi(w1.x), bflo(w1.y), bfhi(w1.y)}; *(LAS f32x4*)(buf + (64 + t) * 8 + 4) = (f32x4){bflo(w1.z), bfhi(w1.z), bflo(w1.w), bfhi(w1.w)}; } }
    LDS_WAIT(); asm volatile("" ::: "memory");
    f32x4 a0 = *(const f32x4*)(cb_ + c0), a1 = *(const f32x4*)(cb_ + c0 + 4);
#pragma unroll
    for (int j = 0; j < 5; ++j) { const f32x4 w0 = *(const f32x4*)(cw + j * 1280 + c0), w1 = *(const f32x4*)(cw + j * 1280 + c0 + 4);
        a0 += w0 * *(const LAS f32x4*)(buf + (t + j) * 8); a1 += w1 * *(const LAS f32x4*)(buf + (t + j) * 8 + 4); }
    float o[8];
#pragma unroll
    for (int i = 0; i < 4; ++i) { o[i] = silu_(a0[i]); o[4 + i] = silu_(a1[i]); }
    v4u w; w.x = pk2(o[0], o[1]); w.y = pk2(o[2], o[3]); w.z = pk2(o[4], o[5]); w.w = pk2(o[6], o[7]);
    if (c0 >= 768) { bf16* nat = (c0 < 1024) ? (bf16*)(F.ws + WS_BN) + (size_t)(row0 + t) * 256 + (c0 - 768) : (bf16*)(F.ws + WS_CN) + (size_t)(row0 + t) * 256 + (c0 - 1024); *(GAS v4u*)nat = w; }
    if (c0 < 1024) { bf16* tr = (c0 < 768) ? (bf16*)(F.ws + WS_XT) + ((size_t)(k * 12 + (c0 >> 6)) * 64 + (c0 & 63)) * 64 + t : (bf16*)(F.ws + WS_BT) + ((size_t)k * 256 + (c0 - 768)) * 64 + t;
#pragma unroll
        for (int i = 0; i < 8; ++i) tr[(size_t)i * 64] = (bf16)f2bf(o[i]); }
    LDS_WAIT(); asm volatile("" ::: "memory");
}
#ifndef ST_HPI
#define ST_HPI 2
#endif
#ifndef CARRY_UNR
#define CARRY_UNR 13
#endif
__device__ __forceinline__ void ssd_states(Frame& F, KArgs a, int l) {
    const int gw = F.vcu * NWAVES + F.wave, NGW = F.G * NWAVES, lane = F.lane, r = lane & 15, q = lane >> 4;
    LAS float* wb = (LAS float*)(F.lds + RING_OFF + F.wave * 2048);
    const float* DT = (const float*)(F.ws + WS_DT); const bf16* XT = (const bf16*)(F.ws + WS_XT); const bf16* BT = (const bf16*)(F.ws + WS_BT);
    bf16* ST = (bf16*)(F.ws + WS_STATES); float* CHD = (float*)(F.ws + WS_CHD); const float* alog = AIN(I_ALOG) + l * 24;
    for (int item = gw; item < (MR / 64) * 4 * (6 / ST_HPI); item += NGW) {
        const int hp = item % (6 / ST_HPI), i4 = item / (6 / ST_HPI), k = i4 >> 2, g = (i4 >> 1) & 1, d = i4 & 1, row0 = 64 * k;
#pragma unroll
        for (int hh = 0; hh < ST_HPI; ++hh) { const int dh = d * 12 + g * 6 + hp * ST_HPI + hh; const float dt = DT[(size_t)(row0 + lane) * 24 + dh]; const float A = -__expf(alog[dh]);
            const float cum = scan64(A * dt, d, lane); const float tot = __int_as_float(d ? __builtin_amdgcn_readlane(__float_as_int(cum), 0) : __builtin_amdgcn_readlane(__float_as_int(cum), 63));
            wb[hh * 64 + lane] = dt * __expf(tot - cum);
            if (lane == 0) CHD[k * 24 + dh] = __expf(tot); }
        LDS_WAIT(); asm volatile("" ::: "memory");
        for (int hh = 0; hh < ST_HPI; ++hh) {
            const int h = g * 6 + hp * ST_HPI + hh, dh = d * 12 + h;
            bf16x8 af[4][2];
#pragma unroll
            for (int ks = 0; ks < 2; ++ks) { const f32x4 w0 = *(const LAS f32x4*)(wb + hh * 64 + 32 * ks + 8 * q), w1 = *(const LAS f32x4*)(wb + hh * 64 + 32 * ks + 8 * q + 4);
#pragma unroll
                for (int pt = 0; pt < 4; ++pt) { const v4u x = *(const GAS v4u*)(XT + ((size_t)(k * 12 + h) * 64 + 16 * pt + r) * 64 + 32 * ks + 8 * q);
                    v4u y; y.x = pk2(bflo(x.x) * w0.x, bfhi(x.x) * w0.y); y.y = pk2(bflo(x.y) * w0.z, bfhi(x.y) * w0.w); y.z = pk2(bflo(x.z) * w1.x, bfhi(x.z) * w1.y); y.w = pk2(bflo(x.w) * w1.z, bfhi(x.w) * w1.w);
                    af[pt][ks] = __builtin_bit_cast(bf16x8, y); } }
#pragma unroll
            for (int half = 0; half < 2; ++half) {
                f32x4 acc[4][4];
#pragma unroll
                for (int pt = 0; pt < 4; ++pt)
#pragma unroll
                    for (int nt = 0; nt < 4; ++nt) acc[pt][nt] = (f32x4){0.f, 0.f, 0.f, 0.f};
#pragma unroll
                for (int ks = 0; ks < 2; ++ks)
#pragma unroll
                    for (int nt = 0; nt < 4; ++nt) { const bf16x8 bv = ldg8(BT + ((size_t)(k * 2 + g) * 128 + 64 * half + 16 * nt + r) * 64 + 32 * ks + 8 * q);
#pragma unroll
                        for (int pt = 0; pt < 4; ++pt) acc[pt][nt] = __builtin_amdgcn_mfma_f32_16x16x32_bf16(af[pt][ks], bv, acc[pt][nt], 0, 0, 0); }
#pragma unroll
                for (int pt = 0; pt < 4; ++pt)
#pragma unroll
                    for (int nt = 0; nt < 4; ++nt)
#pragma unroll
                        for (int rg = 0; rg < 4; ++rg) ST[((size_t)(k * 24 + dh) * 64 + 16 * pt + 4 * q + rg) * 128 + 64 * half + 16 * nt + r] = (bf16)f2bf(acc[pt][nt][rg]);
            }
        }
        LDS_WAIT(); asm volatile("" ::: "memory");
    }
}
__device__ __forceinline__ void ssd_carry(Frame& F) {
    const bf16* ST = (const bf16*)(F.ws + WS_STATES); const float* CHD = (const float*)(F.ws + WS_CHD); bf16* SB = (bf16*)(F.ws + WS_SINB);
    for (int idx = F.vcu * 512 + F.tid; idx < 24 * 64 * 32; idx += F.G * 512) {
        const int dh = idx >> 11, rem = idx & 2047, d = dh / 12; const size_t eo = (size_t)(rem >> 5) * 128 + (rem & 31) * 4;
        f32x4 S = {0.f, 0.f, 0.f, 0.f};
        for (int j = 0; j < MR / 64; j += CARRY_UNR) {
            f32x4 st[CARRY_UNR]; float dc[CARRY_UNR]; size_t off[CARRY_UNR];
#pragma unroll
            for (int i = 0; i < CARRY_UNR; ++i) { const int k = ssd_chunk_of(d, j + i); off[i] = (size_t)(k * 24 + dh) * 8192 + eo; const v2u sw = *(const GAS v2u*)(ST + off[i]); st[i] = (f32x4){bflo(sw.x), bfhi(sw.x), bflo(sw.y), bfhi(sw.y)}; dc[i] = CHD[k * 24 + dh]; }
#pragma unroll
            for (int i = 0; i < CARRY_UNR; ++i) { v2u w; w.x = pk2(S.x, S.y); w.y = pk2(S.z, S.w); *(GAS v2u*)(SB + off[i]) = w; S = S * dc[i] + st[i]; }
        }
    }
}
__device__ __forceinline__ void ssd_outputs(Frame& F, KArgs a, int l) {
    const int gw = F.vcu * NWAVES + F.wave, NGW = F.G * NWAVES, lane = F.lane, r = lane & 15, q = lane >> 4;
    LAS bf16* Mb = (LAS bf16*)(F.lds + RING_OFF + F.wave * 10240);
    LAS float* cumb = (LAS float*)(F.lds + RING_OFF + F.wave * 10240 + 8192);
    const float* DT = (const float*)(F.ws + WS_DT); const bf16* XT = (const bf16*)(F.ws + WS_XT); const bf16* BN = (const bf16*)(F.ws + WS_BN); const bf16* CN = (const bf16*)(F.ws + WS_CN);
    const bf16* SB = (const bf16*)(F.ws + WS_SINB); bf16* YS = (bf16*)(F.ws + WS_YS); const float* alog = AIN(I_ALOG) + l * 24;
    for (int base = 0, rnd = 0; base < (MR / 64) * 12; base += NGW, ++rnd) {
        const int item = base + ((rnd & 1) ? NGW - 1 - gw : gw); if (item >= (MR / 64) * 12) continue;
        const int hp = item % 3, i4 = item / 3, k = i4 >> 2, g = (i4 >> 1) & 1, d = i4 & 1, row0 = 64 * k;
        f32x4 G[4][4];
#pragma unroll
        for (int it = 0; it < 4; ++it)
#pragma unroll
            for (int st = 0; st < 4; ++st) G[it][st] = (f32x4){0.f, 0.f, 0.f, 0.f};
#pragma unroll 1
        for (int ks = 0; ks < 4; ++ks) { bf16x8 cf[4], bfr[4];
#pragma unroll
            for (int i = 0; i < 4; ++i) { cf[i] = ldg8(CN + (size_t)(row0 + 16 * i + r) * 256 + g * 128 + 32 * ks + 8 * q); bfr[i] = ldg8(BN + (size_t)(row0 + 16 * i + r) * 256 + g * 128 + 32 * ks + 8 * q); }
#pragma unroll
            for (int it = 0; it < 4; ++it)
#pragma unroll
                for (int st = 0; st < 4; ++st) G[it][st] = __builtin_amdgcn_mfma_f32_16x16x32_bf16(cf[it], bfr[st], G[it][st], 0, 0, 0); }
        for (int hh = 2 * hp; hh < 2 * hp + 2; ++hh) {
            const int h = g * 6 + hh, dh = d * 12 + h; const float dskip = AIN(I_SSDD)[l * 12 + h];
            { const float dt = DT[(size_t)(row0 + lane) * 24 + dh]; const float A = -__expf(alog[dh]); const float cum = scan64(A * dt, d, lane);
              cumb[lane] = cum; cumb[64 + lane] = __expf(cum); cumb[128 + lane] = dt; }
            LDS_WAIT(); asm volatile("" ::: "memory");
            { float cs[4], ds[4];
#pragma unroll
              for (int st = 0; st < 4; ++st) { cs[st] = cumb[16 * st + r]; ds[st] = cumb[128 + 16 * st + r]; }
#pragma unroll
              for (int it = 0; it < 4; ++it)
#pragma unroll
                  for (int rg = 0; rg < 4; ++rg) { const int i = 16 * it + 4 * q + rg; const float ci = cumb[i];
#pragma unroll
                      for (int st = 0; st < 4; ++st) { const int s = 16 * st + r; const bool on = d ? (s >= i) : (s <= i);
                          float v = on ? G[it][st][rg] * __expf(ci - cs[st]) * ds[st] : 0.f; if (s == i && d == 0) v += dskip; Mb[i * 64 + s] = (bf16)f2bf(v); } } }
            f32x4 acc[4][4];
#pragma unroll
            for (int it = 0; it < 4; ++it)
#pragma unroll
                for (int pt = 0; pt < 4; ++pt) acc[it][pt] = (f32x4){0.f, 0.f, 0.f, 0.f};
#pragma unroll 1
            for (int ks = 0; ks < 4; ++ks) { bf16x8 cf[4], sf[4];
#pragma unroll
                for (int i = 0; i < 4; ++i) { cf[i] = ldg8(CN + (size_t)(row0 + 16 * i + r) * 256 + g * 128 + 32 * ks + 8 * q); sf[i] = ldg8(SB + ((size_t)(k * 24 + dh) * 64 + 16 * i + r) * 128 + 32 * ks + 8 * q); }
#pragma unroll
                for (int it = 0; it < 4; ++it)
#pragma unroll
                    for (int pt = 0; pt < 4; ++pt) acc[it][pt] = __builtin_amdgcn_mfma_f32_16x16x32_bf16(cf[it], sf[pt], acc[it][pt], 0, 0, 0); }
#pragma unroll
            for (int it = 0; it < 4; ++it)
#pragma unroll
                for (int rg = 0; rg < 4; ++rg) { const float e = cumb[64 + 16 * it + 4 * q + rg];
#pragma unroll
                    for (int pt = 0; pt < 4; ++pt) acc[it][pt][rg] *= e; }
            LDS_WAIT(); asm volatile("" ::: "memory");
#pragma unroll 1
            for (int ks = 0; ks < 2; ++ks) { bf16x8 mf[4], xf[4];
#pragma unroll
                for (int i = 0; i < 4; ++i) { mf[i] = *(const LAS bf16x8*)(Mb + (16 * i + r) * 64 + 32 * ks + 8 * q); xf[i] = ldg8(XT + ((size_t)(k * 12 + h) * 64 + 16 * i + r) * 64 + 32 * ks + 8 * q); }
#pragma unroll
                for (int it = 0; it < 4; ++it)
#pragma unroll
                    for (int pt = 0; pt < 4; ++pt) acc[it][pt] = __builtin_amdgcn_mfma_f32_16x16x32_bf16(mf[it], xf[pt], acc[it][pt], 0, 0, 0); }
#pragma unroll
            for (int it = 0; it < 4; ++it)
#pragma unroll
                for (int pt = 0; pt < 4; ++pt)
#pragma unroll
                    for (int rg = 0; rg < 4; ++rg) YS[((size_t)d * MR + row0 + 16 * it + 4 * q + rg) * 768 + h * 64 + 16 * pt + r] = (bf16)f2bf(acc[it][pt][rg]);
            LDS_WAIT(); asm volatile("" ::: "memory");
        }
    }
}
#ifndef SWA_EARLY
#define SWA_EARLY 304
#endif
#ifndef PREPDUP
#define PREPDUP 0
#endif
#ifndef PREP_REV
#define PREP_REV 0
#endif
__device__ __forceinline__ void prep_phase(Frame& F, KArgs a, int l) {
    const bf16* P = (const bf16*)(F.ws + WS_P);
    { const float* cw = AIN(I_CONVW) + (size_t)l * 5 * 1280; const float* cb = AIN(I_CONVB) + (size_t)l * 1280;
      LAS float* cbuf = (LAS float*)(F.lds + RING_OFF + F.wave * 4096);
      for (int rep_ = 0; rep_ <= (PREPDUP & 1); ++rep_)
      for (int it = F.vcu * NWAVES + F.wave; it < (MR / 64) * 160; it += F.G * NWAVES) conv_wave_item(F, cw, cb, it / 160, 8 * (it % 160), cbuf);
      __syncthreads(); }
    { const float* DTR = (const float*)(F.ws + WS_DTRAW); float* DT = (float*)(F.ws + WS_DT); const float* dtb = AIN(I_DTB) + l * 24;
      for (int i = F.vcu * 512 + F.tid; i < MR * 24; i += F.G * 512) { const int m = i / 24, j = i % 24; const float x = DTR[m * 32 + j] + dtb[j];
          DT[i] = fmaxf(x, 0.f) + __logf(1.0f + __expf(-fabsf(x))); } }
    { const int gw = F.vcu * NWAVES + F.wave, NGW = F.G * NWAVES, lane = F.lane, j8 = lane & 7;
      float inv[8];
#pragma unroll
      for (int j = 0; j < 8; ++j) inv[j] = __builtin_amdgcn_exp2f(-(float)(((j8 & 1) * 8 + j)) * (13.287712379549449f / 16.0f));
      bf16* QS = (bf16*)(F.ws + WS_QS); bf16* QG = (bf16*)(F.ws + WS_QG); bf16* KS = (bf16*)(F.ws + WS_KS); bf16* KG = (bf16*)(F.ws + WS_KG);
      const float* gsw = AIN(I_SWAG) + l * 128; const float* ggl = AIN(I_GLBG) + l * 128;
      for (int rep_ = 0; rep_ <= ((PREPDUP >> 1) & 1); ++rep_)
      for (int it = gw; it < MR * 3; it += NGW) {
          const int m = PREP_REV ? (MR - 1 - it / 3) : it / 3, part = it % 3; const bool act = part < 2 || lane < 32; const bool glb = part == 1 || (part == 2 && lane >= 16); const bool isk = part == 2;
          const int hl = isk ? ((lane >> 3) & 1) : (lane >> 3);
          const int col = (glb ? (isk ? PC_GK : PC_GQ) : (isk ? PC_SK : PC_SQ)) + 64 * hl + 8 * j8;
          v4u w = (v4u){0u, 0u, 0u, 0u}; if (act) w = *(const GAS v4u*)(P + (size_t)m * NP + col);
          float x[8] = {bflo(w.x), bfhi(w.x), bflo(w.y), bfhi(w.y), bflo(w.z), bfhi(w.z), bflo(w.w), bfhi(w.w)};
          float ss = 0.f;
#pragma unroll
          for (int j = 0; j < 8; ++j) ss += x[j] * x[j];
          ss += bperm(ss, lane ^ 1); ss += bperm(ss, lane ^ 2); ss += bperm(ss, lane ^ 4);
          const float rs = 1.0f / sqrtf(ss * (1.0f / 64.0f) + 1e-6f);
          const float* gp = (glb ? ggl : gsw) + (isk ? 64 : 0) + 8 * j8; const f32x4 g0 = *(const f32x4*)gp, g1 = *(const f32x4*)(gp + 4);
          const float gg[8] = {g0.x, g0.y, g0.z, g0.w, g1.x, g1.y, g1.z, g1.w};
#pragma unroll
          for (int j = 0; j < 8; ++j) x[j] = x[j] * rs * gg[j];
          if (m < SEQ) { const float pos = ((j8 & 3) < 2) ? (float)(m >> 6) : (float)(m & 63); const bool lo = j8 < 4;
#pragma unroll
              for (int j = 0; j < 8; ++j) { float sn, cs; sincos_hw(pos * inv[j], sn, cs); const float other = bperm(x[j], lane ^ 4); x[j] = lo ? (x[j] * cs - other * sn) : (other * sn + x[j] * cs); } }
          if (!isk) {
#pragma unroll
              for (int j = 0; j < 8; ++j) x[j] *= QSCALE; }
          v4u o; o.x = pk2(x[0], x[1]); o.y = pk2(x[2], x[3]); o.z = pk2(x[4], x[5]); o.w = pk2(x[6], x[7]);
          bf16* dst = isk ? ((glb ? KG : KS) + (size_t)m * 128 + 64 * hl + 8 * j8) : ((glb ? QG : QS) + (size_t)m * 512 + 64 * hl + 8 * j8);
          if (act) *(GAS v4u*)dst = o;
      } }
}
#ifndef ATT_SKIPCTX
#define ATT_SKIPCTX 1
#endif
__device__ __forceinline__ void attn_all(Frame& F, KArgs a, int l) {
    typedef attn_body::bf16 ab;
    char* shm = (char*)(unsigned char*)(F.lds + RING_OFF);
#ifndef NO_MODE0
    for (int u = F.vcu; u < ((ATT_SKIPCTX && l == DEPTH - 1) ? 512 : 528); u += F.G) {
        unsigned long long w_ = (unsigned long long)F.ws; asm volatile("" : "+s"(w_)); unsigned char* ws = (unsigned char*)(GAS unsigned char*)w_;
        if (u < 512) { const int kvh = u >> 8, g = (u >> 6) & 3, qb = u & 63, head = kvh * 4 + g; const size_t qo = (size_t)(qb * 256) * 512 + head * 64, oo = (size_t)(qb * 256) * YPITCH + YC_D + head * 64;
            attn_body::attn_unit<8, 0>((const ab*)(ws + WS_QG) + qo, (const ab*)(ws + WS_KG) + kvh * 64, (const ab*)(ws + WS_P) + PC_GV + kvh * 64, (ab*)(ws + WS_YALL) + oo, MR / 64, 0, 0, 0, 0, 0.f, false, shm); }
        else { const int ty = (u - 512) >> 3, head = (u - 512) & 7, kvh = head >> 2; const size_t qo = (size_t)SEQ * 512 + head * 64, oo = (size_t)SEQ * YPITCH + (ty ? YC_C : YC_D) + head * 64;
            const float s2 = ty ? (AIN(I_SINK) + l * 8)[head] * LOG2E : 0.f;
            attn_body::attn_unit<8, 0>((const ab*)(ws + (ty ? WS_QS : WS_QG)) + qo, (const ab*)(ws + (ty ? WS_KS : WS_KG)) + (size_t)SEQ * 128 + kvh * 64, (const ab*)(ws + WS_P) + (ty ? PC_SV : PC_GV) + (size_t)SEQ * NP + kvh * 64,
                                       (ab*)(ws + WS_YALL) + oo, 4, 0, 0, 0, 0, s2, ty != 0, shm); }
    }
#endif
}
__device__ __forceinline__ void attn_swa(Frame& F, KArgs a, int l, int ubeg, int uend, int bfirst, int nb) {
    typedef attn_body::bf16 ab;
    char* shm = (char*)(unsigned char*)(F.lds + RING_OFF);
    if (F.vcu < bfirst || F.vcu >= bfirst + nb) return;
    for (int u = ubeg + F.vcu - bfirst; u < uend; u += nb) {
        unsigned long long w_ = (unsigned long long)F.ws; asm volatile("" : "+s"(w_)); unsigned char* ws = (unsigned char*)(GAS unsigned char*)w_;
        const int head = u >> 6, qb = u & 63, kvh = head >> 2, q0 = qb * 256; const int wlo = q0 - 128 < 0 ? 0 : q0 - 128, whi = q0 + 384 > SEQ ? SEQ : q0 + 384; const size_t qo = (size_t)q0 * 512 + head * 64, oo = (size_t)q0 * YPITCH + YC_C + head * 64;
        attn_body::attn_unit<8, 1>((const ab*)(ws + WS_QS) + qo, (const ab*)(ws + WS_KS) + kvh * 64, (const ab*)(ws + WS_P) + PC_SV + kvh * 64, (ab*)(ws + WS_YALL) + oo, 4 + (whi - wlo) / 64, 4, SEQ, wlo, q0, (AIN(I_SINK) + l * 8)[head] * LOG2E, true, shm);
    }
}
#ifndef MIXDUP
#define MIXDUP 0
#endif
__device__ __forceinline__ void mixers_phase(Frame& F0, KArgs a, int l) {
    for (int rep_ = 0; rep_ <= ((MIXDUP >> 0) & 1); ++rep_) { Frame F = fresh(F0); attn_all(F, a, l); __syncthreads(); }
    { Frame F = fresh(F0); attn_swa(F, a, l, SWA_EARLY, 512, 0, F.G); __syncthreads(); }
#if 0
    for (int rep_ = 0; rep_ <= ((MIXDUP >> 1) & 1); ++rep_) { Frame F = fresh(F0); for (int it = F.vcu; it < 256; it += F.G) attn_simple_item(F, a, l, 1, it >> 7, it & 127); __syncthreads(); }
#endif
    for (int rep_ = 0; rep_ <= ((MIXDUP >> 2) & 1); ++rep_) { Frame F = fresh(F0); s5_pass<true>(F, a, l); __syncthreads(); }
    for (int rep_ = 0; rep_ <= ((MIXDUP >> 3) & 1); ++rep_) { Frame F = fresh(F0); ssd_outputs(F, a, l); __syncthreads(); }
}
__device__ __forceinline__ void post_phase(Frame& F, KArgs a, int l) {
    const int gw = F.vcu * NWAVES + F.wave, NGW = F.G * NWAVES;
    const bf16* P = (const bf16*)(F.ws + WS_P); const bf16* YS = (const bf16*)(F.ws + WS_YS);
    bf16* YA = (bf16*)(F.ws + WS_YALL); const float* ng = AIN(I_SSDNG) + l * 768;
    for (int m = gw; m < MR; m += NGW) {
        float y[12]; float ss = 0.f;
#pragma unroll
        for (int j = 0; j < 3; ++j) { const int c = 4 * F.lane + 256 * j;
            const v2u yfw = *(const GAS v2u*)(YS + (size_t)m * 768 + c), ybw = *(const GAS v2u*)(YS + (size_t)(MR + m) * 768 + c); const f32x4 yf = {bflo(yfw.x), bfhi(yfw.x), bflo(yfw.y), bfhi(yfw.y)}, yb = {bflo(ybw.x), bfhi(ybw.x), bflo(ybw.y), bfhi(ybw.y)};
            const v2u zw = *(const GAS v2u*)(P + (size_t)m * NP + PC_Z + c);
            const float z[4] = {bflo(zw.x), bfhi(zw.x), bflo(zw.y), bfhi(zw.y)};
#pragma unroll
            for (int i = 0; i < 4; ++i) { const float t = (yf[i] + yb[i]) * silu_(z[i]); y[4 * j + i] = t; ss += t * t; } }
        const float rstd = 1.0f / sqrtf(wave_sum(ss, F.lane) * (1.0f / 768.0f) + 1e-6f);
#pragma unroll
        for (int j = 0; j < 3; ++j) { const int c = 4 * F.lane + 256 * j; const f32x4 gg = *(const f32x4*)(ng + c);
            v2u w; w.x = pk2(y[4 * j] * rstd * gg.x, y[4 * j + 1] * rstd * gg.y); w.y = pk2(y[4 * j + 2] * rstd * gg.z, y[4 * j + 3] * rstd * gg.w);
            *(GAS v2u*)(YA + (size_t)m * YPITCH + c) = w; }
    }
    const bf16* YBF = (const bf16*)(F.ws + WS_YBF); bf16* YBP = (bf16*)(F.ws + WS_YBP); const float* d5 = AIN(I_S5D) + l * 512;
    for (int i = F.vcu * 512 + F.tid; i < MR * 128; i += F.G * 512) {
        const int m = i >> 7, c = (i & 127) * 4;
        const v2u y0w = *(const GAS v2u*)(YBF + (size_t)m * 512 + c), y1w = *(const GAS v2u*)(YBF + (size_t)(MR + m) * 512 + c); const f32x4 y0 = {bflo(y0w.x), bfhi(y0w.x), bflo(y0w.y), bfhi(y0w.y)}, y1 = {bflo(y1w.x), bfhi(y1w.x), bflo(y1w.y), bfhi(y1w.y)}, dd = *(const f32x4*)(d5 + c);
        const v2u uw = *(const GAS v2u*)(P + (size_t)m * NP + PC_U + c); const float u[4] = {bflo(uw.x), bfhi(uw.x), bflo(uw.y), bfhi(uw.y)}; float r[4];
#pragma unroll
        for (int q = 0; q < 4; ++q) { const float x = y0[q] + y1[q] + dd[q] * u[q]; const float t = 0.7978845608028654f * (x + 0.044715f * x * x * x);
            const float th = 1.0f - 2.0f * __builtin_amdgcn_rcpf(1.0f + __builtin_amdgcn_exp2f(2.0f * LOG2E * t));
            r[q] = 0.5f * x * (1.0f + th); }
        v2u w; w.x = pk2(r[0], r[1]); w.y = pk2(r[2], r[3]); *(GAS v2u*)(YBP + (size_t)m * 512 + c) = w;
    }
}
#ifndef MK_PER_PHASE
#define MK_PER_PHASE 0
#endif
#ifndef REV_RES
#define REV_RES 1
#endif
#ifndef WGM_FFI
#define WGM_FFI 2
#endif
#ifndef WGM_WIN
#define WGM_WIN 2
#endif
#ifndef WGM_RES
#define WGM_RES 2
#endif
#ifndef WGM_MRG
#define WGM_MRG 2
#endif
constexpr int PH_PER_LAYER = 16, NPHASE = 2 + DEPTH * PH_PER_LAYER;
#ifndef GPA
#define GPA true
#endif
#ifndef GPS
#define GPS true
#endif
#ifndef GPAR
#define GPAR true
#endif
constexpr bool GP_ALIGN = GPA, GP_SP2 = GPS, GP_ALIGN_RESID = GPAR;
__global__ void __launch_bounds__(NWAVES * 64, 2) trunk_fwd(Args args) {
    extern __shared__ __attribute__((aligned(16))) unsigned char lds[];
    KArgs KA = (KArgs)__builtin_amdgcn_kernarg_segment_ptr();
    Frame F;
    F.lds = (LAS unsigned char*)lds;
    F.MISC = (volatile LAS unsigned*)(F.lds + MISC_OFF);
    F.tid = threadIdx.x; F.lane = F.tid & 63; F.wave = __builtin_amdgcn_readfirstlane(F.tid >> 6);
    F.G = gridDim.x; { const int bx = blockIdx.x; F.vcu = (F.G % 8 == 0) ? (bx % 8) * (F.G / 8) + bx / 8 : bx; }
    F.ws = (unsigned char*)(GAS unsigned char*)args.ws; F.ctl = (gu32*)(args.ws + WS_CTL);
    for (int u = F.tid; u < (LDS_BYTES - LDSCTL_OFF) / 4; u += NWAVES * 64) ((LAS unsigned*)(F.lds + LDSCTL_OFF))[u] = 0u;
    __syncthreads();
    XcdBarrier bar; bar.bar = (unsigned*)(F.ctl + CW_BAR); bar.x = 0; bar.st = nullptr;
    if (!MK_PER_PHASE) bar = xcd_barrier_post((unsigned*)(F.ctl + CW_BAR), F.MISC + 8);
    const int lo = args.ph_lo, hi = args.ph_hi;
#ifndef ONLY
#define ONLY -1
#endif
#define KON(i) (ONLY < 0 || ONLY == (i))
#ifndef MERGE_SEG
#define MERGE_SEG 1
#endif
#ifndef MERGE_SEG_LAST
#define MERGE_SEG_LAST 0
#endif
#ifndef DUPMASK
#define DUPMASK 0ull
#endif
#define DUPK(i) ((int)(((unsigned long long)(DUPMASK) >> (i)) & 1ull))
#define IN(k) (lo <= (k) && (k) < hi)
#define GEMM_PTRS() FRESH(); unsigned char* ws = Fp.ws; float* X = (float*)(ws + WS_X); bf16* H = (bf16*)(ws + WS_H); bf16* HID = (bf16*)(ws + WS_HID); bf16* P = (bf16*)(ws + WS_P); const bf16* WL = (const bf16*)(ws + WS_W) + (size_t)lp * WL_SIZE; \
    const float* modl = (const float*)(ws + WS_MOD) + (size_t)(lp * 2 + 0) * NMODV; const float* modc = (const float*)(ws + WS_MOD) + (size_t)(lp * 2 + 1) * NMODV; (void)X; (void)H; (void)HID; (void)P; (void)WL; (void)modl; (void)modc;
#define FRESH() Frame Fp = fresh(F); int lp = l; asm volatile("" : "+s"(lp));
#define SEAM(k) do { if (!MK_PER_PHASE && (k) + 1 < hi) xcd_barrier(bar); } while (0)
    PG8_LAS unsigned char* ring = (PG8_LAS unsigned char*)(F.lds + RING_OFF);

    if (KON(100) && IN(0)) { for (int rep_ = 0; rep_ <= DUPK(40); ++rep_) { if (rep_) xcd_barrier(bar); p0_prologue(F, KA); } SEAM(0); }
    if (KON(101) && IN(1)) { p1_modfinal(F, KA); SEAM(1); }
    for (int st = 0; st < 2 * DEPTH; ++st) {
        const int l = st >> 1, f = st & 1; const int pb = 2 + PH_PER_LAYER * l;
        if (f) {
            if (KON(3) && IN(pb + 3)) { FRESH(); norm_phase(Fp, KA, lp, 1, DFF / 512); SEAM(pb + 3); }
            if (KON(4) && IN(pb + 4)) { for (int rep_ = 0; rep_ <= DUPK(4); ++rep_) { if (rep_) xcd_barrier(bar); { GEMM_PTRS(); pg8::Gemm g{H, WL + WL_WIN, MR, NP, DM, DM}; pg8::StaticOrder S; S.init(MR, NP, Fp.G, (int)blockIdx.x, WGM_WIN); pg8::EpiWin E{P, NP, PC_GATE / 256, PC_GATE};
                pg8::gemm_phase<pg8::EpiWin, pg8::StaticOrder, GP_ALIGN, GP_SP2>(ring, g, S, E);
                if (HIDE_CONVERT) { convert_idle(Fp, KA, (int)blockIdx.x, (MR / 256) * (NP / 256) % Fp.G, lp, IT_GA + IT_GB, IT_GC + (lp == DEPTH - 1 ? IT_GD : IT_GD / 2)); }    dt_gemm(Fp, lp, (int)blockIdx.x, (MR / 256) * (NP / 256) % Fp.G); } } SEAM(pb + 4); }
            if (KON(5) && IN(pb + 5)) { for (int rep_ = 0; rep_ <= DUPK(5); ++rep_) { if (rep_) xcd_barrier(bar); { FRESH(); prep_phase(Fp, KA, lp); __syncthreads(); for (int r2_ = 0; r2_ <= ((PREPDUP >> 2) & 1); ++r2_) s5_pass<false>(Fp, KA, lp); } } SEAM(pb + 5); }
            if (KON(6) && IN(pb + 6)) { for (int rep_ = 0; rep_ <= DUPK(6); ++rep_) { if (rep_) xcd_barrier(bar); { { FRESH(); ssd_states(Fp, KA, lp); } } } SEAM(pb + 6); }
            if (KON(7) && IN(pb + 7)) { for (int rep_ = 0; rep_ <= DUPK(7); ++rep_) { if (rep_) xcd_barrier(bar); { { FRESH(); s5_carry(Fp, KA, lp, 96 * NWAVES); } { FRESH(); ssd_carry(Fp); } if (SWA_EARLY > 0) { FRESH(); attn_swa(Fp, KA, lp, 0, SWA_EARLY, 104, Fp.G - 104); } } } SEAM(pb + 7); }
            if (KON(8) && IN(pb + 8)) { for (int rep_ = 0; rep_ <= DUPK(8); ++rep_) { if (rep_) xcd_barrier(bar); { FRESH(); mixers_phase(Fp, KA, lp); } } SEAM(pb + 8); }
            if (KON(9) && IN(pb + 9)) { for (int rep_ = 0; rep_ <= DUPK(9); ++rep_) { if (rep_) xcd_barrier(bar); { FRESH(); post_phase(Fp, KA, lp); } } SEAM(pb + 9); }
            if (KON(10) && IN(pb + 10)) { for (int rep_ = 0; rep_ <= DUPK(10); ++rep_) { if (rep_) xcd_barrier(bar); { GEMM_PTRS(); const int Mq = (lp == DEPTH - 1) ? SEQ : MR; pg8::Gemm g{(const bf16*)(ws + WS_YBP), WL + WL_GLU, Mq, 1024, 512, 512}; pg8::StaticOrder S; S.init(Mq, 1024, Fp.G, (int)blockIdx.x);
                pg8::EpiGated<1> E{(bf16*)(ws + WS_YALL) + YC_B, YPITCH, ((const float*)(const GAS float*)KA->in[I_GLUB]) + (size_t)lp * 1024, 512};
                pg8::gemm_phase<pg8::EpiGated<1>, pg8::StaticOrder, GP_ALIGN, GP_SP2>(ring, g, S, E); } } SEAM(pb + 10); }
            if (KON(11) && IN(pb + 11)) { for (int rep_ = 0; rep_ <= DUPK(11); ++rep_) { if (rep_) xcd_barrier(bar); { GEMM_PTRS(); const int Mq = (MERGE_SEG || lp == DEPTH - 1) ? SEQ : MR;
                if (MERGE_SEG && lp < DEPTH - 1) { pg8::Gemm g2{(const bf16*)(ws + WS_YALL), WL + WL_BRALL, MR, DM, YPITCH, YPITCH}; pg8::SegOrder S2{SEQ / 256, Fp.G, (MERGE_SEG_LAST ? Fp.G - 1 - (int)blockIdx.x : (int)blockIdx.x)}; pg8::EpiMergeSeg E2{P + PC_GATE, NP, (bf16*)(ws + WS_MGC)};
                  pg8::gemm_phase<pg8::EpiMergeSeg, pg8::SegOrder, GP_ALIGN, GP_SP2>(ring, g2, S2, E2); }
                pg8::Gemm g{(const bf16*)(ws + WS_YALL), WL + WL_BRALL, Mq, DM, YPITCH, YPITCH}; pg8::MergeOrder S; S.so.init(Mq, DM, Fp.G, (int)blockIdx.x, WGM_MRG); pg8::EpiMergeR E{P + PC_GATE, NP, (bf16*)(ws + WS_MG)};
                pg8::gemm_phase<pg8::EpiMergeR, pg8::MergeOrder, GP_ALIGN, GP_SP2>(ring, g, S, E);
                if (HIDE_CONVERT && lp < DEPTH - 1) { const int rem = (MR / 256) * (DM / 256) % Fp.G; convert_idle(Fp, KA, (int)blockIdx.x, rem, lp, IT_LAYER - IT_GD / 2, IT_GD / 2); convert_idle(Fp, KA, (int)blockIdx.x, rem, lp + 1, 0, IT_GA / 2); } } } SEAM(pb + 11); }
            if (KON(12) && IN(pb + 12)) { for (int rep_ = 0; rep_ <= DUPK(12); ++rep_) { if (rep_) xcd_barrier(bar); { GEMM_PTRS();
                { pg8::Gemm g{(const bf16*)(ws + WS_MG), WL + WL_OUT, SEQ, DM, DM, DM}; pg8::StaticOrder S; S.init(SEQ, DM, Fp.G, (int)blockIdx.x, WGM_RES, REV_RES); pg8::EpiResid E{X, (rep_ < DUPK(12)) ? (float*)(ws + WS_MGF) : X, X, modl + 5 * DM, modc + 5 * DM, 1.0f, SEQ / 256};
                  pg8::gemm_phase<pg8::EpiResid, pg8::StaticOrder, GP_ALIGN_RESID, GP_SP2>(ring, g, S, E); }
                if (!MERGE_SEG && lp < DEPTH - 1) { pg8::Gemm g{(const bf16*)(ws + WS_MG), WL + WL_OUT, MR, DM, 512, DM}; pg8::SplitKOrder S{SEQ / 256, DM / 256, DM / 512, Fp.G, (int)blockIdx.x}; pg8::EpiPartial E{(float*)(ws + WS_PART), modc + 5 * DM, 1.0f};
                  pg8::gemm_phase<pg8::EpiPartial, pg8::SplitKOrder, GP_ALIGN, GP_SP2>(ring, g, S, E); }
                if (MERGE_SEG && lp < DEPTH - 1) { pg8::Gemm g{(const bf16*)(ws + WS_MGC), WL + WL_OUT, 1024, DM, 512, DM}; pg8::SplitKOrderM S{4, DM / 256, DM / 512, Fp.G, (int)blockIdx.x}; pg8::EpiPartial E{(float*)(ws + WS_PART), modc + 5 * DM, 1.0f};
                  pg8::gemm_phase<pg8::EpiPartial, pg8::SplitKOrderM, GP_ALIGN, GP_SP2>(ring, g, S, E); }
                } } SEAM(pb + 12); }
        }
        const int pf = pb + (f ? 13 : 0); const bool no_ctx = (f == 1 && l == DEPTH - 1);
        if (KON(0) && IN(pf + 0)) { FRESH(); int fp = f; asm volatile("" : "+s"(fp)); norm_phase(Fp, KA, lp, 2 * fp, fp ? (lp < DEPTH - 1 ? (MERGE_SEG ? 16 : DM / 512) : 0) : (lp > 0 ? DFF / 512 : 0)); SEAM(pf + 0); }
        if (KON(1) && IN(pf + 1)) { GEMM_PTRS(); int fp = f; asm volatile("" : "+s"(fp)); const int Mq = no_ctx ? SEQ : MR;
            pg8::Gemm g{H, WL + WL_FFI + (size_t)fp * NFF * DM, Mq, NFF, DM, DM}; pg8::StaticOrder S; S.init(Mq, NFF, Fp.G, (int)blockIdx.x, WGM_FFI); pg8::EpiGated<0> E{HID, DFF, nullptr, 0};
            pg8::gemm_phase<pg8::EpiGated<0>, pg8::StaticOrder, GP_ALIGN, GP_SP2>(ring, g, S, E); SEAM(pf + 1); }
        if (KON(2) && IN(pf + 2)) { GEMM_PTRS(); int fp = f; asm volatile("" : "+s"(fp)); const bf16* Wo = WL + WL_FFO + (size_t)fp * DM * DFF; const int gs = (2 + 6 * fp) * DM;
            { pg8::Gemm g{HID, Wo, SEQ, DM, DFF, DFF}; pg8::StaticOrder S; S.init(SEQ, DM, Fp.G, (int)blockIdx.x, WGM_RES, REV_RES);
              pg8::EpiResid E{X, (fp == 1 && lp == DEPTH - 1) ? (float*)KA->out : X, X, modl + gs, modc + gs, 0.5f, SEQ / 256};
              pg8::gemm_phase<pg8::EpiResid, pg8::StaticOrder, GP_ALIGN_RESID, GP_SP2>(ring, g, S, E); }
            if (!no_ctx) { pg8::Gemm g{HID, Wo, MR, DM, 512, DFF}; pg8::SplitKOrder S{SEQ / 256, DM / 256, DFF / 512, Fp.G, (int)blockIdx.x}; pg8::EpiPartial E{(float*)(ws + WS_PART), modc + gs, 0.5f};
              pg8::gemm_phase<pg8::EpiPartial, pg8::SplitKOrder, GP_ALIGN, GP_SP2>(ring, g, S, E); }
            SEAM(pf + 2); }
    }
#undef IN
#undef SEAM
}

extern "C" void kernel_launch(void* const* d_in, const int* in_sizes, int n_in, void* d_out, int out_size, void* d_ws, size_t ws_size, hipStream_t stream) {
    static int grid = 0;
    if (grid == 0) {
        if (n_in != N_IN || out_size != SEQ * DM || ws_size < WS_END) { fprintf(stderr, "kernel_launch: built for %d inputs, %d outputs, >= %zu bytes of workspace; got n_in %d, out %d, ws %zu; nothing launched\n", N_IN, SEQ * DM, (size_t)WS_END, n_in, out_size, ws_size); grid = -1; return; }
        int dev = 0, cus = 0, per_cu = 0;
        if (hipGetDevice(&dev) != hipSuccess || hipDeviceGetAttribute(&cus, hipDeviceAttributeMultiprocessorCount, dev) != hipSuccess) { fprintf(stderr, "kernel_launch: hipGetDevice / hipDeviceGetAttribute failed\n"); grid = -1; return; }
        if (hipFuncSetAttribute((const void*)trunk_fwd, hipFuncAttributeMaxDynamicSharedMemorySize, LDS_BYTES) != hipSuccess) { fprintf(stderr, "kernel_launch: hipFuncSetAttribute failed\n"); grid = -1; return; }
        if (hipOccupancyMaxActiveBlocksPerMultiprocessor(&per_cu, (const void*)trunk_fwd, NWAVES * 64, LDS_BYTES) != hipSuccess || per_cu < 1)
            fprintf(stderr, "kernel_launch: note: occupancy query reports %d workgroups per CU\n", per_cu);
        (void)hipGetLastError();
        grid = cus;
        if (grid % 8 != 0 || grid < 8) { fprintf(stderr, "kernel_launch: unexpected CU count %d\n", cus); }
    }
    if (grid < 0) return;
    if (hipMemsetAsync((char*)d_ws + WS_CTL, 0, CTL_ZERO_BYTES, stream) != hipSuccess) { fprintf(stderr, "kernel_launch: hipMemsetAsync failed\n"); return; }
    Args a{};
    for (int i = 0; i < N_IN; ++i) a.in[i] = (const float*)d_in[i];
    a.out = (float*)d_out; a.ws = (unsigned char*)d_ws;
#if MK_PER_PHASE
    for (int k = 0; k < NPHASE; ++k) { a.ph_lo = k; a.ph_hi = k + 1; hipLaunchKernelGGL(trunk_fwd, dim3(grid), dim3(NWAVES * 64), LDS_BYTES, stream, a); }
#else
    a.ph_lo = 0; a.ph_hi = NPHASE;
    hipLaunchKernelGGL(trunk_fwd, dim3(grid), dim3(NWAVES * 64), LDS_BYTES, stream, a);
#endif
    const hipError_t le = hipPeekAtLastError();
    if (le != hipSuccess) fprintf(stderr, "kernel_launch: launch failed: %s\n", hipGetErrorName(le));
}
```
